# Optimizing an MI355X kernel written in HIP

```python
import math
import jax, jax.numpy as jnp
from jax import lax
import numpy as np

D_MODEL = 2048
BATCH = 4
SEQ = 8192
DEPTH = 4

CHUNK = 64
N_MIXERS = 3
DN_ALPHA = (2.0 * DEPTH) ** 0.25
DN_BETA = (8.0 * DEPTH) ** -0.25
LN_EPS = 1e-5
POOL_WINDOWS = (2, 4, 8, 16)
POOL_GROUPS = len(POOL_WINDOWS)
POOL_GROUP_DIM = D_MODEL // POOL_GROUPS
POOL_MAX_WINDOW = max(POOL_WINDOWS)
SSM_GROUP_DIM = 16
SSM_GROUPS = D_MODEL // SSM_GROUP_DIM
SSM_STATE = 64
SSM_DT_MIN = 1e-3
SSM_DT_MAX = 1e-1
ATTN_HEADS = 16
ATTN_HEAD_DIM = D_MODEL // ATTN_HEADS
ATTN_LEFT_CHUNKS = 8
ATTN_LEFT = ATTN_LEFT_CHUNKS * CHUNK
ATTN_BAND = (ATTN_LEFT_CHUNKS + 1) * CHUNK
ATTN_MAX_REL = 2 * CHUNK
NEG_INF = -1e30
PEER_N_KEYS = 128
PEER_EXPERTS = PEER_N_KEYS * PEER_N_KEYS
PEER_HEADS = 8
PEER_QUERY_DIM = 256
PEER_HALF = PEER_QUERY_DIM // 2
PEER_TOPK = 16
PEER_TOKEN_BLOCK = 128
PLE_DIM = 256
N_POOL_LAYERS = len(range(0, DEPTH, N_MIXERS))
N_SSM_LAYERS = len(range(1, DEPTH, N_MIXERS))
N_ATTN_LAYERS = len(range(2, DEPTH, N_MIXERS))

kernel_name = 'hybrid_pool_s5_chunkattn_peer_deepnorm'


def layer_norm(x, g, b):
    xf = x.astype(jnp.float32)
    mu = jnp.mean(xf, axis=-1, keepdims=True)
    var = jnp.mean(jnp.square(xf - mu), axis=-1, keepdims=True)
    y = (xf - mu) * lax.rsqrt(var + LN_EPS) * g.astype(jnp.float32) + b.astype(jnp.float32)
    return y.astype(x.dtype)


def pool_mixer(h, w_in, w_group, scale, w_out):
    bsz, seq, _ = h.shape
    u = (h @ w_in).astype(jnp.float32)
    csum = jnp.pad(jnp.cumsum(u, axis=1), ((0, 0), (POOL_MAX_WINDOW, 0), (0, 0)))
    t = jnp.arange(seq, dtype=jnp.float32)
    outs = []
    for g, w in enumerate(POOL_WINDOWS):
        sl = slice(g * POOL_GROUP_DIM, (g + 1) * POOL_GROUP_DIM)
        upper = csum[:, POOL_MAX_WINDOW:, sl]
        lower = csum[:, POOL_MAX_WINDOW - w:POOL_MAX_WINDOW - w + seq, sl]
        count = jnp.minimum(t + 1.0, float(w))[None, :, None]
        outs.append((upper - lower) / count - u[:, :, sl])
    pooled = jnp.stack(outs, axis=2)
    mixed = jnp.einsum('bsgc,gcd->bsgd', pooled, w_group.astype(jnp.float32)).reshape(bsz, seq, D_MODEL)
    mixed = (mixed * scale.astype(jnp.float32)).astype(h.dtype)
    return mixed @ w_out


def _cmul(ar, ai, br, bi):
    return ar * br - ai * bi, ar * bi + ai * br


def _ssm_combine(e1, e2):
    a1r, a1i, b1r, b1i = e1
    a2r, a2i, b2r, b2i = e2
    ar, ai = _cmul(a2r, a2i, a1r, a1i)
    br, bi = _cmul(a2r, a2i, b1r, b1i)
    return ar, ai, br + b2r, bi + b2i


def ssm_mixer(h, w_in, lam_re, lam_im, log_step, b_re, b_im, c_re, c_im, d_skip, w_glu, w_out):
    bsz, seq, _ = h.shape
    n_chunks = seq // CHUNK
    f32 = jnp.float32
    u = (h @ w_in).astype(f32).reshape(bsz, n_chunks, CHUNK, SSM_GROUPS, SSM_GROUP_DIM)
    u = jnp.moveaxis(u, 1, 0)
    lr, li = lam_re.astype(f32), lam_im.astype(f32)
    dt = jnp.exp(log_step.astype(f32))[:, None]
    mag = jnp.exp(dt * lr)
    abar_r, abar_i = mag * jnp.cos(dt * li), mag * jnp.sin(dt * li)
    den = lr * lr + li * li
    k_r = ((abar_r - 1.0) * lr + abar_i * li) / den
    k_i = (abar_i * lr - (abar_r - 1.0) * li) / den
    bb_r, bb_i = _cmul(k_r[..., None], k_i[..., None], b_re.astype(f32), b_im.astype(f32))
    a_r = jnp.broadcast_to(abar_r, (bsz, CHUNK, SSM_GROUPS, SSM_STATE))
    a_i = jnp.broadcast_to(abar_i, (bsz, CHUNK, SSM_GROUPS, SSM_STATE))
    cr, ci = c_re.astype(f32), c_im.astype(f32)
    dd = d_skip.astype(f32).reshape(SSM_GROUPS, SSM_GROUP_DIM)

    def step(state, u_c):
        s_r, s_i = state
        bu_r = jnp.einsum('blgc,gpc->blgp', u_c, bb_r)
        bu_i = jnp.einsum('blgc,gpc->blgp', u_c, bb_i)
        cum_r, cum_i, loc_r, loc_i = lax.associative_scan(_ssm_combine, (a_r, a_i, bu_r, bu_i), axis=1)
        car_r, car_i = _cmul(cum_r, cum_i, s_r[:, None], s_i[:, None])
        hr, hi = loc_r + car_r, loc_i + car_i
        y = jnp.einsum('gcp,blgp->blgc', cr, hr) - jnp.einsum('gcp,blgp->blgc', ci, hi) + dd * u_c
        return (hr[:, -1], hi[:, -1]), y

    init = (jnp.zeros((bsz, SSM_GROUPS, SSM_STATE), f32), jnp.zeros((bsz, SSM_GROUPS, SSM_STATE), f32))
    _, y = lax.scan(step, init, u)
    y = jnp.moveaxis(y, 0, 1).reshape(bsz, seq, D_MODEL)
    g = jax.nn.gelu(y, approximate=False).astype(h.dtype)
    g = g * jax.nn.sigmoid(g @ w_glu)
    return g @ w_out


def chunk_attention(h, w_qkv, rel_bias, w_out):
    bsz, seq, _ = h.shape
    n_chunks = seq // CHUNK
    qkv = (h @ w_qkv).reshape(bsz, seq, 3, ATTN_HEADS, ATTN_HEAD_DIM)
    q = qkv[:, :, 0] * (ATTN_HEAD_DIM ** -0.5)
    k = jnp.pad(qkv[:, :, 1], ((0, 0), (ATTN_LEFT, 0), (0, 0), (0, 0)))
    v = jnp.pad(qkv[:, :, 2], ((0, 0), (ATTN_LEFT, 0), (0, 0), (0, 0)))
    qi = jnp.arange(CHUNK)[:, None]
    kj = jnp.arange(ATTN_BAND)[None, :]
    rel = jnp.clip(qi + ATTN_LEFT - kj, -ATTN_MAX_REL, ATTN_MAX_REL) + ATTN_MAX_REL
    bias = rel_bias.astype(jnp.float32)[:, rel]
    band_offsets = jnp.arange(ATTN_BAND)

    def one_chunk(c):
        start = c * CHUNK
        q_c = lax.dynamic_slice_in_dim(q, start, CHUNK, axis=1)
        k_c = lax.dynamic_slice_in_dim(k, start, ATTN_BAND, axis=1)
        v_c = lax.dynamic_slice_in_dim(v, start, ATTN_BAND, axis=1)
        s = jnp.einsum('bqhd,bkhd->bhqk', q_c, k_c).astype(jnp.float32) + bias
        valid = (start - ATTN_LEFT + band_offsets) >= 0
        s = jnp.where(valid, s, NEG_INF)
        pr = jax.nn.softmax(s, axis=-1).astype(v_c.dtype)
        return jnp.einsum('bhqk,bkhd->bqhd', pr, v_c)

    o = lax.map(one_chunk, jnp.arange(n_chunks))
    o = jnp.moveaxis(o, 0, 1).reshape(bsz, seq, D_MODEL)
    return o @ w_out


def peer_ffn(h, w_q, sub_keys, u_table, v_table):
    bsz, seq, _ = h.shape
    n_tok = bsz * seq
    n_blk = n_tok // PEER_TOKEN_BLOCK
    xt = h.reshape(n_tok, D_MODEL)
    q = (xt @ w_q).astype(jnp.float32).reshape(n_tok, PEER_HEADS, 2, PEER_HALF)
    scores = jnp.einsum('thsk,snk->thsn', q, sub_keys.astype(jnp.float32))
    top_s, top_i = lax.top_k(scores, PEER_TOPK)
    cand = top_s[:, :, 0, :, None] + top_s[:, :, 1, None, :]
    cand = cand.reshape(n_tok, PEER_HEADS, PEER_TOPK * PEER_TOPK)
    best_s, best_c = lax.top_k(cand, PEER_TOPK)
    idx1 = jnp.take_along_axis(top_i[:, :, 0], best_c // PEER_TOPK, axis=-1)
    idx2 = jnp.take_along_axis(top_i[:, :, 1], best_c % PEER_TOPK, axis=-1)
    expert = (idx1 * PEER_N_KEYS + idx2).reshape(n_blk, PEER_TOKEN_BLOCK, PEER_HEADS * PEER_TOPK)
    gate = jax.nn.softmax(best_s, axis=-1).reshape(n_blk, PEER_TOKEN_BLOCK, PEER_HEADS * PEER_TOPK)
    xb = xt.reshape(n_blk, PEER_TOKEN_BLOCK, D_MODEL)

    def token_block(args):
        x_b, e_b, g_b = args
        u_sel = jnp.take(u_table, e_b, axis=0)
        act = jax.nn.gelu(jnp.einsum('td,tkd->tk', x_b, u_sel).astype(jnp.float32), approximate=False) * g_b
        v_sel = jnp.take(v_table, e_b, axis=0)
        return jnp.einsum('tk,tkd->td', act.astype(v_sel.dtype), v_sel)

    y = lax.map(token_block, (xb, expert, gate))
    return y.reshape(bsz, seq, D_MODEL).astype(h.dtype)


def _normal(key, shape, scale):
    return scale * jax.random.normal(key, shape, jnp.float32)


def setup_inputs(seed: int = 0) -> dict:
    key = jax.random.key(seed)
    ks = jax.random.split(key, 40)
    D = D_MODEL
    s_d = D ** -0.5
    qkv_col_scale = jnp.concatenate([jnp.ones((2 * D,), jnp.float32), jnp.full((D,), DN_BETA, jnp.float32)])
    lam_im_base = jnp.pi * jnp.arange(SSM_STATE, dtype=jnp.float32)
    return {
        'x': _normal(ks[0], (BATCH, SEQ, D), 1.0),
        'p': _normal(ks[1], (DEPTH, BATCH, SEQ, PLE_DIM), 1.0),
        'ln_mix_g': 1.0 + _normal(ks[2], (DEPTH, D), 0.02),
        'ln_mix_b': _normal(ks[3], (DEPTH, D), 0.02),
        'ln_ffn_g': 1.0 + _normal(ks[4], (DEPTH, D), 0.02),
        'ln_ffn_b': _normal(ks[5], (DEPTH, D), 0.02),
        'pool_w_in': _normal(ks[6], (N_POOL_LAYERS, D, D), s_d),
        'pool_w_group': _normal(ks[7], (N_POOL_LAYERS, POOL_GROUPS, POOL_GROUP_DIM, POOL_GROUP_DIM), POOL_GROUP_DIM ** -0.5),
        'pool_scale': 1.0 + _normal(ks[8], (N_POOL_LAYERS, D), 0.1),
        'pool_w_out': _normal(ks[9], (N_POOL_LAYERS, D, D), s_d * DN_BETA),
        'ssm_w_in': _normal(ks[10], (N_SSM_LAYERS, D, D), s_d),
        'ssm_lambda_re': -0.5 + _normal(ks[11], (N_SSM_LAYERS, SSM_GROUPS, SSM_STATE), 0.01),
        'ssm_lambda_im': lam_im_base + _normal(ks[12], (N_SSM_LAYERS, SSM_GROUPS, SSM_STATE), 0.01),
        'ssm_log_step': jax.random.uniform(ks[13], (N_SSM_LAYERS, SSM_GROUPS), jnp.float32, math.log(SSM_DT_MIN), math.log(SSM_DT_MAX)),
        'ssm_b_re': _normal(ks[14], (N_SSM_LAYERS, SSM_GROUPS, SSM_STATE, SSM_GROUP_DIM), (2.0 * SSM_GROUP_DIM) ** -0.5),
        'ssm_b_im': _normal(ks[15], (N_SSM_LAYERS, SSM_GROUPS, SSM_STATE, SSM_GROUP_DIM), (2.0 * SSM_GROUP_DIM) ** -0.5),
        'ssm_c_re': _normal(ks[16], (N_SSM_LAYERS, SSM_GROUPS, SSM_GROUP_DIM, SSM_STATE), (2.0 * SSM_STATE) ** -0.5),
        'ssm_c_im': _normal(ks[17], (N_SSM_LAYERS, SSM_GROUPS, SSM_GROUP_DIM, SSM_STATE), (2.0 * SSM_STATE) ** -0.5),
        'ssm_d': _normal(ks[18], (N_SSM_LAYERS, D), 1.0),
        'ssm_w_glu': _normal(ks[19], (N_SSM_LAYERS, D, D), s_d),
        'ssm_w_out': _normal(ks[20], (N_SSM_LAYERS, D, D), s_d * DN_BETA),
        'attn_w_qkv': _normal(ks[21], (N_ATTN_LAYERS, D, 3 * D), s_d) * qkv_col_scale,
        'attn_rel_bias': _normal(ks[22], (N_ATTN_LAYERS, ATTN_HEADS, 2 * ATTN_MAX_REL + 1), 0.2),
        'attn_w_out': _normal(ks[23], (N_ATTN_LAYERS, D, D), s_d * DN_BETA),
        'peer_w_q': _normal(ks[24], (DEPTH, D, PEER_HEADS * PEER_QUERY_DIM), s_d),
        'peer_sub_keys': _normal(ks[25], (DEPTH, 2, PEER_N_KEYS, PEER_HALF), PEER_HALF ** -0.5),
        'peer_u': _normal(ks[26], (DEPTH, PEER_EXPERTS, D), s_d),
        'peer_v': _normal(ks[27], (DEPTH, PEER_EXPERTS, D), DN_BETA),
        'ple_w_proj': _normal(ks[28], (DEPTH, PLE_DIM, D), PLE_DIM ** -0.5),
        'ple_w_gate': _normal(ks[29], (DEPTH, D, D), s_d),
        'ple_b_gate': _normal(ks[30], (DEPTH, D), 0.02),
    }


def reference(x, p, ln_mix_g, ln_mix_b, ln_ffn_g, ln_ffn_b, pool_w_in, pool_w_group, pool_scale, pool_w_out, ssm_w_in, ssm_lambda_re, ssm_lambda_im, ssm_log_step, ssm_b_re, ssm_b_im, ssm_c_re, ssm_c_im, ssm_d, ssm_w_glu, ssm_w_out, attn_w_qkv, attn_rel_bias, attn_w_out, peer_w_q, peer_sub_keys, peer_u, peer_v, ple_w_proj, ple_w_gate, ple_b_gate):
    h = x
    for i in range(DEPTH):
        kind, j = i % N_MIXERS, i // N_MIXERS
        if kind == 0:
            m = pool_mixer(h, pool_w_in[j], pool_w_group[j], pool_scale[j], pool_w_out[j])
        elif kind == 1:
            m = ssm_mixer(h, ssm_w_in[j], ssm_lambda_re[j], ssm_lambda_im[j], ssm_log_step[j], ssm_b_re[j], ssm_b_im[j], ssm_c_re[j], ssm_c_im[j], ssm_d[j], ssm_w_glu[j], ssm_w_out[j])
        else:
            m = chunk_attention(h, attn_w_qkv[j], attn_rel_bias[j], attn_w_out[j])
        h = layer_norm(DN_ALPHA * h + m.astype(h.dtype), ln_mix_g[i], ln_mix_b[i])
        f = peer_ffn(h, peer_w_q[i], peer_sub_keys[i], peer_u[i], peer_v[i])
        h = layer_norm(DN_ALPHA * h + f, ln_ffn_g[i], ln_ffn_b[i])
        h = h + jax.nn.sigmoid(h @ ple_w_gate[i] + ple_b_gate[i]) * (p[i] @ ple_w_proj[i])
    return h
```

```cpp
#include <hip/hip_runtime.h>
#include <cstdio>
#include <cstdint>

#ifndef MK_PER_PHASE
#define MK_PER_PHASE 0
#endif

namespace pg8 {
#define PG8_LAS __attribute__((address_space(3)))
typedef unsigned short bf16_t;
typedef short bf16x8 __attribute__((ext_vector_type(8)));
typedef float f32x4 __attribute__((ext_vector_type(4)));
typedef unsigned u32x4 __attribute__((ext_vector_type(4)));
constexpr int BM = 256, BK = 64, HALF = 128, HTB = HALF * BK * 2, STAGE_BYTES = 8 * HTB, NXCD = 8, WGM = 8;

__host__ __device__ __forceinline__ int lds_byte(int r, int c) { const int st = (r >> 4) * 2 + (c >> 5), rr = r & 15, cc = c & 31, ob = rr * 64 + cc * 2; return st * 1024 + (ob ^ (((ob >> 9) & 1) << 5)); }
__host__ __device__ __forceinline__ int lds_byte8(int r, int c) { const int st = (r >> 4) * 2 + (c >> 5), rr = r & 15, cc = c & 31, ob = rr * 64 + cc * 2; return st * 1024 + (ob ^ (((ob >> 9) & 1) << 5) ^ (((ob >> 8) & 1) << 4)); }
__host__ __device__ __forceinline__ void stage_rc8(int b, int& R, int& C) { const int st = b / 1024, sb = b % 1024, swz = sb ^ (((sb >> 9) & 1) << 5) ^ (((sb >> 8) & 1) << 4); R = (st >> 1) * 16 + swz / 64; C = (st & 1) * 32 + (swz % 64) / 2; }
__host__ __device__ __forceinline__ void stage_rc(int b, int& R, int& C) { const int st = b / 1024, sb = b % 1024, swz = sb ^ (((sb >> 9) & 1) << 5); R = (st >> 1) * 16 + swz / 64; C = (st & 1) * 32 + (swz % 64) / 2; }
__host__ __device__ __forceinline__ int perm32(int rho) { const int n = rho >> 4, i = rho & 15; return 8 * (i >> 2) + 4 * n + (i & 3); }
__host__ __device__ __forceinline__ int perm32f8(int rho) { return 16 * ((rho >> 2) & 1) + (rho & 3) + 4 * (rho >> 3); }

__device__ __forceinline__ int lane_now() { int l; asm volatile("v_mbcnt_lo_u32_b32 %0, -1, 0\n\tv_mbcnt_hi_u32_b32 %0, -1, %0" : "=v"(l)); return l; }
struct Unit { int pm, pn; };
struct Gemm { const bf16_t* A; const bf16_t* Bt; int M, N, K, lda, agrp; };

struct StaticOrder {
    int nM, nN, nwg, G, c;
    __host__ __device__ void init(int M, int N, int G_, int c_) { nM = M / BM; nN = N / BM; nwg = nM * nN; G = G_; c = c_; }
    __host__ __device__ bool next(int i, Unit& u) const {
        const long L = (long)i * G + c; if (L >= nwg) return false;
        int wgid = (int)L; { const int q = nwg / NXCD, r = nwg % NXCD, xcd = wgid % NXCD, off = wgid / NXCD; wgid = (xcd < r ? xcd * (q + 1) : r * (q + 1) + (xcd - r) * q) + off; }
        const int nig = WGM * nN, gid = wgid / nig, fm = gid * WGM, gsz = (nM - fm) < WGM ? (nM - fm) : WGM;
        u.pm = fm + ((wgid % nig) % gsz); u.pn = (wgid % nig) / gsz; return true;
    }
};

__device__ __forceinline__ unsigned cvt_pk_bf16(float lo, float hi) { unsigned r; asm volatile("v_cvt_pk_bf16_f32 %0, %1, %2" : "=v"(r) : "v"(lo), "v"(hi)); return r; }
__device__ __forceinline__ float bf_lo(unsigned w) { return __builtin_bit_cast(float, w << 16); }
__device__ __forceinline__ float bf_hi(unsigned w) { return __builtin_bit_cast(float, w & 0xffff0000u); }
__device__ __forceinline__ float sigmoid_f(float x) { return __builtin_amdgcn_rcpf(1.f + __builtin_amdgcn_exp2f(-1.4426950408889634f * x)); }
#ifdef DBG_PLE_HALF
__device__ __forceinline__ float sigmoid_p(float x) { return 0.5f; }
#else
__device__ __forceinline__ float sigmoid_p(float x) { return sigmoid_f(x); }
#endif

typedef int v8i_t __attribute__((ext_vector_type(8)));
typedef unsigned u32x2 __attribute__((ext_vector_type(2)));
typedef float f32x16 __attribute__((ext_vector_type(16)));
typedef float f32x2_ __attribute__((ext_vector_type(2)));
__device__ __forceinline__ u32x2 pack8_fp8(const f32x4 v0, const f32x4 v1) {
    int a = 0, b = 0;
    a = __builtin_amdgcn_cvt_pk_fp8_f32(v0[0], v0[1], a, false); a = __builtin_amdgcn_cvt_pk_fp8_f32(v0[2], v0[3], a, true);
    b = __builtin_amdgcn_cvt_pk_fp8_f32(v1[0], v1[1], b, false); b = __builtin_amdgcn_cvt_pk_fp8_f32(v1[2], v1[3], b, true);
    return (u32x2){(unsigned)a, (unsigned)b};
}
__device__ __forceinline__ u32x4 pack8_bf16(const f32x4 v0, const f32x4 v1) { u32x4 w; w.x = cvt_pk_bf16(v0[0], v0[1]); w.y = cvt_pk_bf16(v0[2], v0[3]); w.z = cvt_pk_bf16(v1[0], v1[1]); w.w = cvt_pk_bf16(v1[2], v1[3]); return w; }
struct EpiBf16 {
    bf16_t* O; int ldc; const float* cscale; int split_cols; size_t split_stride; float scale0; bf16_t* VT; float oscale;
    __device__ __forceinline__ void chunk(int row, int col, f32x4 v0, f32x4 v1) const {
        if (cscale) { v0 = v0 * *(const f32x4*)(cscale + col); v1 = v1 * *(const f32x4*)(cscale + col + 4); }
        if (!split_cols) { *(u32x4*)(O + (size_t)row * ldc + col) = pack8_bf16(v0 * oscale, v1 * oscale); return; }
        const int t = col / split_cols, c = col - t * split_cols, hd = c >> 7, d = c & 127, b = row >> 13, sq = row & 8191;
        const float sc = (t == 0) ? oscale * scale0 : oscale;
        const u32x4 w = pack8_bf16(v0 * sc, v1 * sc);
        bf16_t* base = O + (size_t)t * split_stride;
        const size_t bh = (size_t)(b * 16 + hd) * 256 + (sq >> 5);
        if (t < 2) *(u32x4*)(base + ((bh * 8 + (d >> 4)) * 512) + (size_t)((sq & 31) + 32 * ((d >> 3) & 1)) * 8) = w;
        else { const int kk = sq & 31, k16 = kk & 15; bf16_t* p = base + ((((bh * 4 + (d >> 5)) * 2 + (kk >> 4)) * 512) + (size_t)((d & 31) + 32 * ((k16 >> 2) & 1)) * 8) + (k16 & 3) + 4 * (k16 >> 3);
            p[0] = (bf16_t)(w.x & 0xffffu); p[8] = (bf16_t)(w.x >> 16); p[16] = (bf16_t)(w.y & 0xffffu); p[24] = (bf16_t)(w.y >> 16);
            p[32] = (bf16_t)(w.z & 0xffffu); p[40] = (bf16_t)(w.z >> 16); p[48] = (bf16_t)(w.w & 0xffffu); p[56] = (bf16_t)(w.w >> 16); }
    }
};
struct EpiF8 {
    unsigned char* O; int ldc; const float* cscale; float oscale;
    __device__ __forceinline__ void chunk(int row, int col, f32x4 v0, f32x4 v1) const {
        if (cscale) { v0 = v0 * *(const f32x4*)(cscale + col); v1 = v1 * *(const f32x4*)(cscale + col + 4); }
        *(u32x2*)(O + (size_t)row * ldc + col) = pack8_fp8(v0 * oscale, v1 * oscale);
    }
};
struct EpiGlu8 {
    const unsigned char* Gin; unsigned char* O; int ld; float oscale;
    __device__ __forceinline__ void chunk(int row, int col, f32x4 a0, f32x4 a1) const {
        const size_t ro = (size_t)row * ld + col; const u32x2 g = *(const u32x2*)(Gin + ro); a0 = a0 * oscale; a1 = a1 * oscale;
        const unsigned gx = g.x, gy = g.y;
        const f32x2_ g01 = __builtin_amdgcn_cvt_pk_f32_fp8((int)gx, false), g23 = __builtin_amdgcn_cvt_pk_f32_fp8((int)gx, true), g45 = __builtin_amdgcn_cvt_pk_f32_fp8((int)gy, false), g67 = __builtin_amdgcn_cvt_pk_f32_fp8((int)gy, true);
        const f32x4 o0 = {g01.x * sigmoid_f(a0[0]), g01.y * sigmoid_f(a0[1]), g23.x * sigmoid_f(a0[2]), g23.y * sigmoid_f(a0[3])};
        const f32x4 o1 = {g45.x * sigmoid_f(a1[0]), g45.y * sigmoid_f(a1[1]), g67.x * sigmoid_f(a1[2]), g67.y * sigmoid_f(a1[3])};
        *(u32x2*)(O + ro) = pack8_fp8(o0, o1);
    }
};
struct EpiRes {
    const bf16_t* hres; bf16_t* out; int ld; float alpha; float mscale;
    __device__ __forceinline__ void chunk(int row, int col, f32x4 a0, f32x4 a1) const {
        const size_t ro = (size_t)row * ld + col; const u32x4 h = *(const u32x4*)(hres + ro); a0 = a0 * mscale; a1 = a1 * mscale;
        const f32x4 o0 = {bf_lo(h.x) * alpha + a0[0], bf_hi(h.x) * alpha + a0[1], bf_lo(h.y) * alpha + a0[2], bf_hi(h.y) * alpha + a0[3]};
        const f32x4 o1 = {bf_lo(h.z) * alpha + a1[0], bf_hi(h.z) * alpha + a1[1], bf_lo(h.w) * alpha + a1[2], bf_hi(h.w) * alpha + a1[3]};
        *(u32x4*)(out + ro) = pack8_bf16(o0, o1);
    }
};
struct EpiPle {
    const bf16_t* hin; const unsigned char* proj; bf16_t* hob; unsigned char* ho8; float* fout; const float* bias; int ld; float oscale;
    __device__ __forceinline__ void chunk(int row, int col, f32x4 a0, f32x4 a1) const {
        const size_t ro = (size_t)row * ld + col; const u32x2 pj8 = *(const u32x2*)(proj + ro); const u32x4 hh = *(const u32x4*)(hin + ro);
        const unsigned pjx = pj8.x, pjy = pj8.y;
        const f32x2_ q01 = __builtin_amdgcn_cvt_pk_f32_fp8((int)pjx, false), q23 = __builtin_amdgcn_cvt_pk_f32_fp8((int)pjx, true), q45 = __builtin_amdgcn_cvt_pk_f32_fp8((int)pjy, false), q67 = __builtin_amdgcn_cvt_pk_f32_fp8((int)pjy, true);
        const float pjs = 1.f / 8.f;
        const float p0 = q01.x * pjs, p1 = q01.y * pjs, p2 = q23.x * pjs, p3 = q23.y * pjs, p4 = q45.x * pjs, p5 = q45.y * pjs, p6 = q67.x * pjs, p7 = q67.y * pjs;
        a0 = a0 * oscale + *(const f32x4*)(bias + col); a1 = a1 * oscale + *(const f32x4*)(bias + col + 4);
        f32x4 h0, h1;
        h0[0] = bf_lo(hh.x) + sigmoid_p(a0[0]) * p0; h0[1] = bf_hi(hh.x) + sigmoid_p(a0[1]) * p1; h0[2] = bf_lo(hh.y) + sigmoid_p(a0[2]) * p2; h0[3] = bf_hi(hh.y) + sigmoid_p(a0[3]) * p3;
        h1[0] = bf_lo(hh.z) + sigmoid_p(a1[0]) * p4; h1[1] = bf_hi(hh.z) + sigmoid_p(a1[1]) * p5; h1[2] = bf_lo(hh.w) + sigmoid_p(a1[2]) * p6; h1[3] = bf_hi(hh.w) + sigmoid_p(a1[3]) * p7;
        if (fout != nullptr) { *(f32x4*)(fout + ro) = h0; *(f32x4*)(fout + ro + 4) = h1; }
        else { *(u32x4*)(hob + ro) = pack8_bf16(h0, h1); *(u32x2*)(ho8 + ro) = pack8_fp8(h0, h1); }
    }
};

template <class Epi, bool F8 = false>
__device__ __forceinline__ void gemm_phase(PG8_LAS unsigned char* lds, const Gemm g, const StaticOrder& S, const Epi& E, const int tid) {
    const int wid = __builtin_amdgcn_readfirstlane(tid >> 6), lane = tid & 63, wr = wid >> 2, wc = wid & 3, fr = lane & 15, fq = lane >> 4;
    const int K = g.K, nt = K / BK, lda = g.lda;
    unsigned voffA[2], voffB[2];
#pragma unroll
    for (int i = 0; i < 2; ++i) { int R, C; if (F8) stage_rc8(tid * 16 + i * 8192, R, C); else stage_rc(tid * 16 + i * 8192, R, C); const int Rb = (R & ~31) + (F8 ? perm32f8(R & 31) : perm32(R & 31));
        voffA[i] = (unsigned)(R * lda + C) * 2u; voffB[i] = (unsigned)(Rb * K + C) * 2u; }
    const size_t kstep = (size_t)(BK * 2);
    const size_t hstepA = (size_t)HALF * lda * 2, hstepB = (size_t)HALF * K * 2;
    const size_t tstepA = 2 * hstepA, tstepB = 2 * hstepB;
    const unsigned ldsw = (unsigned)wid * 1024u;
    const int l31 = lane & 31, h32 = lane >> 5;
    const int aoff = F8 ? lds_byte8(wr * 64 + l31, 16 * h32) : lds_byte(wr * 64 + fr, fq * 8);
    const int boff = F8 ? lds_byte8(wc * 32 + l31, 16 * h32) : lds_byte(wc * 32 + fr, fq * 8);
    const int aoffx = aoff ^ 16, boffx = boff ^ 16;
#define PG8_SA(b, h) (((b) * 2 + (h)) * HTB)
#define PG8_SB(b, h) ((4 + (b) * 2 + (h)) * HTB)
#define PG8_STAGE(bufoff, gbase, voff) do { _Pragma("unroll") for (int _i = 0; _i < 2; ++_i) \
        __builtin_amdgcn_global_load_lds((const unsigned*)((const char*)(gbase) + (voff)[_i]), (PG8_LAS unsigned*)(lds + (bufoff) + ldsw + _i * 8192), 16, 0, 0); } while (0)
#define PG8_LD32(dst, off, offx) do { typedef int _v4i __attribute__((ext_vector_type(4))); const _v4i _lo = *(const PG8_LAS _v4i*)(lds + (off)), _hi = *(const PG8_LAS _v4i*)(lds + (offx)); \
        dst = __builtin_shufflevector(_lo, _hi, 0, 1, 2, 3, 4, 5, 6, 7); } while (0)
#define PG8_LDA(dst, b, h) do { if constexpr (F8) { _Pragma("unroll") for (int m2 = 0; m2 < 2; ++m2) _Pragma("unroll") for (int ks = 0; ks < 2; ++ks) PG8_LD32(dst##8[m2][ks], PG8_SA(b, h) + aoff + m2 * 4096 + ks * 1024, PG8_SA(b, h) + aoffx + m2 * 4096 + ks * 1024); } \
        else { _Pragma("unroll") for (int m = 0; m < 4; ++m) _Pragma("unroll") for (int k = 0; k < 2; ++k) dst[m][k] = *(const PG8_LAS bf16x8*)(lds + PG8_SA(b, h) + aoff + m * 2048 + k * 1024); } } while (0)
#define PG8_LDB(dst, b, h) do { if constexpr (F8) { _Pragma("unroll") for (int ks = 0; ks < 2; ++ks) PG8_LD32(dst##8[ks], PG8_SB(b, h) + boff + ks * 1024, PG8_SB(b, h) + boffx + ks * 1024); } \
        else { _Pragma("unroll") for (int n = 0; n < 2; ++n) _Pragma("unroll") for (int k = 0; k < 2; ++k) dst[n][k] = *(const PG8_LAS bf16x8*)(lds + PG8_SB(b, h) + boff + n * 2048 + k * 1024); } } while (0)
#define PG8_MMA(ai, bj, At, Bt) do { __builtin_amdgcn_s_setprio(1); \
        if constexpr (F8) { _Pragma("unroll") for (int m2 = 0; m2 < 2; ++m2) _Pragma("unroll") for (int ks = 0; ks < 2; ++ks) \
            acc32[ai][bj][m2] = __builtin_amdgcn_mfma_scale_f32_32x32x64_f8f6f4(Bt##8[ks], At##8[m2][ks], acc32[ai][bj][m2], 0, 0, 0, 0, 0, 0); } \
        else { _Pragma("unroll") for (int m = 0; m < 4; ++m) _Pragma("unroll") for (int n = 0; n < 2; ++n) _Pragma("unroll") for (int k = 0; k < 2; ++k) \
            acc[ai][bj][m][n] = __builtin_amdgcn_mfma_f32_16x16x32_bf16(Bt[n][k], At[m][k], acc[ai][bj][m][n], 0, 0, 0); } \
        __builtin_amdgcn_s_setprio(0); } while (0)
#define PG8_WAIT_V(n) asm volatile("s_waitcnt vmcnt(" #n ")" ::: "memory")
#define PG8_WAIT_L(n) asm volatile("s_waitcnt lgkmcnt(" #n ")" ::: "memory")
#define PG8_BAR __builtin_amdgcn_s_barrier()
#define PG8_SCHED __builtin_amdgcn_sched_barrier(0)
#define PG8_ACOL(u) ((g.agrp > 0) ? (size_t)((u).pn / g.agrp) * (size_t)K * 2 : (size_t)0)
    Unit cur, nxt; int ui = 0;
    if (!S.next(0, cur)) return;
    f32x4 acc[2][2][4][2];
#pragma unroll
    for (int a = 0; a < 2; ++a)
#pragma unroll
        for (int b = 0; b < 2; ++b)
#pragma unroll
            for (int m = 0; m < 4; ++m)
#pragma unroll
                for (int n = 0; n < 2; ++n) acc[a][b][m][n] = (f32x4){0.f, 0.f, 0.f, 0.f};
    bf16x8 At[4][2], B0[2][2], B1[2][2];
    v8i_t At8[2][2], B08[2], B18[2];
    f32x16 acc32[2][2][2];
#pragma unroll
    for (int a = 0; a < 2; ++a)
#pragma unroll
        for (int b = 0; b < 2; ++b)
#pragma unroll
            for (int m2 = 0; m2 < 2; ++m2)
#pragma unroll
                for (int i = 0; i < 16; ++i) acc32[a][b][m2][i] = 0.f;
    const char* cA = (const char*)g.A + (size_t)cur.pm * tstepA + PG8_ACOL(cur); const char* cB = (const char*)g.Bt + (size_t)cur.pn * tstepB;
    PG8_STAGE(PG8_SB(0, 0), cB, voffB); PG8_STAGE(PG8_SB(0, 1), cB + hstepB, voffB); PG8_STAGE(PG8_SA(0, 0), cA, voffA); PG8_STAGE(PG8_SA(0, 1), cA + hstepA, voffA);
    if (wr == 1) PG8_BAR;
    PG8_WAIT_V(2); PG8_BAR;
    PG8_STAGE(PG8_SB(1, 0), cB + kstep, voffB); PG8_STAGE(PG8_SA(1, 0), cA + kstep, voffA); PG8_STAGE(PG8_SB(1, 1), cB + hstepB + kstep, voffB);
    PG8_WAIT_V(6); PG8_BAR;
    for (;;) {
        const bool has_next = S.next(ui + 1, nxt);
        const char* nA = has_next ? (const char*)g.A + (size_t)nxt.pm * tstepA + PG8_ACOL(nxt) : cA; const char* nB = has_next ? (const char*)g.Bt + (size_t)nxt.pn * tstepB : cB;
        for (int t = 0; t < nt; t += 2) {
            const bool last = (t == nt - 2);
            const char* a1 = cA + (size_t)(t + 1) * kstep;
            const char* a2 = last ? nA : cA + (size_t)(t + 2) * kstep; const char* b2 = last ? nB : cB + (size_t)(t + 2) * kstep;
            const char* a3 = a2 + kstep; const char* b3 = b2 + kstep;
            PG8_LDB(B0, 0, 0); PG8_LDB(B1, 0, 1); PG8_SCHED; PG8_LDA(At, 0, 0); PG8_STAGE(PG8_SA(1, 1), a1 + hstepA, voffA);
            PG8_WAIT_V(8); PG8_WAIT_L(0); PG8_BAR; PG8_MMA(0, 0, At, B0); PG8_MMA(0, 1, At, B1); PG8_BAR; PG8_SCHED;
            PG8_LDA(At, 0, 1); PG8_STAGE(PG8_SB(0, 0), b2, voffB); PG8_STAGE(PG8_SB(0, 1), b2 + hstepB, voffB); PG8_STAGE(PG8_SA(0, 0), a2, voffA);
            PG8_WAIT_V(8); PG8_WAIT_L(0); PG8_BAR; PG8_MMA(1, 0, At, B0); PG8_MMA(1, 1, At, B1); PG8_BAR; PG8_SCHED;
            PG8_LDB(B0, 1, 0); PG8_LDB(B1, 1, 1); PG8_SCHED; PG8_LDA(At, 1, 0); PG8_STAGE(PG8_SA(0, 1), a2 + hstepA, voffA);
            PG8_WAIT_V(8); PG8_WAIT_L(0); PG8_BAR; PG8_MMA(0, 0, At, B0); PG8_MMA(0, 1, At, B1); PG8_BAR; PG8_SCHED;
            PG8_LDA(At, 1, 1); PG8_STAGE(PG8_SB(1, 0), b3, voffB); PG8_STAGE(PG8_SB(1, 1), b3 + hstepB, voffB); PG8_STAGE(PG8_SA(1, 0), a3, voffA);
            PG8_WAIT_V(8); PG8_WAIT_L(0); PG8_BAR; PG8_MMA(1, 0, At, B0); PG8_MMA(1, 1, At, B1); PG8_BAR; PG8_SCHED;
        }
        if (wr == 0) PG8_BAR;
        if constexpr (F8) {
            const int lnE = lane_now(); const int rowF = cur.pm * BM + wr * 64 + (lnE & 31), colF = cur.pn * BM + wc * 32 + 16 * (lnE >> 5);
#pragma unroll
            for (int a = 0; a < 2; ++a)
#pragma unroll
                for (int m2 = 0; m2 < 2; ++m2)
#pragma unroll
                    for (int b = 0; b < 2; ++b) { const f32x16 v = acc32[a][b][m2];
                        E.chunk(rowF + a * HALF + 32 * m2, colF + b * HALF, (f32x4){v[0], v[1], v[2], v[3]}, (f32x4){v[4], v[5], v[6], v[7]});
                        E.chunk(rowF + a * HALF + 32 * m2, colF + b * HALF + 8, (f32x4){v[8], v[9], v[10], v[11]}, (f32x4){v[12], v[13], v[14], v[15]});
#pragma unroll
                        for (int i = 0; i < 16; ++i) acc32[a][b][m2][i] = 0.f; }
        } else {
            const int lnE = lane_now(); const int row0 = cur.pm * BM + wr * 64 + (lnE & 15), col0 = cur.pn * BM + wc * 32 + 8 * (lnE >> 4);
#pragma unroll
            for (int a = 0; a < 2; ++a)
#pragma unroll
                for (int m = 0; m < 4; ++m)
#pragma unroll
                    for (int b = 0; b < 2; ++b) E.chunk(row0 + a * HALF + m * 16, col0 + b * HALF, acc[a][b][m][0], acc[a][b][m][1]);
        }
        if (!has_next) break;
#pragma unroll
        for (int a = 0; a < 2; ++a)
#pragma unroll
            for (int b = 0; b < 2; ++b)
#pragma unroll
                for (int m = 0; m < 4; ++m)
#pragma unroll
                    for (int n = 0; n < 2; ++n) acc[a][b][m][n] = (f32x4){0.f, 0.f, 0.f, 0.f};
        cur = nxt; cA = nA; cB = nB; ++ui;
        if (wr == 1) PG8_BAR;
    }
    PG8_WAIT_V(0);
    PG8_BAR;
#undef PG8_SA
#undef PG8_SB
#undef PG8_STAGE
#undef PG8_LDA
#undef PG8_LD32
#undef PG8_LDB
#undef PG8_MMA
#undef PG8_WAIT_V
#undef PG8_WAIT_L
#undef PG8_BAR
#undef PG8_SCHED
#undef PG8_ACOL
}
}

constexpr int NWAVES = 8;
constexpr int D = 2048, BATCH = 4, SEQ = 8192, DEPTH = 4, M = BATCH * SEQ;
constexpr int NEXP = 16384, PLE = 256;
constexpr float LN_EPS = 1e-5f;
constexpr float DN_ALPHA = 1.681792830507429f;
constexpr float LOG2E = 1.4426950408889634f;
constexpr float ATTN_QSCALE = 0.08838834764831845f * LOG2E;
constexpr float W8S = 64.f, O8S = 16.f;

constexpr size_t MiB = 1u << 20;
constexpr size_t WS_CTL = 0, CTL_ZERO_BYTES = 1 * MiB;
constexpr size_t WS_STATS = WS_CTL + 512 * 1024;
constexpr size_t WS_W = 1 * MiB;
constexpr size_t W_POOL_IN = WS_W, W_POOL_GRP = W_POOL_IN + 16 * MiB, W_POOL_OUT = W_POOL_GRP + 4 * MiB;
constexpr size_t W_SSM_IN = W_POOL_OUT + 16 * MiB, W_SSM_GLU = W_SSM_IN + 8 * MiB, W_SSM_OUT = W_SSM_GLU + 8 * MiB;
constexpr size_t W_ATTN_QKV = W_SSM_OUT + 8 * MiB, W_ATTN_OUT = W_ATTN_QKV + 24 * MiB;
constexpr size_t W_PEER_Q = W_ATTN_OUT + 8 * MiB, W_PLE_GATE = W_PEER_Q + 32 * MiB, W_PLE_PROJ = W_PLE_GATE + 32 * MiB;
constexpr size_t WS_SK = W_PLE_PROJ + 4 * MiB;
constexpr size_t WS_TU = WS_SK + 1 * MiB;
constexpr size_t WS_TV = WS_TU + 256 * MiB;
constexpr size_t WS_PB = WS_TV + 256 * MiB;
constexpr size_t WS_HB0 = WS_PB + 64 * MiB, WS_HB1 = WS_HB0 + 128 * MiB;
constexpr size_t WS_T1 = WS_HB1 + 128 * MiB, WS_T2 = WS_T1 + 128 * MiB, WS_T3 = WS_T2 + 128 * MiB;
constexpr size_t WS_IDX = WS_T3 + 128 * MiB, WS_GATE = WS_IDX + 16 * MiB;
constexpr size_t WS_SSMP = WS_GATE + 16 * MiB;
constexpr size_t WS_SU = WS_SSMP + 2 * MiB, WS_SV = WS_SU + 1 * MiB;
constexpr size_t WS_S8 = WS_SV + 1 * MiB;
constexpr size_t WS_X8 = WS_S8 + 64 * MiB;
constexpr size_t WS_END = WS_X8 + 64 * MiB;
static_assert(WS_END <= 2048 * MiB, "d_ws map");
constexpr int CW_BAR = 4096;

constexpr int RING_BYTES = 131072;
constexpr int LDSCTL_OFF = RING_BYTES, MISC_OFF = LDSCTL_OFF + 320;
constexpr int LDS_BYTES = 147456;

#define LAS __attribute__((address_space(3)))
typedef unsigned short bf16;
typedef unsigned v4u __attribute__((ext_vector_type(4)));
typedef unsigned v2u __attribute__((ext_vector_type(2)));
typedef float f32x4 __attribute__((ext_vector_type(4)));
typedef float f32x16 __attribute__((ext_vector_type(16)));
typedef short bf16x8 __attribute__((ext_vector_type(8)));
typedef __bf16 bf16x2_t __attribute__((ext_vector_type(2)));
#define LDS_WAIT() asm volatile("s_waitcnt lgkmcnt(0)" ::: "memory")
#define VM_WAIT() asm volatile("s_waitcnt vmcnt(0)" ::: "memory")
__device__ __forceinline__ unsigned f2bf(float f) { unsigned u = __builtin_bit_cast(unsigned, f); return (u + 0x7fffu + ((u >> 16) & 1u)) >> 16; }
__device__ __forceinline__ unsigned pk2(float lo, float hi) { return f2bf(lo) | (f2bf(hi) << 16); }
__device__ __forceinline__ float bflo(unsigned w) { return __builtin_bit_cast(float, w << 16); }
__device__ __forceinline__ float bfhi(unsigned w) { return __builtin_bit_cast(float, w & 0xffff0000u); }
__device__ __forceinline__ float dot2bf(unsigned a, unsigned b, float c) { return __builtin_amdgcn_fdot2_f32_bf16(__builtin_bit_cast(bf16x2_t, a), __builtin_bit_cast(bf16x2_t, b), c, false); }
__device__ __forceinline__ float gelu_f(float v) {
    const float av = __builtin_fabsf(v), d = av * 0.2316418882f + 1.0f, t = __builtin_amdgcn_rcpf(d);
    float q = t * 0.5307027145f + (-0.7265760135f); q = q * t + 0.7107068705f; q = q * t + (-0.142248368f); q = q * t + 0.127414796f; q = q * t;
    const float e = __builtin_amdgcn_exp2f((v * v) * (-0.72134752044f));
    const float m = v * (q * e); return v < 0.f ? m : v - m;
}
#define WDPP(v, ctrl) __builtin_bit_cast(float, __builtin_amdgcn_update_dpp(0, __builtin_bit_cast(int, (v)), (ctrl), 0xF, 0xF, true))
#define WRL(v, l) __builtin_bit_cast(float, __builtin_amdgcn_readlane(__builtin_bit_cast(int, (v)), (l)))
__device__ __forceinline__ float wave_sum(float v) {
    v += WDPP(v, 0xB1); v += WDPP(v, 0x4E); v += WDPP(v, 0x141); v += WDPP(v, 0x140);
    return (WRL(v, 0) + WRL(v, 16)) + (WRL(v, 32) + WRL(v, 48));
}
__device__ __forceinline__ float shfl_xor_lane(float v, int m, int lane) { return __builtin_bit_cast(float, __builtin_amdgcn_ds_bpermute((lane ^ m) << 2, __builtin_bit_cast(int, v))); }
__device__ __forceinline__ int shfl_idx_lane(int v, int src) { return __builtin_amdgcn_ds_bpermute(src << 2, v); }
#define SHFL_XOR(v, m) shfl_xor_lane((v), (m), lane)

#define XB_TMO      128
#define XB_XCNT(j)  (256  + 64 * (j))
#define XB_XSUB(j)  (1280 + 64 * (j))
#define XB_XGEN(j)  (2304 + 64 * (j))
#define XB_TOP      3328
#define XB_TOPGEN   3392
#define XCD_BAR_WORDS 3456
#define XB_SPIN_CAP (1u << 23)

__device__ __forceinline__ unsigned xb_ld(unsigned* p)              { return __hip_atomic_load(p, __ATOMIC_RELAXED, __HIP_MEMORY_SCOPE_AGENT); }
__device__ __forceinline__ unsigned xb_add(unsigned* p, unsigned v) { return __hip_atomic_fetch_add(p, v, __ATOMIC_RELAXED, __HIP_MEMORY_SCOPE_AGENT); }
__device__ __forceinline__ unsigned xb_xcc_id() { return (unsigned)__builtin_amdgcn_s_getreg((3 << 11) | 20) & 0xFu; }
#define XB_SPIN(cond, bar) do { unsigned _sp = 0; while (cond) { __builtin_amdgcn_s_sleep(1); \
    if ((++_sp & 255u) == 0u) { if (xb_ld(&(bar)[XB_TMO])) break; if (_sp > XB_SPIN_CAP) { atomicAdd(&(bar)[XB_TMO], 1u); break; } } } } while (0)

struct XcdBarrier { unsigned* bar; unsigned x; volatile LAS unsigned* st; int wave; };
__device__ __forceinline__ int lane_id() { int l; asm volatile("v_mbcnt_lo_u32_b32 %0, -1, 0\n\tv_mbcnt_hi_u32_b32 %0, -1, %0" : "=v"(l)); return l; }

__device__ __forceinline__ XcdBarrier xcd_barrier_post(unsigned* bar, volatile LAS unsigned* st) {
    XcdBarrier b; b.bar = bar; b.x = xb_xcc_id(); b.st = st; b.wave = __builtin_amdgcn_readfirstlane((int)(threadIdx.x >> 6));
    if (threadIdx.x == 0) (void)xb_add(&bar[XB_XCNT(b.x)], 1u);
    return b;
}
__device__ __forceinline__ void xcd_barrier_complete(unsigned* bar, unsigned x, unsigned& nloc, unsigned& nx) {
    const unsigned G = gridDim.x * gridDim.y * gridDim.z;
    unsigned sum, cnt, mine, sp = 0u;
    for (;;) {
        sum = 0u; cnt = 0u; mine = 0u;
#pragma unroll
        for (unsigned j = 0; j < 16; ++j) { const unsigned c = xb_ld(&bar[XB_XCNT(j)]); sum += c; cnt += (c > 0u) ? 1u : 0u; mine = (j == x) ? c : mine; }
        if (sum == G) break;
        __builtin_amdgcn_s_sleep(1);
        if ((++sp & 255u) == 0u) { if (xb_ld(&bar[XB_TMO])) break; if (sp > XB_SPIN_CAP) { atomicAdd(&bar[XB_TMO], 1u); break; } }
    }
    nloc = mine > 0u ? mine : 1u; nx = cnt > 0u ? cnt : 1u;
}
__device__ __forceinline__ void xcd_barrier(const XcdBarrier& b_in) {
    asm volatile("s_waitcnt vmcnt(0)" ::: "memory");
    __syncthreads();
    if (b_in.wave == 0 && lane_id() == 0) {
        XcdBarrier b = b_in; asm volatile("" : "+s"(b.x)); asm volatile("" : "+s"(b.bar));
        unsigned* bar = b.bar;
        __builtin_amdgcn_s_waitcnt(0);
        unsigned nloc = b.st[0], nx = b.st[1];
        if (nloc == 0u) { xcd_barrier_complete(bar, b.x, nloc, nx); b.st[0] = nloc; b.st[1] = nx; }
        const unsigned old = xb_add(&bar[XB_XSUB(b.x)], 1u);
        const unsigned gen = old / nloc;
        if (old + 1u == (gen + 1u) * nloc) {
            __builtin_amdgcn_fence(__ATOMIC_RELEASE, "agent");
            asm volatile("s_waitcnt vmcnt(0)" ::: "memory");
            const unsigned og = xb_add(&bar[XB_TOP], 1u);
            const unsigned tg = og / nx;
            if (og + 1u == (tg + 1u) * nx) xb_add(&bar[XB_TOPGEN], 1u);
            else XB_SPIN(xb_ld(&bar[XB_TOPGEN]) == tg, bar);
            __builtin_amdgcn_fence(__ATOMIC_ACQUIRE, "agent");
            xb_add(&bar[XB_XGEN(b.x)], 1u);
            asm volatile("s_waitcnt vmcnt(0)" ::: "memory");
        } else {
            XB_SPIN(xb_ld(&bar[XB_XGEN(b.x)]) == gen, bar);
            __builtin_amdgcn_fence(__ATOMIC_ACQUIRE, "agent");
            asm volatile("s_waitcnt vmcnt(0)" ::: "memory");
        }
    }
    __syncthreads();
}

__device__ __forceinline__ void transpose_item(const float* W, int K, int N, bf16* WT, int row_off, LAS float* scr, int item, int lane) {
    const int nblk = N / 32, kb = item / nblk, nb = item % nblk, k0 = 64 * kb, n0 = 32 * nb;
#pragma unroll 8
    for (int i = 0; i < 32; ++i) { const int kk = 2 * i + (lane >> 5); scr[kk * 33 + (lane & 31)] = W[(size_t)(k0 + kk) * N + n0 + (lane & 31)]; }
    LDS_WAIT(); asm volatile("" ::: "memory");
    const int c = lane & 7;
#pragma unroll
    for (int j = 0; j < 4; ++j) { const int n = (lane >> 3) + 8 * j; const LAS float* s = scr + (8 * c) * 33 + n;
        v4u o; o.x = pk2(s[0 * 33], s[1 * 33]); o.y = pk2(s[2 * 33], s[3 * 33]); o.z = pk2(s[4 * 33], s[5 * 33]); o.w = pk2(s[6 * 33], s[7 * 33]);
        *(v4u*)(WT + (size_t)(row_off + n0 + n) * K + k0 + 8 * c) = o; }
    LDS_WAIT(); asm volatile("" ::: "memory");
}
__device__ __forceinline__ void transpose_item8(const float* W, int K, int N, unsigned char* WT, int row_off, LAS float* scr, int item, int lane) {
    const int nblk = N / 32, kb = item / nblk, nb = item % nblk, k0 = 64 * kb, n0 = 32 * nb;
#pragma unroll 8
    for (int i = 0; i < 32; ++i) { const int kk = 2 * i + (lane >> 5); scr[kk * 33 + (lane & 31)] = W[(size_t)(k0 + kk) * N + n0 + (lane & 31)]; }
    LDS_WAIT(); asm volatile("" ::: "memory");
    const int c = lane & 7;
#pragma unroll
    for (int j = 0; j < 4; ++j) { const int n = (lane >> 3) + 8 * j; const LAS float* sp = scr + (8 * c) * 33 + n;
        int a = 0, b = 0;
        a = __builtin_amdgcn_cvt_pk_fp8_f32(sp[0 * 33] * W8S, sp[1 * 33] * W8S, a, false); a = __builtin_amdgcn_cvt_pk_fp8_f32(sp[2 * 33] * W8S, sp[3 * 33] * W8S, a, true);
        b = __builtin_amdgcn_cvt_pk_fp8_f32(sp[4 * 33] * W8S, sp[5 * 33] * W8S, b, false); b = __builtin_amdgcn_cvt_pk_fp8_f32(sp[6 * 33] * W8S, sp[7 * 33] * W8S, b, true);
        v2u o; o.x = (unsigned)a; o.y = (unsigned)b;
        *(v2u*)(WT + (size_t)(row_off + n0 + n) * K + k0 + 8 * c) = o; }
    LDS_WAIT(); asm volatile("" ::: "memory");
}
__device__ __forceinline__ void transpose_item8b(const float* W, int K, int N, unsigned char* WT, int row_off, LAS unsigned* scr, int item, int lane) {
    const int nblk = N / 64, kb = item / nblk, nb = item % nblk, k0 = 128 * kb, n0 = 64 * nb;
    const int r4 = lane >> 4, l15 = lane & 15;
    f32x4 v[32];
#pragma unroll
    for (int i = 0; i < 32; ++i) v[i] = *(const __attribute__((address_space(1))) f32x4*)(W + (size_t)(k0 + 32 * r4 + i) * N + n0 + 4 * l15);
#pragma unroll
    for (int i4 = 0; i4 < 8; ++i4) {
        const f32x4 q0 = v[4 * i4] * W8S, q1 = v[4 * i4 + 1] * W8S, q2 = v[4 * i4 + 2] * W8S, q3 = v[4 * i4 + 3] * W8S;
        int a0 = 0, a1 = 0, a2 = 0, a3 = 0;
        a0 = __builtin_amdgcn_cvt_pk_fp8_f32(q0.x, q1.x, a0, false); a0 = __builtin_amdgcn_cvt_pk_fp8_f32(q2.x, q3.x, a0, true);
        a1 = __builtin_amdgcn_cvt_pk_fp8_f32(q0.y, q1.y, a1, false); a1 = __builtin_amdgcn_cvt_pk_fp8_f32(q2.y, q3.y, a1, true);
        a2 = __builtin_amdgcn_cvt_pk_fp8_f32(q0.z, q1.z, a2, false); a2 = __builtin_amdgcn_cvt_pk_fp8_f32(q2.z, q3.z, a2, true);
        a3 = __builtin_amdgcn_cvt_pk_fp8_f32(q0.w, q1.w, a3, false); a3 = __builtin_amdgcn_cvt_pk_fp8_f32(q2.w, q3.w, a3, true);
        LAS unsigned* rowp = scr + (8 * r4 + i4) * 64;
        rowp[(4 * l15 + 0 + r4) & 63] = (unsigned)a0; rowp[(4 * l15 + 1 + r4) & 63] = (unsigned)a1; rowp[(4 * l15 + 2 + r4) & 63] = (unsigned)a2; rowp[(4 * l15 + 3 + r4) & 63] = (unsigned)a3; }
    LDS_WAIT(); asm volatile("" ::: "memory");
    unsigned char* orow = WT + (size_t)(row_off + n0 + lane) * K + k0;
#pragma unroll
    for (int q = 0; q < 8; ++q) { v4u o;
        o.x = scr[(4 * q + 0) * 64 + ((lane + (q >> 1)) & 63)]; o.y = scr[(4 * q + 1) * 64 + ((lane + (q >> 1)) & 63)]; o.z = scr[(4 * q + 2) * 64 + ((lane + (q >> 1)) & 63)]; o.w = scr[(4 * q + 3) * 64 + ((lane + (q >> 1)) & 63)];
        *(__attribute__((address_space(1))) v4u*)(orow + 16 * q) = o; }
    LDS_WAIT(); asm volatile("" ::: "memory");
}
__device__ __forceinline__ void transpose_mat8b(const float* W, int K, int N, unsigned char* WT, int row_off, LAS unsigned* scr, int gw, int NGW, int lane, int& woff) {
    const int nit = (K / 128) * (N / 64);
    int sgw = gw - woff % NGW; if (sgw < 0) sgw += NGW;
    for (int it = sgw; it < nit; it += NGW) transpose_item8b(W, K, N, WT, row_off, scr, it, lane);
    woff += nit;
}
__device__ __forceinline__ void transpose_mat8(const float* W, int K, int N, unsigned char* WT, int row_off, LAS float* scr, int gw, int NGW, int lane) {
    const int nit = (K / 64) * (N / 32);
    for (int it = gw; it < nit; it += NGW) transpose_item8(W, K, N, WT, row_off, scr, it, lane);
}
__device__ __forceinline__ void transpose_mat(const float* W, int K, int N, bf16* WT, int row_off, LAS float* scr, int gw, int NGW, int lane) {
    const int nit = (K / 64) * (N / 32);
    for (int it = gw; it < nit; it += NGW) transpose_item(W, K, N, WT, row_off, scr, it, lane);
}
__device__ __forceinline__ void cvt_rows(const float* src, bf16* dst, size_t n, size_t gtid, size_t gthreads) {
    size_t i = gtid * 8;
    for (; i + 3 * gthreads * 8 < n; i += gthreads * 32) {
        f32x4 a[4], b[4];
#pragma unroll
        for (int u = 0; u < 4; ++u) { a[u] = *(const __attribute__((address_space(1))) f32x4*)(src + i + u * gthreads * 8); b[u] = *(const __attribute__((address_space(1))) f32x4*)(src + i + u * gthreads * 8 + 4); }
#pragma unroll
        for (int u = 0; u < 4; ++u) { v4u o; o.x = pk2(a[u].x, a[u].y); o.y = pk2(a[u].z, a[u].w); o.z = pk2(b[u].x, b[u].y); o.w = pk2(b[u].z, b[u].w);
            *(__attribute__((address_space(1))) v4u*)(dst + i + u * gthreads * 8) = o; }
    }
    for (; i < n; i += gthreads * 8) {
        const f32x4 a = *(const f32x4*)(src + i), b = *(const f32x4*)(src + i + 4);
        v4u o; o.x = pk2(a.x, a.y); o.y = pk2(a.z, a.w); o.z = pk2(b.x, b.y); o.w = pk2(b.z, b.w);
        *(v4u*)(dst + i) = o;
    }
}


#define GAS __attribute__((address_space(1)))
typedef unsigned char u8;
typedef float f32x2 __attribute__((ext_vector_type(2)));
constexpr float TU_SCALE = 64.f, TV_SCALE = 4.f;
__device__ __forceinline__ v4u gld16(const void* p) { return *(const GAS v4u*)p; }
__device__ __forceinline__ void cvt_rows_fp8(const float* src, u8* dst, size_t n, float scale, size_t gtid, size_t gthreads) {
    for (size_t i = gtid * 16; i < n; i += gthreads * 16) {
        const GAS f32x4* p = (const GAS f32x4*)(src + i);
        const f32x4 a = p[0] * scale, b = p[1] * scale, c = p[2] * scale, d = p[3] * scale;
        int w0 = 0, w1 = 0, w2 = 0, w3 = 0;
        w0 = __builtin_amdgcn_cvt_pk_fp8_f32(a.x, a.y, w0, false); w0 = __builtin_amdgcn_cvt_pk_fp8_f32(a.z, a.w, w0, true);
        w1 = __builtin_amdgcn_cvt_pk_fp8_f32(b.x, b.y, w1, false); w1 = __builtin_amdgcn_cvt_pk_fp8_f32(b.z, b.w, w1, true);
        w2 = __builtin_amdgcn_cvt_pk_fp8_f32(c.x, c.y, w2, false); w2 = __builtin_amdgcn_cvt_pk_fp8_f32(c.z, c.w, w2, true);
        w3 = __builtin_amdgcn_cvt_pk_fp8_f32(d.x, d.y, w3, false); w3 = __builtin_amdgcn_cvt_pk_fp8_f32(d.z, d.w, w3, true);
        v4u o; o.x = (unsigned)w0; o.y = (unsigned)w1; o.z = (unsigned)w2; o.w = (unsigned)w3;
        *(GAS v4u*)(dst + i) = o;
    }
}

template <bool X4 = false>
__device__ __forceinline__ void ln_phase(bf16* S, const float* g, const float* b, int gw, int NGW, int lane, unsigned char* f8 = nullptr, unsigned char* f8b = nullptr, float* stats = nullptr) {
    for (int m = gw; m < M; m += NGW) {
        bf16* row = S + (size_t)m * D + 8 * lane;
        float v[32]; float s = 0.f;
#pragma unroll
        for (int j = 0; j < 4; ++j) { const v4u w = *(const GAS v4u*)(row + 512 * j);
            v[8 * j + 0] = bflo(w.x); v[8 * j + 1] = bfhi(w.x); v[8 * j + 2] = bflo(w.y); v[8 * j + 3] = bfhi(w.y); v[8 * j + 4] = bflo(w.z); v[8 * j + 5] = bfhi(w.z); v[8 * j + 6] = bflo(w.w); v[8 * j + 7] = bfhi(w.w); }
#pragma unroll
        for (int i = 0; i < 32; ++i) s += v[i];
        const float mean = wave_sum(s) * (1.f / D); float s2 = 0.f;
#pragma unroll
        for (int i = 0; i < 32; ++i) { v[i] -= mean; s2 += v[i] * v[i]; }
        const float rstd = 1.f / sqrtf(wave_sum(s2) * (1.f / D) + LN_EPS);
        if constexpr (X4) { if (lane == 0) *(GAS f32x2*)(stats + 2 * (size_t)m) = (f32x2){mean, rstd}; }
#pragma unroll
        for (int j = 0; j < 4; ++j) { const float* gp = g + 512 * j + 8 * lane; const float* bp = b + 512 * j + 8 * lane;
            const f32x4 g0 = *(const GAS f32x4*)gp, g1 = *(const GAS f32x4*)(gp + 4), b0 = *(const GAS f32x4*)bp, b1 = *(const GAS f32x4*)(bp + 4);
            v4u w; w.x = pk2(v[8 * j + 0] * rstd * g0.x + b0.x, v[8 * j + 1] * rstd * g0.y + b0.y); w.y = pk2(v[8 * j + 2] * rstd * g0.z + b0.z, v[8 * j + 3] * rstd * g0.w + b0.w);
            w.z = pk2(v[8 * j + 4] * rstd * g1.x + b1.x, v[8 * j + 5] * rstd * g1.y + b1.y); w.w = pk2(v[8 * j + 6] * rstd * g1.z + b1.z, v[8 * j + 7] * rstd * g1.w + b1.w);
            if constexpr (!X4) *(GAS v4u*)(row + 512 * j) = w;
            if constexpr (X4) {
                const float y0 = v[8 * j + 0] * rstd * g0.x + b0.x, y1 = v[8 * j + 1] * rstd * g0.y + b0.y, y2 = v[8 * j + 2] * rstd * g0.z + b0.z, y3 = v[8 * j + 3] * rstd * g0.w + b0.w;
                const float y4 = v[8 * j + 4] * rstd * g1.x + b1.x, y5 = v[8 * j + 5] * rstd * g1.y + b1.y, y6 = v[8 * j + 6] * rstd * g1.z + b1.z, y7 = v[8 * j + 7] * rstd * g1.w + b1.w;
                unsigned wh = 0u; wh = __builtin_amdgcn_cvt_scalef32_pk_fp4_f32(wh, y0, y1, 1.0f, 0); wh = __builtin_amdgcn_cvt_scalef32_pk_fp4_f32(wh, y2, y3, 1.0f, 1);
                wh = __builtin_amdgcn_cvt_scalef32_pk_fp4_f32(wh, y4, y5, 1.0f, 2); wh = __builtin_amdgcn_cvt_scalef32_pk_fp4_f32(wh, y6, y7, 1.0f, 3);
                const f32x2 h01 = __builtin_amdgcn_cvt_scalef32_pk_f32_fp4(wh, 1.0f, 0), h23 = __builtin_amdgcn_cvt_scalef32_pk_f32_fp4(wh, 1.0f, 1), h45 = __builtin_amdgcn_cvt_scalef32_pk_f32_fp4(wh, 1.0f, 2), h67 = __builtin_amdgcn_cvt_scalef32_pk_f32_fp4(wh, 1.0f, 3);
                unsigned wl = 0u; wl = __builtin_amdgcn_cvt_scalef32_pk_fp4_f32(wl, (y0 - h01.x) * 8.f, (y1 - h01.y) * 8.f, 1.0f, 0); wl = __builtin_amdgcn_cvt_scalef32_pk_fp4_f32(wl, (y2 - h23.x) * 8.f, (y3 - h23.y) * 8.f, 1.0f, 1);
                wl = __builtin_amdgcn_cvt_scalef32_pk_fp4_f32(wl, (y4 - h45.x) * 8.f, (y5 - h45.y) * 8.f, 1.0f, 2); wl = __builtin_amdgcn_cvt_scalef32_pk_fp4_f32(wl, (y6 - h67.x) * 8.f, (y7 - h67.y) * 8.f, 1.0f, 3);
                unsigned char* xq = f8 + (size_t)m * 2048 + 256 * j + 4 * lane;
                *(GAS unsigned*)xq = wh; *(GAS unsigned*)(xq + 1024) = wl;
                int a8 = 0, b8 = 0;
                a8 = __builtin_amdgcn_cvt_pk_fp8_f32(y0, y1, a8, false); a8 = __builtin_amdgcn_cvt_pk_fp8_f32(y2, y3, a8, true);
                b8 = __builtin_amdgcn_cvt_pk_fp8_f32(y4, y5, b8, false); b8 = __builtin_amdgcn_cvt_pk_fp8_f32(y6, y7, b8, true);
                v2u o8; o8.x = (unsigned)a8; o8.y = (unsigned)b8; *(GAS v2u*)(f8b + (size_t)m * D + 512 * j + 8 * lane) = o8; }
            else if (f8 != nullptr) { int a8 = 0, b8 = 0;
                a8 = __builtin_amdgcn_cvt_pk_fp8_f32(v[8 * j + 0] * rstd * g0.x + b0.x, v[8 * j + 1] * rstd * g0.y + b0.y, a8, false); a8 = __builtin_amdgcn_cvt_pk_fp8_f32(v[8 * j + 2] * rstd * g0.z + b0.z, v[8 * j + 3] * rstd * g0.w + b0.w, a8, true);
                b8 = __builtin_amdgcn_cvt_pk_fp8_f32(v[8 * j + 4] * rstd * g1.x + b1.x, v[8 * j + 5] * rstd * g1.y + b1.y, b8, false); b8 = __builtin_amdgcn_cvt_pk_fp8_f32(v[8 * j + 6] * rstd * g1.z + b1.z, v[8 * j + 7] * rstd * g1.w + b1.w, b8, true);
                v2u o8; o8.x = (unsigned)a8; o8.y = (unsigned)b8; *(GAS v2u*)(f8 + (size_t)m * D + 512 * j + 8 * lane) = o8; } }
    }
}

__device__ __forceinline__ void pool_phase(const bf16* U, unsigned char* P, int gw, int NGW, int lane) {
    for (int it = gw; it < (M / 64) * 4; it += NGW) {
        const int g = it & 3, t0 = (it >> 2) * 64, w = 2 << g, col = g * 512 + 8 * lane;
        const int s0 = t0 & (SEQ - 1);
        float a[8];
#pragma unroll
        for (int i = 0; i < 8; ++i) a[i] = 0.f;
        const bf16* base = U + (size_t)t0 * D + col;
        const int nb = (s0 < w - 1) ? s0 : (w - 1);
        for (int r = 1; r <= nb; ++r) { const v4u x = *(const GAS v4u*)(base - (size_t)r * D);
            a[0] += bflo(x.x); a[1] += bfhi(x.x); a[2] += bflo(x.y); a[3] += bfhi(x.y); a[4] += bflo(x.z); a[5] += bfhi(x.z); a[6] += bflo(x.w); a[7] += bfhi(x.w); }
#pragma unroll 4
        for (int t = 0; t < 64; ++t) {
            const int s = s0 + t;
            const v4u cur = *(const GAS v4u*)(base + (size_t)t * D);
            a[0] += bflo(cur.x); a[1] += bfhi(cur.x); a[2] += bflo(cur.y); a[3] += bfhi(cur.y); a[4] += bflo(cur.z); a[5] += bfhi(cur.z); a[6] += bflo(cur.w); a[7] += bfhi(cur.w);
            const int n = (s + 1 < w) ? (s + 1) : w;
            const float inv = 1.f / (float)n;
            int w0 = 0, w1 = 0;
            w0 = __builtin_amdgcn_cvt_pk_fp8_f32(a[0] * inv - bflo(cur.x), a[1] * inv - bfhi(cur.x), w0, false); w0 = __builtin_amdgcn_cvt_pk_fp8_f32(a[2] * inv - bflo(cur.y), a[3] * inv - bfhi(cur.y), w0, true);
            w1 = __builtin_amdgcn_cvt_pk_fp8_f32(a[4] * inv - bflo(cur.z), a[5] * inv - bfhi(cur.z), w1, false); w1 = __builtin_amdgcn_cvt_pk_fp8_f32(a[6] * inv - bflo(cur.w), a[7] * inv - bfhi(cur.w), w1, true);
            v2u o; o.x = (unsigned)w0; o.y = (unsigned)w1;
            *(GAS v2u*)(P + (size_t)(t0 + t) * D + col) = o;
            if (s + 1 >= w) { const v4u x = *(const GAS v4u*)(base + (size_t)(t + 1 - w) * D);
                a[0] -= bflo(x.x); a[1] -= bfhi(x.x); a[2] -= bflo(x.y); a[3] -= bfhi(x.y); a[4] -= bflo(x.z); a[5] -= bfhi(x.z); a[6] -= bflo(x.w); a[7] -= bfhi(x.w); }
        }
    }
}

typedef __bf16 bf16x2v __attribute__((ext_vector_type(2)));
__device__ __forceinline__ unsigned cvtpk(float lo, float hi) { const f32x2 v = {lo, hi}; return __builtin_bit_cast(unsigned, __builtin_convertvector(v, bf16x2v)); }
constexpr int SSM_L = 1856, SSM_L3 = SEQ - 3 * SSM_L;
static_assert(SSM_L % 64 == 0 && SSM_L3 % 64 == 0 && SSM_L3 > 0, "segments");
template <bool WR>
__device__ __forceinline__ void ssm_block16m(const bf16x8 ua, const bf16x8 (&BbR)[4], const bf16x8 (&BbI)[4], LAS unsigned char* bubuf, LAS unsigned char* hbuf, const f32x2 ar2, const f32x2 ai2, f32x2& h2, int p, int lane) {
    f32x4 dr[4], di[4];
    const f32x4 z = {0.f, 0.f, 0.f, 0.f};
    __builtin_amdgcn_sched_barrier(0);
    asm volatile("s_nop 15\n\ts_nop 15\n\ts_nop 15\n\ts_nop 15" ::: "memory");
    __builtin_amdgcn_sched_barrier(0);
#pragma unroll
    for (int pt = 0; pt < 4; ++pt) { dr[pt] = __builtin_amdgcn_mfma_f32_16x16x32_bf16(ua, BbR[pt], z, 0, 0, 0); di[pt] = __builtin_amdgcn_mfma_f32_16x16x32_bf16(ua, BbI[pt], z, 0, 0, 0); }
    __builtin_amdgcn_sched_barrier(0);
    asm volatile("s_nop 15\n\ts_nop 15\n\ts_nop 15\n\ts_nop 15\n\ts_nop 15\n\ts_nop 15\n\ts_nop 15\n\ts_nop 15" ::: "memory");
    __builtin_amdgcn_sched_barrier(0);
#pragma unroll
    for (int pt = 0; pt < 4; ++pt)
#pragma unroll
        for (int r = 0; r < 4; ++r) *(LAS f32x2*)(bubuf + (4 * (lane >> 4) + r) * 528 + (16 * pt + (lane & 15)) * 8) = (f32x2){dr[pt][r], di[pt][r]};
    LDS_WAIT();
#pragma unroll
    for (int l = 0; l < 16; ++l) {
        const f32x2 bu = *(const LAS f32x2*)(bubuf + l * 528 + p * 8);
        float tx, ty, nx, ny; const float hx = h2.x, hy = h2.y, bux = bu.x, buy = bu.y, arx = ar2.x, aix = ai2.x, aiy = ai2.y;
        asm("v_fma_f32 %0, %1, %2, %3" : "=v"(tx) : "v"(arx), "v"(hx), "v"(bux));
        asm("v_fma_f32 %0, %1, %2, %3" : "=v"(ty) : "v"(arx), "v"(hy), "v"(buy));
        asm("v_fma_f32 %0, %1, %2, %3" : "=v"(nx) : "v"(aix), "v"(hy), "v"(tx));
        asm("v_fma_f32 %0, %1, %2, %3" : "=v"(ny) : "v"(aiy), "v"(hx), "v"(ty));
        h2 = (f32x2){nx, ny};
        if (WR) *(LAS unsigned*)(hbuf + l * 272 + 4 * p) = cvtpk(h2.x, h2.y);
    }
}
__device__ __forceinline__ void ssm_phase_m(const bf16* U, unsigned char* Y, const float* ssmp,
                                          const float* c_re, const float* c_im, const float* d_skip, LAS unsigned char* lds, int vcu, int G, int wave, int lane) {
    LAS unsigned char* hbuf = lds + wave * 16384;
    LAS unsigned char* ebuf = lds + wave * 16384 + 4352;
    LAS unsigned char* bubuf = lds + wave * 16384 + 4864;
    const int ntask = BATCH * 128 * 4;
    for (int tb = vcu * NWAVES; tb < ntask; tb += G * NWAVES) {
        const int task = tb + wave, seg = (wave + 3 * (wave >> 2)) & 3, g = (task >> 2) & 127, b = task >> 9, p = lane;
        const float* pp_ = ssmp + (size_t)(g * 64 + p) * 34;
        const float ar = pp_[0], ai = pp_[1];
        const int cc = lane & 15, kg = lane >> 4;
        bf16x8 BbR[4], BbI[4];
#pragma unroll
        for (int pt = 0; pt < 4; ++pt) { const float* q_ = ssmp + (size_t)(g * 64 + 16 * pt + cc) * 34 + 8 * (kg & 1);
            v4u tr, ti; tr.x = cvtpk(q_[2], q_[3]); tr.y = cvtpk(q_[4], q_[5]); tr.z = cvtpk(q_[6], q_[7]); tr.w = cvtpk(q_[8], q_[9]);
            ti.x = cvtpk(q_[18], q_[19]); ti.y = cvtpk(q_[20], q_[21]); ti.z = cvtpk(q_[22], q_[23]); ti.w = cvtpk(q_[24], q_[25]);
            if (kg >= 2) { tr = (v4u){0u, 0u, 0u, 0u}; ti = (v4u){0u, 0u, 0u, 0u}; }
            BbR[pt] = __builtin_bit_cast(bf16x8, tr); BbI[pt] = __builtin_bit_cast(bf16x8, ti); }
        const int tstart = seg * SSM_L, tlen = (seg == 3) ? SSM_L3 : SSM_L;
        const bf16* ub = U + ((size_t)b * SEQ + tstart) * D + g * 16;
        const bf16* ua_p = ub + (size_t)(lane & 15) * D + 8 * (kg & 1);
        unsigned char* yb = Y + ((size_t)b * SEQ + tstart) * D + g * 16;
        const f32x2 ar2 = {ar, ar}, ai2 = {-ai, ai};
        f32x2 h2 = {0.f, 0.f};
        const v4u zero4 = {0u, 0u, 0u, 0u};
        if (seg < 3) {
            v4u pre[4];
#pragma unroll
            for (int i = 0; i < 4; ++i) pre[i] = *(const GAS v4u*)(ua_p + (size_t)(16 * i) * D);
            for (int t0 = 0; t0 < SSM_L; t0 += 64) {
                v4u cur[4];
#pragma unroll
                for (int i = 0; i < 4; ++i) cur[i] = (kg < 2) ? pre[i] : zero4;
                if (t0 + 64 < SSM_L) {
#pragma unroll
                    for (int i = 0; i < 4; ++i) pre[i] = *(const GAS v4u*)(ua_p + (size_t)(t0 + 64 + 16 * i) * D); }
#pragma unroll
                for (int blk = 0; blk < 4; ++blk) { ssm_block16m<false>(__builtin_bit_cast(bf16x8, cur[blk]), BbR, BbI, bubuf, hbuf, ar2, ai2, h2, p, lane); LDS_WAIT(); }
            }
            *(LAS f32x2*)(ebuf + 8 * p) = h2;
        }
        LDS_WAIT();
        __syncthreads();
        {
            f32x2 pw = {1.f, 0.f}, base = {ar, ai};
#pragma unroll 1
            for (int bit = SSM_L; bit > 0; bit >>= 1) {
                if (bit & 1) pw = (f32x2){pw.x * base.x - pw.y * base.y, pw.x * base.y + pw.y * base.x};
                base = (f32x2){base.x * base.x - base.y * base.y, 2.f * base.x * base.y};
            }
            LAS unsigned char* e0 = lds + (wave & 4) * 16384 + 4352;
            f32x2 sst = {0.f, 0.f};
            for (int j = 0; j < seg; ++j) { const f32x2 e = *(const LAS f32x2*)(e0 + ((j + (wave >> 2)) & 3) * 16384 + 8 * p);
                sst = (f32x2){pw.x * sst.x - pw.y * sst.y + e.x, pw.x * sst.y + pw.y * sst.x + e.y}; }
            h2 = sst;
        }
        bf16x8 cB[4];
#pragma unroll
        for (int ks = 0; ks < 4; ++ks) { unsigned w[4];
#pragma unroll
            for (int jj = 0; jj < 4; ++jj) { const int k = 32 * ks + 8 * (lane >> 4) + 2 * jj, pp = k >> 1;
                w[jj] = cvtpk(c_re[(g * 16 + cc) * 64 + pp], -c_im[(g * 16 + cc) * 64 + pp]); }
            v4u t; t.x = w[0]; t.y = w[1]; t.z = w[2]; t.w = w[3]; cB[ks] = __builtin_bit_cast(bf16x8, t); }
        const float dd = d_skip[g * 16 + cc];
        {
            v4u pre[4];
#pragma unroll
            for (int i = 0; i < 4; ++i) pre[i] = *(const GAS v4u*)(ua_p + (size_t)(16 * i) * D);
            for (int t0 = 0; t0 < tlen; t0 += 64) {
                v4u cur[4];
#pragma unroll
                for (int i = 0; i < 4; ++i) cur[i] = (kg < 2) ? pre[i] : zero4;
                if (t0 + 64 < tlen) {
#pragma unroll
                    for (int i = 0; i < 4; ++i) pre[i] = *(const GAS v4u*)(ua_p + (size_t)(t0 + 64 + 16 * i) * D); }
#pragma unroll
                for (int blk = 0; blk < 4; ++blk) {
                    unsigned short uq[4];
#pragma unroll
                    for (int r = 0; r < 4; ++r) uq[r] = *(const GAS unsigned short*)(ub + (size_t)(t0 + 16 * blk + 4 * (lane >> 4) + r) * D + cc);
                    ssm_block16m<true>(__builtin_bit_cast(bf16x8, cur[blk]), BbR, BbI, bubuf, hbuf, ar2, ai2, h2, p, lane);
                    LDS_WAIT();
                    f32x4 acc = (f32x4){0.f, 0.f, 0.f, 0.f};
#pragma unroll
                    for (int ks = 0; ks < 4; ++ks) { const bf16x8 a = *(const LAS bf16x8*)(hbuf + (lane & 15) * 272 + 16 * (lane >> 4) + 64 * ks);
                        acc = __builtin_amdgcn_mfma_f32_16x16x32_bf16(a, cB[ks], acc, 0, 0, 0); }
#pragma unroll
                    for (int r = 0; r < 4; ++r) { const int l = 4 * (lane >> 4) + r;
                        const float uu = __builtin_bit_cast(float, (unsigned)uq[r] << 16);
                        const float y = acc[r] + dd * uu;
                        *(GAS unsigned char*)(yb + (size_t)(t0 + 16 * blk + l) * D + cc) = (unsigned char)(__builtin_amdgcn_cvt_pk_fp8_f32(gelu_f(y), 0.f, 0, false) & 0xff); }
                    LDS_WAIT();
                }
            }
        }
        __syncthreads();
    }
}

__device__ __forceinline__ void attn_tile(const bf16* Kbh, const bf16* Vbh, const LAS float* rbh, int kp0, bool has_next, int qpos, int hl, int lane,
                                          const bf16x8 (&kc)[8], bf16x8 (&kn)[8], const bf16x8 (&qf)[8], f32x16 (&o)[4], float& mrun, float& lrun) {
    bf16x8 vf[8];
    { const bf16* vp = Vbh + (size_t)(kp0 >> 5) * 4096 + (size_t)lane * 8;
#pragma unroll
      for (int q = 0; q < 8; ++q) vf[q] = *(const GAS bf16x8*)(vp + 512 * q); }
    if (has_next) { const bf16* kp = Kbh + (size_t)((kp0 >> 5) + 1) * 4096 + (size_t)lane * 8;
#pragma unroll
      for (int ks = 0; ks < 8; ++ks) kn[ks] = *(const GAS bf16x8*)(kp + 512 * ks); }
    __builtin_amdgcn_sched_barrier(0);
    f32x16 s;
#pragma unroll
    for (int i = 0; i < 16; ++i) s[i] = 0.f;
#pragma unroll
    for (int ks = 0; ks < 8; ++ks) s = __builtin_amdgcn_mfma_f32_32x32x16_bf16(kc[ks], qf[ks], s, 0, 0, 0);
    float tmax = -1e30f;
#pragma unroll
    for (int i = 0; i < 16; ++i) { const int kpos = kp0 + (i & 3) + 8 * (i >> 2) + 4 * hl; int rel = qpos - kpos; rel = rel > 128 ? 128 : rel; s[i] += rbh[rel + 128]; tmax = fmaxf(tmax, s[i]); }
    tmax = fmaxf(tmax, SHFL_XOR(tmax, 32));
    const float mnew = fmaxf(mrun, tmax), alpha = __builtin_amdgcn_exp2f(mrun - mnew);
    float rs = 0.f;
#pragma unroll
    for (int i = 0; i < 16; ++i) { s[i] = __builtin_amdgcn_exp2f(s[i] - mnew); rs += s[i]; }
    rs += SHFL_XOR(rs, 32);
    lrun = lrun * alpha + rs; mrun = mnew;
    bf16x8 pf[2];
#pragma unroll
    for (int sidx = 0; sidx < 2; ++sidx) { v4u t; t.x = cvtpk(s[8 * sidx + 0], s[8 * sidx + 1]); t.y = cvtpk(s[8 * sidx + 2], s[8 * sidx + 3]);
        t.z = cvtpk(s[8 * sidx + 4], s[8 * sidx + 5]); t.w = cvtpk(s[8 * sidx + 6], s[8 * sidx + 7]); pf[sidx] = __builtin_bit_cast(bf16x8, t); }
#pragma unroll
    for (int dt = 0; dt < 4; ++dt) {
#pragma unroll
        for (int i = 0; i < 16; ++i) o[dt][i] *= alpha;
#pragma unroll
        for (int sidx = 0; sidx < 2; ++sidx) o[dt] = __builtin_amdgcn_mfma_f32_32x32x16_bf16(vf[2 * dt + sidx], pf[sidx], o[dt], 0, 0, 0);
    }
}
__device__ __forceinline__ void attn_phase(const bf16* QO, const bf16* Kb, const bf16* VT, unsigned char* O8, const LAS float* rb, int gw, int NGW, int lane) {
    const int r32 = lane & 31, hl = lane >> 5;
    for (int task = gw; task < BATCH * 16 * 128 * 2; task += NGW) {
        const int half = task & 1, c = (task >> 1) & 127, h = (task >> 8) & 15, b = task >> 12;
        const int qpos = 64 * c + 32 * half + r32;
        const size_t qrow = (size_t)b * SEQ + qpos;
        bf16x8 qf[8];
        const size_t bh256 = (size_t)(b * 16 + h) * 256;
        { const bf16* qt = QO + ((bh256 + 2 * c + half) * 8) * 512 + (size_t)lane * 8;
#pragma unroll
          for (int ks = 0; ks < 8; ++ks) qf[ks] = *(const GAS bf16x8*)(qt + ks * 512); }
        f32x16 o[4];
#pragma unroll
        for (int dt = 0; dt < 4; ++dt)
#pragma unroll
            for (int i = 0; i < 16; ++i) o[dt][i] = 0.f;
        float mrun = -1e30f, lrun = 0.f;
        const LAS float* rbh = rb + h * 257;
        const bf16* Kbh = Kb + bh256 * 4096; const bf16* Vbh = VT + bh256 * 4096;
        int kt0 = 16 - 2 * c; if (kt0 < 0) kt0 = 0;
        bf16x8 kA[8], kB[8];
        { const bf16* kp = Kbh + (size_t)((64 * c - 512 + 32 * kt0) >> 5) * 4096 + (size_t)lane * 8;
#pragma unroll
          for (int ks = 0; ks < 8; ++ks) kA[ks] = *(const GAS bf16x8*)(kp + 512 * ks); }
        for (int kt = kt0; kt < 18; kt += 2) {
            const int kp0 = 64 * c - 512 + 32 * kt;
            attn_tile(Kbh, Vbh, rbh, kp0, true, qpos, hl, lane, kA, kB, qf, o, mrun, lrun);
            attn_tile(Kbh, Vbh, rbh, kp0 + 32, kt + 2 < 18, qpos, hl, lane, kB, kA, qf, o, mrun, lrun);
        }
        const float inv = O8S / lrun;
        unsigned char* op = O8 + qrow * D + h * 128 + 4 * hl;
#pragma unroll
        for (int dt = 0; dt < 4; ++dt)
#pragma unroll
            for (int rq = 0; rq < 4; ++rq) { int w = 0; w = __builtin_amdgcn_cvt_pk_fp8_f32(o[dt][4 * rq + 0] * inv, o[dt][4 * rq + 1] * inv, w, false); w = __builtin_amdgcn_cvt_pk_fp8_f32(o[dt][4 * rq + 2] * inv, o[dt][4 * rq + 3] * inv, w, true);
                *(int*)(op + 32 * dt + 8 * rq) = w; }
    }
}

__device__ __forceinline__ void attn_a_qk(f32x16& s, const bf16x8 (&kc)[8], const bf16x8 (&qh)[8]) {
#pragma unroll
    for (int i = 0; i < 16; ++i) s[i] = 0.f;
#pragma unroll
    for (int ks = 0; ks < 8; ++ks) s = __builtin_amdgcn_mfma_f32_32x32x16_bf16(kc[ks], qh[ks], s, 0, 0, 0);
}
__device__ __forceinline__ void attn_a_half(f32x16& s, const LAS float* rbh, int kp0, int qbase, int r32, int hl, int lane, float& mrun, float& lrun, LAS unsigned char* pw, LAS float* aw) {
    const int qpos = qbase + r32; float tmax = -1e30f;
    if (qbase - (kp0 + 31) >= 128) { const float cb = rbh[256];
#pragma unroll
        for (int i = 0; i < 16; ++i) { s[i] += cb; tmax = fmaxf(tmax, s[i]); } }
    else {
#pragma unroll
        for (int i = 0; i < 16; ++i) { const int kpos = kp0 + (i & 3) + 8 * (i >> 2) + 4 * hl; int rel = qpos - kpos; rel = rel > 128 ? 128 : rel; s[i] += rbh[rel + 128]; tmax = fmaxf(tmax, s[i]); } }
    tmax = fmaxf(tmax, SHFL_XOR(tmax, 32));
    const float mnew = fmaxf(mrun, tmax), alpha = __builtin_amdgcn_exp2f(mrun - mnew);
    float rs = 0.f;
#pragma unroll
    for (int i = 0; i < 16; ++i) { s[i] = __builtin_amdgcn_exp2f(s[i] - mnew); rs += s[i]; }
    rs += SHFL_XOR(rs, 32);
    lrun = lrun * alpha + rs; mrun = mnew;
    v4u t0, t1; t0.x = cvtpk(s[0], s[1]); t0.y = cvtpk(s[2], s[3]); t0.z = cvtpk(s[4], s[5]); t0.w = cvtpk(s[6], s[7]);
    t1.x = cvtpk(s[8], s[9]); t1.y = cvtpk(s[10], s[11]); t1.z = cvtpk(s[12], s[13]); t1.w = cvtpk(s[14], s[15]);
    *(LAS v4u*)pw = t0; *(LAS v4u*)(pw + 16) = t1; *aw = alpha;
}
__device__ __forceinline__ void attn_b_half(const bf16x8 (&vc)[8], f32x16 (&oh)[4], const LAS unsigned char* pr, const LAS float* ar) {
    const v4u p0 = *(const LAS v4u*)pr, p1 = *(const LAS v4u*)(pr + 16); const float al = *ar;
    const bf16x8 pf0 = __builtin_bit_cast(bf16x8, p0), pf1 = __builtin_bit_cast(bf16x8, p1);
#pragma unroll
    for (int dt = 0; dt < 4; ++dt) {
#pragma unroll
        for (int i = 0; i < 16; ++i) oh[dt][i] *= al;
        oh[dt] = __builtin_amdgcn_mfma_f32_32x32x16_bf16(vc[2 * dt], pf0, oh[dt], 0, 0, 0); oh[dt] = __builtin_amdgcn_mfma_f32_32x32x16_bf16(vc[2 * dt + 1], pf1, oh[dt], 0, 0, 0); }
}
__device__ __forceinline__ void attn_ld8(bf16x8 (&d)[8], const bf16* p) {
#pragma unroll
    for (int q = 0; q < 8; ++q) d[q] = *(const GAS bf16x8*)(p + 512 * q);
}
__device__ __forceinline__ void attn_phase_split(const bf16* QO, const bf16* Kb, const bf16* VT, unsigned char* O8, const LAS float* rb, LAS unsigned char* xch, int vcu, int G, int wave, int lane) {
    const int r32 = lane & 31, hl = lane >> 5;
    const int pr = wave & 3, role = wave >> 2;
    LAS unsigned char* xp = xch + pr * 9728;
    LAS unsigned char* pl = xp + lane * 32; LAS float* al = (LAS float*)(xp + 8192) + lane;
    for (int batch = vcu; batch < BATCH * 16 * 128 * 2 / 8; batch += G) {
        const int T0 = batch * 8, c0 = (T0 >> 1) & 127, h = (T0 >> 8) & 15, b = T0 >> 12, c = c0 + pr;
        const size_t bh256 = (size_t)(b * 16 + h) * 256;
        const bf16* Kl = Kb + bh256 * 4096 + (size_t)lane * 8; const bf16* Vl = VT + bh256 * 4096 + (size_t)lane * 8;
        const LAS float* rbh = rb + h * 257;
        int kt0 = 16 - 2 * c; if (kt0 < 0) kt0 = 0;
        const int kbase = 64 * c - 512, tb = kbase >> 5;
        if (role == 0) {
            bf16x8 q0[8], q1[8];
            attn_ld8(q0, QO + ((bh256 + 2 * c + 0) * 8) * 512 + (size_t)lane * 8); attn_ld8(q1, QO + ((bh256 + 2 * c + 1) * 8) * 512 + (size_t)lane * 8);
            float mrun0 = -1e30f, mrun1 = -1e30f, lrun0 = 0.f, lrun1 = 0.f;
            bf16x8 kc[8];
            attn_ld8(kc, Kl + (size_t)(tb + kt0) * 4096);
            for (int t = 0; t < 18; ++t) {
                if (t >= kt0) { f32x16 s0, s1;
                    attn_a_qk(s0, kc, q0); attn_a_qk(s1, kc, q1);
                    __builtin_amdgcn_sched_barrier(0);
                    if (t + 1 < 18) attn_ld8(kc, Kl + (size_t)(tb + t + 1) * 4096);
                    __builtin_amdgcn_sched_barrier(0);
                    const int so = (t & 1) * 4096, ao = (t & 1) * 128;
                    attn_a_half(s0, rbh, kbase + 32 * t, 64 * c, r32, hl, lane, mrun0, lrun0, pl + so, al + ao);
                    attn_a_half(s1, rbh, kbase + 32 * t, 64 * c + 32, r32, hl, lane, mrun1, lrun1, pl + so + 2048, al + ao + 64); }
                if (t == 17) { *(LAS float*)(xp + 9216 + lane * 4) = lrun0; *(LAS float*)(xp + 9216 + 256 + lane * 4) = lrun1; }
                LDS_WAIT(); __syncthreads();
            }
            __syncthreads();
        } else {
            f32x16 oA[4], oB[4];
#pragma unroll
            for (int dt = 0; dt < 4; ++dt)
#pragma unroll
                for (int i = 0; i < 16; ++i) { oA[dt][i] = 0.f; oB[dt][i] = 0.f; }
            bf16x8 vc[8];
            attn_ld8(vc, Vl + (size_t)(tb + kt0) * 4096);
            __syncthreads();
            for (int t = 0; t < 18; ++t) {
                if (t >= kt0) { const int so = (t & 1) * 4096, ao = (t & 1) * 128;
                    attn_b_half(vc, oA, pl + so, al + ao); attn_b_half(vc, oB, pl + so + 2048, al + ao + 64);
                    __builtin_amdgcn_sched_barrier(0);
                    if (t + 1 < 18) attn_ld8(vc, Vl + (size_t)(tb + t + 1) * 4096); }
                LDS_WAIT(); __syncthreads();
            }
            {   const float lf0 = *(const LAS float*)(xp + 9216 + lane * 4), lf1 = *(const LAS float*)(xp + 9216 + 256 + lane * 4);
                const float inv0 = O8S / lf0, inv1 = O8S / lf1;
                unsigned char* op0 = O8 + ((size_t)b * SEQ + 64 * c + r32) * D + h * 128 + 4 * hl; unsigned char* op1 = op0 + (size_t)32 * D;
#pragma unroll
                for (int dt = 0; dt < 4; ++dt)
#pragma unroll
                    for (int rq = 0; rq < 4; ++rq) { int w = 0; w = __builtin_amdgcn_cvt_pk_fp8_f32(oA[dt][4 * rq + 0] * inv0, oA[dt][4 * rq + 1] * inv0, w, false); w = __builtin_amdgcn_cvt_pk_fp8_f32(oA[dt][4 * rq + 2] * inv0, oA[dt][4 * rq + 3] * inv0, w, true);
                        *(int*)(op0 + 32 * dt + 8 * rq) = w;
                        int w2 = 0; w2 = __builtin_amdgcn_cvt_pk_fp8_f32(oB[dt][4 * rq + 0] * inv1, oB[dt][4 * rq + 1] * inv1, w2, false); w2 = __builtin_amdgcn_cvt_pk_fp8_f32(oB[dt][4 * rq + 2] * inv1, oB[dt][4 * rq + 3] * inv1, w2, true);
                        *(int*)(op1 + 32 * dt + 8 * rq) = w2; }
            }
        }
        __syncthreads();
    }
}

#define INS16(L, x) do { _Pragma("unroll") for (int _j = 15; _j >= 1; --_j) L[_j] = __builtin_amdgcn_fmed3f(L[_j - 1], L[_j], (x)); L[0] = fmaxf(L[0], (x)); } while (0)
__device__ __forceinline__ void peer_select_phase(const bf16* Q, const LAS unsigned char* skl  , int* idx_out, float* gate_out, int gw, int NGW, int lane) {
    const int r = lane & 31, half = lane >> 5;
    for (int it = gw; it < M / 4; it += NGW) {
        const int t = 4 * it + (r >> 3), hh = r & 7;
        float L[2][16];
#pragma unroll
        for (int s = 0; s < 2; ++s) {
#pragma unroll
            for (int j = 0; j < 16; ++j) L[s][j] = -3.0e38f;
            bf16x8 qf[8];
            const bf16* qp = Q + (size_t)t * D + hh * 256 + s * 128 + 8 * half;
#pragma unroll
            for (int ks = 0; ks < 8; ++ks) qf[ks] = *(const bf16x8*)(qp + 16 * ks);
#pragma unroll 1
            for (int nt = 0; nt < 4; ++nt) {
                f32x16 sc;
#pragma unroll
                for (int i = 0; i < 16; ++i) sc[i] = 0.f;
                const LAS unsigned char* kp = skl + (size_t)(s * 128 + 32 * nt + r) * 272 + 16 * half;
#pragma unroll
                for (int ks = 0; ks < 8; ++ks) { const bf16x8 kf = *(const LAS bf16x8*)(kp + 32 * ks); sc = __builtin_amdgcn_mfma_f32_32x32x16_bf16(kf, qf[ks], sc, 0, 0, 0); }
#pragma unroll
                for (int i = 0; i < 16; ++i) { const unsigned n = 32 * nt + (i & 3) + 8 * (i >> 2) + 4 * half;
                    const float sv = sc[i];
                    const float x = __builtin_bit_cast(float, (__builtin_bit_cast(unsigned, sv) & ~127u) | n);
                    INS16(L[s], x); }
            }
        }
        float mine[16], oth[16];
#pragma unroll
        for (int j = 0; j < 16; ++j) { const float o0 = SHFL_XOR(L[0][j], 32), o1 = SHFL_XOR(L[1][j], 32); mine[j] = half ? L[1][j] : L[0][j]; oth[j] = half ? o1 : o0; }
#pragma unroll
        for (int j = 0; j < 16; ++j) { const float x = oth[j]; INS16(mine, x); }
        float A[16], B[16];
#pragma unroll
        for (int j = 0; j < 16; ++j) { const float o = SHFL_XOR(mine[j], 32); A[j] = half ? o : mine[j]; B[j] = half ? mine[j] : o; }
        float T[16];
#pragma unroll
        for (int j = 0; j < 16; ++j) T[j] = -3.0e38f;
#pragma unroll
        for (int a = 0; a < 16; ++a)
#pragma unroll
            for (int bq = 0; bq < 16; ++bq) if ((a + 1) * (bq + 1) <= 16) { const float x = A[a] + B[bq]; INS16(T, x); }
        const float tau = T[15], mx = T[0];
        float den = 0.f;
#pragma unroll
        for (int j = 0; j < 16; ++j) den += __builtin_amdgcn_exp2f((T[j] - mx) * LOG2E);
        const float rden = 1.f / den;
        int cnt = 0;
        const size_t ob = (size_t)t * 128 + hh * 16;
#pragma unroll
        for (int a = 0; a < 16; ++a)
#pragma unroll
            for (int bq = 0; bq < 16; ++bq) if ((a + 1) * (bq + 1) <= 16) {
                const float x = A[a] + B[bq];
                if (x >= tau && cnt < 16) {
                    if (half == 0) idx_out[ob + cnt] = (int)(((__builtin_bit_cast(unsigned, A[a]) & 127u) << 7) | (__builtin_bit_cast(unsigned, B[bq]) & 127u));
                    else gate_out[ob + cnt] = __builtin_amdgcn_exp2f((x - mx) * LOG2E) * rden;
                    ++cnt;
                }
            }
    }
}

__device__ __forceinline__ void peer_gather_phase(float* hio, bf16* hb, const int* idx, const float* gate, const bf16* TU, const bf16* TV, const float* lg, const float* lb, int gw, int NGW, int lane) {
    for (int m = gw; m < M; m += NGW) {
        v4u xr[4];
#pragma unroll
        for (int j = 0; j < 4; ++j) xr[j] = *(const v4u*)(hb + (size_t)m * D + 512 * j + 8 * lane);
        const int i0 = idx[(size_t)m * 128 + lane], i1 = idx[(size_t)m * 128 + 64 + lane];
        float y[32];
#pragma unroll
        for (int i = 0; i < 32; ++i) y[i] = 0.f;
#ifdef DBG_NO_PEER
        for (int hb_ = 0; hb_ < 0; ++hb_) {
#else
        for (int hb_ = 0; hb_ < 8; ++hb_) {
#endif
            float part[16];
            const int isel = (hb_ < 4) ? i0 : i1;
#pragma unroll
            for (int kk = 0; kk < 16; ++kk) {
                const int e = __builtin_amdgcn_readlane(isel, ((hb_ & 3) << 4) + kk);
                const bf16* up = TU + (size_t)e * D + 8 * lane;
                float acc = 0.f;
#pragma unroll
                for (int j = 0; j < 4; ++j) { const v4u w = *(const v4u*)(up + 512 * j);
                    acc = dot2bf(w.x, xr[j].x, acc); acc = dot2bf(w.y, xr[j].y, acc); acc = dot2bf(w.z, xr[j].z, acc); acc = dot2bf(w.w, xr[j].w, acc); }
                part[kk] = acc;
            }
#pragma unroll
            for (int kk = 0; kk < 16; ++kk) { part[kk] += SHFL_XOR(part[kk], 32); part[kk] += SHFL_XOR(part[kk], 16); }
            {
                const bool b3 = (lane & 8) != 0, b2 = (lane & 4) != 0, b1 = (lane & 2) != 0, b0 = (lane & 1) != 0;
#pragma unroll
                for (int i = 0; i < 8; ++i) { const float send = b3 ? part[i] : part[i + 8], keep = b3 ? part[i + 8] : part[i]; part[i] = keep + SHFL_XOR(send, 8); }
#pragma unroll
                for (int i = 0; i < 4; ++i) { const float send = b2 ? part[i] : part[i + 4], keep = b2 ? part[i + 4] : part[i]; part[i] = keep + SHFL_XOR(send, 4); }
#pragma unroll
                for (int i = 0; i < 2; ++i) { const float send = b1 ? part[i] : part[i + 2], keep = b1 ? part[i + 2] : part[i]; part[i] = keep + SHFL_XOR(send, 2); }
                { const float send = b0 ? part[0] : part[1], keep = b0 ? part[1] : part[0]; part[0] = keep + SHFL_XOR(send, 1); }
            }
            const float gt = gate[(size_t)m * 128 + hb_ * 16 + (lane & 15)];
            const float act = gelu_f(part[0]) * gt;
            const unsigned actb = f2bf(act);
#pragma unroll
            for (int kk = 0; kk < 16; ++kk) {
                const int e = __builtin_amdgcn_readlane(isel, ((hb_ & 3) << 4) + kk);
                const unsigned ab = (unsigned)__builtin_amdgcn_readlane((int)actb, kk);
                const unsigned alo = ab, ahi = ab << 16;
                const bf16* vp = TV + (size_t)e * D + 8 * lane;
#pragma unroll
                for (int j = 0; j < 4; ++j) { const v4u w = *(const v4u*)(vp + 512 * j);
                    y[8 * j + 0] = dot2bf(w.x, alo, y[8 * j + 0]); y[8 * j + 1] = dot2bf(w.x, ahi, y[8 * j + 1]);
                    y[8 * j + 2] = dot2bf(w.y, alo, y[8 * j + 2]); y[8 * j + 3] = dot2bf(w.y, ahi, y[8 * j + 3]);
                    y[8 * j + 4] = dot2bf(w.z, alo, y[8 * j + 4]); y[8 * j + 5] = dot2bf(w.z, ahi, y[8 * j + 5]);
                    y[8 * j + 6] = dot2bf(w.w, alo, y[8 * j + 6]); y[8 * j + 7] = dot2bf(w.w, ahi, y[8 * j + 7]); }
            }
        }
        float* row = hio + (size_t)m * D + 8 * lane;
        float s = 0.f;
#pragma unroll
        for (int j = 0; j < 4; ++j) { const f32x4 a = *(const f32x4*)(row + 512 * j), b = *(const f32x4*)(row + 512 * j + 4);
            y[8 * j + 0] += DN_ALPHA * a.x; y[8 * j + 1] += DN_ALPHA * a.y; y[8 * j + 2] += DN_ALPHA * a.z; y[8 * j + 3] += DN_ALPHA * a.w;
            y[8 * j + 4] += DN_ALPHA * b.x; y[8 * j + 5] += DN_ALPHA * b.y; y[8 * j + 6] += DN_ALPHA * b.z; y[8 * j + 7] += DN_ALPHA * b.w; }
#pragma unroll
        for (int i = 0; i < 32; ++i) s += y[i];
        const float mean = wave_sum(s) * (1.f / D); float s2 = 0.f;
#pragma unroll
        for (int i = 0; i < 32; ++i) { y[i] -= mean; s2 += y[i] * y[i]; }
        const float rstd = 1.f / sqrtf(wave_sum(s2) * (1.f / D) + LN_EPS);
#pragma unroll
        for (int j = 0; j < 4; ++j) { const float* gp = lg + 512 * j + 8 * lane; const float* bp = lb + 512 * j + 8 * lane;
            const f32x4 g0 = *(const f32x4*)gp, g1 = *(const f32x4*)(gp + 4), b0 = *(const f32x4*)bp, b1 = *(const f32x4*)(bp + 4);
            f32x4 o0, o1; o0.x = y[8 * j + 0] * rstd * g0.x + b0.x; o0.y = y[8 * j + 1] * rstd * g0.y + b0.y; o0.z = y[8 * j + 2] * rstd * g0.z + b0.z; o0.w = y[8 * j + 3] * rstd * g0.w + b0.w;
            o1.x = y[8 * j + 4] * rstd * g1.x + b1.x; o1.y = y[8 * j + 5] * rstd * g1.y + b1.y; o1.z = y[8 * j + 6] * rstd * g1.z + b1.z; o1.w = y[8 * j + 7] * rstd * g1.w + b1.w;
            *(f32x4*)(row + 512 * j) = o0; *(f32x4*)(row + 512 * j + 4) = o1;
            v4u w; w.x = pk2(o0.x, o0.y); w.y = pk2(o0.z, o0.w); w.z = pk2(o1.x, o1.y); w.w = pk2(o1.z, o1.w);
            *(v4u*)(hb + (size_t)m * D + 512 * j + 8 * lane) = w; }
    }
}


__device__ __forceinline__ float udot8(const v4u (&w)[2], const f32x2 (&x2)[16]) {
    f32x2 a0 = {0.f, 0.f}, a1 = {0.f, 0.f};
#pragma unroll
    for (int j = 0; j < 2; ++j) {
        const unsigned d0 = w[j].x, d1 = w[j].y, d2 = w[j].z, d3 = w[j].w;
        a0 = __builtin_elementwise_fma(__builtin_amdgcn_cvt_pk_f32_fp8((int)d0, false), x2[8 * j + 0], a0); a1 = __builtin_elementwise_fma(__builtin_amdgcn_cvt_pk_f32_fp8((int)d0, true), x2[8 * j + 1], a1);
        a0 = __builtin_elementwise_fma(__builtin_amdgcn_cvt_pk_f32_fp8((int)d1, false), x2[8 * j + 2], a0); a1 = __builtin_elementwise_fma(__builtin_amdgcn_cvt_pk_f32_fp8((int)d1, true), x2[8 * j + 3], a1);
        a0 = __builtin_elementwise_fma(__builtin_amdgcn_cvt_pk_f32_fp8((int)d2, false), x2[8 * j + 4], a0); a1 = __builtin_elementwise_fma(__builtin_amdgcn_cvt_pk_f32_fp8((int)d2, true), x2[8 * j + 5], a1);
        a0 = __builtin_elementwise_fma(__builtin_amdgcn_cvt_pk_f32_fp8((int)d3, false), x2[8 * j + 6], a0); a1 = __builtin_elementwise_fma(__builtin_amdgcn_cvt_pk_f32_fp8((int)d3, true), x2[8 * j + 7], a1);
    }
    return (a0.x + a0.y) + (a1.x + a1.y);
}
__device__ __forceinline__ void vacc8(const v4u (&w)[2], const f32x2 a2, f32x2 (&y2)[16]) {
#pragma unroll
    for (int j = 0; j < 2; ++j) {
        const unsigned d0 = w[j].x, d1 = w[j].y, d2 = w[j].z, d3 = w[j].w;
        y2[8 * j + 0] = __builtin_elementwise_fma(__builtin_amdgcn_cvt_pk_f32_fp8((int)d0, false), a2, y2[8 * j + 0]); y2[8 * j + 1] = __builtin_elementwise_fma(__builtin_amdgcn_cvt_pk_f32_fp8((int)d0, true), a2, y2[8 * j + 1]);
        y2[8 * j + 2] = __builtin_elementwise_fma(__builtin_amdgcn_cvt_pk_f32_fp8((int)d1, false), a2, y2[8 * j + 2]); y2[8 * j + 3] = __builtin_elementwise_fma(__builtin_amdgcn_cvt_pk_f32_fp8((int)d1, true), a2, y2[8 * j + 3]);
        y2[8 * j + 4] = __builtin_elementwise_fma(__builtin_amdgcn_cvt_pk_f32_fp8((int)d2, false), a2, y2[8 * j + 4]); y2[8 * j + 5] = __builtin_elementwise_fma(__builtin_amdgcn_cvt_pk_f32_fp8((int)d2, true), a2, y2[8 * j + 5]);
        y2[8 * j + 6] = __builtin_elementwise_fma(__builtin_amdgcn_cvt_pk_f32_fp8((int)d3, false), a2, y2[8 * j + 6]); y2[8 * j + 7] = __builtin_elementwise_fma(__builtin_amdgcn_cvt_pk_f32_fp8((int)d3, true), a2, y2[8 * j + 7]);
    }
}
#define ROWLD8(dst, base, e) do { const u8* _p = (base) + (size_t)(e) * D + 16 * lane; dst[0] = gld16(_p); dst[1] = gld16(_p + 1024); } while (0)
__device__ __forceinline__ void peer_gather_fp8(float* hio, bf16* hb, float* hio_w, bf16* hb_w, const int* idx, const float* gate, const u8* TU8, const u8* TV8, const float* lg, const float* lb, int gw, int NGW, int lane_in) {
    for (int m = gw; m < M; m += NGW) {
        int lane = lane_in; asm volatile("" : "+v"(lane));
        float* row = hio + (size_t)m * D + 16 * lane;
        f32x2 x2[16];
#pragma unroll
        for (int j = 0; j < 2; ++j)
#pragma unroll
            for (int q = 0; q < 4; ++q) { const f32x4 t = *(const GAS f32x4*)(row + 1024 * j + 4 * q); x2[8 * j + 2 * q] = (f32x2){t.x, t.y}; x2[8 * j + 2 * q + 1] = (f32x2){t.z, t.w}; }
        const int i0 = *(const GAS int*)(idx + (size_t)m * 128 + lane), i1 = *(const GAS int*)(idx + (size_t)m * 128 + 64 + lane);
        f32x2 y2[16];
#pragma unroll
        for (int i = 0; i < 16; ++i) y2[i] = (f32x2){0.f, 0.f};
        v4u buf[4][2];
#pragma unroll
        for (int q = 0; q < 4; ++q) { const int e = __builtin_amdgcn_readlane(i0, q); ROWLD8(buf[q], TU8, e); }
        for (int hb_ = 0; hb_ < 8; ++hb_) {
            const int isel = (hb_ < 4) ? i0 : i1, inext = (hb_ + 1 < 4) ? i0 : i1;
            const int lb0 = (hb_ & 3) << 4, lbn = ((hb_ + 1) & 3) << 4;
            const float gt = *(const GAS float*)(gate + (size_t)m * 128 + hb_ * 16 + (lane & 15));
            float part[16];
#pragma unroll
            for (int kk = 0; kk < 16; ++kk) {
                part[kk] = udot8(buf[kk & 3], x2);
                if (kk + 4 < 16) { const int e = __builtin_amdgcn_readlane(isel, lb0 + kk + 4); ROWLD8(buf[kk & 3], TU8, e); }
                else { const int e = __builtin_amdgcn_readlane(isel, lb0 + kk + 4 - 16); ROWLD8(buf[kk & 3], TV8, e); }
                __builtin_amdgcn_sched_barrier(0);
            }
#pragma unroll
            for (int kk = 0; kk < 16; ++kk) { part[kk] += SHFL_XOR(part[kk], 32); part[kk] += SHFL_XOR(part[kk], 16); }
            {
                const bool b3 = (lane & 8) != 0, b2 = (lane & 4) != 0, b1 = (lane & 2) != 0, b0 = (lane & 1) != 0;
#pragma unroll
                for (int i = 0; i < 8; ++i) { const float send = b3 ? part[i] : part[i + 8], keep = b3 ? part[i + 8] : part[i]; part[i] = keep + SHFL_XOR(send, 8); }
#pragma unroll
                for (int i = 0; i < 4; ++i) { const float send = b2 ? part[i] : part[i + 4], keep = b2 ? part[i + 4] : part[i]; part[i] = keep + SHFL_XOR(send, 4); }
#pragma unroll
                for (int i = 0; i < 2; ++i) { const float send = b1 ? part[i] : part[i + 2], keep = b1 ? part[i + 2] : part[i]; part[i] = keep + SHFL_XOR(send, 2); }
                { const float send = b0 ? part[0] : part[1], keep = b0 ? part[1] : part[0]; part[0] = keep + SHFL_XOR(send, 1); }
            }
            const float act = gelu_f(part[0] * (1.f / TU_SCALE)) * gt * (1.f / TV_SCALE);
            const int acti = __builtin_bit_cast(int, act);
#pragma unroll
            for (int kk = 0; kk < 16; ++kk) {
                const float a = __builtin_bit_cast(float, __builtin_amdgcn_readlane(acti, kk));
                vacc8(buf[kk & 3], (f32x2){a, a}, y2);
                if (kk + 4 < 16) { const int e = __builtin_amdgcn_readlane(isel, lb0 + kk + 4); ROWLD8(buf[kk & 3], TV8, e); }
                else if (hb_ < 7) { const int e = __builtin_amdgcn_readlane(inext, lbn + kk + 4 - 16); ROWLD8(buf[kk & 3], TU8, e); }
                __builtin_amdgcn_sched_barrier(0);
            }
        }
        float s = 0.f;
#pragma unroll
        for (int i = 0; i < 16; ++i) { y2[i] = y2[i] + x2[i] * DN_ALPHA; s += y2[i].x + y2[i].y; }
        const float mean = wave_sum(s) * (1.f / D); float s2 = 0.f;
#pragma unroll
        for (int i = 0; i < 16; ++i) { y2[i] = y2[i] - mean; s2 += y2[i].x * y2[i].x + y2[i].y * y2[i].y; }
        const float rstd = 1.f / sqrtf(wave_sum(s2) * (1.f / D) + LN_EPS);
#pragma unroll
        for (int j = 0; j < 2; ++j)
#pragma unroll
            for (int q = 0; q < 4; ++q) { const int off = 1024 * j + 16 * lane + 4 * q;
                const f32x4 g4 = *(const GAS f32x4*)(lg + off), b4 = *(const GAS f32x4*)(lb + off);
                const f32x2 ya = y2[8 * j + 2 * q], yb = y2[8 * j + 2 * q + 1];
                f32x4 o; o.x = ya.x * rstd * g4.x + b4.x; o.y = ya.y * rstd * g4.y + b4.y; o.z = yb.x * rstd * g4.z + b4.z; o.w = yb.y * rstd * g4.w + b4.w;
                *(GAS f32x4*)(hio_w + (size_t)m * D + off) = o;
                v2u w; w.x = pk2(o.x, o.y); w.y = pk2(o.z, o.w); *(GAS v2u*)(hb_w + (size_t)m * D + off) = w; }
    }
}


__device__ __forceinline__ float wave_max(float v) {
    v = fmaxf(v, WDPP(v, 0xB1)); v = fmaxf(v, WDPP(v, 0x4E)); v = fmaxf(v, WDPP(v, 0x141)); v = fmaxf(v, WDPP(v, 0x140));
    return fmaxf(fmaxf(WRL(v, 0), WRL(v, 16)), fmaxf(WRL(v, 32), WRL(v, 48)));
}
__device__ __forceinline__ void cvt_rows_fp4(const float* src, u8* dst, float* scales, int nrows, int gw, int NGW, int lane) {
    for (int r0 = gw; r0 < nrows; r0 += 4 * NGW) {
        f32x4 v[4][8];
#pragma unroll
        for (int u = 0; u < 4; ++u) { const GAS f32x4* p = (const GAS f32x4*)(src + (size_t)(r0 + u * NGW) * D + 4 * lane);
#pragma unroll
            for (int q = 0; q < 8; ++q) v[u][q] = p[64 * q]; }
#pragma unroll
        for (int u = 0; u < 4; ++u) { const int r = r0 + u * NGW; float mx = 0.f;
#pragma unroll
            for (int q = 0; q < 8; ++q) mx = fmaxf(mx, fmaxf(fmaxf(__builtin_fabsf(v[u][q].x), __builtin_fabsf(v[u][q].y)), fmaxf(__builtin_fabsf(v[u][q].z), __builtin_fabsf(v[u][q].w))));
            mx = wave_max(mx);
            const float inv = mx > 0.f ? 6.f / mx : 0.f;
            const int lay = r / NEXP, e = r % NEXP;
#pragma unroll
            for (int q = 0; q < 8; ++q) { unsigned t = 0u; const f32x4 a = v[u][q] * inv;
                t = __builtin_amdgcn_cvt_scalef32_pk_fp4_f32(t, a.x, a.y, 1.0f, 0); t = __builtin_amdgcn_cvt_scalef32_pk_fp4_f32(t, a.z, a.w, 1.0f, 1);
                *(GAS unsigned short*)(dst + (((size_t)lay * 8 + q) * NEXP + e) * 128 + 2 * lane) = (unsigned short)(t & 0xffffu); }
            if (lane == 0) scales[r] = mx * (1.f / 6.f); }
    }
}
__device__ __forceinline__ float udot4(const v4u w, const f32x2 (&x2)[16]) {
    f32x2 a0 = {0.f, 0.f}, a1 = {0.f, 0.f};
    const unsigned d0 = w.x, d1 = w.y, d2 = w.z, d3 = w.w;
#define UD4(dw, k) a0 = __builtin_elementwise_fma(__builtin_amdgcn_cvt_scalef32_pk_f32_fp4(dw, 1.0f, 0), x2[4 * (k) + 0], a0); a1 = __builtin_elementwise_fma(__builtin_amdgcn_cvt_scalef32_pk_f32_fp4(dw, 1.0f, 1), x2[4 * (k) + 1], a1); \
                   a0 = __builtin_elementwise_fma(__builtin_amdgcn_cvt_scalef32_pk_f32_fp4(dw, 1.0f, 2), x2[4 * (k) + 2], a0); a1 = __builtin_elementwise_fma(__builtin_amdgcn_cvt_scalef32_pk_f32_fp4(dw, 1.0f, 3), x2[4 * (k) + 3], a1);
    UD4(d0, 0) UD4(d1, 1) UD4(d2, 2) UD4(d3, 3)
#undef UD4
    return (a0.x + a0.y) + (a1.x + a1.y);
}
__device__ __forceinline__ void vacc4(const v4u w, const f32x2 a2, f32x2 (&y2)[16]) {
    const unsigned d0 = w.x, d1 = w.y, d2 = w.z, d3 = w.w;
#define VA4(dw, k) y2[4 * (k) + 0] = __builtin_elementwise_fma(__builtin_amdgcn_cvt_scalef32_pk_f32_fp4(dw, 1.0f, 0), a2, y2[4 * (k) + 0]); y2[4 * (k) + 1] = __builtin_elementwise_fma(__builtin_amdgcn_cvt_scalef32_pk_f32_fp4(dw, 1.0f, 1), a2, y2[4 * (k) + 1]); \
                   y2[4 * (k) + 2] = __builtin_elementwise_fma(__builtin_amdgcn_cvt_scalef32_pk_f32_fp4(dw, 1.0f, 2), a2, y2[4 * (k) + 2]); y2[4 * (k) + 3] = __builtin_elementwise_fma(__builtin_amdgcn_cvt_scalef32_pk_f32_fp4(dw, 1.0f, 3), a2, y2[4 * (k) + 3]);
    VA4(d0, 0) VA4(d1, 1) VA4(d2, 2) VA4(d3, 3)
#undef VA4
}
#define ROWLD4(dst, base, e) do { dst = gld16((base) + (size_t)(e) * 1024 + 16 * lane); } while (0)
__device__ __forceinline__ void peer_gather_fp4(float* hio, bf16* hb, float* hio_w, bf16* hb_w, const int* idx, const float* gate, const u8* TU4, const u8* TV4, const float* SU, const float* SV,
                                                const float* lg, const float* lb, int gw, int NGW, int lane_in) {
    for (int m = gw; m < M; m += NGW) {
        int lane = lane_in; asm volatile("" : "+v"(lane));
        const float* row = hio + (size_t)m * D + 32 * lane;
        f32x2 x2[16];
#pragma unroll
        for (int q = 0; q < 8; ++q) { const f32x4 t = *(const GAS f32x4*)(row + 4 * q); x2[2 * q] = (f32x2){t.x, t.y}; x2[2 * q + 1] = (f32x2){t.z, t.w}; }
        const int i0 = *(const GAS int*)(idx + (size_t)m * 128 + lane), i1 = *(const GAS int*)(idx + (size_t)m * 128 + 64 + lane);
        f32x2 y2[16];
#pragma unroll
        for (int i = 0; i < 16; ++i) y2[i] = (f32x2){0.f, 0.f};
        v4u buf[8];
#pragma unroll
        for (int q = 0; q < 8; ++q) { const int e = __builtin_amdgcn_readlane(i0, q); ROWLD4(buf[q], TU4, e); }
        for (int hb_ = 0; hb_ < 8; ++hb_) {
            const int isel = (hb_ < 4) ? i0 : i1, inext = (hb_ + 1 < 4) ? i0 : i1;
            const int lb0 = (hb_ & 3) << 4, lbn = ((hb_ + 1) & 3) << 4;
            const float gt = *(const GAS float*)(gate + (size_t)m * 128 + hb_ * 16 + (lane & 15));
            const int ek = shfl_idx_lane(isel, lb0 + (lane & 15));
            const float su = *(const GAS float*)(SU + ek), sv = *(const GAS float*)(SV + ek);
            float part[16];
#pragma unroll
            for (int kk = 0; kk < 16; ++kk) {
                part[kk] = udot4(buf[kk & 7], x2);
                if (kk + 8 < 16) { const int e = __builtin_amdgcn_readlane(isel, lb0 + kk + 8); ROWLD4(buf[kk & 7], TU4, e); }
                else { const int e = __builtin_amdgcn_readlane(isel, lb0 + kk + 8 - 16); ROWLD4(buf[kk & 7], TV4, e); }
                __builtin_amdgcn_sched_barrier(0);
            }
#pragma unroll
            for (int kk = 0; kk < 16; ++kk) { part[kk] += SHFL_XOR(part[kk], 32); part[kk] += SHFL_XOR(part[kk], 16); }
            {
                const bool b3 = (lane & 8) != 0, b2 = (lane & 4) != 0, b1 = (lane & 2) != 0, b0 = (lane & 1) != 0;
#pragma unroll
                for (int i = 0; i < 8; ++i) { const float send = b3 ? part[i] : part[i + 8], keep = b3 ? part[i + 8] : part[i]; part[i] = keep + SHFL_XOR(send, 8); }
#pragma unroll
                for (int i = 0; i < 4; ++i) { const float send = b2 ? part[i] : part[i + 4], keep = b2 ? part[i + 4] : part[i]; part[i] = keep + SHFL_XOR(send, 4); }
#pragma unroll
                for (int i = 0; i < 2; ++i) { const float send = b1 ? part[i] : part[i + 2], keep = b1 ? part[i + 2] : part[i]; part[i] = keep + SHFL_XOR(send, 2); }
                { const float send = b0 ? part[0] : part[1], keep = b0 ? part[1] : part[0]; part[0] = keep + SHFL_XOR(send, 1); }
            }
            const float act = gelu_f(part[0] * su) * gt * sv;
            const int acti = __builtin_bit_cast(int, act);
#pragma unroll
            for (int kk = 0; kk < 16; ++kk) {
                const float a = __builtin_bit_cast(float, __builtin_amdgcn_readlane(acti, kk));
                vacc4(buf[kk & 7], (f32x2){a, a}, y2);
                if (kk + 8 < 16) { const int e = __builtin_amdgcn_readlane(isel, lb0 + kk + 8); ROWLD4(buf[kk & 7], TV4, e); }
                else if (hb_ < 7) { const int e = __builtin_amdgcn_readlane(inext, lbn + kk + 8 - 16); ROWLD4(buf[kk & 7], TU4, e); }
                __builtin_amdgcn_sched_barrier(0);
            }
        }
        float s = 0.f;
#pragma unroll
        for (int i = 0; i < 16; ++i) { y2[i] = y2[i] + x2[i] * DN_ALPHA; s += y2[i].x + y2[i].y; }
        const float mean = wave_sum(s) * (1.f / D); float s2 = 0.f;
#pragma unroll
        for (int i = 0; i < 16; ++i) { y2[i] = y2[i] - mean; s2 += y2[i].x * y2[i].x + y2[i].y * y2[i].y; }
        const float rstd = 1.f / sqrtf(wave_sum(s2) * (1.f / D) + LN_EPS);
#pragma unroll
        for (int q = 0; q < 8; ++q) { const int off = 32 * lane + 4 * q;
            const f32x4 g4 = *(const GAS f32x4*)(lg + off), b4 = *(const GAS f32x4*)(lb + off);
            const f32x2 ya = y2[2 * q], yb = y2[2 * q + 1];
            f32x4 o; o.x = ya.x * rstd * g4.x + b4.x; o.y = ya.y * rstd * g4.y + b4.y; o.z = yb.x * rstd * g4.z + b4.z; o.w = yb.y * rstd * g4.w + b4.w;
            *(GAS f32x4*)(hio_w + (size_t)m * D + off) = o;
            v2u w; w.x = pk2(o.x, o.y); w.y = pk2(o.z, o.w); *(GAS v2u*)(hb_w + (size_t)m * D + off) = w; }
    }
}


typedef _Float16 h16x2 __attribute__((ext_vector_type(2)));
#define CVT_H2_FP4(dw, b) __builtin_bit_cast(h16x2, __builtin_amdgcn_cvt_scalef32_pk_f16_fp4(dw, 1.0f, b))
__device__ __forceinline__ float udot4h(const v4u w, const h16x2 (&xh)[16]) {
    h16x2 a0 = {(_Float16)0.f, (_Float16)0.f}, a1 = {(_Float16)0.f, (_Float16)0.f};
    const unsigned d0 = w.x, d1 = w.y, d2 = w.z, d3 = w.w;
#define UD4H(dw, k) a0 = __builtin_elementwise_fma(CVT_H2_FP4(dw, 0), xh[4 * (k) + 0], a0); a1 = __builtin_elementwise_fma(CVT_H2_FP4(dw, 1), xh[4 * (k) + 1], a1); \
                    a0 = __builtin_elementwise_fma(CVT_H2_FP4(dw, 2), xh[4 * (k) + 2], a0); a1 = __builtin_elementwise_fma(CVT_H2_FP4(dw, 3), xh[4 * (k) + 3], a1);
    UD4H(d0, 0) UD4H(d1, 1) UD4H(d2, 2) UD4H(d3, 3)
#undef UD4H
    return ((float)a0.x + (float)a0.y) + ((float)a1.x + (float)a1.y);
}
__device__ __forceinline__ void vacc4h(const v4u w, const h16x2 a2, h16x2 (&yh)[16]) {
    const unsigned d0 = w.x, d1 = w.y, d2 = w.z, d3 = w.w;
#define VA4H(dw, k) yh[4 * (k) + 0] = __builtin_elementwise_fma(CVT_H2_FP4(dw, 0), a2, yh[4 * (k) + 0]); yh[4 * (k) + 1] = __builtin_elementwise_fma(CVT_H2_FP4(dw, 1), a2, yh[4 * (k) + 1]); \
                    yh[4 * (k) + 2] = __builtin_elementwise_fma(CVT_H2_FP4(dw, 2), a2, yh[4 * (k) + 2]); yh[4 * (k) + 3] = __builtin_elementwise_fma(CVT_H2_FP4(dw, 3), a2, yh[4 * (k) + 3]);
    VA4H(d0, 0) VA4H(d1, 1) VA4H(d2, 2) VA4H(d3, 3)
#undef VA4H
}

#define DPP_ADD(v, ctrl) ((v) + __builtin_bit_cast(float, __builtin_amdgcn_update_dpp(0, __builtin_bit_cast(int, (v)), (ctrl), 0xF, 0xF, true)))
#define LOAD_II16(dst, mm) do { const GAS v4u* _ip = (const GAS v4u*)(idx + (size_t)(mm) * 128 + 16 * eg); const v4u _a = _ip[0], _b = _ip[1], _c = _ip[2], _d = _ip[3]; \
    dst[0] = _a.x; dst[1] = _a.y; dst[2] = _a.z; dst[3] = _a.w; dst[4] = _b.x; dst[5] = _b.y; dst[6] = _b.z; dst[7] = _b.w; dst[8] = _c.x; dst[9] = _c.y; dst[10] = _c.z; dst[11] = _c.w; dst[12] = _d.x; dst[13] = _d.y; dst[14] = _d.z; dst[15] = _d.w; } while (0)
typedef int v8i_m __attribute__((ext_vector_type(8)));
#define U_QADD(keep, send, ctrl) ((keep) + __builtin_bit_cast(float, __builtin_amdgcn_update_dpp(0, __builtin_bit_cast(int, (send)), (ctrl), 0xF, 0xF, true)))
__device__ __forceinline__ void u_step(const u8* x4, const int* idx, const u8* tab, float* Ps, int m, int mn, int mnn, int eg, int aoff, int xoff, bool xval, bool b0, bool b1, int poff, int sc1, int scb,
                                       const v4u (&bufC)[16], const v4u& xC, const unsigned (&idxN)[16], v4u (&bufN)[16], v4u& xN, unsigned (&idxNN)[16]) {
#pragma unroll
    for (int t = 0; t < 16; ++t) bufN[t] = gld16(tab + (size_t)idxN[t] * 128 + aoff);
    xN = gld16(x4 + (size_t)mn * 2048 + xoff);
    LOAD_II16(idxNN, mnn);
    __builtin_amdgcn_sched_barrier(0);
    const v8i_m bx = {xval ? (int)xC.x : 0, xval ? (int)xC.y : 0, xval ? (int)xC.z : 0, xval ? (int)xC.w : 0, 0, 0, 0, 0};
    f32x4 acc[16];
#pragma unroll
    for (int t = 0; t < 16; ++t) { const v8i_m a8 = {(int)bufC[t].x, (int)bufC[t].y, (int)bufC[t].z, (int)bufC[t].w, 0, 0, 0, 0};
        acc[t] = __builtin_amdgcn_mfma_scale_f32_16x16x128_f8f6f4(a8, bx, (f32x4){0.f, 0.f, 0.f, 0.f}, 4, 4, 0, sc1, 0, scb); }
    float v[16];
#pragma unroll
    for (int t = 0; t < 16; ++t) { const float lo = b0 ? acc[t].y : acc[t].x, hi = b0 ? acc[t].w : acc[t].z; const float vv = b1 ? hi : lo; v[t] = U_QADD(vv, vv, 0x128); }
    float w[8];
#pragma unroll
    for (int i = 0; i < 8; ++i) { const float send = b0 ? v[i] : v[i + 8], keep = b0 ? v[i + 8] : v[i]; w[i] = U_QADD(keep, send, 0xB1); }
    f32x4 z;
#pragma unroll
    for (int i = 0; i < 4; ++i) { const float send = b1 ? w[i] : w[i + 4], keep = b1 ? w[i + 4] : w[i]; z[i] = U_QADD(keep, send, 0x4E); }
    if (poff >= 0) { const h16x2 zl = {(_Float16)z[0], (_Float16)z[1]}, zh = {(_Float16)z[2], (_Float16)z[3]};
        *(GAS v2u*)((_Float16*)Ps + (size_t)m * 128 + poff) = (v2u){__builtin_bit_cast(unsigned, zl), __builtin_bit_cast(unsigned, zh)}; }
    __builtin_amdgcn_sched_barrier(0);
}
__device__ __forceinline__ void peer_u_pass(const u8* x4, const int* idx, const u8* TUl, float* P, int bx, int G, int wave, int lane_in) {
    const int s = bx & 7, cu = bx >> 3, nW = (G >> 3) * NWAVES;
    const u8* tab = TUl + (size_t)s * NEXP * 128;
    float* Ps = (float*)((_Float16*)P + (size_t)s * M * 128);
    int lane = lane_in; asm volatile("" : "+v"(lane));
    const int n = lane & 15, kg = lane >> 4;
    const int eg = 2 * (n >> 2) + (kg >> 1);
    const int aoff = 16 * (4 * (kg & 1) + (n & 3));
    const int xoff = 128 * s + aoff + ((n & 8) ? 1024 : 0);
    const bool xval = (kg >> 1) == ((n >> 2) & 1);
    const bool b0 = (lane & 1) != 0, b1 = (lane & 2) != 0;
    const int poff = (n < 8) ? 16 * (2 * kg + (n >> 2)) + (b0 ? 8 : 0) + (b1 ? 4 : 0) : -1;
    const int m0 = cu * NWAVES + wave;
    int sc1 = 0x7F7F7F7F, sc8 = (n & 8) ? 0x7C7C7C7C : 0x7F7F7F7F; asm volatile("" : "+v"(sc1), "+v"(sc8));
    unsigned iiX[16], iiY[16]; v4u bufA[16], bufB[16]; v4u xA, xB;
    {   LOAD_II16(iiY, m0);
#pragma unroll
        for (int t = 0; t < 16; ++t) bufA[t] = gld16(tab + (size_t)iiY[t] * 128 + aoff);
        xA = gld16(x4 + (size_t)m0 * 2048 + xoff);
        const int m1 = (m0 + nW < M) ? m0 + nW : m0; LOAD_II16(iiX, m1); }
#define CLAMPM(x) (((x) < M) ? (x) : m0)
    for (int m = m0; m < M; m += 2 * nW) {
        u_step(x4, idx, tab, Ps, m, CLAMPM(m + nW), CLAMPM(m + 2 * nW), eg, aoff, xoff, xval, b0, b1, poff, sc1, sc8, bufA, xA, iiX, bufB, xB, iiY);
        u_step(x4, idx, tab, Ps, m + nW, CLAMPM(m + 2 * nW), CLAMPM(m + 3 * nW), eg, aoff, xoff, xval, b0, b1, poff, sc1, sc8, bufB, xB, iiY, bufA, xA, iiX);
    }
}
__device__ __forceinline__ void peer_act_phase(const float* P, const int* idx, float* gate, const float* SU, const float* SV, int gw, int NGW, int lane) {
    for (int m = gw; m < M; m += NGW) {
#pragma unroll
        for (int h = 0; h < 2; ++h) { const int k = 64 * h + lane;
            float z = 0.f;
#pragma unroll
            for (int sl = 0; sl < 8; ++sl) z += (float)*(const GAS _Float16*)((const _Float16*)P + ((size_t)sl * M + m) * 128 + k);
            const int e = *(const GAS int*)(idx + (size_t)m * 128 + k);
            const float su = *(const GAS float*)(SU + e), sv = *(const GAS float*)(SV + e), gt = *(const GAS float*)(gate + (size_t)m * 128 + k);
            *(GAS float*)(gate + (size_t)m * 128 + k) = gelu_f(z * su) * gt * sv; }
    }
}
#define LOAD_AA16(dst, mm) do { const GAS f32x4* _ap = (const GAS f32x4*)(act + (size_t)(mm) * 128 + 16 * eg); const f32x4 _a = _ap[0], _b = _ap[1], _c = _ap[2], _d = _ap[3]; \
    dst[0] = _a.x; dst[1] = _a.y; dst[2] = _a.z; dst[3] = _a.w; dst[4] = _b.x; dst[5] = _b.y; dst[6] = _b.z; dst[7] = _b.w; dst[8] = _c.x; dst[9] = _c.y; dst[10] = _c.z; dst[11] = _c.w; dst[12] = _d.x; dst[13] = _d.y; dst[14] = _d.z; dst[15] = _d.w; } while (0)
__device__ __forceinline__ void v_step(bf16* hio, const int* idx, const float* act, const u8* tab, const float* stats, const f32x4 lg, const f32x4 lb, int m, int mn, int mnn, int lane, int c, int eg, int coff, bool b0,
                                       const v4u (&bufC)[16], const float (&aaC)[16], const unsigned (&idxN)[16], v4u (&bufN)[16], float (&aaN)[16], unsigned (&idxNN)[16]) {
#pragma unroll
    for (int g = 0; g < 16; ++g) bufN[g] = gld16(tab + (size_t)idxN[g] * 128 + 16 * c);
    LOAD_AA16(aaN, mn);
    LOAD_II16(idxNN, mnn);
    bf16* op = hio + (size_t)m * D + coff;
    const v2u xw = *(const GAS v2u*)op;
    const f32x2 st = *(const GAS f32x2*)(stats + 2 * (size_t)m);
    __builtin_amdgcn_sched_barrier(0);
    h16x2 y2[16];
#pragma unroll
    for (int i = 0; i < 16; ++i) y2[i] = (h16x2){(_Float16)0.f, (_Float16)0.f};
#pragma unroll
    for (int g = 0; g < 16; ++g) { const _Float16 a = (_Float16)aaC[g]; vacc4h(bufC[g], (h16x2){a, a}, y2); }
#pragma unroll
    for (int i = 0; i < 8; ++i) { const h16x2 send = b0 ? y2[i] : y2[i + 8], keep = b0 ? y2[i + 8] : y2[i];
        y2[i] = keep + __builtin_bit_cast(h16x2, __builtin_amdgcn_update_dpp(0, __builtin_bit_cast(int, send), 0x128, 0xF, 0xF, true)); }
#pragma unroll
    for (int i = 0; i < 4; ++i) { const auto sw = __builtin_amdgcn_permlane16_swap(__builtin_bit_cast(unsigned, y2[i]), __builtin_bit_cast(unsigned, y2[i + 4]), false, false);
        const unsigned s0 = sw[0], s1 = sw[1]; y2[i] = __builtin_bit_cast(h16x2, s0) + __builtin_bit_cast(h16x2, s1); }
#pragma unroll
    for (int i = 0; i < 2; ++i) { const auto sw = __builtin_amdgcn_permlane32_swap(__builtin_bit_cast(unsigned, y2[i]), __builtin_bit_cast(unsigned, y2[i + 2]), false, false);
        const unsigned s0 = sw[0], s1 = sw[1]; y2[i] = __builtin_bit_cast(h16x2, s0) + __builtin_bit_cast(h16x2, s1); }
    const float x0 = (bflo(xw.x) - st.x) * st.y * lg.x + lb.x, x1 = (bfhi(xw.x) - st.x) * st.y * lg.y + lb.y, x2 = (bflo(xw.y) - st.x) * st.y * lg.z + lb.z, x3 = (bfhi(xw.y) - st.x) * st.y * lg.w + lb.w;
    v2u o; o.x = pk2(x0 * DN_ALPHA + (float)y2[0].x, x1 * DN_ALPHA + (float)y2[0].y); o.y = pk2(x2 * DN_ALPHA + (float)y2[1].x, x3 * DN_ALPHA + (float)y2[1].y);
    *(GAS v2u*)op = o;
    __builtin_amdgcn_sched_barrier(0);
}
__device__ __forceinline__ void peer_v_pass(bf16* hio, const int* idx, const float* act, const u8* TVl, const float* stats, const float* lng, const float* lnb, int bx, int G, int wave, int lane_in) {
    const int s = bx & 7, cu = bx >> 3, nW = (G >> 3) * NWAVES;
    const u8* tab = TVl + (size_t)s * NEXP * 128;
    int lane = lane_in; asm volatile("" : "+v"(lane));
    const int c = lane & 7, eg = lane >> 3;
    const bool b0 = (lane & 8) != 0, b1 = (lane & 16) != 0, b2 = (lane & 32) != 0;
    const int coff = 256 * s + 32 * c + (b0 ? 16 : 0) + (b1 ? 8 : 0) + (b2 ? 4 : 0);
    const int m0 = cu * NWAVES + wave;
    const f32x4 lg = *(const GAS f32x4*)(lng + coff), lb = *(const GAS f32x4*)(lnb + coff);
    unsigned iiX[16], iiY[16]; v4u bufA[16], bufB[16]; float aaA[16], aaB[16];
    {   LOAD_II16(iiY, m0);
#pragma unroll
        for (int g = 0; g < 16; ++g) bufA[g] = gld16(tab + (size_t)iiY[g] * 128 + 16 * c);
        LOAD_AA16(aaA, m0);
        const int m1 = (m0 + nW < M) ? m0 + nW : m0; LOAD_II16(iiX, m1); }
    for (int m = m0; m < M; m += 2 * nW) {
        v_step(hio, idx, act, tab, stats, lg, lb, m, CLAMPM(m + nW), CLAMPM(m + 2 * nW), lane, c, eg, coff, b0, bufA, aaA, iiX, bufB, aaB, iiY);
        v_step(hio, idx, act, tab, stats, lg, lb, m + nW, CLAMPM(m + 2 * nW), CLAMPM(m + 3 * nW), lane, c, eg, coff, b0, bufB, aaB, iiY, bufA, aaA, iiX);
    }
}

constexpr int N_SLOTS = 11;
struct Args { const float* in[31]; float* out; unsigned char* ws; int slot, layer, pad0, pad1; };

constexpr int TAB_OFF = MISC_OFF + 128;
__device__ __forceinline__ void store_tab(const Args& a, LAS unsigned char* lds) {
    if (threadIdx.x == 0) { LAS unsigned long long* t = (LAS unsigned long long*)(lds + TAB_OFF);
#pragma unroll
        for (int i = 0; i < 31; ++i) t[i] = (unsigned long long)a.in[i];
        t[31] = (unsigned long long)a.out; t[32] = (unsigned long long)a.ws; }
    __syncthreads();
}
struct Tab { unsigned tab;
    __device__ __forceinline__ unsigned long long raw(int k) const { const v2u v = *(const LAS v2u*)(tab + 8 * k);
        return ((unsigned long long)(unsigned)__builtin_amdgcn_readfirstlane((int)v.y) << 32) | (unsigned)__builtin_amdgcn_readfirstlane((int)v.x); }
    __device__ __forceinline__ const float* in(int k) const { return (const float*)raw(k); }
};
#define ARG_IN(k) T_.in(k)

template <int SLOT>
__device__ __forceinline__ void run_slot(LAS unsigned char* lds, int layer, int wave_s) {
    int tid = wave_s * 64 + lane_id(); asm volatile("" : "+v"(tid));
    Tab T_; T_.tab = (unsigned)(unsigned long long)(lds + TAB_OFF); asm volatile("" : "+s"(T_.tab));
    unsigned char* ws = (unsigned char*)T_.raw(32);
    const int lane = tid & 63, wave = __builtin_amdgcn_readfirstlane(tid >> 6);
    const int G = gridDim.x; const int bx = blockIdx.x; const int vcu = (G % 8 == 0) ? (bx % 8) * (G / 8) + bx / 8 : bx;
    const int gw = vcu * NWAVES + wave, NGW = G * NWAVES;
    const int gtid = vcu * (NWAVES * 64) + tid, gthreads = G * NWAVES * 64;
    const int kind = layer % 3, jj = layer / 3;
    float* hout = (float*)T_.raw(31);
    bf16* HB0 = (bf16*)(ws + WS_HB0); bf16* HB1 = (bf16*)(ws + WS_HB1);
    bf16* T1 = (bf16*)(ws + WS_T1); bf16* T2 = (bf16*)(ws + WS_T2); bf16* T3 = (bf16*)(ws + WS_T3);
    int* IDX = (int*)(ws + WS_IDX); float* GATE = (float*)(ws + WS_GATE);
    bf16* TU = (bf16*)(ws + WS_TU); bf16* TV = (bf16*)(ws + WS_TV); bf16* PB = (bf16*)(ws + WS_PB); bf16* SKB = (bf16*)(ws + WS_SK);
    bf16* Sin = (layer & 1) ? HB1 : HB0;
    bf16* Sout = (layer & 1) ? HB0 : HB1;

    if constexpr (SLOT == 0) {
        LAS float* scr = (LAS float*)(lds + wave * 16384); LAS unsigned* scr8 = (LAS unsigned*)(lds + wave * 16384); int woff = 0;
        for (int j = 0; j < 2; ++j) {
            transpose_mat8b(ARG_IN(6) + (size_t)j * D * D, D, D, ws + W_POOL_IN + (size_t)j * D * D, 0, scr8, gw, NGW, lane, woff);
            for (int g = 0; g < 4; ++g) transpose_mat8b(ARG_IN(7) + (size_t)(j * 4 + g) * 512 * 512, 512, 512, ws + W_POOL_GRP + (size_t)j * D * 512, g * 512, scr8, gw, NGW, lane, woff);
            transpose_mat8b(ARG_IN(9) + (size_t)j * D * D, D, D, ws + W_POOL_OUT + (size_t)j * D * D, 0, scr8, gw, NGW, lane, woff);
        }
        transpose_mat8b(ARG_IN(10), D, D, ws + W_SSM_IN, 0, scr8, gw, NGW, lane, woff);
        transpose_mat8b(ARG_IN(19), D, D, ws + W_SSM_GLU, 0, scr8, gw, NGW, lane, woff);
        transpose_mat8b(ARG_IN(20), D, D, ws + W_SSM_OUT, 0, scr8, gw, NGW, lane, woff);
        transpose_mat8b(ARG_IN(21), D, 3 * D, ws + W_ATTN_QKV, 0, scr8, gw, NGW, lane, woff);
        transpose_mat8b(ARG_IN(23), D, D, ws + W_ATTN_OUT, 0, scr8, gw, NGW, lane, woff);
        for (int i = 0; i < DEPTH; ++i) {
            transpose_mat8b(ARG_IN(24) + (size_t)i * D * D, D, D, ws + W_PEER_Q + (size_t)i * D * D, 0, scr8, gw, NGW, lane, woff);
            transpose_mat8b(ARG_IN(29) + (size_t)i * D * D, D, D, ws + W_PLE_GATE + (size_t)i * D * D, 0, scr8, gw, NGW, lane, woff);
            transpose_mat(ARG_IN(28) + (size_t)i * PLE * D, PLE, D, (bf16*)(ws + W_PLE_PROJ) + (size_t)i * PLE * D, 0, scr, gw, NGW, lane);
        }
        cvt_rows_fp4(ARG_IN(26), (u8*)TU, (float*)(ws + WS_SU), DEPTH * NEXP, gw, NGW, lane);
        cvt_rows_fp4(ARG_IN(27), (u8*)TV, (float*)(ws + WS_SV), DEPTH * NEXP, gw, NGW, lane);
        cvt_rows(ARG_IN(1), PB, (size_t)DEPTH * M * PLE, (size_t)gtid, (size_t)gthreads);
        cvt_rows(ARG_IN(25), SKB, (size_t)DEPTH * 2 * 128 * 128, (size_t)gtid, (size_t)gthreads);
        {
            const float* xs = ARG_IN(0); unsigned char* s8 = ws + WS_S8;
            const size_t gs = (size_t)gthreads * 8;
            for (size_t i0 = (size_t)gtid * 8; i0 < (size_t)M * D; i0 += 4 * gs) {
                f32x4 a[4], b[4];
#pragma unroll
                for (int u = 0; u < 4; ++u) { a[u] = *(const GAS f32x4*)(xs + i0 + u * gs); b[u] = *(const GAS f32x4*)(xs + i0 + u * gs + 4); }
#pragma unroll
                for (int u = 0; u < 4; ++u) { const size_t i = i0 + u * gs;
                    v4u o; o.x = pk2(a[u].x, a[u].y); o.y = pk2(a[u].z, a[u].w); o.z = pk2(b[u].x, b[u].y); o.w = pk2(b[u].z, b[u].w);
                    *(GAS v4u*)(HB0 + i) = o;
                    int w0 = 0, w1 = 0;
                    w0 = __builtin_amdgcn_cvt_pk_fp8_f32(a[u].x, a[u].y, w0, false); w0 = __builtin_amdgcn_cvt_pk_fp8_f32(a[u].z, a[u].w, w0, true);
                    w1 = __builtin_amdgcn_cvt_pk_fp8_f32(b[u].x, b[u].y, w1, false); w1 = __builtin_amdgcn_cvt_pk_fp8_f32(b[u].z, b[u].w, w1, true);
                    v2u o8; o8.x = (unsigned)w0; o8.y = (unsigned)w1; *(GAS v2u*)(s8 + i) = o8; } } }
        {
            const float* lam_re = ARG_IN(11); const float* lam_im = ARG_IN(12); const float* log_step = ARG_IN(13); const float* b_re = ARG_IN(14); const float* b_im = ARG_IN(15);
            float* ssmp = (float*)(ws + WS_SSMP);
            for (int i = gtid; i < 128 * 64; i += gthreads) { const int g = i >> 6;
                const float lr = lam_re[i], li = lam_im[i], dt = expf(log_step[g]);
                const float mag = expf(dt * lr), ar = mag * cosf(dt * li), ai = mag * sinf(dt * li);
                const float den = lr * lr + li * li;
                const float kr = ((ar - 1.f) * lr + ai * li) / den, ki = (ai * lr - (ar - 1.f) * li) / den;
                float* o = ssmp + (size_t)i * 34; o[0] = ar; o[1] = ai;
                for (int c = 0; c < 16; ++c) { const float br = b_re[i * 16 + c], bi = b_im[i * 16 + c]; o[2 + c] = kr * br - ki * bi; o[18 + c] = kr * bi + ki * br; } }
        }
    }
    if constexpr (SLOT == 1) {
        pg8::StaticOrder S;
        if (kind == 2) {
            pg8::Gemm g{(const bf16*)(ws + WS_S8), (const bf16*)(ws + W_ATTN_QKV), M, 3 * D, D / 2, D / 2, 0}; S.init(M, 3 * D, G, bx);
            pg8::EpiBf16 E{T1, D, nullptr, D, (size_t)(WS_T2 - WS_T1) / 2, ATTN_QSCALE, nullptr, 1.f / W8S};
            pg8::gemm_phase<pg8::EpiBf16, true>(lds, g, S, E, tid);
        } else {
            const unsigned char* W = (kind == 0) ? ws + W_POOL_IN + (size_t)jj * D * D : ws + W_SSM_IN;
            pg8::Gemm g{(const bf16*)(ws + WS_S8), (const bf16*)W, M, D, D / 2, D / 2, 0}; S.init(M, D, G, bx);
            pg8::EpiBf16 E{T1, D, nullptr, 0, 0, 1.f, nullptr, 1.f / W8S};
            pg8::gemm_phase<pg8::EpiBf16, true>(lds, g, S, E, tid);
        }
    }
    if constexpr (SLOT == 2) {
        if (kind == 0) pool_phase(T1, (u8*)T2, gw, NGW, lane);
        else if (kind == 1) ssm_phase_m(T1, (u8*)T2, (const float*)(ws + WS_SSMP), ARG_IN(16), ARG_IN(17), ARG_IN(18), lds, vcu, G, wave, lane);
        else {
            LAS float* rb = (LAS float*)lds;
            for (int i = tid; i < 16 * 257; i += NWAVES * 64) rb[i] = ARG_IN(22)[i] * LOG2E;
            __syncthreads();
            attn_phase_split(T1, T2, T3, ws + WS_X8, rb, lds + 32768, vcu, G, wave, lane);
            __syncthreads();
        }
    }
    if constexpr (SLOT == 3) {
        pg8::StaticOrder S; S.init(M, D, G, bx);
        if (kind == 0) {
            pg8::Gemm g{(const bf16*)T2, (const bf16*)(ws + W_POOL_GRP + (size_t)jj * D * 512), M, D, 256, D / 2, 2};
            pg8::EpiF8 E{(unsigned char*)T1, D, ARG_IN(8) + (size_t)jj * D, 1.f / W8S};
            pg8::gemm_phase<pg8::EpiF8, true>(lds, g, S, E, tid);
        } else if (kind == 1) {
            pg8::Gemm g{(const bf16*)T2, (const bf16*)(ws + W_SSM_GLU), M, D, D / 2, D / 2, 0};
            pg8::EpiGlu8 E{(const unsigned char*)T2, (unsigned char*)T1, D, 1.f / W8S};
            pg8::gemm_phase<pg8::EpiGlu8, true>(lds, g, S, E, tid);
        }
    }
    if constexpr (SLOT == 4) {
        const unsigned char* W = (kind == 0) ? ws + W_POOL_OUT + (size_t)jj * D * D : (kind == 1) ? ws + W_SSM_OUT : ws + W_ATTN_OUT;
        pg8::Gemm g{(kind == 2) ? (const bf16*)(ws + WS_X8) : (const bf16*)T1, (const bf16*)W, M, D, D / 2, D / 2, 0}; pg8::StaticOrder S; S.init(M, D, G, bx);
        pg8::EpiRes E{Sin, Sin, D, DN_ALPHA, (kind == 2) ? 1.f / (W8S * O8S) : 1.f / W8S};
        pg8::gemm_phase<pg8::EpiRes, true>(lds, g, S, E, tid);
    }
    if constexpr (SLOT == 5) ln_phase<true>(Sin, ARG_IN(2) + (size_t)layer * D, ARG_IN(3) + (size_t)layer * D, gw, NGW, lane, ws + WS_X8, ws + WS_S8, (float*)(ws + WS_STATS));
    if constexpr (SLOT == 6) {
        { pg8::Gemm g{(const bf16*)(ws + WS_S8), (const bf16*)(ws + W_PEER_Q + (size_t)layer * D * D), M, D, D / 2, D / 2, 0}; pg8::StaticOrder S; S.init(M, D, G, bx);
          pg8::EpiBf16 E{T1, D, nullptr, 0, 0, 1.f, nullptr, 1.f / W8S};
          pg8::gemm_phase<pg8::EpiBf16, true>(lds, g, S, E, tid); }
    }
    if constexpr (SLOT == 14) {
        __syncthreads();
        { pg8::Gemm g{PB + (size_t)layer * M * PLE, (const bf16*)(ws + W_PLE_PROJ) + (size_t)layer * PLE * D, M, D, PLE, PLE, 0}; pg8::StaticOrder S; S.init(M, D, G, bx);
          pg8::EpiF8 E{(unsigned char*)T3, D, nullptr, 8.f};
          pg8::gemm_phase<pg8::EpiF8>(lds, g, S, E, tid); }
    }
    if constexpr (SLOT == 7) {
        const bf16* sk = SKB + (size_t)layer * 2 * 128 * 128;
        for (int i = tid; i < 256 * 16; i += NWAVES * 64) { const int rowi = i >> 4, ch = i & 15; *(LAS v4u*)(lds + rowi * 272 + ch * 16) = *(const v4u*)(sk + rowi * 128 + ch * 8); }
        __syncthreads();
        peer_select_phase(T1, lds, IDX, GATE, gw, NGW, lane);
        __syncthreads();
    }
    if constexpr (SLOT == 8) peer_u_pass(ws + WS_X8, IDX, (const u8*)TU + (size_t)layer * NEXP * 1024, (float*)T2, bx, G, wave, lane);
    if constexpr (SLOT == 11) peer_act_phase((const float*)T2, IDX, GATE, (const float*)(ws + WS_SU) + layer * NEXP, (const float*)(ws + WS_SV) + layer * NEXP, gw, NGW, lane);
    if constexpr (SLOT == 12) peer_v_pass(Sin, IDX, GATE, (const u8*)TV + (size_t)layer * NEXP * 1024, (const float*)(ws + WS_STATS), ARG_IN(2) + (size_t)layer * D, ARG_IN(3) + (size_t)layer * D, bx, G, wave, lane);
    if constexpr (SLOT == 13) ln_phase(Sin, ARG_IN(4) + (size_t)layer * D, ARG_IN(5) + (size_t)layer * D, gw, NGW, lane, ws + WS_X8);
    if constexpr (SLOT == 10) {
        pg8::Gemm g{(const bf16*)(ws + WS_X8), (const bf16*)(ws + W_PLE_GATE + (size_t)layer * D * D), M, D, D / 2, D / 2, 0}; pg8::StaticOrder S; S.init(M, D, G, bx);
        pg8::EpiPle E{Sin, (const unsigned char*)T3, Sout, ws + WS_S8, (layer == DEPTH - 1) ? hout : nullptr, ARG_IN(30) + (size_t)layer * D, D, 1.f / W8S};
        pg8::gemm_phase<pg8::EpiPle, true>(lds, g, S, E, tid);
    }
}

template <int SLOT>
__global__ void __launch_bounds__(NWAVES * 64, 2) mk_slot(Args args) {
    extern __shared__ __attribute__((aligned(16))) unsigned char lds_raw[];
    store_tab(args, (LAS unsigned char*)lds_raw);
    run_slot<SLOT>((LAS unsigned char*)lds_raw, args.layer, __builtin_amdgcn_readfirstlane((int)(threadIdx.x >> 6)));
}

#if !MK_PER_PHASE
__global__ void __launch_bounds__(NWAVES * 64, 2) mk_fwd(Args args) {
    extern __shared__ __attribute__((aligned(16))) unsigned char lds_raw[];
    LAS unsigned char* lds = (LAS unsigned char*)lds_raw;
    volatile LAS unsigned* MISC = (volatile LAS unsigned*)(lds + MISC_OFF);
    for (int u = threadIdx.x; u < (LDS_BYTES - LDSCTL_OFF) / 4; u += NWAVES * 64) ((LAS unsigned*)(lds + LDSCTL_OFF))[u] = 0u;
    __syncthreads();
    store_tab(args, lds);
    const XcdBarrier bar = xcd_barrier_post((unsigned*)(args.ws + WS_CTL) + CW_BAR, MISC + 8);
    run_slot<0>(lds, 0, bar.wave); xcd_barrier(bar);
    for (int layer = 0; layer < DEPTH; ++layer) {
        run_slot<1>(lds, layer, bar.wave); xcd_barrier(bar);
        run_slot<2>(lds, layer, bar.wave); xcd_barrier(bar);
        if (layer % 3 != 2) { run_slot<3>(lds, layer, bar.wave); xcd_barrier(bar); }
        run_slot<4>(lds, layer, bar.wave); xcd_barrier(bar);
        run_slot<5>(lds, layer, bar.wave); xcd_barrier(bar);
        run_slot<6>(lds, layer, bar.wave); run_slot<14>(lds, layer, bar.wave); xcd_barrier(bar);
        run_slot<7>(lds, layer, bar.wave); xcd_barrier(bar);
        run_slot<8>(lds, layer, bar.wave); xcd_barrier(bar);
        run_slot<11>(lds, layer, bar.wave); xcd_barrier(bar);
        run_slot<12>(lds, layer, bar.wave); xcd_barrier(bar);
        run_slot<13>(lds, layer, bar.wave); xcd_barrier(bar);
        run_slot<10>(lds, layer, bar.wave); if (layer + 1 < DEPTH) xcd_barrier(bar);
    }
}
#endif

template <int SLOT> static void launch_slot(const Args& a0, int layer, int grid, hipStream_t stream) {
    static bool attr_done = false;
    if (!attr_done) { (void)hipFuncSetAttribute((const void*)mk_slot<SLOT>, hipFuncAttributeMaxDynamicSharedMemorySize, LDS_BYTES); attr_done = true; }
    Args a = a0; a.slot = SLOT; a.layer = layer;
    hipLaunchKernelGGL(mk_slot<SLOT>, dim3(grid), dim3(NWAVES * 64), LDS_BYTES, stream, a);
}

extern "C" void kernel_launch(void* const* d_in, const int* in_sizes, int n_in, void* d_out, int out_size, void* d_ws, size_t ws_size, hipStream_t stream) {
    static int grid = 0;
    if (grid == 0) {
        if (n_in != 31 || out_size != M * D || ws_size < WS_END) { fprintf(stderr, "kernel_launch: unexpected shapes (n_in %d out %d ws %zu)\n", n_in, out_size, ws_size); grid = -1; return; }
        int dev = 0, cus = 0, per_cu = 0;
        if (hipGetDevice(&dev) != hipSuccess || hipDeviceGetAttribute(&cus, hipDeviceAttributeMultiprocessorCount, dev) != hipSuccess) { grid = -1; return; }
#if !MK_PER_PHASE
        if (hipFuncSetAttribute((const void*)mk_fwd, hipFuncAttributeMaxDynamicSharedMemorySize, LDS_BYTES) != hipSuccess) { fprintf(stderr, "kernel_launch: hipFuncSetAttribute failed\n"); grid = -1; return; }
        if (hipOccupancyMaxActiveBlocksPerMultiprocessor(&per_cu, (const void*)mk_fwd, NWAVES * 64, LDS_BYTES) != hipSuccess || per_cu < 1) { fprintf(stderr, "kernel_launch: occupancy query says %d\n", per_cu); }
        (void)hipGetLastError();
#endif
        (void)per_cu;
        grid = cus;
    }
    if (grid < 0) return;
    Args a{};
    for (int i = 0; i < 31; ++i) a.in[i] = (const float*)d_in[i];
    a.out = (float*)d_out; a.ws = (unsigned char*)d_ws;
#if MK_PER_PHASE
    launch_slot<0>(a, 0, grid, stream);
    for (int layer = 0; layer < DEPTH; ++layer) {
        launch_slot<1>(a, layer, grid, stream); launch_slot<2>(a, layer, grid, stream);
        if (layer % 3 != 2) launch_slot<3>(a, layer, grid, stream);
        launch_slot<4>(a, layer, grid, stream); launch_slot<5>(a, layer, grid, stream); launch_slot<6>(a, layer, grid, stream); launch_slot<14>(a, layer, grid, stream); launch_slot<7>(a, layer, grid, stream);
        launch_slot<8>(a, layer, grid, stream); launch_slot<11>(a, layer, grid, stream); launch_slot<12>(a, layer, grid, stream); launch_slot<13>(a, layer, grid, stream); launch_slot<10>(a, layer, grid, stream);
    }
#else
    if (hipMemsetAsync((char*)d_ws + WS_CTL, 0, CTL_ZERO_BYTES, stream) != hipSuccess) return;
    hipLaunchKernelGGL(mk_fwd, dim3(grid), dim3(NWAVES * 64), LDS_BYTES, stream, a);
#endif
}
```

```cpp
#include <hip/hip_runtime.h>
#include <cstdio>
#include <cstdint>

#ifndef MK_PER_PHASE
#define MK_PER_PHASE 0
#endif

namespace pg8 {
#define PG8_LAS __attribute__((address_space(3)))
typedef unsigned short bf16_t;
typedef short bf16x8 __attribute__((ext_vector_type(8)));
typedef float f32x4 __attribute__((ext_vector_type(4)));
typedef unsigned u32x4 __attribute__((ext_vector_type(4)));
constexpr int BM = 256, BK = 64, HALF = 128, HTB = HALF * BK * 2, STAGE_BYTES = 8 * HTB, NXCD = 8, WGM = 8;

__host__ __device__ __forceinline__ int lds_byte(int r, int c) { const int st = (r >> 4) * 2 + (c >> 5), rr = r & 15, cc = c & 31, ob = rr * 64 + cc * 2; return st * 1024 + (ob ^ (((ob >> 9) & 1) << 5)); }
__host__ __device__ __forceinline__ int lds_byte8(int r, int c) { const int st = (r >> 4) * 2 + (c >> 5), rr = r & 15, cc = c & 31, ob = rr * 64 + cc * 2; return st * 1024 + (ob ^ (((ob >> 9) & 1) << 5) ^ (((ob >> 8) & 1) << 4)); }
__host__ __device__ __forceinline__ void stage_rc8(int b, int& R, int& C) { const int st = b / 1024, sb = b % 1024, swz = sb ^ (((sb >> 9) & 1) << 5) ^ (((sb >> 8) & 1) << 4); R = (st >> 1) * 16 + swz / 64; C = (st & 1) * 32 + (swz % 64) / 2; }
__host__ __device__ __forceinline__ void stage_rc(int b, int& R, int& C) { const int st = b / 1024, sb = b % 1024, swz = sb ^ (((sb >> 9) & 1) << 5); R = (st >> 1) * 16 + swz / 64; C = (st & 1) * 32 + (swz % 64) / 2; }
__host__ __device__ __forceinline__ int perm32(int rho) { const int n = rho >> 4, i = rho & 15; return 8 * (i >> 2) + 4 * n + (i & 3); }
__host__ __device__ __forceinline__ int perm32f8(int rho) { return 16 * ((rho >> 2) & 1) + (rho & 3) + 4 * (rho >> 3); }

__device__ __forceinline__ int lane_now() { int l; asm volatile("v_mbcnt_lo_u32_b32 %0, -1, 0\n\tv_mbcnt_hi_u32_b32 %0, -1, %0" : "=v"(l)); return l; }
struct Unit { int pm, pn; };
struct Gemm { const bf16_t* A; const bf16_t* Bt; int M, N, K, lda, agrp; };

struct StaticOrder {
    int nM, nN, nwg, G, c;
    __host__ __device__ void init(int M, int N, int G_, int c_) { nM = M / BM; nN = N / BM; nwg = nM * nN; G = G_; c = c_; }
    __host__ __device__ bool next(int i, Unit& u) const {
        const long L = (long)i * G + c; if (L >= nwg) return false;
        int wgid = (int)L; { const int q = nwg / NXCD, r = nwg % NXCD, xcd = wgid % NXCD, off = wgid / NXCD; wgid = (xcd < r ? xcd * (q + 1) : r * (q + 1) + (xcd - r) * q) + off; }
        const int nig = WGM * nN, gid = wgid / nig, fm = gid * WGM, gsz = (nM - fm) < WGM ? (nM - fm) : WGM;
        u.pm = fm + ((wgid % nig) % gsz); u.pn = (wgid % nig) / gsz; return true;
    }
};

__device__ __forceinline__ unsigned cvt_pk_bf16(float lo, float hi) { unsigned r; asm volatile("v_cvt_pk_bf16_f32 %0, %1, %2" : "=v"(r) : "v"(lo), "v"(hi)); return r; }
__device__ __forceinline__ float bf_lo(unsigned w) { return __builtin_bit_cast(float, w << 16); }
__device__ __forceinline__ float bf_hi(unsigned w) { return __builtin_bit_cast(float, w & 0xffff0000u); }
__device__ __forceinline__ float sigmoid_f(float x) { return __builtin_amdgcn_rcpf(1.f + __builtin_amdgcn_exp2f(-1.4426950408889634f * x)); }
#ifdef DBG_PLE_HALF
__device__ __forceinline__ float sigmoid_p(float x) { return 0.5f; }
#else
__device__ __forceinline__ float sigmoid_p(float x) { return sigmoid_f(x); }
#endif

typedef int v8i_t __attribute__((ext_vector_type(8)));
typedef unsigned u32x2 __attribute__((ext_vector_type(2)));
typedef float f32x16 __attribute__((ext_vector_type(16)));
typedef float f32x2_ __attribute__((ext_vector_type(2)));
__device__ __forceinline__ u32x2 pack8_fp8(const f32x4 v0, const f32x4 v1) {
    int a = 0, b = 0;
    a = __builtin_amdgcn_cvt_pk_fp8_f32(v0[0], v0[1], a, false); a = __builtin_amdgcn_cvt_pk_fp8_f32(v0[2], v0[3], a, true);
    b = __builtin_amdgcn_cvt_pk_fp8_f32(v1[0], v1[1], b, false); b = __builtin_amdgcn_cvt_pk_fp8_f32(v1[2], v1[3], b, true);
    return (u32x2){(unsigned)a, (unsigned)b};
}
__device__ __forceinline__ u32x4 pack8_bf16(const f32x4 v0, const f32x4 v1) { u32x4 w; w.x = cvt_pk_bf16(v0[0], v0[1]); w.y = cvt_pk_bf16(v0[2], v0[3]); w.z = cvt_pk_bf16(v1[0], v1[1]); w.w = cvt_pk_bf16(v1[2], v1[3]); return w; }
struct EpiBf16 {
    bf16_t* O; int ldc; const float* cscale; int split_cols; size_t split_stride; float scale0; bf16_t* VT; float oscale;
    __device__ __forceinline__ void chunk(int row, int col, f32x4 v0, f32x4 v1) const {
        if (cscale) { v0 = v0 * *(const f32x4*)(cscale + col); v1 = v1 * *(const f32x4*)(cscale + col + 4); }
        if (!split_cols) { *(u32x4*)(O + (size_t)row * ldc + col) = pack8_bf16(v0 * oscale, v1 * oscale); return; }
        const int t = col / split_cols, c = col - t * split_cols, hd = c >> 7, d = c & 127, b = row >> 13, sq = row & 8191;
        const float sc = (t == 0) ? oscale * scale0 : oscale;
        const u32x4 w = pack8_bf16(v0 * sc, v1 * sc);
        bf16_t* base = O + (size_t)t * split_stride;
        const size_t bh = (size_t)(b * 16 + hd) * 256 + (sq >> 5);
        if (t < 2) *(u32x4*)(base + ((bh * 8 + (d >> 4)) * 512) + (size_t)((sq & 31) + 32 * ((d >> 3) & 1)) * 8) = w;
        else { const int kk = sq & 31, k16 = kk & 15; bf16_t* p = base + ((((bh * 4 + (d >> 5)) * 2 + (kk >> 4)) * 512) + (size_t)((d & 31) + 32 * ((k16 >> 2) & 1)) * 8) + (k16 & 3) + 4 * (k16 >> 3);
            p[0] = (bf16_t)(w.x & 0xffffu); p[8] = (bf16_t)(w.x >> 16); p[16] = (bf16_t)(w.y & 0xffffu); p[24] = (bf16_t)(w.y >> 16);
            p[32] = (bf16_t)(w.z & 0xffffu); p[40] = (bf16_t)(w.z >> 16); p[48] = (bf16_t)(w.w & 0xffffu); p[56] = (bf16_t)(w.w >> 16); }
    }
};
struct EpiF8 {
    unsigned char* O; int ldc; const float* cscale; float oscale;
    __device__ __forceinline__ void chunk(int row, int col, f32x4 v0, f32x4 v1) const {
        if (cscale) { v0 = v0 * *(const f32x4*)(cscale + col); v1 = v1 * *(const f32x4*)(cscale + col + 4); }
        *(u32x2*)(O + (size_t)row * ldc + col) = pack8_fp8(v0 * oscale, v1 * oscale);
    }
};
struct EpiGlu8 {
    const unsigned char* Gin; unsigned char* O; int ld; float oscale;
    __device__ __forceinline__ void chunk(int row, int col, f32x4 a0, f32x4 a1) const {
        const size_t ro = (size_t)row * ld + col; const u32x2 g = *(const u32x2*)(Gin + ro); a0 = a0 * oscale; a1 = a1 * oscale;
        const unsigned gx = g.x, gy = g.y;
        const f32x2_ g01 = __builtin_amdgcn_cvt_pk_f32_fp8((int)gx, false), g23 = __builtin_amdgcn_cvt_pk_f32_fp8((int)gx, true), g45 = __builtin_amdgcn_cvt_pk_f32_fp8((int)gy, false), g67 = __builtin_amdgcn_cvt_pk_f32_fp8((int)gy, true);
        const f32x4 o0 = {g01.x * sigmoid_f(a0[0]), g01.y * sigmoid_f(a0[1]), g23.x * sigmoid_f(a0[2]), g23.y * sigmoid_f(a0[3])};
        const f32x4 o1 = {g45.x * sigmoid_f(a1[0]), g45.y * sigmoid_f(a1[1]), g67.x * sigmoid_f(a1[2]), g67.y * sigmoid_f(a1[3])};
        *(u32x2*)(O + ro) = pack8_fp8(o0, o1);
    }
};
struct EpiRes {
    const bf16_t* hres; bf16_t* out; int ld; float alpha; float mscale;
    __device__ __forceinline__ void chunk(int row, int col, f32x4 a0, f32x4 a1) const {
        const size_t ro = (size_t)row * ld + col; const u32x4 h = *(const u32x4*)(hres + ro); a0 = a0 * mscale; a1 = a1 * mscale;
        const f32x4 o0 = {bf_lo(h.x) * alpha + a0[0], bf_hi(h.x) * alpha + a0[1], bf_lo(h.y) * alpha + a0[2], bf_hi(h.y) * alpha + a0[3]};
        const f32x4 o1 = {bf_lo(h.z) * alpha + a1[0], bf_hi(h.z) * alpha + a1[1], bf_lo(h.w) * alpha + a1[2], bf_hi(h.w) * alpha + a1[3]};
        *(u32x4*)(out + ro) = pack8_bf16(o0, o1);
    }
};
struct EpiPle {
    const bf16_t* hin; const unsigned char* proj; bf16_t* hob; unsigned char* ho8; float* fout; const float* bias; int ld; float oscale;
    __device__ __forceinline__ void chunk(int row, int col, f32x4 a0, f32x4 a1) const {
        const size_t ro = (size_t)row * ld + col; const u32x2 pj8 = *(const u32x2*)(proj + ro); const u32x4 hh = *(const u32x4*)(hin + ro);
        const unsigned pjx = pj8.x, pjy = pj8.y;
        const f32x2_ q01 = __builtin_amdgcn_cvt_pk_f32_fp8((int)pjx, false), q23 = __builtin_amdgcn_cvt_pk_f32_fp8((int)pjx, true), q45 = __builtin_amdgcn_cvt_pk_f32_fp8((int)pjy, false), q67 = __builtin_amdgcn_cvt_pk_f32_fp8((int)pjy, true);
        const float pjs = 1.f / 8.f;
        const float p0 = q01.x * pjs, p1 = q01.y * pjs, p2 = q23.x * pjs, p3 = q23.y * pjs, p4 = q45.x * pjs, p5 = q45.y * pjs, p6 = q67.x * pjs, p7 = q67.y * pjs;
        a0 = a0 * oscale + *(const f32x4*)(bias + col); a1 = a1 * oscale + *(const f32x4*)(bias + col + 4);
        f32x4 h0, h1;
        h0[0] = bf_lo(hh.x) + sigmoid_p(a0[0]) * p0; h0[1] = bf_hi(hh.x) + sigmoid_p(a0[1]) * p1; h0[2] = bf_lo(hh.y) + sigmoid_p(a0[2]) * p2; h0[3] = bf_hi(hh.y) + sigmoid_p(a0[3]) * p3;
        h1[0] = bf_lo(hh.z) + sigmoid_p(a1[0]) * p4; h1[1] = bf_hi(hh.z) + sigmoid_p(a1[1]) * p5; h1[2] = bf_lo(hh.w) + sigmoid_p(a1[2]) * p6; h1[3] = bf_hi(hh.w) + sigmoid_p(a1[3]) * p7;
        if (fout != nullptr) { *(f32x4*)(fout + ro) = h0; *(f32x4*)(fout + ro + 4) = h1; }
        else { *(u32x4*)(hob + ro) = pack8_bf16(h0, h1); *(u32x2*)(ho8 + ro) = pack8_fp8(h0, h1); }
    }
};

template <class Epi, bool F8 = false>
__device__ __forceinline__ void gemm_phase(PG8_LAS unsigned char* lds, const Gemm g, const StaticOrder& S, const Epi& E, const int tid) {
    const int wid = __builtin_amdgcn_readfirstlane(tid >> 6), lane = tid & 63, wr = wid >> 2, wc = wid & 3, fr = lane & 15, fq = lane >> 4;
    const int K = g.K, nt = K / BK, lda = g.lda;
    unsigned voffA[2], voffB[2];
#pragma unroll
    for (int i = 0; i < 2; ++i) { int R, C; if (F8) stage_rc8(tid * 16 + i * 8192, R, C); else stage_rc(tid * 16 + i * 8192, R, C); const int Rb = (R & ~31) + (F8 ? perm32f8(R & 31) : perm32(R & 31));
        voffA[i] = (unsigned)(R * lda + C) * 2u; voffB[i] = (unsigned)(Rb * K + C) * 2u; }
    const size_t kstep = (size_t)(BK * 2);
    const size_t hstepA = (size_t)HALF * lda * 2, hstepB = (size_t)HALF * K * 2;
    const size_t tstepA = 2 * hstepA, tstepB = 2 * hstepB;
    const unsigned ldsw = (unsigned)wid * 1024u;
    const int l31 = lane & 31, h32 = lane >> 5;
    const int aoff = F8 ? lds_byte8(wr * 64 + l31, 16 * h32) : lds_byte(wr * 64 + fr, fq * 8);
    const int boff = F8 ? lds_byte8(wc * 32 + l31, 16 * h32) : lds_byte(wc * 32 + fr, fq * 8);
    const int aoffx = aoff ^ 16, boffx = boff ^ 16;
#define PG8_SA(b, h) (((b) * 2 + (h)) * HTB)
#define PG8_SB(b, h) ((4 + (b) * 2 + (h)) * HTB)
#define PG8_STAGE(bufoff, gbase, voff) do { _Pragma("unroll") for (int _i = 0; _i < 2; ++_i) \
        __builtin_amdgcn_global_load_lds((const unsigned*)((const char*)(gbase) + (voff)[_i]), (PG8_LAS unsigned*)(lds + (bufoff) + ldsw + _i * 8192), 16, 0, 0); } while (0)
#define PG8_LD32(dst, off, offx) do { typedef int _v4i __attribute__((ext_vector_type(4))); const _v4i _lo = *(const PG8_LAS _v4i*)(lds + (off)), _hi = *(const PG8_LAS _v4i*)(lds + (offx)); \
        dst = __builtin_shufflevector(_lo, _hi, 0, 1, 2, 3, 4, 5, 6, 7); } while (0)
#define PG8_LDA(dst, b, h) do { if constexpr (F8) { _Pragma("unroll") for (int m2 = 0; m2 < 2; ++m2) _Pragma("unroll") for (int ks = 0; ks < 2; ++ks) PG8_LD32(dst##8[m2][ks], PG8_SA(b, h) + aoff + m2 * 4096 + ks * 1024, PG8_SA(b, h) + aoffx + m2 * 4096 + ks * 1024); } \
        else { _Pragma("unroll") for (int m = 0; m < 4; ++m) _Pragma("unroll") for (int k = 0; k < 2; ++k) dst[m][k] = *(const PG8_LAS bf16x8*)(lds + PG8_SA(b, h) + aoff + m * 2048 + k * 1024); } } while (0)
#define PG8_LDB(dst, b, h) do { if constexpr (F8) { _Pragma("unroll") for (int ks = 0; ks < 2; ++ks) PG8_LD32(dst##8[ks], PG8_SB(b, h) + boff + ks * 1024, PG8_SB(b, h) + boffx + ks * 1024); } \
        else { _Pragma("unroll") for (int n = 0; n < 2; ++n) _Pragma("unroll") for (int k = 0; k < 2; ++k) dst[n][k] = *(const PG8_LAS bf16x8*)(lds + PG8_SB(b, h) + boff + n * 2048 + k * 1024); } } while (0)
#define PG8_MMA(ai, bj, At, Bt) do { __builtin_amdgcn_s_setprio(1); \
        if constexpr (F8) { _Pragma("unroll") for (int m2 = 0; m2 < 2; ++m2) _Pragma("unroll") for (int ks = 0; ks < 2; ++ks) \
            acc32[ai][bj][m2] = __builtin_amdgcn_mfma_scale_f32_32x32x64_f8f6f4(Bt##8[ks], At##8[m2][ks], acc32[ai][bj][m2], 0, 0, 0, 0, 0, 0); } \
        else { _Pragma("unroll") for (int m = 0; m < 4; ++m) _Pragma("unroll") for (int n = 0; n < 2; ++n) _Pragma("unroll") for (int k = 0; k < 2; ++k) \
            acc[ai][bj][m][n] = __builtin_amdgcn_mfma_f32_16x16x32_bf16(Bt[n][k], At[m][k], acc[ai][bj][m][n], 0, 0, 0); } \
        __builtin_amdgcn_s_setprio(0); } while (0)
#define PG8_WAIT_V(n) asm volatile("s_waitcnt vmcnt(" #n ")" ::: "memory")
#define PG8_WAIT_L(n) asm volatile("s_waitcnt lgkmcnt(" #n ")" ::: "memory")
#define PG8_BAR __builtin_amdgcn_s_barrier()
#define PG8_SCHED __builtin_amdgcn_sched_barrier(0)
#define PG8_ACOL(u) ((g.agrp > 0) ? (size_t)((u).pn / g.agrp) * (size_t)K * 2 : (size_t)0)
    Unit cur, nxt; int ui = 0;
    if (!S.next(0, cur)) return;
    f32x4 acc[2][2][4][2];
#pragma unroll
    for (int a = 0; a < 2; ++a)
#pragma unroll
        for (int b = 0; b < 2; ++b)
#pragma unroll
            for (int m = 0; m < 4; ++m)
#pragma unroll
                for (int n = 0; n < 2; ++n) acc[a][b][m][n] = (f32x4){0.f, 0.f, 0.f, 0.f};
    bf16x8 At[4][2], B0[2][2], B1[2][2];
    v8i_t At8[2][2], B08[2], B18[2];
    f32x16 acc32[2][2][2];
#pragma unroll
    for (int a = 0; a < 2; ++a)
#pragma unroll
        for (int b = 0; b < 2; ++b)
#pragma unroll
            for (int m2 = 0; m2 < 2; ++m2)
#pragma unroll
                for (int i = 0; i < 16; ++i) acc32[a][b][m2][i] = 0.f;
    const char* cA = (const char*)g.A + (size_t)cur.pm * tstepA + PG8_ACOL(cur); const char* cB = (const char*)g.Bt + (size_t)cur.pn * tstepB;
    PG8_STAGE(PG8_SB(0, 0), cB, voffB); PG8_STAGE(PG8_SB(0, 1), cB + hstepB, voffB); PG8_STAGE(PG8_SA(0, 0), cA, voffA); PG8_STAGE(PG8_SA(0, 1), cA + hstepA, voffA);
    if (wr == 1) PG8_BAR;
    PG8_WAIT_V(2); PG8_BAR;
    PG8_STAGE(PG8_SB(1, 0), cB + kstep, voffB); PG8_STAGE(PG8_SA(1, 0), cA + kstep, voffA); PG8_STAGE(PG8_SB(1, 1), cB + hstepB + kstep, voffB);
    PG8_WAIT_V(6); PG8_BAR;
    for (;;) {
        const bool has_next = S.next(ui + 1, nxt);
        const char* nA = has_next ? (const char*)g.A + (size_t)nxt.pm * tstepA + PG8_ACOL(nxt) : cA; const char* nB = has_next ? (const char*)g.Bt + (size_t)nxt.pn * tstepB : cB;
        for (int t = 0; t < nt; t += 2) {
            const bool last = (t == nt - 2);
            const char* a1 = cA + (size_t)(t + 1) * kstep;
            const char* a2 = last ? nA : cA + (size_t)(t + 2) * kstep; const char* b2 = last ? nB : cB + (size_t)(t + 2) * kstep;
            const char* a3 = a2 + kstep; const char* b3 = b2 + kstep;
            PG8_LDB(B0, 0, 0); PG8_LDB(B1, 0, 1); PG8_SCHED; PG8_LDA(At, 0, 0); PG8_STAGE(PG8_SA(1, 1), a1 + hstepA, voffA);
            PG8_WAIT_V(8); PG8_WAIT_L(0); PG8_BAR; PG8_MMA(0, 0, At, B0); PG8_MMA(0, 1, At, B1); PG8_BAR; PG8_SCHED;
            PG8_LDA(At, 0, 1); PG8_STAGE(PG8_SB(0, 0), b2, voffB); PG8_STAGE(PG8_SB(0, 1), b2 + hstepB, voffB); PG8_STAGE(PG8_SA(0, 0), a2, voffA);
            PG8_WAIT_V(8); PG8_WAIT_L(0); PG8_BAR; PG8_MMA(1, 0, At, B0); PG8_MMA(1, 1, At, B1); PG8_BAR; PG8_SCHED;
            PG8_LDB(B0, 1, 0); PG8_LDB(B1, 1, 1); PG8_SCHED; PG8_LDA(At, 1, 0); PG8_STAGE(PG8_SA(0, 1), a2 + hstepA, voffA);
            PG8_WAIT_V(8); PG8_WAIT_L(0); PG8_BAR; PG8_MMA(0, 0, At, B0); PG8_MMA(0, 1, At, B1); PG8_BAR; PG8_SCHED;
            PG8_LDA(At, 1, 1); PG8_STAGE(PG8_SB(1, 0), b3, voffB); PG8_STAGE(PG8_SB(1, 1), b3 + hstepB, voffB); PG8_STAGE(PG8_SA(1, 0), a3, voffA);
            PG8_WAIT_V(8); PG8_WAIT_L(0); PG8_BAR; PG8_MMA(1, 0, At, B0); PG8_MMA(1, 1, At, B1); PG8_BAR; PG8_SCHED;
        }
        if (wr == 0) PG8_BAR;
        if constexpr (F8) {
            const int lnE = lane_now(); const int rowF = cur.pm * BM + wr * 64 + (lnE & 31), colF = cur.pn * BM + wc * 32 + 16 * (lnE >> 5);
#pragma unroll
            for (int a = 0; a < 2; ++a)
#pragma unroll
                for (int m2 = 0; m2 < 2; ++m2)
#pragma unroll
                    for (int b = 0; b < 2; ++b) { const f32x16 v = acc32[a][b][m2];
                        E.chunk(rowF + a * HALF + 32 * m2, colF + b * HALF, (f32x4){v[0], v[1], v[2], v[3]}, (f32x4){v[4], v[5], v[6], v[7]});
                        E.chunk(rowF + a * HALF + 32 * m2, colF + b * HALF + 8, (f32x4){v[8], v[9], v[10], v[11]}, (f32x4){v[12], v[13], v[14], v[15]});
#pragma unroll
                        for (int i = 0; i < 16; ++i) acc32[a][b][m2][i] = 0.f; }
        } else {
            const int lnE = lane_now(); const int row0 = cur.pm * BM + wr * 64 + (lnE & 15), col0 = cur.pn * BM + wc * 32 + 8 * (lnE >> 4);
#pragma unroll
            for (int a = 0; a < 2; ++a)
#pragma unroll
                for (int m = 0; m < 4; ++m)
#pragma unroll
                    for (int b = 0; b < 2; ++b) E.chunk(row0 + a * HALF + m * 16, col0 + b * HALF, acc[a][b][m][0], acc[a][b][m][1]);
        }
        if (!has_next) break;
#pragma unroll
        for (int a = 0; a < 2; ++a)
#pragma unroll
            for (int b = 0; b < 2; ++b)
#pragma unroll
                for (int m = 0; m < 4; ++m)
#pragma unroll
                    for (int n = 0; n < 2; ++n) acc[a][b][m][n] = (f32x4){0.f, 0.f, 0.f, 0.f};
        cur = nxt; cA = nA; cB = nB; ++ui;
        if (wr == 1) PG8_BAR;
    }
    PG8_WAIT_V(0);
    PG8_BAR;
#undef PG8_SA
#undef PG8_SB
#undef PG8_STAGE
#undef PG8_LDA
#undef PG8_LD32
#undef PG8_LDB
#undef PG8_MMA
#undef PG8_WAIT_V
#undef PG8_WAIT_L
#undef PG8_BAR
#undef PG8_SCHED
#undef PG8_ACOL
}
}

constexpr int NWAVES = 8;
constexpr int D = 2048, BATCH = 4, SEQ = 8192, DEPTH = 4, M = BATCH * SEQ;
constexpr int NEXP = 16384, PLE = 256;
constexpr float LN_EPS = 1e-5f;
constexpr float DN_ALPHA = 1.681792830507429f;
constexpr float LOG2E = 1.4426950408889634f;
constexpr float ATTN_QSCALE = 0.08838834764831845f * LOG2E;
constexpr float W8S = 64.f, O8S = 16.f;

constexpr size_t MiB = 1u << 20;
constexpr size_t WS_CTL = 0, CTL_ZERO_BYTES = 1 * MiB;
constexpr size_t WS_STATS = WS_CTL + 512 * 1024;
constexpr size_t WS_W = 1 * MiB;
constexpr size_t W_POOL_IN = WS_W, W_POOL_GRP = W_POOL_IN + 16 * MiB, W_POOL_OUT = W_POOL_GRP + 4 * MiB;
constexpr size_t W_SSM_IN = W_POOL_OUT + 16 * MiB, W_SSM_GLU = W_SSM_IN + 8 * MiB, W_SSM_OUT = W_SSM_GLU + 8 * MiB;
constexpr size_t W_ATTN_QKV = W_SSM_OUT + 8 * MiB, W_ATTN_OUT = W_ATTN_QKV + 24 * MiB;
constexpr size_t W_PEER_Q = W_ATTN_OUT + 8 * MiB, W_PLE_GATE = W_PEER_Q + 32 * MiB, W_PLE_PROJ = W_PLE_GATE + 32 * MiB;
constexpr size_t WS_SK = W_PLE_PROJ + 4 * MiB;
constexpr size_t WS_TU = WS_SK + 1 * MiB;
constexpr size_t WS_TV = WS_TU + 256 * MiB;
constexpr size_t WS_PB = WS_TV + 256 * MiB;
constexpr size_t WS_HB0 = WS_PB + 64 * MiB, WS_HB1 = WS_HB0 + 128 * MiB;
constexpr size_t WS_T1 = WS_HB1 + 128 * MiB, WS_T2 = WS_T1 + 128 * MiB, WS_T3 = WS_T2 + 128 * MiB;
constexpr size_t WS_IDX = WS_T3 + 128 * MiB, WS_GATE = WS_IDX + 16 * MiB;
constexpr size_t WS_SSMP = WS_GATE + 16 * MiB;
constexpr size_t WS_SU = WS_SSMP + 2 * MiB, WS_SV = WS_SU + 1 * MiB;
constexpr size_t WS_S8 = WS_SV + 1 * MiB;
constexpr size_t WS_X8 = WS_S8 + 64 * MiB;
constexpr size_t WS_END = WS_X8 + 64 * MiB;
static_assert(WS_END <= 2048 * MiB, "d_ws map");
constexpr int CW_BAR = 4096;

constexpr int RING_BYTES = 131072;
constexpr int LDSCTL_OFF = RING_BYTES, MISC_OFF = LDSCTL_OFF + 320;
constexpr int LDS_BYTES = 147456;

#define LAS __attribute__((address_space(3)))
typedef unsigned short bf16;
typedef unsigned v4u __attribute__((ext_vector_type(4)));
typedef unsigned v2u __attribute__((ext_vector_type(2)));
typedef float f32x4 __attribute__((ext_vector_type(4)));
typedef float f32x16 __attribute__((ext_vector_type(16)));
typedef short bf16x8 __attribute__((ext_vector_type(8)));
typedef __bf16 bf16x2_t __attribute__((ext_vector_type(2)));
#define LDS_WAIT() asm volatile("s_waitcnt lgkmcnt(0)" ::: "memory")
#define VM_WAIT() asm volatile("s_waitcnt vmcnt(0)" ::: "memory")
__device__ __forceinline__ unsigned f2bf(float f) { unsigned u = __builtin_bit_cast(unsigned, f); return (u + 0x7fffu + ((u >> 16) & 1u)) >> 16; }
__device__ __forceinline__ unsigned pk2(float lo, float hi) { return f2bf(lo) | (f2bf(hi) << 16); }
__device__ __forceinline__ float bflo(unsigned w) { return __builtin_bit_cast(float, w << 16); }
__device__ __forceinline__ float bfhi(unsigned w) { return __builtin_bit_cast(float, w & 0xffff0000u); }
__device__ __forceinline__ float dot2bf(unsigned a, unsigned b, float c) { return __builtin_amdgcn_fdot2_f32_bf16(__builtin_bit_cast(bf16x2_t, a), __builtin_bit_cast(bf16x2_t, b), c, false); }
__device__ __forceinline__ float gelu_f(float v) {
    const float av = __builtin_fabsf(v), d = av * 0.2316418882f + 1.0f, t = __builtin_amdgcn_rcpf(d);
    float q = t * 0.5307027145f + (-0.7265760135f); q = q * t + 0.7107068705f; q = q * t + (-0.142248368f); q = q * t + 0.127414796f; q = q * t;
    const float e = __builtin_amdgcn_exp2f((v * v) * (-0.72134752044f));
    const float m = v * (q * e); return v < 0.f ? m : v - m;
}
#define WDPP(v, ctrl) __builtin_bit_cast(float, __builtin_amdgcn_update_dpp(0, __builtin_bit_cast(int, (v)), (ctrl), 0xF, 0xF, true))
#define WRL(v, l) __builtin_bit_cast(float, __builtin_amdgcn_readlane(__builtin_bit_cast(int, (v)), (l)))
__device__ __forceinline__ float wave_sum(float v) {
    v += WDPP(v, 0xB1); v += WDPP(v, 0x4E); v += WDPP(v, 0x141); v += WDPP(v, 0x140);
    return (WRL(v, 0) + WRL(v, 16)) + (WRL(v, 32) + WRL(v, 48));
}
__device__ __forceinline__ float shfl_xor_lane(float v, int m, int lane) { return __builtin_bit_cast(float, __builtin_amdgcn_ds_bpermute((lane ^ m) << 2, __builtin_bit_cast(int, v))); }
__device__ __forceinline__ int shfl_idx_lane(int v, int src) { return __builtin_amdgcn_ds_bpermute(src << 2, v); }
#define SHFL_XOR(v, m) shfl_xor_lane((v), (m), lane)

#define XB_TMO      128
#define XB_XCNT(j)  (256  + 64 * (j))
#define XB_XSUB(j)  (1280 + 64 * (j))
#define XB_XGEN(j)  (2304 + 64 * (j))
#define XB_TOP      3328
#define XB_TOPGEN   3392
#define XCD_BAR_WORDS 3456
#define XB_SPIN_CAP (1u << 23)

__device__ __forceinline__ unsigned xb_ld(unsigned* p)              { return __hip_atomic_load(p, __ATOMIC_RELAXED, __HIP_MEMORY_SCOPE_AGENT); }
__device__ __forceinline__ unsigned xb_add(unsigned* p, unsigned v) { return __hip_atomic_fetch_add(p, v, __ATOMIC_RELAXED, __HIP_MEMORY_SCOPE_AGENT); }
__device__ __forceinline__ unsigned xb_xcc_id() { return (unsigned)__builtin_amdgcn_s_getreg((3 << 11) | 20) & 0xFu; }
#define XB_SPIN(cond, bar) do { unsigned _sp = 0; while (cond) { __builtin_amdgcn_s_sleep(1); \
    if ((++_sp & 255u) == 0u) { if (xb_ld(&(bar)[XB_TMO])) break; if (_sp > XB_SPIN_CAP) { atomicAdd(&(bar)[XB_TMO], 1u); break; } } } } while (0)

struct XcdBarrier { unsigned* bar; unsigned x; volatile LAS unsigned* st; int wave; };
__device__ __forceinline__ int lane_id() { int l; asm volatile("v_mbcnt_lo_u32_b32 %0, -1, 0\n\tv_mbcnt_hi_u32_b32 %0, -1, %0" : "=v"(l)); return l; }

__device__ __forceinline__ XcdBarrier xcd_barrier_post(unsigned* bar, volatile LAS unsigned* st) {
    XcdBarrier b; b.bar = bar; b.x = xb_xcc_id(); b.st = st; b.wave = __builtin_amdgcn_readfirstlane((int)(threadIdx.x >> 6));
    if (threadIdx.x == 0) (void)xb_add(&bar[XB_XCNT(b.x)], 1u);
    return b;
}
__device__ __forceinline__ void xcd_barrier_complete(unsigned* bar, unsigned x, unsigned& nloc, unsigned& nx) {
    const unsigned G = gridDim.x * gridDim.y * gridDim.z;
    unsigned sum, cnt, mine, sp = 0u;
    for (;;) {
        sum = 0u; cnt = 0u; mine = 0u;
#pragma unroll
        for (unsigned j = 0; j < 16; ++j) { const unsigned c = xb_ld(&bar[XB_XCNT(j)]); sum += c; cnt += (c > 0u) ? 1u : 0u; mine = (j == x) ? c : mine; }
        if (sum == G) break;
        __builtin_amdgcn_s_sleep(1);
        if ((++sp & 255u) == 0u) { if (xb_ld(&bar[XB_TMO])) break; if (sp > XB_SPIN_CAP) { atomicAdd(&bar[XB_TMO], 1u); break; } }
    }
    nloc = mine > 0u ? mine : 1u; nx = cnt > 0u ? cnt : 1u;
}
__device__ __forceinline__ void xcd_barrier(const XcdBarrier& b_in) {
    asm volatile("s_waitcnt vmcnt(0)" ::: "memory");
    __syncthreads();
    if (b_in.wave == 0 && lane_id() == 0) {
        XcdBarrier b = b_in; asm volatile("" : "+s"(b.x)); asm volatile("" : "+s"(b.bar));
        unsigned* bar = b.bar;
        __builtin_amdgcn_s_waitcnt(0);
        unsigned nloc = b.st[0], nx = b.st[1];
        if (nloc == 0u) { xcd_barrier_complete(bar, b.x, nloc, nx); b.st[0] = nloc; b.st[1] = nx; }
        const unsigned old = xb_add(&bar[XB_XSUB(b.x)], 1u);
        const unsigned gen = old / nloc;
        if (old + 1u == (gen + 1u) * nloc) {
            __builtin_amdgcn_fence(__ATOMIC_RELEASE, "agent");
            asm volatile("s_waitcnt vmcnt(0)" ::: "memory");
            const unsigned og = xb_add(&bar[XB_TOP], 1u);
            const unsigned tg = og / nx;
            if (og + 1u == (tg + 1u) * nx) xb_add(&bar[XB_TOPGEN], 1u);
            else XB_SPIN(xb_ld(&bar[XB_TOPGEN]) == tg, bar);
            __builtin_amdgcn_fence(__ATOMIC_ACQUIRE, "agent");
            xb_add(&bar[XB_XGEN(b.x)], 1u);
            asm volatile("s_waitcnt vmcnt(0)" ::: "memory");
        } else {
            XB_SPIN(xb_ld(&bar[XB_XGEN(b.x)]) == gen, bar);
            __builtin_amdgcn_fence(__ATOMIC_ACQUIRE, "agent");
            asm volatile("s_waitcnt vmcnt(0)" ::: "memory");
        }
    }
    __syncthreads();
}

__device__ __forceinline__ void transpose_item(const float* W, int K, int N, bf16* WT, int row_off, LAS float* scr, int item, int lane) {
    const int nblk = N / 32, kb = item / nblk, nb = item % nblk, k0 = 64 * kb, n0 = 32 * nb;
#pragma unroll 8
    for (int i = 0; i < 32; ++i) { const int kk = 2 * i + (lane >> 5); scr[kk * 33 + (lane & 31)] = W[(size_t)(k0 + kk) * N + n0 + (lane & 31)]; }
    LDS_WAIT(); asm volatile("" ::: "memory");
    const int c = lane & 7;
#pragma unroll
    for (int j = 0; j < 4; ++j) { const int n = (lane >> 3) + 8 * j; const LAS float* s = scr + (8 * c) * 33 + n;
        v4u o; o.x = pk2(s[0 * 33], s[1 * 33]); o.y = pk2(s[2 * 33], s[3 * 33]); o.z = pk2(s[4 * 33], s[5 * 33]); o.w = pk2(s[6 * 33], s[7 * 33]);
        *(v4u*)(WT + (size_t)(row_off + n0 + n) * K + k0 + 8 * c) = o; }
    LDS_WAIT(); asm volatile("" ::: "memory");
}
__device__ __forceinline__ void transpose_item8(const float* W, int K, int N, unsigned char* WT, int row_off, LAS float* scr, int item, int lane) {
    const int nblk = N / 32, kb = item / nblk, nb = item % nblk, k0 = 64 * kb, n0 = 32 * nb;
#pragma unroll 8
    for (int i = 0; i < 32; ++i) { const int kk = 2 * i + (lane >> 5); scr[kk * 33 + (lane & 31)] = W[(size_t)(k0 + kk) * N + n0 + (lane & 31)]; }
    LDS_WAIT(); asm volatile("" ::: "memory");
    const int c = lane & 7;
#pragma unroll
    for (int j = 0; j < 4; ++j) { const int n = (lane >> 3) + 8 * j; const LAS float* sp = scr + (8 * c) * 33 + n;
        int a = 0, b = 0;
        a = __builtin_amdgcn_cvt_pk_fp8_f32(sp[0 * 33] * W8S, sp[1 * 33] * W8S, a, false); a = __builtin_amdgcn_cvt_pk_fp8_f32(sp[2 * 33] * W8S, sp[3 * 33] * W8S, a, true);
        b = __builtin_amdgcn_cvt_pk_fp8_f32(sp[4 * 33] * W8S, sp[5 * 33] * W8S, b, false); b = __builtin_amdgcn_cvt_pk_fp8_f32(sp[6 * 33] * W8S, sp[7 * 33] * W8S, b, true);
        v2u o; o.x = (unsigned)a; o.y = (unsigned)b;
        *(v2u*)(WT + (size_t)(row_off + n0 + n) * K + k0 + 8 * c) = o; }
    LDS_WAIT(); asm volatile("" ::: "memory");
}
__device__ __forceinline__ void transpose_item8b(const float* W, int K, int N, unsigned char* WT, int row_off, LAS unsigned* scr, int item, int lane) {
    const int nblk = N / 64, kb = item / nblk, nb = item % nblk, k0 = 128 * kb, n0 = 64 * nb;
    const int r4 = lane >> 4, l15 = lane & 15;
    f32x4 v[32];
#pragma unroll
    for (int i = 0; i < 32; ++i) v[i] = *(const __attribute__((address_space(1))) f32x4*)(W + (size_t)(k0 + 32 * r4 + i) * N + n0 + 4 * l15);
#pragma unroll
    for (int i4 = 0; i4 < 8; ++i4) {
        const f32x4 q0 = v[4 * i4] * W8S, q1 = v[4 * i4 + 1] * W8S, q2 = v[4 * i4 + 2] * W8S, q3 = v[4 * i4 + 3] * W8S;
        int a0 = 0, a1 = 0, a2 = 0, a3 = 0;
        a0 = __builtin_amdgcn_cvt_pk_fp8_f32(q0.x, q1.x, a0, false); a0 = __builtin_amdgcn_cvt_pk_fp8_f32(q2.x, q3.x, a0, true);
        a1 = __builtin_amdgcn_cvt_pk_fp8_f32(q0.y, q1.y, a1, false); a1 = __builtin_amdgcn_cvt_pk_fp8_f32(q2.y, q3.y, a1, true);
        a2 = __builtin_amdgcn_cvt_pk_fp8_f32(q0.z, q1.z, a2, false); a2 = __builtin_amdgcn_cvt_pk_fp8_f32(q2.z, q3.z, a2, true);
        a3 = __builtin_amdgcn_cvt_pk_fp8_f32(q0.w, q1.w, a3, false); a3 = __builtin_amdgcn_cvt_pk_fp8_f32(q2.w, q3.w, a3, true);
        LAS unsigned* rowp = scr + (8 * r4 + i4) * 64;
        rowp[(4 * l15 + 0 + r4) & 63] = (unsigned)a0; rowp[(4 * l15 + 1 + r4) & 63] = (unsigned)a1; rowp[(4 * l15 + 2 + r4) & 63] = (unsigned)a2; rowp[(4 * l15 + 3 + r4) & 63] = (unsigned)a3; }
    LDS_WAIT(); asm volatile("" ::: "memory");
    unsigned char* orow = WT + (size_t)(row_off + n0 + lane) * K + k0;
#pragma unroll
    for (int q = 0; q < 8; ++q) { v4u o;
        o.x = scr[(4 * q + 0) * 64 + ((lane + (q >> 1)) & 63)]; o.y = scr[(4 * q + 1) * 64 + ((lane + (q >> 1)) & 63)]; o.z = scr[(4 * q + 2) * 64 + ((lane + (q >> 1)) & 63)]; o.w = scr[(4 * q + 3) * 64 + ((lane + (q >> 1)) & 63)];
        *(__attribute__((address_space(1))) v4u*)(orow + 16 * q) = o; }
    LDS_WAIT(); asm volatile("" ::: "memory");
}
__device__ __forceinline__ void transpose_mat8b(const float* W, int K, int N, unsigned char* WT, int row_off, LAS unsigned* scr, int gw, int NGW, int lane, int& woff) {
    const int nit = (K / 128) * (N / 64);
    int sgw = gw - woff % NGW; if (sgw < 0) sgw += NGW;
    for (int it = sgw; it < nit; it += NGW) transpose_item8b(W, K, N, WT, row_off, scr, it, lane);
    woff += nit;
}
__device__ __forceinline__ void transpose_mat8(const float* W, int K, int N, unsigned char* WT, int row_off, LAS float* scr, int gw, int NGW, int lane) {
    const int nit = (K / 64) * (N / 32);
    for (int it = gw; it < nit; it += NGW) transpose_item8(W, K, N, WT, row_off, scr, it, lane);
}
__device__ __forceinline__ void transpose_mat(const float* W, int K, int N, bf16* WT, int row_off, LAS float* scr, int gw, int NGW, int lane) {
    const int nit = (K / 64) * (N / 32);
    for (int it = gw; it < nit; it += NGW) transpose_item(W, K, N, WT, row_off, scr, it, lane);
}
__device__ __forceinline__ void cvt_rows(const float* src, bf16* dst, size_t n, size_t gtid, size_t gthreads) {
    size_t i = gtid * 8;
    for (; i + 3 * gthreads * 8 < n; i += gthreads * 32) {
        f32x4 a[4], b[4];
#pragma unroll
        for (int u = 0; u < 4; ++u) { a[u] = *(const __attribute__((address_space(1))) f32x4*)(src + i + u * gthreads * 8); b[u] = *(const __attribute__((address_space(1))) f32x4*)(src + i + u * gthreads * 8 + 4); }
#pragma unroll
        for (int u = 0; u < 4; ++u) { v4u o; o.x = pk2(a[u].x, a[u].y); o.y = pk2(a[u].z, a[u].w); o.z = pk2(b[u].x, b[u].y); o.w = pk2(b[u].z, b[u].w);
            *(__attribute__((address_space(1))) v4u*)(dst + i + u * gthreads * 8) = o; }
    }
    for (; i < n; i += gthreads * 8) {
        const f32x4 a = *(const f32x4*)(src + i), b = *(const f32x4*)(src + i + 4);
        v4u o; o.x = pk2(a.x, a.y); o.y = pk2(a.z, a.w); o.z = pk2(b.x, b.y); o.w = pk2(b.z, b.w);
        *(v4u*)(dst + i) = o;
    }
}


#define GAS __attribute__((address_space(1)))
typedef unsigned char u8;
typedef float f32x2 __attribute__((ext_vector_type(2)));
constexpr float TU_SCALE = 64.f, TV_SCALE = 4.f;
__device__ __forceinline__ v4u gld16(const void* p) { return *(const GAS v4u*)p; }
__device__ __forceinline__ void cvt_rows_fp8(const float* src, u8* dst, size_t n, float scale, size_t gtid, size_t gthreads) {
    for (size_t i = gtid * 16; i < n; i += gthreads * 16) {
        const GAS f32x4* p = (const GAS f32x4*)(src + i);
        const f32x4 a = p[0] * scale, b = p[1] * scale, c = p[2] * scale, d = p[3] * scale;
        int w0 = 0, w1 = 0, w2 = 0, w3 = 0;
        w0 = __builtin_amdgcn_cvt_pk_fp8_f32(a.x, a.y, w0, false); w0 = __builtin_amdgcn_cvt_pk_fp8_f32(a.z, a.w, w0, true);
        w1 = __builtin_amdgcn_cvt_pk_fp8_f32(b.x, b.y, w1, false); w1 = __builtin_amdgcn_cvt_pk_fp8_f32(b.z, b.w, w1, true);
        w2 = __builtin_amdgcn_cvt_pk_fp8_f32(c.x, c.y, w2, false); w2 = __builtin_amdgcn_cvt_pk_fp8_f32(c.z, c.w, w2, true);
        w3 = __builtin_amdgcn_cvt_pk_fp8_f32(d.x, d.y, w3, false); w3 = __builtin_amdgcn_cvt_pk_fp8_f32(d.z, d.w, w3, true);
        v4u o; o.x = (unsigned)w0; o.y = (unsigned)w1; o.z = (unsigned)w2; o.w = (unsigned)w3;
        *(GAS v4u*)(dst + i) = o;
    }
}

template <bool X4 = false>
__device__ __forceinline__ void ln_phase(bf16* S, const float* g, const float* b, int gw, int NGW, int lane, unsigned char* f8 = nullptr, unsigned char* f8b = nullptr, float* stats = nullptr) {
    for (int m = gw; m < M; m += NGW) {
        bf16* row = S + (size_t)m * D + 8 * lane;
        float v[32]; float s = 0.f;
#pragma unroll
        for (int j = 0; j < 4; ++j) { const v4u w = *(const GAS v4u*)(row + 512 * j);
            v[8 * j + 0] = bflo(w.x); v[8 * j + 1] = bfhi(w.x); v[8 * j + 2] = bflo(w.y); v[8 * j + 3] = bfhi(w.y); v[8 * j + 4] = bflo(w.z); v[8 * j + 5] = bfhi(w.z); v[8 * j + 6] = bflo(w.w); v[8 * j + 7] = bfhi(w.w); }
#pragma unroll
        for (int i = 0; i < 32; ++i) s += v[i];
        const float mean = wave_sum(s) * (1.f / D); float s2 = 0.f;
#pragma unroll
        for (int i = 0; i < 32; ++i) { v[i] -= mean; s2 += v[i] * v[i]; }
        const float rstd = 1.f / sqrtf(wave_sum(s2) * (1.f / D) + LN_EPS);
        if constexpr (X4) { if (lane == 0) *(GAS f32x2*)(stats + 2 * (size_t)m) = (f32x2){mean, rstd}; }
#pragma unroll
        for (int j = 0; j < 4; ++j) { const float* gp = g + 512 * j + 8 * lane; const float* bp = b + 512 * j + 8 * lane;
            const f32x4 g0 = *(const GAS f32x4*)gp, g1 = *(const GAS f32x4*)(gp + 4), b0 = *(const GAS f32x4*)bp, b1 = *(const GAS f32x4*)(bp + 4);
            v4u w; w.x = pk2(v[8 * j + 0] * rstd * g0.x + b0.x, v[8 * j + 1] * rstd * g0.y + b0.y); w.y = pk2(v[8 * j + 2] * rstd * g0.z + b0.z, v[8 * j + 3] * rstd * g0.w + b0.w);
            w.z = pk2(v[8 * j + 4] * rstd * g1.x + b1.x, v[8 * j + 5] * rstd * g1.y + b1.y); w.w = pk2(v[8 * j + 6] * rstd * g1.z + b1.z, v[8 * j + 7] * rstd * g1.w + b1.w);
            if constexpr (!X4) *(GAS v4u*)(row + 512 * j) = w;
            if constexpr (X4) {
                const float y0 = v[8 * j + 0] * rstd * g0.x + b0.x, y1 = v[8 * j + 1] * rstd * g0.y + b0.y, y2 = v[8 * j + 2] * rstd * g0.z + b0.z, y3 = v[8 * j + 3] * rstd * g0.w + b0.w;
                const float y4 = v[8 * j + 4] * rstd * g1.x + b1.x, y5 = v[8 * j + 5] * rstd * g1.y + b1.y, y6 = v[8 * j + 6] * rstd * g1.z + b1.z, y7 = v[8 * j + 7] * rstd * g1.w + b1.w;
                unsigned wh = 0u; wh = __builtin_amdgcn_cvt_scalef32_pk_fp4_f32(wh, y0, y1, 1.0f, 0); wh = __builtin_amdgcn_cvt_scalef32_pk_fp4_f32(wh, y2, y3, 1.0f, 1);
                wh = __builtin_amdgcn_cvt_scalef32_pk_fp4_f32(wh, y4, y5, 1.0f, 2); wh = __builtin_amdgcn_cvt_scalef32_pk_fp4_f32(wh, y6, y7, 1.0f, 3);
                const f32x2 h01 = __builtin_amdgcn_cvt_scalef32_pk_f32_fp4(wh, 1.0f, 0), h23 = __builtin_amdgcn_cvt_scalef32_pk_f32_fp4(wh, 1.0f, 1), h45 = __builtin_amdgcn_cvt_scalef32_pk_f32_fp4(wh, 1.0f, 2), h67 = __builtin_amdgcn_cvt_scalef32_pk_f32_fp4(wh, 1.0f, 3);
                unsigned wl = 0u; wl = __builtin_amdgcn_cvt_scalef32_pk_fp4_f32(wl, (y0 - h01.x) * 8.f, (y1 - h01.y) * 8.f, 1.0f, 0); wl = __builtin_amdgcn_cvt_scalef32_pk_fp4_f32(wl, (y2 - h23.x) * 8.f, (y3 - h23.y) * 8.f, 1.0f, 1);
                wl = __builtin_amdgcn_cvt_scalef32_pk_fp4_f32(wl, (y4 - h45.x) * 8.f, (y5 - h45.y) * 8.f, 1.0f, 2); wl = __builtin_amdgcn_cvt_scalef32_pk_fp4_f32(wl, (y6 - h67.x) * 8.f, (y7 - h67.y) * 8.f, 1.0f, 3);
                unsigned char* xq = f8 + (size_t)m * 2048 + 256 * j + 4 * lane;
                *(GAS unsigned*)xq = wh; *(GAS unsigned*)(xq + 1024) = wl;
                int a8 = 0, b8 = 0;
                a8 = __builtin_amdgcn_cvt_pk_fp8_f32(y0, y1, a8, false); a8 = __builtin_amdgcn_cvt_pk_fp8_f32(y2, y3, a8, true);
                b8 = __builtin_amdgcn_cvt_pk_fp8_f32(y4, y5, b8, false); b8 = __builtin_amdgcn_cvt_pk_fp8_f32(y6, y7, b8, true);
                v2u o8; o8.x = (unsigned)a8; o8.y = (unsigned)b8; *(GAS v2u*)(f8b + (size_t)m * D + 512 * j + 8 * lane) = o8; }
            else if (f8 != nullptr) { int a8 = 0, b8 = 0;
                a8 = __builtin_amdgcn_cvt_pk_fp8_f32(v[8 * j + 0] * rstd * g0.x + b0.x, v[8 * j + 1] * rstd * g0.y + b0.y, a8, false); a8 = __builtin_amdgcn_cvt_pk_fp8_f32(v[8 * j + 2] * rstd * g0.z + b0.z, v[8 * j + 3] * rstd * g0.w + b0.w, a8, true);
                b8 = __builtin_amdgcn_cvt_pk_fp8_f32(v[8 * j + 4] * rstd * g1.x + b1.x, v[8 * j + 5] * rstd * g1.y + b1.y, b8, false); b8 = __builtin_amdgcn_cvt_pk_fp8_f32(v[8 * j + 6] * rstd * g1.z + b1.z, v[8 * j + 7] * rstd * g1.w + b1.w, b8, true);
                v2u o8; o8.x = (unsigned)a8; o8.y = (unsigned)b8; *(GAS v2u*)(f8 + (size_t)m * D + 512 * j + 8 * lane) = o8; } }
    }
}

__device__ __forceinline__ void pool_phase(const bf16* U, unsigned char* P, int gw, int NGW, int lane) {
    for (int it = gw; it < (M / 64) * 4; it += NGW) {
        const int g = it & 3, t0 = (it >> 2) * 64, w = 2 << g, col = g * 512 + 8 * lane;
        const int s0 = t0 & (SEQ - 1);
        float a[8];
#pragma unroll
        for (int i = 0; i < 8; ++i) a[i] = 0.f;
        const bf16* base = U + (size_t)t0 * D + col;
        const int nb = (s0 < w - 1) ? s0 : (w - 1);
        for (int r = 1; r <= nb; ++r) { const v4u x = *(const GAS v4u*)(base - (size_t)r * D);
            a[0] += bflo(x.x); a[1] += bfhi(x.x); a[2] += bflo(x.y); a[3] += bfhi(x.y); a[4] += bflo(x.z); a[5] += bfhi(x.z); a[6] += bflo(x.w); a[7] += bfhi(x.w); }
#pragma unroll 4
        for (int t = 0; t < 64; ++t) {
            const int s = s0 + t;
            const v4u cur = *(const GAS v4u*)(base + (size_t)t * D);
            a[0] += bflo(cur.x); a[1] += bfhi(cur.x); a[2] += bflo(cur.y); a[3] += bfhi(cur.y); a[4] += bflo(cur.z); a[5] += bfhi(cur.z); a[6] += bflo(cur.w); a[7] += bfhi(cur.w);
            const int n = (s + 1 < w) ? (s + 1) : w;
            const float inv = 1.f / (float)n;
            int w0 = 0, w1 = 0;
            w0 = __builtin_amdgcn_cvt_pk_fp8_f32(a[0] * inv - bflo(cur.x), a[1] * inv - bfhi(cur.x), w0, false); w0 = __builtin_amdgcn_cvt_pk_fp8_f32(a[2] * inv - bflo(cur.y), a[3] * inv - bfhi(cur.y), w0, true);
            w1 = __builtin_amdgcn_cvt_pk_fp8_f32(a[4] * inv - bflo(cur.z), a[5] * inv - bfhi(cur.z), w1, false); w1 = __builtin_amdgcn_cvt_pk_fp8_f32(a[6] * inv - bflo(cur.w), a[7] * inv - bfhi(cur.w), w1, true);
            v2u o; o.x = (unsigned)w0; o.y = (unsigned)w1;
            *(GAS v2u*)(P + (size_t)(t0 + t) * D + col) = o;
            if (s + 1 >= w) { const v4u x = *(const GAS v4u*)(base + (size_t)(t + 1 - w) * D);
                a[0] -= bflo(x.x); a[1] -= bfhi(x.x); a[2] -= bflo(x.y); a[3] -= bfhi(x.y); a[4] -= bflo(x.z); a[5] -= bfhi(x.z); a[6] -= bflo(x.w); a[7] -= bfhi(x.w); }
        }
    }
}

typedef __bf16 bf16x2v __attribute__((ext_vector_type(2)));
__device__ __forceinline__ unsigned cvtpk(float lo, float hi) { const f32x2 v = {lo, hi}; return __builtin_bit_cast(unsigned, __builtin_convertvector(v, bf16x2v)); }
constexpr int SSM_L = 1664, SSM_L3 = SEQ - 3 * SSM_L;
static_assert(SSM_L % 64 == 0 && SSM_L3 % 64 == 0 && SSM_L3 > 0, "segments");
template <bool WR>
__device__ __forceinline__ void ssm_block16m(const bf16x8 ua, const bf16x8 (&BbR)[4], const bf16x8 (&BbI)[4], LAS unsigned char* bubuf, LAS unsigned char* hbuf, const f32x2 ar2, const f32x2 ai2, f32x2& h2, int p, int lane) {
    f32x4 dr[4], di[4];
    const f32x4 z = {0.f, 0.f, 0.f, 0.f};
    __builtin_amdgcn_sched_barrier(0);
    asm volatile("s_nop 15\n\ts_nop 15\n\ts_nop 15\n\ts_nop 15" ::: "memory");
    __builtin_amdgcn_sched_barrier(0);
#pragma unroll
    for (int pt = 0; pt < 4; ++pt) { dr[pt] = __builtin_amdgcn_mfma_f32_16x16x32_bf16(ua, BbR[pt], z, 0, 0, 0); di[pt] = __builtin_amdgcn_mfma_f32_16x16x32_bf16(ua, BbI[pt], z, 0, 0, 0); }
    __builtin_amdgcn_sched_barrier(0);
    asm volatile("s_nop 15\n\ts_nop 15\n\ts_nop 15\n\ts_nop 15\n\ts_nop 15\n\ts_nop 15\n\ts_nop 15\n\ts_nop 15" ::: "memory");
    __builtin_amdgcn_sched_barrier(0);
#pragma unroll
    for (int pt = 0; pt < 4; ++pt)
#pragma unroll
        for (int r = 0; r < 4; ++r) *(LAS f32x2*)(bubuf + (4 * (lane >> 4) + r) * 528 + (16 * pt + (lane & 15)) * 8) = (f32x2){dr[pt][r], di[pt][r]};
    LDS_WAIT();
#pragma unroll
    for (int l = 0; l < 16; ++l) {
        const f32x2 bu = *(const LAS f32x2*)(bubuf + l * 528 + p * 8);
        float tx, ty, nx, ny; const float hx = h2.x, hy = h2.y, bux = bu.x, buy = bu.y, arx = ar2.x, aix = ai2.x, aiy = ai2.y;
        asm("v_fma_f32 %0, %1, %2, %3" : "=v"(tx) : "v"(arx), "v"(hx), "v"(bux));
        asm("v_fma_f32 %0, %1, %2, %3" : "=v"(ty) : "v"(arx), "v"(hy), "v"(buy));
        asm("v_fma_f32 %0, %1, %2, %3" : "=v"(nx) : "v"(aix), "v"(hy), "v"(tx));
        asm("v_fma_f32 %0, %1, %2, %3" : "=v"(ny) : "v"(aiy), "v"(hx), "v"(ty));
        h2 = (f32x2){nx, ny};
        if (WR) *(LAS unsigned*)(hbuf + l * 272 + 4 * p) = cvtpk(h2.x, h2.y);
    }
}
__device__ __forceinline__ void ssm_phase_m(const bf16* U, unsigned char* Y, const float* ssmp,
                                          const float* c_re, const float* c_im, const float* d_skip, LAS unsigned char* lds, int vcu, int G, int wave, int lane) {
    LAS unsigned char* hbuf = lds + wave * 16384;
    LAS unsigned char* ebuf = lds + wave * 16384 + 4352;
    LAS unsigned char* bubuf = lds + wave * 16384 + 4864;
    const int ntask = BATCH * 128 * 4;
    for (int tb = vcu * NWAVES; tb < ntask; tb += G * NWAVES) {
        const int task = tb + wave, seg = (wave + 3 * (wave >> 2)) & 3, g = (task >> 2) & 127, b = task >> 9, p = lane;
        const float* pp_ = ssmp + (size_t)(g * 64 + p) * 34;
        const float ar = pp_[0], ai = pp_[1];
        const int cc = lane & 15, kg = lane >> 4;
        bf16x8 BbR[4], BbI[4];
#pragma unroll
        for (int pt = 0; pt < 4; ++pt) { const float* q_ = ssmp + (size_t)(g * 64 + 16 * pt + cc) * 34 + 8 * (kg & 1);
            v4u tr, ti; tr.x = cvtpk(q_[2], q_[3]); tr.y = cvtpk(q_[4], q_[5]); tr.z = cvtpk(q_[6], q_[7]); tr.w = cvtpk(q_[8], q_[9]);
            ti.x = cvtpk(q_[18], q_[19]); ti.y = cvtpk(q_[20], q_[21]); ti.z = cvtpk(q_[22], q_[23]); ti.w = cvtpk(q_[24], q_[25]);
            if (kg >= 2) { tr = (v4u){0u, 0u, 0u, 0u}; ti = (v4u){0u, 0u, 0u, 0u}; }
            BbR[pt] = __builtin_bit_cast(bf16x8, tr); BbI[pt] = __builtin_bit_cast(bf16x8, ti); }
        const int tstart = seg * SSM_L, tlen = (seg == 3) ? SSM_L3 : SSM_L;
        const bf16* ub = U + ((size_t)b * SEQ + tstart) * D + g * 16;
        const bf16* ua_p = ub + (size_t)(lane & 15) * D + 8 * (kg & 1);
        unsigned char* yb = Y + ((size_t)b * SEQ + tstart) * D + g * 16;
        const f32x2 ar2 = {ar, ar}, ai2 = {-ai, ai};
        f32x2 h2 = {0.f, 0.f};
        const v4u zero4 = {0u, 0u, 0u, 0u};
        if (seg < 3) {
            v4u pre[4];
#pragma unroll
            for (int i = 0; i < 4; ++i) pre[i] = *(const GAS v4u*)(ua_p + (size_t)(16 * i) * D);
            for (int t0 = 0; t0 < SSM_L; t0 += 64) {
                v4u cur[4];
#pragma unroll
                for (int i = 0; i < 4; ++i) cur[i] = (kg < 2) ? pre[i] : zero4;
                if (t0 + 64 < SSM_L) {
#pragma unroll
                    for (int i = 0; i < 4; ++i) pre[i] = *(const GAS v4u*)(ua_p + (size_t)(t0 + 64 + 16 * i) * D); }
#pragma unroll
                for (int blk = 0; blk < 4; ++blk) { ssm_block16m<false>(__builtin_bit_cast(bf16x8, cur[blk]), BbR, BbI, bubuf, hbuf, ar2, ai2, h2, p, lane); LDS_WAIT(); }
            }
            *(LAS f32x2*)(ebuf + 8 * p) = h2;
        }
        LDS_WAIT();
        __syncthreads();
        {
            f32x2 pw = {1.f, 0.f}, base = {ar, ai};
#pragma unroll 1
            for (int bit = SSM_L; bit > 0; bit >>= 1) {
                if (bit & 1) pw = (f32x2){pw.x * base.x - pw.y * base.y, pw.x * base.y + pw.y * base.x};
                base = (f32x2){base.x * base.x - base.y * base.y, 2.f * base.x * base.y};
            }
            LAS unsigned char* e0 = lds + (wave & 4) * 16384 + 4352;
            f32x2 sst = {0.f, 0.f};
            for (int j = 0; j < seg; ++j) { const f32x2 e = *(const LAS f32x2*)(e0 + ((j + (wave >> 2)) & 3) * 16384 + 8 * p);
                sst = (f32x2){pw.x * sst.x - pw.y * sst.y + e.x, pw.x * sst.y + pw.y * sst.x + e.y}; }
            h2 = sst;
        }
        bf16x8 cB[4];
#pragma unroll
        for (int ks = 0; ks < 4; ++ks) { unsigned w[4];
#pragma unroll
            for (int jj = 0; jj < 4; ++jj) { const int k = 32 * ks + 8 * (lane >> 4) + 2 * jj, pp = k >> 1;
                w[jj] = cvtpk(c_re[(g * 16 + cc) * 64 + pp], -c_im[(g * 16 + cc) * 64 + pp]); }
            v4u t; t.x = w[0]; t.y = w[1]; t.z = w[2]; t.w = w[3]; cB[ks] = __builtin_bit_cast(bf16x8, t); }
        const float dd = d_skip[g * 16 + cc];
        {
            v4u pre[4];
#pragma unroll
            for (int i = 0; i < 4; ++i) pre[i] = *(const GAS v4u*)(ua_p + (size_t)(16 * i) * D);
            for (int t0 = 0; t0 < tlen; t0 += 64) {
                v4u cur[4];
#pragma unroll
                for (int i = 0; i < 4; ++i) cur[i] = (kg < 2) ? pre[i] : zero4;
                if (t0 + 64 < tlen) {
#pragma unroll
                    for (int i = 0; i < 4; ++i) pre[i] = *(const GAS v4u*)(ua_p + (size_t)(t0 + 64 + 16 * i) * D); }
#pragma unroll
                for (int blk = 0; blk < 4; ++blk) {
                    unsigned short uq[4];
#pragma unroll
                    for (int r = 0; r < 4; ++r) uq[r] = *(const GAS unsigned short*)(ub + (size_t)(t0 + 16 * blk + 4 * (lane >> 4) + r) * D + cc);
                    ssm_block16m<true>(__builtin_bit_cast(bf16x8, cur[blk]), BbR, BbI, bubuf, hbuf, ar2, ai2, h2, p, lane);
                    LDS_WAIT();
                    f32x4 acc = (f32x4){0.f, 0.f, 0.f, 0.f};
#pragma unroll
                    for (int ks = 0; ks < 4; ++ks) { const bf16x8 a = *(const LAS bf16x8*)(hbuf + (lane & 15) * 272 + 16 * (lane >> 4) + 64 * ks);
                        acc = __builtin_amdgcn_mfma_f32_16x16x32_bf16(a, cB[ks], acc, 0, 0, 0); }
#pragma unroll
                    for (int r = 0; r < 4; ++r) { const int l = 4 * (lane >> 4) + r;
                        const float uu = __builtin_bit_cast(float, (unsigned)uq[r] << 16);
                        const float y = acc[r] + dd * uu;
                        *(GAS unsigned char*)(yb + (size_t)(t0 + 16 * blk + l) * D + cc) = (unsigned char)(__builtin_amdgcn_cvt_pk_fp8_f32(gelu_f(y), 0.f, 0, false) & 0xff); }
                    LDS_WAIT();
                }
            }
        }
        __syncthreads();
    }
}

__device__ __forceinline__ void attn_tile(const bf16* Kbh, const bf16* Vbh, const LAS float* rbh, int kp0, bool has_next, int qpos, int hl, int lane,
                                          const bf16x8 (&kc)[8], bf16x8 (&kn)[8], const bf16x8 (&qf)[8], f32x16 (&o)[4], float& mrun, float& lrun) {
    bf16x8 vf[8];
    { const bf16* vp = Vbh + (size_t)(kp0 >> 5) * 4096 + (size_t)lane * 8;
#pragma unroll
      for (int q = 0; q < 8; ++q) vf[q] = *(const GAS bf16x8*)(vp + 512 * q); }
    if (has_next) { const bf16* kp = Kbh + (size_t)((kp0 >> 5) + 1) * 4096 + (size_t)lane * 8;
#pragma unroll
      for (int ks = 0; ks < 8; ++ks) kn[ks] = *(const GAS bf16x8*)(kp + 512 * ks); }
    __builtin_amdgcn_sched_barrier(0);
    f32x16 s;
#pragma unroll
    for (int i = 0; i < 16; ++i) s[i] = 0.f;
#pragma unroll
    for (int ks = 0; ks < 8; ++ks) s = __builtin_amdgcn_mfma_f32_32x32x16_bf16(kc[ks], qf[ks], s, 0, 0, 0);
    float tmax = -1e30f;
#pragma unroll
    for (int i = 0; i < 16; ++i) { const int kpos = kp0 + (i & 3) + 8 * (i >> 2) + 4 * hl; int rel = qpos - kpos; rel = rel > 128 ? 128 : rel; s[i] += rbh[rel + 128]; tmax = fmaxf(tmax, s[i]); }
    tmax = fmaxf(tmax, SHFL_XOR(tmax, 32));
    const float mnew = fmaxf(mrun, tmax), alpha = __builtin_amdgcn_exp2f(mrun - mnew);
    float rs = 0.f;
#pragma unroll
    for (int i = 0; i < 16; ++i) { s[i] = __builtin_amdgcn_exp2f(s[i] - mnew); rs += s[i]; }
    rs += SHFL_XOR(rs, 32);
    lrun = lrun * alpha + rs; mrun = mnew;
    bf16x8 pf[2];
#pragma unroll
    for (int sidx = 0; sidx < 2; ++sidx) { v4u t; t.x = cvtpk(s[8 * sidx + 0], s[8 * sidx + 1]); t.y = cvtpk(s[8 * sidx + 2], s[8 * sidx + 3]);
        t.z = cvtpk(s[8 * sidx + 4], s[8 * sidx + 5]); t.w = cvtpk(s[8 * sidx + 6], s[8 * sidx + 7]); pf[sidx] = __builtin_bit_cast(bf16x8, t); }
#pragma unroll
    for (int dt = 0; dt < 4; ++dt) {
#pragma unroll
        for (int i = 0; i < 16; ++i) o[dt][i] *= alpha;
#pragma unroll
        for (int sidx = 0; sidx < 2; ++sidx) o[dt] = __builtin_amdgcn_mfma_f32_32x32x16_bf16(vf[2 * dt + sidx], pf[sidx], o[dt], 0, 0, 0);
    }
}
__device__ __forceinline__ void attn_phase(const bf16* QO, const bf16* Kb, const bf16* VT, unsigned char* O8, const LAS float* rb, int gw, int NGW, int lane) {
    const int r32 = lane & 31, hl = lane >> 5;
    for (int task = gw; task < BATCH * 16 * 128 * 2; task += NGW) {
        const int half = task & 1, c = (task >> 1) & 127, h = (task >> 8) & 15, b = task >> 12;
        const int qpos = 64 * c + 32 * half + r32;
        const size_t qrow = (size_t)b * SEQ + qpos;
        bf16x8 qf[8];
        const size_t bh256 = (size_t)(b * 16 + h) * 256;
        { const bf16* qt = QO + ((bh256 + 2 * c + half) * 8) * 512 + (size_t)lane * 8;
#pragma unroll
          for (int ks = 0; ks < 8; ++ks) qf[ks] = *(const GAS bf16x8*)(qt + ks * 512); }
        f32x16 o[4];
#pragma unroll
        for (int dt = 0; dt < 4; ++dt)
#pragma unroll
            for (int i = 0; i < 16; ++i) o[dt][i] = 0.f;
        float mrun = -1e30f, lrun = 0.f;
        const LAS float* rbh = rb + h * 257;
        const bf16* Kbh = Kb + bh256 * 4096; const bf16* Vbh = VT + bh256 * 4096;
        int kt0 = 16 - 2 * c; if (kt0 < 0) kt0 = 0;
        bf16x8 kA[8], kB[8];
        { const bf16* kp = Kbh + (size_t)((64 * c - 512 + 32 * kt0) >> 5) * 4096 + (size_t)lane * 8;
#pragma unroll
          for (int ks = 0; ks < 8; ++ks) kA[ks] = *(const GAS bf16x8*)(kp + 512 * ks); }
        for (int kt = kt0; kt < 18; kt += 2) {
            const int kp0 = 64 * c - 512 + 32 * kt;
            attn_tile(Kbh, Vbh, rbh, kp0, true, qpos, hl, lane, kA, kB, qf, o, mrun, lrun);
            attn_tile(Kbh, Vbh, rbh, kp0 + 32, kt + 2 < 18, qpos, hl, lane, kB, kA, qf, o, mrun, lrun);
        }
        const float inv = O8S / lrun;
        unsigned char* op = O8 + qrow * D + h * 128 + 4 * hl;
#pragma unroll
        for (int dt = 0; dt < 4; ++dt)
#pragma unroll
            for (int rq = 0; rq < 4; ++rq) { int w = 0; w = __builtin_amdgcn_cvt_pk_fp8_f32(o[dt][4 * rq + 0] * inv, o[dt][4 * rq + 1] * inv, w, false); w = __builtin_amdgcn_cvt_pk_fp8_f32(o[dt][4 * rq + 2] * inv, o[dt][4 * rq + 3] * inv, w, true);
                *(int*)(op + 32 * dt + 8 * rq) = w; }
    }
}

__device__ __forceinline__ void attn_a_qk(f32x16& s, const bf16x8 (&kc)[8], const bf16x8 (&qh)[8]) {
#pragma unroll
    for (int i = 0; i < 16; ++i) s[i] = 0.f;
#pragma unroll
    for (int ks = 0; ks < 8; ++ks) s = __builtin_amdgcn_mfma_f32_32x32x16_bf16(kc[ks], qh[ks], s, 0, 0, 0);
}
__device__ __forceinline__ void attn_a_half(f32x16& s, const LAS float* rbh, int kp0, int qbase, int r32, int hl, int lane, float& mrun, float& lrun, LAS unsigned char* pw, LAS float* aw) {
    const int qpos = qbase + r32; float tmax = -1e30f;
    if (qbase - (kp0 + 31) >= 128) { const float cb = rbh[256];
#pragma unroll
        for (int i = 0; i < 16; ++i) { s[i] += cb; tmax = fmaxf(tmax, s[i]); } }
    else {
#pragma unroll
        for (int i = 0; i < 16; ++i) { const int kpos = kp0 + (i & 3) + 8 * (i >> 2) + 4 * hl; int rel = qpos - kpos; rel = rel > 128 ? 128 : rel; s[i] += rbh[rel + 128]; tmax = fmaxf(tmax, s[i]); } }
    tmax = fmaxf(tmax, SHFL_XOR(tmax, 32));
    const float mnew = fmaxf(mrun, tmax), alpha = __builtin_amdgcn_exp2f(mrun - mnew);
    float rs = 0.f;
#pragma unroll
    for (int i = 0; i < 16; ++i) { s[i] = __builtin_amdgcn_exp2f(s[i] - mnew); rs += s[i]; }
    rs += SHFL_XOR(rs, 32);
    lrun = lrun * alpha + rs; mrun = mnew;
    v4u t0, t1; t0.x = cvtpk(s[0], s[1]); t0.y = cvtpk(s[2], s[3]); t0.z = cvtpk(s[4], s[5]); t0.w = cvtpk(s[6], s[7]);
    t1.x = cvtpk(s[8], s[9]); t1.y = cvtpk(s[10], s[11]); t1.z = cvtpk(s[12], s[13]); t1.w = cvtpk(s[14], s[15]);
    *(LAS v4u*)pw = t0; *(LAS v4u*)(pw + 16) = t1; *aw = alpha;
}
__device__ __forceinline__ void attn_b_half(const bf16x8 (&vc)[8], f32x16 (&oh)[4], const LAS unsigned char* pr, const LAS float* ar) {
    const v4u p0 = *(const LAS v4u*)pr, p1 = *(const LAS v4u*)(pr + 16); const float al = *ar;
    const bf16x8 pf0 = __builtin_bit_cast(bf16x8, p0), pf1 = __builtin_bit_cast(bf16x8, p1);
#pragma unroll
    for (int dt = 0; dt < 4; ++dt) {
#pragma unroll
        for (int i = 0; i < 16; ++i) oh[dt][i] *= al;
        oh[dt] = __builtin_amdgcn_mfma_f32_32x32x16_bf16(vc[2 * dt], pf0, oh[dt], 0, 0, 0); oh[dt] = __builtin_amdgcn_mfma_f32_32x32x16_bf16(vc[2 * dt + 1], pf1, oh[dt], 0, 0, 0); }
}
__device__ __forceinline__ void attn_ld8(bf16x8 (&d)[8], const bf16* p) {
#pragma unroll
    for (int q = 0; q < 8; ++q) d[q] = *(const GAS bf16x8*)(p + 512 * q);
}
__device__ __forceinline__ void attn_phase_split(const bf16* QO, const bf16* Kb, const bf16* VT, unsigned char* O8, const LAS float* rb, LAS unsigned char* xch, int vcu, int G, int wave, int lane) {
    const int r32 = lane & 31, hl = lane >> 5;
    const int pr = wave & 3, role = wave >> 2;
    LAS unsigned char* xp = xch + pr * 9728;
    LAS unsigned char* pl = xp + lane * 32; LAS float* al = (LAS float*)(xp + 8192) + lane;
    for (int batch = vcu; batch < BATCH * 16 * 128 * 2 / 8; batch += G) {
        const int T0 = batch * 8, c0 = (T0 >> 1) & 127, h = (T0 >> 8) & 15, b = T0 >> 12, c = c0 + pr;
        const size_t bh256 = (size_t)(b * 16 + h) * 256;
        const bf16* Kl = Kb + bh256 * 4096 + (size_t)lane * 8; const bf16* Vl = VT + bh256 * 4096 + (size_t)lane * 8;
        const LAS float* rbh = rb + h * 257;
        int kt0 = 16 - 2 * c; if (kt0 < 0) kt0 = 0;
        const int kbase = 64 * c - 512, tb = kbase >> 5;
        if (role == 0) {
            bf16x8 q0[8], q1[8];
            attn_ld8(q0, QO + ((bh256 + 2 * c + 0) * 8) * 512 + (size_t)lane * 8); attn_ld8(q1, QO + ((bh256 + 2 * c + 1) * 8) * 512 + (size_t)lane * 8);
            float mrun0 = -1e30f, mrun1 = -1e30f, lrun0 = 0.f, lrun1 = 0.f;
            bf16x8 kc[8];
            attn_ld8(kc, Kl + (size_t)(tb + kt0) * 4096);
            for (int t = 0; t < 18; ++t) {
                if (t >= kt0) { f32x16 s0, s1;
                    attn_a_qk(s0, kc, q0); attn_a_qk(s1, kc, q1);
                    __builtin_amdgcn_sched_barrier(0);
                    if (t + 1 < 18) attn_ld8(kc, Kl + (size_t)(tb + t + 1) * 4096);
                    __builtin_amdgcn_sched_barrier(0);
                    const int so = (t & 1) * 4096, ao = (t & 1) * 128;
                    attn_a_half(s0, rbh, kbase + 32 * t, 64 * c, r32, hl, lane, mrun0, lrun0, pl + so, al + ao);
                    attn_a_half(s1, rbh, kbase + 32 * t, 64 * c + 32, r32, hl, lane, mrun1, lrun1, pl + so + 2048, al + ao + 64); }
                if (t == 17) { *(LAS float*)(xp + 9216 + lane * 4) = lrun0; *(LAS float*)(xp + 9216 + 256 + lane * 4) = lrun1; }
                LDS_WAIT(); __syncthreads();
            }
            __syncthreads();
        } else {
            f32x16 oA[4], oB[4];
#pragma unroll
            for (int dt = 0; dt < 4; ++dt)
#pragma unroll
                for (int i = 0; i < 16; ++i) { oA[dt][i] = 0.f; oB[dt][i] = 0.f; }
            bf16x8 vc[8];
            attn_ld8(vc, Vl + (size_t)(tb + kt0) * 4096);
            __syncthreads();
            for (int t = 0; t < 18; ++t) {
                if (t >= kt0) { const int so = (t & 1) * 4096, ao = (t & 1) * 128;
                    attn_b_half(vc, oA, pl + so, al + ao); attn_b_half(vc, oB, pl + so + 2048, al + ao + 64);
                    __builtin_amdgcn_sched_barrier(0);
                    if (t + 1 < 18) attn_ld8(vc, Vl + (size_t)(tb + t + 1) * 4096); }
                LDS_WAIT(); __syncthreads();
            }
            {   const float lf0 = *(const LAS float*)(xp + 9216 + lane * 4), lf1 = *(const LAS float*)(xp + 9216 + 256 + lane * 4);
                const float inv0 = O8S / lf0, inv1 = O8S / lf1;
                unsigned char* op0 = O8 + ((size_t)b * SEQ + 64 * c + r32) * D + h * 128 + 4 * hl; unsigned char* op1 = op0 + (size_t)32 * D;
#pragma unroll
                for (int dt = 0; dt < 4; ++dt)
#pragma unroll
                    for (int rq = 0; rq < 4; ++rq) { int w = 0; w = __builtin_amdgcn_cvt_pk_fp8_f32(oA[dt][4 * rq + 0] * inv0, oA[dt][4 * rq + 1] * inv0, w, false); w = __builtin_amdgcn_cvt_pk_fp8_f32(oA[dt][4 * rq + 2] * inv0, oA[dt][4 * rq + 3] * inv0, w, true);
                        *(int*)(op0 + 32 * dt + 8 * rq) = w;
                        int w2 = 0; w2 = __builtin_amdgcn_cvt_pk_fp8_f32(oB[dt][4 * rq + 0] * inv1, oB[dt][4 * rq + 1] * inv1, w2, false); w2 = __builtin_amdgcn_cvt_pk_fp8_f32(oB[dt][4 * rq + 2] * inv1, oB[dt][4 * rq + 3] * inv1, w2, true);
                        *(int*)(op1 + 32 * dt + 8 * rq) = w2; }
            }
        }
        __syncthreads();
    }
}

#define INS16(L, x) do { _Pragma("unroll") for (int _j = 15; _j >= 1; --_j) L[_j] = __builtin_amdgcn_fmed3f(L[_j - 1], L[_j], (x)); L[0] = fmaxf(L[0], (x)); } while (0)
__device__ __forceinline__ void peer_select_phase(const bf16* Q, const LAS unsigned char* skl  , int* idx_out, float* gate_out, int gw, int NGW, int lane) {
    const int r = lane & 31, half = lane >> 5;
    for (int it = gw; it < M / 4; it += NGW) {
        const int t = 4 * it + (r >> 3), hh = r & 7;
        float L[2][16];
#pragma unroll
        for (int s = 0; s < 2; ++s) {
#pragma unroll
            for (int j = 0; j < 16; ++j) L[s][j] = -3.0e38f;
            bf16x8 qf[8];
            const bf16* qp = Q + (size_t)t * D + hh * 256 + s * 128 + 8 * half;
#pragma unroll
            for (int ks = 0; ks < 8; ++ks) qf[ks] = *(const bf16x8*)(qp + 16 * ks);
#pragma unroll 1
            for (int nt = 0; nt < 4; ++nt) {
                f32x16 sc;
#pragma unroll
                for (int i = 0; i < 16; ++i) sc[i] = 0.f;
                const LAS unsigned char* kp = skl + (size_t)(s * 128 + 32 * nt + r) * 272 + 16 * half;
#pragma unroll
                for (int ks = 0; ks < 8; ++ks) { const bf16x8 kf = *(const LAS bf16x8*)(kp + 32 * ks); sc = __builtin_amdgcn_mfma_f32_32x32x16_bf16(kf, qf[ks], sc, 0, 0, 0); }
#pragma unroll
                for (int i = 0; i < 16; ++i) { const unsigned n = 32 * nt + (i & 3) + 8 * (i >> 2) + 4 * half;
                    const float sv = sc[i];
                    const float x = __builtin_bit_cast(float, (__builtin_bit_cast(unsigned, sv) & ~127u) | n);
                    INS16(L[s], x); }
            }
        }
        float mine[16], oth[16];
#pragma unroll
        for (int j = 0; j < 16; ++j) { const float o0 = SHFL_XOR(L[0][j], 32), o1 = SHFL_XOR(L[1][j], 32); mine[j] = half ? L[1][j] : L[0][j]; oth[j] = half ? o1 : o0; }
#pragma unroll
        for (int j = 0; j < 16; ++j) { const float x = oth[j]; INS16(mine, x); }
        float A[16], B[16];
#pragma unroll
        for (int j = 0; j < 16; ++j) { const float o = SHFL_XOR(mine[j], 32); A[j] = half ? o : mine[j]; B[j] = half ? mine[j] : o; }
        float T[16];
#pragma unroll
        for (int j = 0; j < 16; ++j) T[j] = -3.0e38f;
#pragma unroll
        for (int a = 0; a < 16; ++a)
#pragma unroll
            for (int bq = 0; bq < 16; ++bq) if ((a + 1) * (bq + 1) <= 16) { const float x = A[a] + B[bq]; INS16(T, x); }
        const float tau = T[15], mx = T[0];
        float den = 0.f;
#pragma unroll
        for (int j = 0; j < 16; ++j) den += __builtin_amdgcn_exp2f((T[j] - mx) * LOG2E);
        const float rden = 1.f / den;
        int cnt = 0;
        const size_t ob = (size_t)t * 128 + hh * 16;
#pragma unroll
        for (int a = 0; a < 16; ++a)
#pragma unroll
            for (int bq = 0; bq < 16; ++bq) if ((a + 1) * (bq + 1) <= 16) {
                const float x = A[a] + B[bq];
                if (x >= tau && cnt < 16) {
                    if (half == 0) idx_out[ob + cnt] = (int)(((__builtin_bit_cast(unsigned, A[a]) & 127u) << 7) | (__builtin_bit_cast(unsigned, B[bq]) & 127u));
                    else gate_out[ob + cnt] = __builtin_amdgcn_exp2f((x - mx) * LOG2E) * rden;
                    ++cnt;
                }
            }
    }
}

__device__ __forceinline__ void peer_gather_phase(float* hio, bf16* hb, const int* idx, const float* gate, const bf16* TU, const bf16* TV, const float* lg, const float* lb, int gw, int NGW, int lane) {
    for (int m = gw; m < M; m += NGW) {
        v4u xr[4];
#pragma unroll
        for (int j = 0; j < 4; ++j) xr[j] = *(const v4u*)(hb + (size_t)m * D + 512 * j + 8 * lane);
        const int i0 = idx[(size_t)m * 128 + lane], i1 = idx[(size_t)m * 128 + 64 + lane];
        float y[32];
#pragma unroll
        for (int i = 0; i < 32; ++i) y[i] = 0.f;
#ifdef DBG_NO_PEER
        for (int hb_ = 0; hb_ < 0; ++hb_) {
#else
        for (int hb_ = 0; hb_ < 8; ++hb_) {
#endif
            float part[16];
            const int isel = (hb_ < 4) ? i0 : i1;
#pragma unroll
            for (int kk = 0; kk < 16; ++kk) {
                const int e = __builtin_amdgcn_readlane(isel, ((hb_ & 3) << 4) + kk);
                const bf16* up = TU + (size_t)e * D + 8 * lane;
                float acc = 0.f;
#pragma unroll
                for (int j = 0; j < 4; ++j) { const v4u w = *(const v4u*)(up + 512 * j);
                    acc = dot2bf(w.x, xr[j].x, acc); acc = dot2bf(w.y, xr[j].y, acc); acc = dot2bf(w.z, xr[j].z, acc); acc = dot2bf(w.w, xr[j].w, acc); }
                part[kk] = acc;
            }
#pragma unroll
            for (int kk = 0; kk < 16; ++kk) { part[kk] += SHFL_XOR(part[kk], 32); part[kk] += SHFL_XOR(part[kk], 16); }
            {
                const bool b3 = (lane & 8) != 0, b2 = (lane & 4) != 0, b1 = (lane & 2) != 0, b0 = (lane & 1) != 0;
#pragma unroll
                for (int i = 0; i < 8; ++i) { const float send = b3 ? part[i] : part[i + 8], keep = b3 ? part[i + 8] : part[i]; part[i] = keep + SHFL_XOR(send, 8); }
#pragma unroll
                for (int i = 0; i < 4; ++i) { const float send = b2 ? part[i] : part[i + 4], keep = b2 ? part[i + 4] : part[i]; part[i] = keep + SHFL_XOR(send, 4); }
#pragma unroll
                for (int i = 0; i < 2; ++i) { const float send = b1 ? part[i] : part[i + 2], keep = b1 ? part[i + 2] : part[i]; part[i] = keep + SHFL_XOR(send, 2); }
                { const float send = b0 ? part[0] : part[1], keep = b0 ? part[1] : part[0]; part[0] = keep + SHFL_XOR(send, 1); }
            }
            const float gt = gate[(size_t)m * 128 + hb_ * 16 + (lane & 15)];
            const float act = gelu_f(part[0]) * gt;
            const unsigned actb = f2bf(act);
#pragma unroll
            for (int kk = 0; kk < 16; ++kk) {
                const int e = __builtin_amdgcn_readlane(isel, ((hb_ & 3) << 4) + kk);
                const unsigned ab = (unsigned)__builtin_amdgcn_readlane((int)actb, kk);
                const unsigned alo = ab, ahi = ab << 16;
                const bf16* vp = TV + (size_t)e * D + 8 * lane;
#pragma unroll
                for (int j = 0; j < 4; ++j) { const v4u w = *(const v4u*)(vp + 512 * j);
                    y[8 * j + 0] = dot2bf(w.x, alo, y[8 * j + 0]); y[8 * j + 1] = dot2bf(w.x, ahi, y[8 * j + 1]);
                    y[8 * j + 2] = dot2bf(w.y, alo, y[8 * j + 2]); y[8 * j + 3] = dot2bf(w.y, ahi, y[8 * j + 3]);
                    y[8 * j + 4] = dot2bf(w.z, alo, y[8 * j + 4]); y[8 * j + 5] = dot2bf(w.z, ahi, y[8 * j + 5]);
                    y[8 * j + 6] = dot2bf(w.w, alo, y[8 * j + 6]); y[8 * j + 7] = dot2bf(w.w, ahi, y[8 * j + 7]); }
            }
        }
        float* row = hio + (size_t)m * D + 8 * lane;
        float s = 0.f;
#pragma unroll
        for (int j = 0; j < 4; ++j) { const f32x4 a = *(const f32x4*)(row + 512 * j), b = *(const f32x4*)(row + 512 * j + 4);
            y[8 * j + 0] += DN_ALPHA * a.x; y[8 * j + 1] += DN_ALPHA * a.y; y[8 * j + 2] += DN_ALPHA * a.z; y[8 * j + 3] += DN_ALPHA * a.w;
            y[8 * j + 4] += DN_ALPHA * b.x; y[8 * j + 5] += DN_ALPHA * b.y; y[8 * j + 6] += DN_ALPHA * b.z; y[8 * j + 7] += DN_ALPHA * b.w; }
#pragma unroll
        for (int i = 0; i < 32; ++i) s += y[i];
        const float mean = wave_sum(s) * (1.f / D); float s2 = 0.f;
#pragma unroll
        for (int i = 0; i < 32; ++i) { y[i] -= mean; s2 += y[i] * y[i]; }
        const float rstd = 1.f / sqrtf(wave_sum(s2) * (1.f / D) + LN_EPS);
#pragma unroll
        for (int j = 0; j < 4; ++j) { const float* gp = lg + 512 * j + 8 * lane; const float* bp = lb + 512 * j + 8 * lane;
            const f32x4 g0 = *(const f32x4*)gp, g1 = *(const f32x4*)(gp + 4), b0 = *(const f32x4*)bp, b1 = *(const f32x4*)(bp + 4);
            f32x4 o0, o1; o0.x = y[8 * j + 0] * rstd * g0.x + b0.x; o0.y = y[8 * j + 1] * rstd * g0.y + b0.y; o0.z = y[8 * j + 2] * rstd * g0.z + b0.z; o0.w = y[8 * j + 3] * rstd * g0.w + b0.w;
            o1.x = y[8 * j + 4] * rstd * g1.x + b1.x; o1.y = y[8 * j + 5] * rstd * g1.y + b1.y; o1.z = y[8 * j + 6] * rstd * g1.z + b1.z; o1.w = y[8 * j + 7] * rstd * g1.w + b1.w;
            *(f32x4*)(row + 512 * j) = o0; *(f32x4*)(row + 512 * j + 4) = o1;
            v4u w; w.x = pk2(o0.x, o0.y); w.y = pk2(o0.z, o0.w); w.z = pk2(o1.x, o1.y); w.w = pk2(o1.z, o1.w);
            *(v4u*)(hb + (size_t)m * D + 512 * j + 8 * lane) = w; }
    }
}


__device__ __forceinline__ float udot8(const v4u (&w)[2], const f32x2 (&x2)[16]) {
    f32x2 a0 = {0.f, 0.f}, a1 = {0.f, 0.f};
#pragma unroll
    for (int j = 0; j < 2; ++j) {
        const unsigned d0 = w[j].x, d1 = w[j].y, d2 = w[j].z, d3 = w[j].w;
        a0 = __builtin_elementwise_fma(__builtin_amdgcn_cvt_pk_f32_fp8((int)d0, false), x2[8 * j + 0], a0); a1 = __builtin_elementwise_fma(__builtin_amdgcn_cvt_pk_f32_fp8((int)d0, true), x2[8 * j + 1], a1);
        a0 = __builtin_elementwise_fma(__builtin_amdgcn_cvt_pk_f32_fp8((int)d1, false), x2[8 * j + 2], a0); a1 = __builtin_elementwise_fma(__builtin_amdgcn_cvt_pk_f32_fp8((int)d1, true), x2[8 * j + 3], a1);
        a0 = __builtin_elementwise_fma(__builtin_amdgcn_cvt_pk_f32_fp8((int)d2, false), x2[8 * j + 4], a0); a1 = __builtin_elementwise_fma(__builtin_amdgcn_cvt_pk_f32_fp8((int)d2, true), x2[8 * j + 5], a1);
        a0 = __builtin_elementwise_fma(__builtin_amdgcn_cvt_pk_f32_fp8((int)d3, false), x2[8 * j + 6], a0); a1 = __builtin_elementwise_fma(__builtin_amdgcn_cvt_pk_f32_fp8((int)d3, true), x2[8 * j + 7], a1);
    }
    return (a0.x + a0.y) + (a1.x + a1.y);
}
__device__ __forceinline__ void vacc8(const v4u (&w)[2], const f32x2 a2, f32x2 (&y2)[16]) {
#pragma unroll
    for (int j = 0; j < 2; ++j) {
        const unsigned d0 = w[j].x, d1 = w[j].y, d2 = w[j].z, d3 = w[j].w;
        y2[8 * j + 0] = __builtin_elementwise_fma(__builtin_amdgcn_cvt_pk_f32_fp8((int)d0, false), a2, y2[8 * j + 0]); y2[8 * j + 1] = __builtin_elementwise_fma(__builtin_amdgcn_cvt_pk_f32_fp8((int)d0, true), a2, y2[8 * j + 1]);
        y2[8 * j + 2] = __builtin_elementwise_fma(__builtin_amdgcn_cvt_pk_f32_fp8((int)d1, false), a2, y2[8 * j + 2]); y2[8 * j + 3] = __builtin_elementwise_fma(__builtin_amdgcn_cvt_pk_f32_fp8((int)d1, true), a2, y2[8 * j + 3]);
        y2[8 * j + 4] = __builtin_elementwise_fma(__builtin_amdgcn_cvt_pk_f32_fp8((int)d2, false), a2, y2[8 * j + 4]); y2[8 * j + 5] = __builtin_elementwise_fma(__builtin_amdgcn_cvt_pk_f32_fp8((int)d2, true), a2, y2[8 * j + 5]);
        y2[8 * j + 6] = __builtin_elementwise_fma(__builtin_amdgcn_cvt_pk_f32_fp8((int)d3, false), a2, y2[8 * j + 6]); y2[8 * j + 7] = __builtin_elementwise_fma(__builtin_amdgcn_cvt_pk_f32_fp8((int)d3, true), a2, y2[8 * j + 7]);
    }
}
#define ROWLD8(dst, base, e) do { const u8* _p = (base) + (size_t)(e) * D + 16 * lane; dst[0] = gld16(_p); dst[1] = gld16(_p + 1024); } while (0)
__device__ __forceinline__ void peer_gather_fp8(float* hio, bf16* hb, float* hio_w, bf16* hb_w, const int* idx, const float* gate, const u8* TU8, const u8* TV8, const float* lg, const float* lb, int gw, int NGW, int lane_in) {
    for (int m = gw; m < M; m += NGW) {
        int lane = lane_in; asm volatile("" : "+v"(lane));
        float* row = hio + (size_t)m * D + 16 * lane;
        f32x2 x2[16];
#pragma unroll
        for (int j = 0; j < 2; ++j)
#pragma unroll
            for (int q = 0; q < 4; ++q) { const f32x4 t = *(const GAS f32x4*)(row + 1024 * j + 4 * q); x2[8 * j + 2 * q] = (f32x2){t.x, t.y}; x2[8 * j + 2 * q + 1] = (f32x2){t.z, t.w}; }
        const int i0 = *(const GAS int*)(idx + (size_t)m * 128 + lane), i1 = *(const GAS int*)(idx + (size_t)m * 128 + 64 + lane);
        f32x2 y2[16];
#pragma unroll
        for (int i = 0; i < 16; ++i) y2[i] = (f32x2){0.f, 0.f};
        v4u buf[4][2];
#pragma unroll
        for (int q = 0; q < 4; ++q) { const int e = __builtin_amdgcn_readlane(i0, q); ROWLD8(buf[q], TU8, e); }
        for (int hb_ = 0; hb_ < 8; ++hb_) {
            const int isel = (hb_ < 4) ? i0 : i1, inext = (hb_ + 1 < 4) ? i0 : i1;
            const int lb0 = (hb_ & 3) << 4, lbn = ((hb_ + 1) & 3) << 4;
            const float gt = *(const GAS float*)(gate + (size_t)m * 128 + hb_ * 16 + (lane & 15));
            float part[16];
#pragma unroll
            for (int kk = 0; kk < 16; ++kk) {
                part[kk] = udot8(buf[kk & 3], x2);
                if (kk + 4 < 16) { const int e = __builtin_amdgcn_readlane(isel, lb0 + kk + 4); ROWLD8(buf[kk & 3], TU8, e); }
                else { const int e = __builtin_amdgcn_readlane(isel, lb0 + kk + 4 - 16); ROWLD8(buf[kk & 3], TV8, e); }
                __builtin_amdgcn_sched_barrier(0);
            }
#pragma unroll
            for (int kk = 0; kk < 16; ++kk) { part[kk] += SHFL_XOR(part[kk], 32); part[kk] += SHFL_XOR(part[kk], 16); }
            {
                const bool b3 = (lane & 8) != 0, b2 = (lane & 4) != 0, b1 = (lane & 2) != 0, b0 = (lane & 1) != 0;
#pragma unroll
                for (int i = 0; i < 8; ++i) { const float send = b3 ? part[i] : part[i + 8], keep = b3 ? part[i + 8] : part[i]; part[i] = keep + SHFL_XOR(send, 8); }
#pragma unroll
                for (int i = 0; i < 4; ++i) { const float send = b2 ? part[i] : part[i + 4], keep = b2 ? part[i + 4] : part[i]; part[i] = keep + SHFL_XOR(send, 4); }
#pragma unroll
                for (int i = 0; i < 2; ++i) { const float send = b1 ? part[i] : part[i + 2], keep = b1 ? part[i + 2] : part[i]; part[i] = keep + SHFL_XOR(send, 2); }
                { const float send = b0 ? part[0] : part[1], keep = b0 ? part[1] : part[0]; part[0] = keep + SHFL_XOR(send, 1); }
            }
            const float act = gelu_f(part[0] * (1.f / TU_SCALE)) * gt * (1.f / TV_SCALE);
            const int acti = __builtin_bit_cast(int, act);
#pragma unroll
            for (int kk = 0; kk < 16; ++kk) {
                const float a = __builtin_bit_cast(float, __builtin_amdgcn_readlane(acti, kk));
                vacc8(buf[kk & 3], (f32x2){a, a}, y2);
                if (kk + 4 < 16) { const int e = __builtin_amdgcn_readlane(isel, lb0 + kk + 4); ROWLD8(buf[kk & 3], TV8, e); }
                else if (hb_ < 7) { const int e = __builtin_amdgcn_readlane(inext, lbn + kk + 4 - 16); ROWLD8(buf[kk & 3], TU8, e); }
                __builtin_amdgcn_sched_barrier(0);
            }
        }
        float s = 0.f;
#pragma unroll
        for (int i = 0; i < 16; ++i) { y2[i] = y2[i] + x2[i] * DN_ALPHA; s += y2[i].x + y2[i].y; }
        const float mean = wave_sum(s) * (1.f / D); float s2 = 0.f;
#pragma unroll
        for (int i = 0; i < 16; ++i) { y2[i] = y2[i] - mean; s2 += y2[i].x * y2[i].x + y2[i].y * y2[i].y; }
        const float rstd = 1.f / sqrtf(wave_sum(s2) * (1.f / D) + LN_EPS);
#pragma unroll
        for (int j = 0; j < 2; ++j)
#pragma unroll
            for (int q = 0; q < 4; ++q) { const int off = 1024 * j + 16 * lane + 4 * q;
                const f32x4 g4 = *(const GAS f32x4*)(lg + off), b4 = *(const GAS f32x4*)(lb + off);
                const f32x2 ya = y2[8 * j + 2 * q], yb = y2[8 * j + 2 * q + 1];
                f32x4 o; o.x = ya.x * rstd * g4.x + b4.x; o.y = ya.y * rstd * g4.y + b4.y; o.z = yb.x * rstd * g4.z + b4.z; o.w = yb.y * rstd * g4.w + b4.w;
                *(GAS f32x4*)(hio_w + (size_t)m * D + off) = o;
                v2u w; w.x = pk2(o.x, o.y); w.y = pk2(o.z, o.w); *(GAS v2u*)(hb_w + (size_t)m * D + off) = w; }
    }
}


__device__ __forceinline__ float wave_max(float v) {
    v = fmaxf(v, WDPP(v, 0xB1)); v = fmaxf(v, WDPP(v, 0x4E)); v = fmaxf(v, WDPP(v, 0x141)); v = fmaxf(v, WDPP(v, 0x140));
    return fmaxf(fmaxf(WRL(v, 0), WRL(v, 16)), fmaxf(WRL(v, 32), WRL(v, 48)));
}
__device__ __forceinline__ void cvt_rows_fp4(const float* src, u8* dst, float* scales, int nrows, int gw, int NGW, int lane) {
    for (int r0 = gw; r0 < nrows; r0 += 4 * NGW) {
        f32x4 v[4][8];
#pragma unroll
        for (int u = 0; u < 4; ++u) { const GAS f32x4* p = (const GAS f32x4*)(src + (size_t)(r0 + u * NGW) * D + 4 * lane);
#pragma unroll
            for (int q = 0; q < 8; ++q) v[u][q] = p[64 * q]; }
#pragma unroll
        for (int u = 0; u < 4; ++u) { const int r = r0 + u * NGW; float mx = 0.f;
#pragma unroll
            for (int q = 0; q < 8; ++q) mx = fmaxf(mx, fmaxf(fmaxf(__builtin_fabsf(v[u][q].x), __builtin_fabsf(v[u][q].y)), fmaxf(__builtin_fabsf(v[u][q].z), __builtin_fabsf(v[u][q].w))));
            mx = wave_max(mx);
            const float inv = mx > 0.f ? 6.f / mx : 0.f;
            const int lay = r / NEXP, e = r % NEXP;
#pragma unroll
            for (int q = 0; q < 8; ++q) { unsigned t = 0u; const f32x4 a = v[u][q] * inv;
                t = __builtin_amdgcn_cvt_scalef32_pk_fp4_f32(t, a.x, a.y, 1.0f, 0); t = __builtin_amdgcn_cvt_scalef32_pk_fp4_f32(t, a.z, a.w, 1.0f, 1);
                *(GAS unsigned short*)(dst + (((size_t)lay * 8 + q) * NEXP + e) * 128 + 2 * lane) = (unsigned short)(t & 0xffffu); }
            if (lane == 0) scales[r] = mx * (1.f / 6.f); }
    }
}
__device__ __forceinline__ float udot4(const v4u w, const f32x2 (&x2)[16]) {
    f32x2 a0 = {0.f, 0.f}, a1 = {0.f, 0.f};
    const unsigned d0 = w.x, d1 = w.y, d2 = w.z, d3 = w.w;
#define UD4(dw, k) a0 = __builtin_elementwise_fma(__builtin_amdgcn_cvt_scalef32_pk_f32_fp4(dw, 1.0f, 0), x2[4 * (k) + 0], a0); a1 = __builtin_elementwise_fma(__builtin_amdgcn_cvt_scalef32_pk_f32_fp4(dw, 1.0f, 1), x2[4 * (k) + 1], a1); \
                   a0 = __builtin_elementwise_fma(__builtin_amdgcn_cvt_scalef32_pk_f32_fp4(dw, 1.0f, 2), x2[4 * (k) + 2], a0); a1 = __builtin_elementwise_fma(__builtin_amdgcn_cvt_scalef32_pk_f32_fp4(dw, 1.0f, 3), x2[4 * (k) + 3], a1);
    UD4(d0, 0) UD4(d1, 1) UD4(d2, 2) UD4(d3, 3)
#undef UD4
    return (a0.x + a0.y) + (a1.x + a1.y);
}
__device__ __forceinline__ void vacc4(const v4u w, const f32x2 a2, f32x2 (&y2)[16]) {
    const unsigned d0 = w.x, d1 = w.y, d2 = w.z, d3 = w.w;
#define VA4(dw, k) y2[4 * (k) + 0] = __builtin_elementwise_fma(__builtin_amdgcn_cvt_scalef32_pk_f32_fp4(dw, 1.0f, 0), a2, y2[4 * (k) + 0]); y2[4 * (k) + 1] = __builtin_elementwise_fma(__builtin_amdgcn_cvt_scalef32_pk_f32_fp4(dw, 1.0f, 1), a2, y2[4 * (k) + 1]); \
                   y2[4 * (k) + 2] = __builtin_elementwise_fma(__builtin_amdgcn_cvt_scalef32_pk_f32_fp4(dw, 1.0f, 2), a2, y2[4 * (k) + 2]); y2[4 * (k) + 3] = __builtin_elementwise_fma(__builtin_amdgcn_cvt_scalef32_pk_f32_fp4(dw, 1.0f, 3), a2, y2[4 * (k) + 3]);
    VA4(d0, 0) VA4(d1, 1) VA4(d2, 2) VA4(d3, 3)
#undef VA4
}
#define ROWLD4(dst, base, e) do { dst = gld16((base) + (size_t)(e) * 1024 + 16 * lane); } while (0)
__device__ __forceinline__ void peer_gather_fp4(float* hio, bf16* hb, float* hio_w, bf16* hb_w, const int* idx, const float* gate, const u8* TU4, const u8* TV4, const float* SU, const float* SV,
                                                const float* lg, const float* lb, int gw, int NGW, int lane_in) {
    for (int m = gw; m < M; m += NGW) {
        int lane = lane_in; asm volatile("" : "+v"(lane));
        const float* row = hio + (size_t)m * D + 32 * lane;
        f32x2 x2[16];
#pragma unroll
        for (int q = 0; q < 8; ++q) { const f32x4 t = *(const GAS f32x4*)(row + 4 * q); x2[2 * q] = (f32x2){t.x, t.y}; x2[2 * q + 1] = (f32x2){t.z, t.w}; }
        const int i0 = *(const GAS int*)(idx + (size_t)m * 128 + lane), i1 = *(const GAS int*)(idx + (size_t)m * 128 + 64 + lane);
        f32x2 y2[16];
#pragma unroll
        for (int i = 0; i < 16; ++i) y2[i] = (f32x2){0.f, 0.f};
        v4u buf[8];
#pragma unroll
        for (int q = 0; q < 8; ++q) { const int e = __builtin_amdgcn_readlane(i0, q); ROWLD4(buf[q], TU4, e); }
        for (int hb_ = 0; hb_ < 8; ++hb_) {
            const int isel = (hb_ < 4) ? i0 : i1, inext = (hb_ + 1 < 4) ? i0 : i1;
            const int lb0 = (hb_ & 3) << 4, lbn = ((hb_ + 1) & 3) << 4;
            const float gt = *(const GAS float*)(gate + (size_t)m * 128 + hb_ * 16 + (lane & 15));
            const int ek = shfl_idx_lane(isel, lb0 + (lane & 15));
            const float su = *(const GAS float*)(SU + ek), sv = *(const GAS float*)(SV + ek);
            float part[16];
#pragma unroll
            for (int kk = 0; kk < 16; ++kk) {
                part[kk] = udot4(buf[kk & 7], x2);
                if (kk + 8 < 16) { const int e = __builtin_amdgcn_readlane(isel, lb0 + kk + 8); ROWLD4(buf[kk & 7], TU4, e); }
                else { const int e = __builtin_amdgcn_readlane(isel, lb0 + kk + 8 - 16); ROWLD4(buf[kk & 7], TV4, e); }
                __builtin_amdgcn_sched_barrier(0);
            }
#pragma unroll
            for (int kk = 0; kk < 16; ++kk) { part[kk] += SHFL_XOR(part[kk], 32); part[kk] += SHFL_XOR(part[kk], 16); }
            {
                const bool b3 = (lane & 8) != 0, b2 = (lane & 4) != 0, b1 = (lane & 2) != 0, b0 = (lane & 1) != 0;
#pragma unroll
                for (int i = 0; i < 8; ++i) { const float send = b3 ? part[i] : part[i + 8], keep = b3 ? part[i + 8] : part[i]; part[i] = keep + SHFL_XOR(send, 8); }
#pragma unroll
                for (int i = 0; i < 4; ++i) { const float send = b2 ? part[i] : part[i + 4], keep = b2 ? part[i + 4] : part[i]; part[i] = keep + SHFL_XOR(send, 4); }
#pragma unroll
                for (int i = 0; i < 2; ++i) { const float send = b1 ? part[i] : part[i + 2], keep = b1 ? part[i + 2] : part[i]; part[i] = keep + SHFL_XOR(send, 2); }
                { const float send = b0 ? part[0] : part[1], keep = b0 ? part[1] : part[0]; part[0] = keep + SHFL_XOR(send, 1); }
            }
            const float act = gelu_f(part[0] * su) * gt * sv;
            const int acti = __builtin_bit_cast(int, act);
#pragma unroll
            for (int kk = 0; kk < 16; ++kk) {
                const float a = __builtin_bit_cast(float, __builtin_amdgcn_readlane(acti, kk));
                vacc4(buf[kk & 7], (f32x2){a, a}, y2);
                if (kk + 8 < 16) { const int e = __builtin_amdgcn_readlane(isel, lb0 + kk + 8); ROWLD4(buf[kk & 7], TV4, e); }
                else if (hb_ < 7) { const int e = __builtin_amdgcn_readlane(inext, lbn + kk + 8 - 16); ROWLD4(buf[kk & 7], TU4, e); }
                __builtin_amdgcn_sched_barrier(0);
            }
        }
        float s = 0.f;
#pragma unroll
        for (int i = 0; i < 16; ++i) { y2[i] = y2[i] + x2[i] * DN_ALPHA; s += y2[i].x + y2[i].y; }
        const float mean = wave_sum(s) * (1.f / D); float s2 = 0.f;
#pragma unroll
        for (int i = 0; i < 16; ++i) { y2[i] = y2[i] - mean; s2 += y2[i].x * y2[i].x + y2[i].y * y2[i].y; }
        const float rstd = 1.f / sqrtf(wave_sum(s2) * (1.f / D) + LN_EPS);
#pragma unroll
        for (int q = 0; q < 8; ++q) { const int off = 32 * lane + 4 * q;
            const f32x4 g4 = *(const GAS f32x4*)(lg + off), b4 = *(const GAS f32x4*)(lb + off);
            const f32x2 ya = y2[2 * q], yb = y2[2 * q + 1];
            f32x4 o; o.x = ya.x * rstd * g4.x + b4.x; o.y = ya.y * rstd * g4.y + b4.y; o.z = yb.x * rstd * g4.z + b4.z; o.w = yb.y * rstd * g4.w + b4.w;
            *(GAS f32x4*)(hio_w + (size_t)m * D + off) = o;
            v2u w; w.x = pk2(o.x, o.y); w.y = pk2(o.z, o.w); *(GAS v2u*)(hb_w + (size_t)m * D + off) = w; }
    }
}


typedef _Float16 h16x2 __attribute__((ext_vector_type(2)));
#define CVT_H2_FP4(dw, b) __builtin_bit_cast(h16x2, __builtin_amdgcn_cvt_scalef32_pk_f16_fp4(dw, 1.0f, b))
__device__ __forceinline__ float udot4h(const v4u w, const h16x2 (&xh)[16]) {
    h16x2 a0 = {(_Float16)0.f, (_Float16)0.f}, a1 = {(_Float16)0.f, (_Float16)0.f};
    const unsigned d0 = w.x, d1 = w.y, d2 = w.z, d3 = w.w;
#define UD4H(dw, k) a0 = __builtin_elementwise_fma(CVT_H2_FP4(dw, 0), xh[4 * (k) + 0], a0); a1 = __builtin_elementwise_fma(CVT_H2_FP4(dw, 1), xh[4 * (k) + 1], a1); \
                    a0 = __builtin_elementwise_fma(CVT_H2_FP4(dw, 2), xh[4 * (k) + 2], a0); a1 = __builtin_elementwise_fma(CVT_H2_FP4(dw, 3), xh[4 * (k) + 3], a1);
    UD4H(d0, 0) UD4H(d1, 1) UD4H(d2, 2) UD4H(d3, 3)
#undef UD4H
    return ((float)a0.x + (float)a0.y) + ((float)a1.x + (float)a1.y);
}
__device__ __forceinline__ void vacc4h(const v4u w, const h16x2 a2, h16x2 (&yh)[16]) {
    const unsigned d0 = w.x, d1 = w.y, d2 = w.z, d3 = w.w;
#define VA4H(dw, k) yh[4 * (k) + 0] = __builtin_elementwise_fma(CVT_H2_FP4(dw, 0), a2, yh[4 * (k) + 0]); yh[4 * (k) + 1] = __builtin_elementwise_fma(CVT_H2_FP4(dw, 1), a2, yh[4 * (k) + 1]); \
                    yh[4 * (k) + 2] = __builtin_elementwise_fma(CVT_H2_FP4(dw, 2), a2, yh[4 * (k) + 2]); yh[4 * (k) + 3] = __builtin_elementwise_fma(CVT_H2_FP4(dw, 3), a2, yh[4 * (k) + 3]);
    VA4H(d0, 0) VA4H(d1, 1) VA4H(d2, 2) VA4H(d3, 3)
#undef VA4H
}

#define DPP_ADD(v, ctrl) ((v) + __builtin_bit_cast(float, __builtin_amdgcn_update_dpp(0, __builtin_bit_cast(int, (v)), (ctrl), 0xF, 0xF, true)))
#define LOAD_II16(dst, mm) do { const GAS v4u* _ip = (const GAS v4u*)(idx + (size_t)(mm) * 128 + 16 * eg); const v4u _a = _ip[0], _b = _ip[1], _c = _ip[2], _d = _ip[3]; \
    dst[0] = _a.x; dst[1] = _a.y; dst[2] = _a.z; dst[3] = _a.w; dst[4] = _b.x; dst[5] = _b.y; dst[6] = _b.z; dst[7] = _b.w; dst[8] = _c.x; dst[9] = _c.y; dst[10] = _c.z; dst[11] = _c.w; dst[12] = _d.x; dst[13] = _d.y; dst[14] = _d.z; dst[15] = _d.w; } while (0)
typedef int v8i_m __attribute__((ext_vector_type(8)));
#define U_QADD(keep, send, ctrl) ((keep) + __builtin_bit_cast(float, __builtin_amdgcn_update_dpp(0, __builtin_bit_cast(int, (send)), (ctrl), 0xF, 0xF, true)))
__device__ __forceinline__ void u_step(const u8* x4, const int* idx, const u8* tab, float* Ps, int m, int mn, int mnn, int eg, int aoff, int xoff, bool xval, bool b0, bool b1, int poff, int sc1, int scb,
                                       const v4u (&bufC)[16], const v4u& xC, const unsigned (&idxN)[16], v4u (&bufN)[16], v4u& xN, unsigned (&idxNN)[16]) {
#pragma unroll
    for (int t = 0; t < 16; ++t) bufN[t] = gld16(tab + (size_t)idxN[t] * 128 + aoff);
    xN = gld16(x4 + (size_t)mn * 2048 + xoff);
    LOAD_II16(idxNN, mnn);
    __builtin_amdgcn_sched_barrier(0);
    const v8i_m bx = {xval ? (int)xC.x : 0, xval ? (int)xC.y : 0, xval ? (int)xC.z : 0, xval ? (int)xC.w : 0, 0, 0, 0, 0};
    f32x4 acc[16];
#pragma unroll
    for (int t = 0; t < 16; ++t) { const v8i_m a8 = {(int)bufC[t].x, (int)bufC[t].y, (int)bufC[t].z, (int)bufC[t].w, 0, 0, 0, 0};
        acc[t] = __builtin_amdgcn_mfma_scale_f32_16x16x128_f8f6f4(a8, bx, (f32x4){0.f, 0.f, 0.f, 0.f}, 4, 4, 0, sc1, 0, scb); }
    float v[16];
#pragma unroll
    for (int t = 0; t < 16; ++t) { const float lo = b0 ? acc[t].y : acc[t].x, hi = b0 ? acc[t].w : acc[t].z; const float vv = b1 ? hi : lo; v[t] = U_QADD(vv, vv, 0x128); }
    float w[8];
#pragma unroll
    for (int i = 0; i < 8; ++i) { const float send = b0 ? v[i] : v[i + 8], keep = b0 ? v[i + 8] : v[i]; w[i] = U_QADD(keep, send, 0xB1); }
    f32x4 z;
#pragma unroll
    for (int i = 0; i < 4; ++i) { const float send = b1 ? w[i] : w[i + 4], keep = b1 ? w[i + 4] : w[i]; z[i] = U_QADD(keep, send, 0x4E); }
    if (poff >= 0) { const h16x2 zl = {(_Float16)z[0], (_Float16)z[1]}, zh = {(_Float16)z[2], (_Float16)z[3]};
        *(GAS v2u*)((_Float16*)Ps + (size_t)m * 128 + poff) = (v2u){__builtin_bit_cast(unsigned, zl), __builtin_bit_cast(unsigned, zh)}; }
    __builtin_amdgcn_sched_barrier(0);
}
__device__ __forceinline__ void peer_u_pass(const u8* x4, const int* idx, const u8* TUl, float* P, int bx, int G, int wave, int lane_in) {
    const int s = bx & 7, cu = bx >> 3, nW = (G >> 3) * NWAVES;
    const u8* tab = TUl + (size_t)s * NEXP * 128;
    float* Ps = (float*)((_Float16*)P + (size_t)s * M * 128);
    int lane = lane_in; asm volatile("" : "+v"(lane));
    const int n = lane & 15, kg = lane >> 4;
    const int eg = 2 * (n >> 2) + (kg >> 1);
    const int aoff = 16 * (4 * (kg & 1) + (n & 3));
    const int xoff = 128 * s + aoff + ((n & 8) ? 1024 : 0);
    const bool xval = (kg >> 1) == ((n >> 2) & 1);
    const bool b0 = (lane & 1) != 0, b1 = (lane & 2) != 0;
    const int poff = (n < 8) ? 16 * (2 * kg + (n >> 2)) + (b0 ? 8 : 0) + (b1 ? 4 : 0) : -1;
    const int m0 = cu * NWAVES + wave;
    int sc1 = 0x7F7F7F7F, sc8 = (n & 8) ? 0x7C7C7C7C : 0x7F7F7F7F; asm volatile("" : "+v"(sc1), "+v"(sc8));
    unsigned iiX[16], iiY[16]; v4u bufA[16], bufB[16]; v4u xA, xB;
    {   LOAD_II16(iiY, m0);
#pragma unroll
        for (int t = 0; t < 16; ++t) bufA[t] = gld16(tab + (size_t)iiY[t] * 128 + aoff);
        xA = gld16(x4 + (size_t)m0 * 2048 + xoff);
        const int m1 = (m0 + nW < M) ? m0 + nW : m0; LOAD_II16(iiX, m1); }
#define CLAMPM(x) (((x) < M) ? (x) : m0)
    for (int m = m0; m < M; m += 2 * nW) {
        u_step(x4, idx, tab, Ps, m, CLAMPM(m + nW), CLAMPM(m + 2 * nW), eg, aoff, xoff, xval, b0, b1, poff, sc1, sc8, bufA, xA, iiX, bufB, xB, iiY);
        u_step(x4, idx, tab, Ps, m + nW, CLAMPM(m + 2 * nW), CLAMPM(m + 3 * nW), eg, aoff, xoff, xval, b0, b1, poff, sc1, sc8, bufB, xB, iiY, bufA, xA, iiX);
    }
}
__device__ __forceinline__ void peer_act_phase(const float* P, const int* idx, float* gate, const float* SU, const float* SV, int gw, int NGW, int lane) {
    for (int m = gw; m < M; m += NGW) {
#pragma unroll
        for (int h = 0; h < 2; ++h) { const int k = 64 * h + lane;
            float z = 0.f;
#pragma unroll
            for (int sl = 0; sl < 8; ++sl) z += (float)*(const GAS _Float16*)((const _Float16*)P + ((size_t)sl * M + m) * 128 + k);
            const int e = *(const GAS int*)(idx + (size_t)m * 128 + k);
            const float su = *(const GAS float*)(SU + e), sv = *(const GAS float*)(SV + e), gt = *(const GAS float*)(gate + (size_t)m * 128 + k);
            *(GAS float*)(gate + (size_t)m * 128 + k) = gelu_f(z * su) * gt * sv; }
    }
}
#define LOAD_AA16(dst, mm) do { const GAS f32x4* _ap = (const GAS f32x4*)(act + (size_t)(mm) * 128 + 16 * eg); const f32x4 _a = _ap[0], _b = _ap[1], _c = _ap[2], _d = _ap[3]; \
    dst[0] = _a.x; dst[1] = _a.y; dst[2] = _a.z; dst[3] = _a.w; dst[4] = _b.x; dst[5] = _b.y; dst[6] = _b.z; dst[7] = _b.w; dst[8] = _c.x; dst[9] = _c.y; dst[10] = _c.z; dst[11] = _c.w; dst[12] = _d.x; dst[13] = _d.y; dst[14] = _d.z; dst[15] = _d.w; } while (0)
__device__ __forceinline__ void v_step(bf16* hio, const int* idx, const float* act, const u8* tab, const float* stats, const f32x4 lg, const f32x4 lb, int m, int mn, int mnn, int lane, int c, int eg, int coff, bool b0,
                                       const v4u (&bufC)[16], const float (&aaC)[16], const unsigned (&idxN)[16], v4u (&bufN)[16], float (&aaN)[16], unsigned (&idxNN)[16]) {
#pragma unroll
    for (int g = 0; g < 16; ++g) bufN[g] = gld16(tab + (size_t)idxN[g] * 128 + 16 * c);
    LOAD_AA16(aaN, mn);
    LOAD_II16(idxNN, mnn);
    bf16* op = hio + (size_t)m * D + coff;
    const v2u xw = *(const GAS v2u*)op;
    const f32x2 st = *(const GAS f32x2*)(stats + 2 * (size_t)m);
    __builtin_amdgcn_sched_barrier(0);
    h16x2 y2[16];
#pragma unroll
    for (int i = 0; i < 16; ++i) y2[i] = (h16x2){(_Float16)0.f, (_Float16)0.f};
#pragma unroll
    for (int g = 0; g < 16; ++g) { const _Float16 a = (_Float16)aaC[g]; vacc4h(bufC[g], (h16x2){a, a}, y2); }
#pragma unroll
    for (int i = 0; i < 8; ++i) { const h16x2 send = b0 ? y2[i] : y2[i + 8], keep = b0 ? y2[i + 8] : y2[i];
        y2[i] = keep + __builtin_bit_cast(h16x2, __builtin_amdgcn_update_dpp(0, __builtin_bit_cast(int, send), 0x128, 0xF, 0xF, true)); }
#pragma unroll
    for (int i = 0; i < 4; ++i) { const auto sw = __builtin_amdgcn_permlane16_swap(__builtin_bit_cast(unsigned, y2[i]), __builtin_bit_cast(unsigned, y2[i + 4]), false, false);
        const unsigned s0 = sw[0], s1 = sw[1]; y2[i] = __builtin_bit_cast(h16x2, s0) + __builtin_bit_cast(h16x2, s1); }
#pragma unroll
    for (int i = 0; i < 2; ++i) { const auto sw = __builtin_amdgcn_permlane32_swap(__builtin_bit_cast(unsigned, y2[i]), __builtin_bit_cast(unsigned, y2[i + 2]), false, false);
        const unsigned s0 = sw[0], s1 = sw[1]; y2[i] = __builtin_bit_cast(h16x2, s0) + __builtin_bit_cast(h16x2, s1); }
    const float x0 = (bflo(xw.x) - st.x) * st.y * lg.x + lb.x, x1 = (bfhi(xw.x) - st.x) * st.y * lg.y + lb.y, x2 = (bflo(xw.y) - st.x) * st.y * lg.z + lb.z, x3 = (bfhi(xw.y) - st.x) * st.y * lg.w + lb.w;
    v2u o; o.x = pk2(x0 * DN_ALPHA + (float)y2[0].x, x1 * DN_ALPHA + (float)y2[0].y); o.y = pk2(x2 * DN_ALPHA + (float)y2[1].x, x3 * DN_ALPHA + (float)y2[1].y);
    *(GAS v2u*)op = o;
    __builtin_amdgcn_sched_barrier(0);
}
__device__ __forceinline__ void peer_v_pass(bf16* hio, const int* idx, const float* act, const u8* TVl, const float* stats, const float* lng, const float* lnb, int bx, int G, int wave, int lane_in) {
    const int s = bx & 7, cu = bx >> 3, nW = (G >> 3) * NWAVES;
    const u8* tab = TVl + (size_t)s * NEXP * 128;
    int lane = lane_in; asm volatile("" : "+v"(lane));
    const int c = lane & 7, eg = lane >> 3;
    const bool b0 = (lane & 8) != 0, b1 = (lane & 16) != 0, b2 = (lane & 32) != 0;
    const int coff = 256 * s + 32 * c + (b0 ? 16 : 0) + (b1 ? 8 : 0) + (b2 ? 4 : 0);
    const int m0 = cu * NWAVES + wave;
    const f32x4 lg = *(const GAS f32x4*)(lng + coff), lb = *(const GAS f32x4*)(lnb + coff);
    unsigned iiX[16], iiY[16]; v4u bufA[16], bufB[16]; float aaA[16], aaB[16];
    {   LOAD_II16(iiY, m0);
#pragma unroll
        for (int g = 0; g < 16; ++g) bufA[g] = gld16(tab + (size_t)iiY[g] * 128 + 16 * c);
        LOAD_AA16(aaA, m0);
        const int m1 = (m0 + nW < M) ? m0 + nW : m0; LOAD_II16(iiX, m1); }
    for (int m = m0; m < M; m += 2 * nW) {
        v_step(hio, idx, act, tab, stats, lg, lb, m, CLAMPM(m + nW), CLAMPM(m + 2 * nW), lane, c, eg, coff, b0, bufA, aaA, iiX, bufB, aaB, iiY);
        v_step(hio, idx, act, tab, stats, lg, lb, m + nW, CLAMPM(m + 2 * nW), CLAMPM(m + 3 * nW), lane, c, eg, coff, b0, bufB, aaB, iiY, bufA, aaA, iiX);
    }
}

constexpr int N_SLOTS = 11;
struct Args { const float* in[31]; float* out; unsigned char* ws; int slot, layer, pad0, pad1; };

constexpr int TAB_OFF = MISC_OFF + 128;
__device__ __forceinline__ void store_tab(const Args& a, LAS unsigned char* lds) {
    if (threadIdx.x == 0) { LAS unsigned long long* t = (LAS unsigned long long*)(lds + TAB_OFF);
#pragma unroll
        for (int i = 0; i < 31; ++i) t[i] = (unsigned long long)a.in[i];
        t[31] = (unsigned long long)a.out; t[32] = (unsigned long long)a.ws; }
    __syncthreads();
}
struct Tab { unsigned tab;
    __device__ __forceinline__ unsigned long long raw(int k) const { const v2u v = *(const LAS v2u*)(tab + 8 * k);
        return ((unsigned long long)(unsigned)__builtin_amdgcn_readfirstlane((int)v.y) << 32) | (unsigned)__builtin_amdgcn_readfirstlane((int)v.x); }
    __device__ __forceinline__ const float* in(int k) const { return (const float*)raw(k); }
};
#define ARG_IN(k) T_.in(k)

template <int SLOT>
__device__ __forceinline__ void run_slot(LAS unsigned char* lds, int layer, int wave_s) {
    int tid = wave_s * 64 + lane_id(); asm volatile("" : "+v"(tid));
    Tab T_; T_.tab = (unsigned)(unsigned long long)(lds + TAB_OFF); asm volatile("" : "+s"(T_.tab));
    unsigned char* ws = (unsigned char*)T_.raw(32);
    const int lane = tid & 63, wave = __builtin_amdgcn_readfirstlane(tid >> 6);
    const int G = gridDim.x; const int bx = blockIdx.x; const int vcu = (G % 8 == 0) ? (bx % 8) * (G / 8) + bx / 8 : bx;
    const int gw = vcu * NWAVES + wave, NGW = G * NWAVES;
    const int gtid = vcu * (NWAVES * 64) + tid, gthreads = G * NWAVES * 64;
    const int kind = layer % 3, jj = layer / 3;
    float* hout = (float*)T_.raw(31);
    bf16* HB0 = (bf16*)(ws + WS_HB0); bf16* HB1 = (bf16*)(ws + WS_HB1);
    bf16* T1 = (bf16*)(ws + WS_T1); bf16* T2 = (bf16*)(ws + WS_T2); bf16* T3 = (bf16*)(ws + WS_T3);
    int* IDX = (int*)(ws + WS_IDX); float* GATE = (float*)(ws + WS_GATE);
    bf16* TU = (bf16*)(ws + WS_TU); bf16* TV = (bf16*)(ws + WS_TV); bf16* PB = (bf16*)(ws + WS_PB); bf16* SKB = (bf16*)(ws + WS_SK);
    bf16* Sin = (layer & 1) ? HB1 : HB0;
    bf16* Sout = (layer & 1) ? HB0 : HB1;

    if constexpr (SLOT == 0) {
        LAS float* scr = (LAS float*)(lds + wave * 16384); LAS unsigned* scr8 = (LAS unsigned*)(lds + wave * 16384); int woff = 0;
        for (int j = 0; j < 2; ++j) {
            transpose_mat8b(ARG_IN(6) + (size_t)j * D * D, D, D, ws + W_POOL_IN + (size_t)j * D * D, 0, scr8, gw, NGW, lane, woff);
            for (int g = 0; g < 4; ++g) transpose_mat8b(ARG_IN(7) + (size_t)(j * 4 + g) * 512 * 512, 512, 512, ws + W_POOL_GRP + (size_t)j * D * 512, g * 512, scr8, gw, NGW, lane, woff);
            transpose_mat8b(ARG_IN(9) + (size_t)j * D * D, D, D, ws + W_POOL_OUT + (size_t)j * D * D, 0, scr8, gw, NGW, lane, woff);
        }
        transpose_mat8b(ARG_IN(10), D, D, ws + W_SSM_IN, 0, scr8, gw, NGW, lane, woff);
        transpose_mat8b(ARG_IN(19), D, D, ws + W_SSM_GLU, 0, scr8, gw, NGW, lane, woff);
        transpose_mat8b(ARG_IN(20), D, D, ws + W_SSM_OUT, 0, scr8, gw, NGW, lane, woff);
        transpose_mat8b(ARG_IN(21), D, 3 * D, ws + W_ATTN_QKV, 0, scr8, gw, NGW, lane, woff);
        transpose_mat8b(ARG_IN(23), D, D, ws + W_ATTN_OUT, 0, scr8, gw, NGW, lane, woff);
        for (int i = 0; i < DEPTH; ++i) {
            transpose_mat8b(ARG_IN(24) + (size_t)i * D * D, D, D, ws + W_PEER_Q + (size_t)i * D * D, 0, scr8, gw, NGW, lane, woff);
            transpose_mat8b(ARG_IN(29) + (size_t)i * D * D, D, D, ws + W_PLE_GATE + (size_t)i * D * D, 0, scr8, gw, NGW, lane, woff);
            transpose_mat(ARG_IN(28) + (size_t)i * PLE * D, PLE, D, (bf16*)(ws + W_PLE_PROJ) + (size_t)i * PLE * D, 0, scr, gw, NGW, lane);
        }
        cvt_rows_fp4(ARG_IN(26), (u8*)TU, (float*)(ws + WS_SU), DEPTH * NEXP, gw, NGW, lane);
        cvt_rows_fp4(ARG_IN(27), (u8*)TV, (float*)(ws + WS_SV), DEPTH * NEXP, gw, NGW, lane);
        cvt_rows(ARG_IN(1), PB, (size_t)DEPTH * M * PLE, (size_t)gtid, (size_t)gthreads);
        cvt_rows(ARG_IN(25), SKB, (size_t)DEPTH * 2 * 128 * 128, (size_t)gtid, (size_t)gthreads);
        {
            const float* xs = ARG_IN(0); unsigned char* s8 = ws + WS_S8;
            const size_t gs = (size_t)gthreads * 8;
            for (size_t i0 = (size_t)gtid * 8; i0 < (size_t)M * D; i0 += 4 * gs) {
                f32x4 a[4], b[4];
#pragma unroll
                for (int u = 0; u < 4; ++u) { a[u] = *(const GAS f32x4*)(xs + i0 + u * gs); b[u] = *(const GAS f32x4*)(xs + i0 + u * gs + 4); }
#pragma unroll
                for (int u = 0; u < 4; ++u) { const size_t i = i0 + u * gs;
                    v4u o; o.x = pk2(a[u].x, a[u].y); o.y = pk2(a[u].z, a[u].w); o.z = pk2(b[u].x, b[u].y); o.w = pk2(b[u].z, b[u].w);
                    *(GAS v4u*)(HB0 + i) = o;
                    int w0 = 0, w1 = 0;
                    w0 = __builtin_amdgcn_cvt_pk_fp8_f32(a[u].x, a[u].y, w0, false); w0 = __builtin_amdgcn_cvt_pk_fp8_f32(a[u].z, a[u].w, w0, true);
                    w1 = __builtin_amdgcn_cvt_pk_fp8_f32(b[u].x, b[u].y, w1, false); w1 = __builtin_amdgcn_cvt_pk_fp8_f32(b[u].z, b[u].w, w1, true);
                    v2u o8; o8.x = (unsigned)w0; o8.y = (unsigned)w1; *(GAS v2u*)(s8 + i) = o8; } } }
        {
            const float* lam_re = ARG_IN(11); const float* lam_im = ARG_IN(12); const float* log_step = ARG_IN(13); const float* b_re = ARG_IN(14); const float* b_im = ARG_IN(15);
            float* ssmp = (float*)(ws + WS_SSMP);
            for (int i = gtid; i < 128 * 64; i += gthreads) { const int g = i >> 6;
                const float lr = lam_re[i], li = lam_im[i], dt = expf(log_step[g]);
                const float mag = expf(dt * lr), ar = mag * cosf(dt * li), ai = mag * sinf(dt * li);
                const float den = lr * lr + li * li;
                const float kr = ((ar - 1.f) * lr + ai * li) / den, ki = (ai * lr - (ar - 1.f) * li) / den;
                float* o = ssmp + (size_t)i * 34; o[0] = ar; o[1] = ai;
                for (int c = 0; c < 16; ++c) { const float br = b_re[i * 16 + c], bi = b_im[i * 16 + c]; o[2 + c] = kr * br - ki * bi; o[18 + c] = kr * bi + ki * br; } }
        }
    }
    if constexpr (SLOT == 1) {
        pg8::StaticOrder S;
        if (kind == 2) {
            pg8::Gemm g{(const bf16*)(ws + WS_S8), (const bf16*)(ws + W_ATTN_QKV), M, 3 * D, D / 2, D / 2, 0}; S.init(M, 3 * D, G, bx);
            pg8::EpiBf16 E{T1, D, nullptr, D, (size_t)(WS_T2 - WS_T1) / 2, ATTN_QSCALE, nullptr, 1.f / W8S};
            pg8::gemm_phase<pg8::EpiBf16, true>(lds, g, S, E, tid);
        } else {
            const unsigned char* W = (kind == 0) ? ws + W_POOL_IN + (size_t)jj * D * D : ws + W_SSM_IN;
            pg8::Gemm g{(const bf16*)(ws + WS_S8), (const bf16*)W, M, D, D / 2, D / 2, 0}; S.init(M, D, G, bx);
            pg8::EpiBf16 E{T1, D, nullptr, 0, 0, 1.f, nullptr, 1.f / W8S};
            pg8::gemm_phase<pg8::EpiBf16, true>(lds, g, S, E, tid);
        }
    }
    if constexpr (SLOT == 2) {
        if (kind == 0) pool_phase(T1, (u8*)T2, gw, NGW, lane);
        else if (kind == 1) ssm_phase_m(T1, (u8*)T2, (const float*)(ws + WS_SSMP), ARG_IN(16), ARG_IN(17), ARG_IN(18), lds, vcu, G, wave, lane);
        else {
            LAS float* rb = (LAS float*)lds;
            for (int i = tid; i < 16 * 257; i += NWAVES * 64) rb[i] = ARG_IN(22)[i] * LOG2E;
            __syncthreads();
            attn_phase_split(T1, T2, T3, ws + WS_X8, rb, lds + 32768, vcu, G, wave, lane);
            __syncthreads();
        }
    }
    if constexpr (SLOT == 3) {
        pg8::StaticOrder S; S.init(M, D, G, bx);
        if (kind == 0) {
            pg8::Gemm g{(const bf16*)T2, (const bf16*)(ws + W_POOL_GRP + (size_t)jj * D * 512), M, D, 256, D / 2, 2};
            pg8::EpiF8 E{(unsigned char*)T1, D, ARG_IN(8) + (size_t)jj * D, 1.f / W8S};
            pg8::gemm_phase<pg8::EpiF8, true>(lds, g, S, E, tid);
        } else if (kind == 1) {
            pg8::Gemm g{(const bf16*)T2, (const bf16*)(ws + W_SSM_GLU), M, D, D / 2, D / 2, 0};
            pg8::EpiGlu8 E{(const unsigned char*)T2, (unsigned char*)T1, D, 1.f / W8S};
            pg8::gemm_phase<pg8::EpiGlu8, true>(lds, g, S, E, tid);
        }
    }
    if constexpr (SLOT == 4) {
        const unsigned char* W = (kind == 0) ? ws + W_POOL_OUT + (size_t)jj * D * D : (kind == 1) ? ws + W_SSM_OUT : ws + W_ATTN_OUT;
        pg8::Gemm g{(kind == 2) ? (const bf16*)(ws + WS_X8) : (const bf16*)T1, (const bf16*)W, M, D, D / 2, D / 2, 0}; pg8::StaticOrder S; S.init(M, D, G, bx);
        pg8::EpiRes E{Sin, Sin, D, DN_ALPHA, (kind == 2) ? 1.f / (W8S * O8S) : 1.f / W8S};
        pg8::gemm_phase<pg8::EpiRes, true>(lds, g, S, E, tid);
    }
    if constexpr (SLOT == 5) ln_phase<true>(Sin, ARG_IN(2) + (size_t)layer * D, ARG_IN(3) + (size_t)layer * D, gw, NGW, lane, ws + WS_X8, ws + WS_S8, (float*)(ws + WS_STATS));
    if constexpr (SLOT == 6) {
        { pg8::Gemm g{(const bf16*)(ws + WS_S8), (const bf16*)(ws + W_PEER_Q + (size_t)layer * D * D), M, D, D / 2, D / 2, 0}; pg8::StaticOrder S; S.init(M, D, G, bx);
          pg8::EpiBf16 E{T1, D, nullptr, 0, 0, 1.f, nullptr, 1.f / W8S};
          pg8::gemm_phase<pg8::EpiBf16, true>(lds, g, S, E, tid); }
    }
    if constexpr (SLOT == 14) {
        __syncthreads();
        { pg8::Gemm g{PB + (size_t)layer * M * PLE, (const bf16*)(ws + W_PLE_PROJ) + (size_t)layer * PLE * D, M, D, PLE, PLE, 0}; pg8::StaticOrder S; S.init(M, D, G, bx);
          pg8::EpiF8 E{(unsigned char*)T3, D, nullptr, 8.f};
          pg8::gemm_phase<pg8::EpiF8>(lds, g, S, E, tid); }
    }
    if constexpr (SLOT == 7) {
        const bf16* sk = SKB + (size_t)layer * 2 * 128 * 128;
        for (int i = tid; i < 256 * 16; i += NWAVES * 64) { const int rowi = i >> 4, ch = i & 15; *(LAS v4u*)(lds + rowi * 272 + ch * 16) = *(const v4u*)(sk + rowi * 128 + ch * 8); }
        __syncthreads();
        peer_select_phase(T1, lds, IDX, GATE, gw, NGW, lane);
        __syncthreads();
    }
    if constexpr (SLOT == 8) peer_u_pass(ws + WS_X8, IDX, (const u8*)TU + (size_t)layer * NEXP * 1024, (float*)T2, bx, G, wave, lane);
    if constexpr (SLOT == 11) peer_act_phase((const float*)T2, IDX, GATE, (const float*)(ws + WS_SU) + layer * NEXP, (const float*)(ws + WS_SV) + layer * NEXP, gw, NGW, lane);
    if constexpr (SLOT == 12) peer_v_pass(Sin, IDX, GATE, (const u8*)TV + (size_t)layer * NEXP * 1024, (const float*)(ws + WS_STATS), ARG_IN(2) + (size_t)layer * D, ARG_IN(3) + (size_t)layer * D, bx, G, wave, lane);
    if constexpr (SLOT == 13) ln_phase(Sin, ARG_IN(4) + (size_t)layer * D, ARG_IN(5) + (size_t)layer * D, gw, NGW, lane, ws + WS_X8);
    if constexpr (SLOT == 10) {
        pg8::Gemm g{(const bf16*)(ws + WS_X8), (const bf16*)(ws + W_PLE_GATE + (size_t)layer * D * D), M, D, D / 2, D / 2, 0}; pg8::StaticOrder S; S.init(M, D, G, bx);
        pg8::EpiPle E{Sin, (const unsigned char*)T3, Sout, ws + WS_S8, (layer == DEPTH - 1) ? hout : nullptr, ARG_IN(30) + (size_t)layer * D, D, 1.f / W8S};
        pg8::gemm_phase<pg8::EpiPle, true>(lds, g, S, E, tid);
    }
}

template <int SLOT>
__global__ void __launch_bounds__(NWAVES * 64, 2) mk_slot(Args args) {
    extern __shared__ __attribute__((aligned(16))) unsigned char lds_raw[];
    store_tab(args, (LAS unsigned char*)lds_raw);
    run_slot<SLOT>((LAS unsigned char*)lds_raw, args.layer, __builtin_amdgcn_readfirstlane((int)(threadIdx.x >> 6)));
}

#if !MK_PER_PHASE
__global__ void __launch_bounds__(NWAVES * 64, 2) mk_fwd(Args args) {
    extern __shared__ __attribute__((aligned(16))) unsigned char lds_raw[];
    LAS unsigned char* lds = (LAS unsigned char*)lds_raw;
    volatile LAS unsigned* MISC = (volatile LAS unsigned*)(lds + MISC_OFF);
    for (int u = threadIdx.x; u < (LDS_BYTES - LDSCTL_OFF) / 4; u += NWAVES * 64) ((LAS unsigned*)(lds + LDSCTL_OFF))[u] = 0u;
    __syncthreads();
    store_tab(args, lds);
    const XcdBarrier bar = xcd_barrier_post((unsigned*)(args.ws + WS_CTL) + CW_BAR, MISC + 8);
    run_slot<0>(lds, 0, bar.wave); xcd_barrier(bar);
    for (int layer = 0; layer < DEPTH; ++layer) {
        run_slot<1>(lds, layer, bar.wave); xcd_barrier(bar);
        run_slot<2>(lds, layer, bar.wave); xcd_barrier(bar);
        if (layer % 3 != 2) { run_slot<3>(lds, layer, bar.wave); xcd_barrier(bar); }
        run_slot<4>(lds, layer, bar.wave); xcd_barrier(bar);
        run_slot<5>(lds, layer, bar.wave); xcd_barrier(bar);
        run_slot<6>(lds, layer, bar.wave); xcd_barrier(bar);
        run_slot<7>(lds, layer, bar.wave); xcd_barrier(bar);
        run_slot<8>(lds, layer, bar.wave); xcd_barrier(bar);
        run_slot<11>(lds, layer, bar.wave); xcd_barrier(bar);
        run_slot<12>(lds, layer, bar.wave); xcd_barrier(bar);
        run_slot<13>(lds, layer, bar.wave); run_slot<14>(lds, layer, bar.wave); xcd_barrier(bar);
        run_slot<10>(lds, layer, bar.wave); if (layer + 1 < DEPTH) xcd_barrier(bar);
    }
}
#endif

template <int SLOT> static void launch_slot(const Args& a0, int layer, int grid, hipStream_t stream) {
    static bool attr_done = false;
    if (!attr_done) { (void)hipFuncSetAttribute((const void*)mk_slot<SLOT>, hipFuncAttributeMaxDynamicSharedMemorySize, LDS_BYTES); attr_done = true; }
    Args a = a0; a.slot = SLOT; a.layer = layer;
    hipLaunchKernelGGL(mk_slot<SLOT>, dim3(grid), dim3(NWAVES * 64), LDS_BYTES, stream, a);
}

extern "C" void kernel_launch(void* const* d_in, const int* in_sizes, int n_in, void* d_out, int out_size, void* d_ws, size_t ws_size, hipStream_t stream) {
    static int grid = 0;
    if (grid == 0) {
        if (n_in != 31 || out_size != M * D || ws_size < WS_END) { fprintf(stderr, "kernel_launch: unexpected shapes (n_in %d out %d ws %zu)\n", n_in, out_size, ws_size); grid = -1; return; }
        int dev = 0, cus = 0, per_cu = 0;
        if (hipGetDevice(&dev) != hipSuccess || hipDeviceGetAttribute(&cus, hipDeviceAttributeMultiprocessorCount, dev) != hipSuccess) { grid = -1; return; }
#if !MK_PER_PHASE
        if (hipFuncSetAttribute((const void*)mk_fwd, hipFuncAttributeMaxDynamicSharedMemorySize, LDS_BYTES) != hipSuccess) { fprintf(stderr, "kernel_launch: hipFuncSetAttribute failed\n"); grid = -1; return; }
        if (hipOccupancyMaxActiveBlocksPerMultiprocessor(&per_cu, (const void*)mk_fwd, NWAVES * 64, LDS_BYTES) != hipSuccess || per_cu < 1) { fprintf(stderr, "kernel_launch: occupancy query says %d\n", per_cu); }
        (void)hipGetLastError();
#endif
        (void)per_cu;
        grid = cus;
    }
    if (grid < 0) return;
    Args a{};
    for (int i = 0; i < 31; ++i) a.in[i] = (const float*)d_in[i];
    a.out = (float*)d_out; a.ws = (unsigned char*)d_ws;
#if MK_PER_PHASE
    launch_slot<0>(a, 0, grid, stream);
    for (int layer = 0; layer < DEPTH; ++layer) {
        launch_slot<1>(a, layer, grid, stream); launch_slot<2>(a, layer, grid, stream);
        if (layer % 3 != 2) launch_slot<3>(a, layer, grid, stream);
        launch_slot<4>(a, layer, grid, stream); launch_slot<5>(a, layer, grid, stream); launch_slot<6>(a, layer, grid, stream); launch_slot<7>(a, layer, grid, stream);
        launch_slot<8>(a, layer, grid, stream); launch_slot<11>(a, layer, grid, stream); launch_slot<12>(a, layer, grid, stream); launch_slot<13>(a, layer, grid, stream); launch_slot<14>(a, layer, grid, stream); launch_slot<10>(a, layer, grid, stream);
    }
#else
    if (hipMemsetAsync((char*)d_ws + WS_CTL, 0, CTL_ZERO_BYTES, stream) != hipSuccess) return;
    hipLaunchKernelGGL(mk_fwd, dim3(grid), dim3(NWAVES * 64), LDS_BYTES, stream, a);
#endif
}
```

```cpp
#include <hip/hip_runtime.h>
#include <cstdio>
#include <cstdint>

#ifndef MK_PER_PHASE
#define MK_PER_PHASE 0
#endif

namespace pg8 {
#define PG8_LAS __attribute__((address_space(3)))
typedef unsigned short bf16_t;
typedef short bf16x8 __attribute__((ext_vector_type(8)));
typedef float f32x4 __attribute__((ext_vector_type(4)));
typedef unsigned u32x4 __attribute__((ext_vector_type(4)));
constexpr int BM = 256, BK = 64, HALF = 128, HTB = HALF * BK * 2, STAGE_BYTES = 8 * HTB, NXCD = 8, WGM = 8;

__host__ __device__ __forceinline__ int lds_byte(int r, int c) { const int st = (r >> 4) * 2 + (c >> 5), rr = r & 15, cc = c & 31, ob = rr * 64 + cc * 2; return st * 1024 + (ob ^ (((ob >> 9) & 1) << 5)); }
__host__ __device__ __forceinline__ int lds_byte8(int r, int c) { const int st = (r >> 4) * 2 + (c >> 5), rr = r & 15, cc = c & 31, ob = rr * 64 + cc * 2; return st * 1024 + (ob ^ (((ob >> 9) & 1) << 5) ^ (((ob >> 8) & 1) << 4)); }
__host__ __device__ __forceinline__ void stage_rc8(int b, int& R, int& C) { const int st = b / 1024, sb = b % 1024, swz = sb ^ (((sb >> 9) & 1) << 5) ^ (((sb >> 8) & 1) << 4); R = (st >> 1) * 16 + swz / 64; C = (st & 1) * 32 + (swz % 64) / 2; }
__host__ __device__ __forceinline__ void stage_rc(int b, int& R, int& C) { const int st = b / 1024, sb = b % 1024, swz = sb ^ (((sb >> 9) & 1) << 5); R = (st >> 1) * 16 + swz / 64; C = (st & 1) * 32 + (swz % 64) / 2; }
__host__ __device__ __forceinline__ int perm32(int rho) { const int n = rho >> 4, i = rho & 15; return 8 * (i >> 2) + 4 * n + (i & 3); }
__host__ __device__ __forceinline__ int perm32f8(int rho) { return 16 * ((rho >> 2) & 1) + (rho & 3) + 4 * (rho >> 3); }

__device__ __forceinline__ int lane_now() { int l; asm volatile("v_mbcnt_lo_u32_b32 %0, -1, 0\n\tv_mbcnt_hi_u32_b32 %0, -1, %0" : "=v"(l)); return l; }
struct Unit { int pm, pn; };
struct Gemm { const bf16_t* A; const bf16_t* Bt; int M, N, K, lda, agrp; };

struct StaticOrder {
    int nM, nN, nwg, G, c;
    __host__ __device__ void init(int M, int N, int G_, int c_) { nM = M / BM; nN = N / BM; nwg = nM * nN; G = G_; c = c_; }
    __host__ __device__ bool next(int i, Unit& u) const {
        const long L = (long)i * G + c; if (L >= nwg) return false;
        int wgid = (int)L; { const int q = nwg / NXCD, r = nwg % NXCD, xcd = wgid % NXCD, off = wgid / NXCD; wgid = (xcd < r ? xcd * (q + 1) : r * (q + 1) + (xcd - r) * q) + off; }
        const int nig = WGM * nN, gid = wgid / nig, fm = gid * WGM, gsz = (nM - fm) < WGM ? (nM - fm) : WGM;
        u.pm = fm + ((wgid % nig) % gsz); u.pn = (wgid % nig) / gsz; return true;
    }
};

__device__ __forceinline__ unsigned cvt_pk_bf16(float lo, float hi) { unsigned r; asm volatile("v_cvt_pk_bf16_f32 %0, %1, %2" : "=v"(r) : "v"(lo), "v"(hi)); return r; }
__device__ __forceinline__ float bf_lo(unsigned w) { return __builtin_bit_cast(float, w << 16); }
__device__ __forceinline__ float bf_hi(unsigned w) { return __builtin_bit_cast(float, w & 0xffff0000u); }
__device__ __forceinline__ float sigmoid_f(float x) { return __builtin_amdgcn_rcpf(1.f + __builtin_amdgcn_exp2f(-1.4426950408889634f * x)); }
#ifdef DBG_PLE_HALF
__device__ __forceinline__ float sigmoid_p(float x) { return 0.5f; }
#else
__device__ __forceinline__ float sigmoid_p(float x) { return sigmoid_f(x); }
#endif

typedef int v8i_t __attribute__((ext_vector_type(8)));
typedef unsigned u32x2 __attribute__((ext_vector_type(2)));
typedef float f32x16 __attribute__((ext_vector_type(16)));
typedef float f32x2_ __attribute__((ext_vector_type(2)));
__device__ __forceinline__ u32x2 pack8_fp8(const f32x4 v0, const f32x4 v1) {
    int a = 0, b = 0;
    a = __builtin_amdgcn_cvt_pk_fp8_f32(v0[0], v0[1], a, false); a = __builtin_amdgcn_cvt_pk_fp8_f32(v0[2], v0[3], a, true);
    b = __builtin_amdgcn_cvt_pk_fp8_f32(v1[0], v1[1], b, false); b = __builtin_amdgcn_cvt_pk_fp8_f32(v1[2], v1[3], b, true);
    return (u32x2){(unsigned)a, (unsigned)b};
}
__device__ __forceinline__ u32x4 pack8_bf16(const f32x4 v0, const f32x4 v1) { u32x4 w; w.x = cvt_pk_bf16(v0[0], v0[1]); w.y = cvt_pk_bf16(v0[2], v0[3]); w.z = cvt_pk_bf16(v1[0], v1[1]); w.w = cvt_pk_bf16(v1[2], v1[3]); return w; }
struct EpiBf16 {
    bf16_t* O; int ldc; const float* cscale; int split_cols; size_t split_stride; float scale0; bf16_t* VT; float oscale;
    __device__ __forceinline__ void chunk(int row, int col, f32x4 v0, f32x4 v1) const {
        if (cscale) { v0 = v0 * *(const f32x4*)(cscale + col); v1 = v1 * *(const f32x4*)(cscale + col + 4); }
        if (!split_cols) { *(u32x4*)(O + (size_t)row * ldc + col) = pack8_bf16(v0 * oscale, v1 * oscale); return; }
        const int t = col / split_cols, c = col - t * split_cols, hd = c >> 7, d = c & 127, b = row >> 13, sq = row & 8191;
        const float sc = (t == 0) ? oscale * scale0 : oscale;
        const u32x4 w = pack8_bf16(v0 * sc, v1 * sc);
        bf16_t* base = O + (size_t)t * split_stride;
        const size_t bh = (size_t)(b * 16 + hd) * 256 + (sq >> 5);
        if (t < 2) *(u32x4*)(base + ((bh * 8 + (d >> 4)) * 512) + (size_t)((sq & 31) + 32 * ((d >> 3) & 1)) * 8) = w;
        else { const int kk = sq & 31, k16 = kk & 15; bf16_t* p = base + ((((bh * 4 + (d >> 5)) * 2 + (kk >> 4)) * 512) + (size_t)((d & 31) + 32 * ((k16 >> 2) & 1)) * 8) + (k16 & 3) + 4 * (k16 >> 3);
            p[0] = (bf16_t)(w.x & 0xffffu); p[8] = (bf16_t)(w.x >> 16); p[16] = (bf16_t)(w.y & 0xffffu); p[24] = (bf16_t)(w.y >> 16);
            p[32] = (bf16_t)(w.z & 0xffffu); p[40] = (bf16_t)(w.z >> 16); p[48] = (bf16_t)(w.w & 0xffffu); p[56] = (bf16_t)(w.w >> 16); }
    }
};
struct EpiF8 {
    unsigned char* O; int ldc; const float* cscale; float oscale;
    __device__ __forceinline__ void chunk(int row, int col, f32x4 v0, f32x4 v1) const {
        if (cscale) { v0 = v0 * *(const f32x4*)(cscale + col); v1 = v1 * *(const f32x4*)(cscale + col + 4); }
        *(u32x2*)(O + (size_t)row * ldc + col) = pack8_fp8(v0 * oscale, v1 * oscale);
    }
};
#define PG8_GAS __attribute__((address_space(1)))
struct EpiGlu8 {
    const unsigned char* Gin; unsigned char* O; int ld; float oscale;
    typedef u32x2 Pre;
    __device__ __forceinline__ Pre pre(int row, int col) const { return *(const PG8_GAS u32x2*)(Gin + (size_t)row * ld + col); }
    __device__ __forceinline__ void fin(int row, int col, f32x4 a0, f32x4 a1, const Pre g) const {
        const size_t ro = (size_t)row * ld + col; a0 = a0 * oscale; a1 = a1 * oscale;
        const unsigned gx = g.x, gy = g.y;
        const f32x2_ g01 = __builtin_amdgcn_cvt_pk_f32_fp8((int)gx, false), g23 = __builtin_amdgcn_cvt_pk_f32_fp8((int)gx, true), g45 = __builtin_amdgcn_cvt_pk_f32_fp8((int)gy, false), g67 = __builtin_amdgcn_cvt_pk_f32_fp8((int)gy, true);
        const f32x4 o0 = {g01.x * sigmoid_f(a0[0]), g01.y * sigmoid_f(a0[1]), g23.x * sigmoid_f(a0[2]), g23.y * sigmoid_f(a0[3])};
        const f32x4 o1 = {g45.x * sigmoid_f(a1[0]), g45.y * sigmoid_f(a1[1]), g67.x * sigmoid_f(a1[2]), g67.y * sigmoid_f(a1[3])};
        *(PG8_GAS u32x2*)(O + ro) = pack8_fp8(o0, o1);
    }
};
struct EpiRes {
    const bf16_t* hres; bf16_t* out; int ld; float alpha; float mscale;
    typedef u32x4 Pre;
    __device__ __forceinline__ Pre pre(int row, int col) const { return *(const PG8_GAS u32x4*)(hres + (size_t)row * ld + col); }
    __device__ __forceinline__ void fin(int row, int col, f32x4 a0, f32x4 a1, const Pre h) const {
        const size_t ro = (size_t)row * ld + col; a0 = a0 * mscale; a1 = a1 * mscale;
        const f32x4 o0 = {bf_lo(h.x) * alpha + a0[0], bf_hi(h.x) * alpha + a0[1], bf_lo(h.y) * alpha + a0[2], bf_hi(h.y) * alpha + a0[3]};
        const f32x4 o1 = {bf_lo(h.z) * alpha + a1[0], bf_hi(h.z) * alpha + a1[1], bf_lo(h.w) * alpha + a1[2], bf_hi(h.w) * alpha + a1[3]};
        *(PG8_GAS u32x4*)(out + ro) = pack8_bf16(o0, o1);
    }
};
struct EpiPle {
    const bf16_t* hin; const unsigned char* proj; bf16_t* hob; unsigned char* ho8; float* fout; const float* bias; int ld; float oscale;
    struct Pre { u32x2 pj8; u32x4 hh; f32x4 b0, b1; };
    __device__ __forceinline__ Pre pre(int row, int col) const { const size_t ro = (size_t)row * ld + col; Pre p; p.pj8 = *(const PG8_GAS u32x2*)(proj + ro); p.hh = *(const PG8_GAS u32x4*)(hin + ro);
        p.b0 = *(const PG8_GAS f32x4*)(bias + col); p.b1 = *(const PG8_GAS f32x4*)(bias + col + 4); return p; }
    __device__ __forceinline__ void fin(int row, int col, f32x4 a0, f32x4 a1, const Pre& p) const {
        const size_t ro = (size_t)row * ld + col; const u32x2 pj8 = p.pj8; const u32x4 hh = p.hh;
        const unsigned pjx = pj8.x, pjy = pj8.y;
        const f32x2_ q01 = __builtin_amdgcn_cvt_pk_f32_fp8((int)pjx, false), q23 = __builtin_amdgcn_cvt_pk_f32_fp8((int)pjx, true), q45 = __builtin_amdgcn_cvt_pk_f32_fp8((int)pjy, false), q67 = __builtin_amdgcn_cvt_pk_f32_fp8((int)pjy, true);
        const float pjs = 1.f / 8.f;
        const float p0 = q01.x * pjs, p1 = q01.y * pjs, p2 = q23.x * pjs, p3 = q23.y * pjs, p4 = q45.x * pjs, p5 = q45.y * pjs, p6 = q67.x * pjs, p7 = q67.y * pjs;
        a0 = a0 * oscale + p.b0; a1 = a1 * oscale + p.b1;
        f32x4 h0, h1;
        h0[0] = bf_lo(hh.x) + sigmoid_p(a0[0]) * p0; h0[1] = bf_hi(hh.x) + sigmoid_p(a0[1]) * p1; h0[2] = bf_lo(hh.y) + sigmoid_p(a0[2]) * p2; h0[3] = bf_hi(hh.y) + sigmoid_p(a0[3]) * p3;
        h1[0] = bf_lo(hh.z) + sigmoid_p(a1[0]) * p4; h1[1] = bf_hi(hh.z) + sigmoid_p(a1[1]) * p5; h1[2] = bf_lo(hh.w) + sigmoid_p(a1[2]) * p6; h1[3] = bf_hi(hh.w) + sigmoid_p(a1[3]) * p7;
        if (fout != nullptr) { *(PG8_GAS f32x4*)(fout + ro) = h0; *(PG8_GAS f32x4*)(fout + ro + 4) = h1; }
        else { *(PG8_GAS u32x4*)(hob + ro) = pack8_bf16(h0, h1); *(PG8_GAS u32x2*)(ho8 + ro) = pack8_fp8(h0, h1); }
    }
};

template <class E, class = void> struct HasPre { static constexpr bool value = false; };
template <class E> struct HasPre<E, decltype((void)sizeof(typename E::Pre))> { static constexpr bool value = true; };
template <class Epi, bool F8 = false>
__device__ __forceinline__ void gemm_phase(PG8_LAS unsigned char* lds, const Gemm g, const StaticOrder& S, const Epi& E, const int tid) {
    const int wid = __builtin_amdgcn_readfirstlane(tid >> 6), lane = tid & 63, wr = wid >> 2, wc = wid & 3, fr = lane & 15, fq = lane >> 4;
    const int K = g.K, nt = K / BK, lda = g.lda;
    unsigned voffA[2], voffB[2];
#pragma unroll
    for (int i = 0; i < 2; ++i) { int R, C; if (F8) stage_rc8(tid * 16 + i * 8192, R, C); else stage_rc(tid * 16 + i * 8192, R, C); const int Rb = (R & ~31) + (F8 ? perm32f8(R & 31) : perm32(R & 31));
        voffA[i] = (unsigned)(R * lda + C) * 2u; voffB[i] = (unsigned)(Rb * K + C) * 2u; }
    const size_t kstep = (size_t)(BK * 2);
    const size_t hstepA = (size_t)HALF * lda * 2, hstepB = (size_t)HALF * K * 2;
    const size_t tstepA = 2 * hstepA, tstepB = 2 * hstepB;
    const unsigned ldsw = (unsigned)wid * 1024u;
    const int l31 = lane & 31, h32 = lane >> 5;
    const int aoff = F8 ? lds_byte8(wr * 64 + l31, 16 * h32) : lds_byte(wr * 64 + fr, fq * 8);
    const int boff = F8 ? lds_byte8(wc * 32 + l31, 16 * h32) : lds_byte(wc * 32 + fr, fq * 8);
    const int aoffx = aoff ^ 16, boffx = boff ^ 16;
#define PG8_SA(b, h) (((b) * 2 + (h)) * HTB)
#define PG8_SB(b, h) ((4 + (b) * 2 + (h)) * HTB)
#define PG8_STAGE(bufoff, gbase, voff) do { _Pragma("unroll") for (int _i = 0; _i < 2; ++_i) \
        __builtin_amdgcn_global_load_lds((const unsigned*)((const char*)(gbase) + (voff)[_i]), (PG8_LAS unsigned*)(lds + (bufoff) + ldsw + _i * 8192), 16, 0, 0); } while (0)
#define PG8_LD32(dst, off, offx) do { typedef int _v4i __attribute__((ext_vector_type(4))); const _v4i _lo = *(const PG8_LAS _v4i*)(lds + (off)), _hi = *(const PG8_LAS _v4i*)(lds + (offx)); \
        dst = __builtin_shufflevector(_lo, _hi, 0, 1, 2, 3, 4, 5, 6, 7); } while (0)
#define PG8_LDA(dst, b, h) do { if constexpr (F8) { _Pragma("unroll") for (int m2 = 0; m2 < 2; ++m2) _Pragma("unroll") for (int ks = 0; ks < 2; ++ks) PG8_LD32(dst##8[m2][ks], PG8_SA(b, h) + aoff + m2 * 4096 + ks * 1024, PG8_SA(b, h) + aoffx + m2 * 4096 + ks * 1024); } \
        else { _Pragma("unroll") for (int m = 0; m < 4; ++m) _Pragma("unroll") for (int k = 0; k < 2; ++k) dst[m][k] = *(const PG8_LAS bf16x8*)(lds + PG8_SA(b, h) + aoff + m * 2048 + k * 1024); } } while (0)
#define PG8_LDB(dst, b, h) do { if constexpr (F8) { _Pragma("unroll") for (int ks = 0; ks < 2; ++ks) PG8_LD32(dst##8[ks], PG8_SB(b, h) + boff + ks * 1024, PG8_SB(b, h) + boffx + ks * 1024); } \
        else { _Pragma("unroll") for (int n = 0; n < 2; ++n) _Pragma("unroll") for (int k = 0; k < 2; ++k) dst[n][k] = *(const PG8_LAS bf16x8*)(lds + PG8_SB(b, h) + boff + n * 2048 + k * 1024); } } while (0)
#define PG8_MMA(ai, bj, At, Bt) do { __builtin_amdgcn_s_setprio(1); \
        if constexpr (F8) { _Pragma("unroll") for (int m2 = 0; m2 < 2; ++m2) _Pragma("unroll") for (int ks = 0; ks < 2; ++ks) \
            acc32[ai][bj][m2] = __builtin_amdgcn_mfma_scale_f32_32x32x64_f8f6f4(Bt##8[ks], At##8[m2][ks], acc32[ai][bj][m2], 0, 0, 0, 0, 0, 0); } \
        else { _Pragma("unroll") for (int m = 0; m < 4; ++m) _Pragma("unroll") for (int n = 0; n < 2; ++n) _Pragma("unroll") for (int k = 0; k < 2; ++k) \
            acc[ai][bj][m][n] = __builtin_amdgcn_mfma_f32_16x16x32_bf16(Bt[n][k], At[m][k], acc[ai][bj][m][n], 0, 0, 0); } \
        __builtin_amdgcn_s_setprio(0); } while (0)
#define PG8_WAIT_V(n) asm volatile("s_waitcnt vmcnt(" #n ")" ::: "memory")
#define PG8_WAIT_L(n) asm volatile("s_waitcnt lgkmcnt(" #n ")" ::: "memory")
#define PG8_BAR __builtin_amdgcn_s_barrier()
#define PG8_SCHED __builtin_amdgcn_sched_barrier(0)
#define PG8_ACOL(u) ((g.agrp > 0) ? (size_t)((u).pn / g.agrp) * (size_t)K * 2 : (size_t)0)
    Unit cur, nxt; int ui = 0;
    if (!S.next(0, cur)) return;
    f32x4 acc[2][2][4][2];
#pragma unroll
    for (int a = 0; a < 2; ++a)
#pragma unroll
        for (int b = 0; b < 2; ++b)
#pragma unroll
            for (int m = 0; m < 4; ++m)
#pragma unroll
                for (int n = 0; n < 2; ++n) acc[a][b][m][n] = (f32x4){0.f, 0.f, 0.f, 0.f};
    bf16x8 At[4][2], B0[2][2], B1[2][2];
    v8i_t At8[2][2], B08[2], B18[2];
    f32x16 acc32[2][2][2];
#pragma unroll
    for (int a = 0; a < 2; ++a)
#pragma unroll
        for (int b = 0; b < 2; ++b)
#pragma unroll
            for (int m2 = 0; m2 < 2; ++m2)
#pragma unroll
                for (int i = 0; i < 16; ++i) acc32[a][b][m2][i] = 0.f;
    const char* cA = (const char*)g.A + (size_t)cur.pm * tstepA + PG8_ACOL(cur); const char* cB = (const char*)g.Bt + (size_t)cur.pn * tstepB;
    PG8_STAGE(PG8_SB(0, 0), cB, voffB); PG8_STAGE(PG8_SB(0, 1), cB + hstepB, voffB); PG8_STAGE(PG8_SA(0, 0), cA, voffA); PG8_STAGE(PG8_SA(0, 1), cA + hstepA, voffA);
    if (wr == 1) PG8_BAR;
    PG8_WAIT_V(2); PG8_BAR;
    PG8_STAGE(PG8_SB(1, 0), cB + kstep, voffB); PG8_STAGE(PG8_SA(1, 0), cA + kstep, voffA); PG8_STAGE(PG8_SB(1, 1), cB + hstepB + kstep, voffB);
    PG8_WAIT_V(6); PG8_BAR;
    for (;;) {
        const bool has_next = S.next(ui + 1, nxt);
        const char* nA = has_next ? (const char*)g.A + (size_t)nxt.pm * tstepA + PG8_ACOL(nxt) : cA; const char* nB = has_next ? (const char*)g.Bt + (size_t)nxt.pn * tstepB : cB;
        for (int t = 0; t < nt; t += 2) {
            const bool last = (t == nt - 2);
            const char* a1 = cA + (size_t)(t + 1) * kstep;
            const char* a2 = last ? nA : cA + (size_t)(t + 2) * kstep; const char* b2 = last ? nB : cB + (size_t)(t + 2) * kstep;
            const char* a3 = a2 + kstep; const char* b3 = b2 + kstep;
            PG8_LDB(B0, 0, 0); PG8_LDB(B1, 0, 1); PG8_SCHED; PG8_LDA(At, 0, 0); PG8_STAGE(PG8_SA(1, 1), a1 + hstepA, voffA);
            PG8_WAIT_V(8); PG8_WAIT_L(0); PG8_BAR; PG8_MMA(0, 0, At, B0); PG8_MMA(0, 1, At, B1); PG8_BAR; PG8_SCHED;
            PG8_LDA(At, 0, 1); PG8_STAGE(PG8_SB(0, 0), b2, voffB); PG8_STAGE(PG8_SB(0, 1), b2 + hstepB, voffB); PG8_STAGE(PG8_SA(0, 0), a2, voffA);
            PG8_WAIT_V(8); PG8_WAIT_L(0); PG8_BAR; PG8_MMA(1, 0, At, B0); PG8_MMA(1, 1, At, B1); PG8_BAR; PG8_SCHED;
            PG8_LDB(B0, 1, 0); PG8_LDB(B1, 1, 1); PG8_SCHED; PG8_LDA(At, 1, 0); PG8_STAGE(PG8_SA(0, 1), a2 + hstepA, voffA);
            PG8_WAIT_V(8); PG8_WAIT_L(0); PG8_BAR; PG8_MMA(0, 0, At, B0); PG8_MMA(0, 1, At, B1); PG8_BAR; PG8_SCHED;
            PG8_LDA(At, 1, 1); PG8_STAGE(PG8_SB(1, 0), b3, voffB); PG8_STAGE(PG8_SB(1, 1), b3 + hstepB, voffB); PG8_STAGE(PG8_SA(1, 0), a3, voffA);
            PG8_WAIT_V(8); PG8_WAIT_L(0); PG8_BAR; PG8_MMA(1, 0, At, B0); PG8_MMA(1, 1, At, B1); PG8_BAR; PG8_SCHED;
        }
        if (wr == 0) PG8_BAR;
        if constexpr (F8) {
            const int lnE = lane_now(); const int rowF = cur.pm * BM + wr * 64 + (lnE & 31), colF = cur.pn * BM + wc * 32 + 16 * (lnE >> 5);
            if constexpr (HasPre<Epi>::value) {
#pragma unroll
                for (int a = 0; a < 2; ++a)
#pragma unroll
                    for (int m2 = 0; m2 < 2; ++m2) { const int rowG = rowF + a * HALF + 32 * m2;
                        typename Epi::Pre pq[4];
#pragma unroll
                        for (int b = 0; b < 2; ++b) { pq[2 * b] = E.pre(rowG, colF + b * HALF); pq[2 * b + 1] = E.pre(rowG, colF + b * HALF + 8); }
                        __builtin_amdgcn_sched_barrier(0);
#pragma unroll
                        for (int b = 0; b < 2; ++b) { const f32x16 v = acc32[a][b][m2];
                            E.fin(rowG, colF + b * HALF, (f32x4){v[0], v[1], v[2], v[3]}, (f32x4){v[4], v[5], v[6], v[7]}, pq[2 * b]);
                            E.fin(rowG, colF + b * HALF + 8, (f32x4){v[8], v[9], v[10], v[11]}, (f32x4){v[12], v[13], v[14], v[15]}, pq[2 * b + 1]);
#pragma unroll
                            for (int i = 0; i < 16; ++i) acc32[a][b][m2][i] = 0.f; }
                        __builtin_amdgcn_sched_barrier(0); }
            } else {
#pragma unroll
            for (int a = 0; a < 2; ++a)
#pragma unroll
                for (int m2 = 0; m2 < 2; ++m2)
#pragma unroll
                    for (int b = 0; b < 2; ++b) { const f32x16 v = acc32[a][b][m2];
                        E.chunk(rowF + a * HALF + 32 * m2, colF + b * HALF, (f32x4){v[0], v[1], v[2], v[3]}, (f32x4){v[4], v[5], v[6], v[7]});
                        E.chunk(rowF + a * HALF + 32 * m2, colF + b * HALF + 8, (f32x4){v[8], v[9], v[10], v[11]}, (f32x4){v[12], v[13], v[14], v[15]});
#pragma unroll
                        for (int i = 0; i < 16; ++i) acc32[a][b][m2][i] = 0.f; }
            }
        } else {
            const int lnE = lane_now(); const int row0 = cur.pm * BM + wr * 64 + (lnE & 15), col0 = cur.pn * BM + wc * 32 + 8 * (lnE >> 4);
#pragma unroll
            for (int a = 0; a < 2; ++a)
#pragma unroll
                for (int m = 0; m < 4; ++m)
#pragma unroll
                    for (int b = 0; b < 2; ++b) E.chunk(row0 + a * HALF + m * 16, col0 + b * HALF, acc[a][b][m][0], acc[a][b][m][1]);
        }
        if (!has_next) break;
#pragma unroll
        for (int a = 0; a < 2; ++a)
#pragma unroll
            for (int b = 0; b < 2; ++b)
#pragma unroll
                for (int m = 0; m < 4; ++m)
#pragma unroll
                    for (int n = 0; n < 2; ++n) acc[a][b][m][n] = (f32x4){0.f, 0.f, 0.f, 0.f};
        cur = nxt; cA = nA; cB = nB; ++ui;
        if (wr == 1) PG8_BAR;
    }
    PG8_WAIT_V(0);
    PG8_BAR;
#undef PG8_SA
#undef PG8_SB
#undef PG8_STAGE
#undef PG8_LDA
#undef PG8_LD32
#undef PG8_LDB
#undef PG8_MMA
#undef PG8_WAIT_V
#undef PG8_WAIT_L
#undef PG8_BAR
#undef PG8_SCHED
#undef PG8_ACOL
}
}

constexpr int NWAVES = 8;
constexpr int D = 2048, BATCH = 4, SEQ = 8192, DEPTH = 4, M = BATCH * SEQ;
constexpr int NEXP = 16384, PLE = 256;
constexpr float LN_EPS = 1e-5f;
constexpr float DN_ALPHA = 1.681792830507429f;
constexpr float LOG2E = 1.4426950408889634f;
constexpr float ATTN_QSCALE = 0.08838834764831845f * LOG2E;
constexpr float W8S = 64.f, O8S = 16.f;

constexpr size_t MiB = 1u << 20;
constexpr size_t WS_CTL = 0, CTL_ZERO_BYTES = 1 * MiB;
constexpr size_t WS_STATS = WS_CTL + 512 * 1024;
constexpr size_t WS_W = 1 * MiB;
constexpr size_t W_POOL_IN = WS_W, W_POOL_GRP = W_POOL_IN + 16 * MiB, W_POOL_OUT = W_POOL_GRP + 4 * MiB;
constexpr size_t W_SSM_IN = W_POOL_OUT + 16 * MiB, W_SSM_GLU = W_SSM_IN + 8 * MiB, W_SSM_OUT = W_SSM_GLU + 8 * MiB;
constexpr size_t W_ATTN_QKV = W_SSM_OUT + 8 * MiB, W_ATTN_OUT = W_ATTN_QKV + 24 * MiB;
constexpr size_t W_PEER_Q = W_ATTN_OUT + 8 * MiB, W_PLE_GATE = W_PEER_Q + 32 * MiB, W_PLE_PROJ = W_PLE_GATE + 32 * MiB;
constexpr size_t WS_SK = W_PLE_PROJ + 4 * MiB;
constexpr size_t WS_TU = WS_SK + 1 * MiB;
constexpr size_t WS_TV = WS_TU + 256 * MiB;
constexpr size_t WS_PB = WS_TV + 256 * MiB;
constexpr size_t WS_HB0 = WS_PB + 64 * MiB, WS_HB1 = WS_HB0 + 128 * MiB;
constexpr size_t WS_T1 = WS_HB1 + 128 * MiB, WS_T2 = WS_T1 + 128 * MiB, WS_T3 = WS_T2 + 128 * MiB;
constexpr size_t WS_IDX = WS_T3 + 128 * MiB, WS_GATE = WS_IDX + 16 * MiB;
constexpr size_t WS_SSMP = WS_GATE + 16 * MiB;
constexpr size_t WS_SU = WS_SSMP + 2 * MiB, WS_SV = WS_SU + 1 * MiB;
constexpr size_t WS_S8 = WS_SV + 1 * MiB;
constexpr size_t WS_X8 = WS_S8 + 64 * MiB;
constexpr size_t WS_END = WS_X8 + 64 * MiB;
static_assert(WS_END <= 2048 * MiB, "d_ws map");
constexpr int CW_BAR = 4096;

constexpr int RING_BYTES = 131072;
constexpr int LDSCTL_OFF = RING_BYTES, MISC_OFF = LDSCTL_OFF + 320;
constexpr int LDS_BYTES = 147456;

#define LAS __attribute__((address_space(3)))
typedef unsigned short bf16;
typedef unsigned v4u __attribute__((ext_vector_type(4)));
typedef unsigned v2u __attribute__((ext_vector_type(2)));
typedef float f32x4 __attribute__((ext_vector_type(4)));
typedef float f32x16 __attribute__((ext_vector_type(16)));
typedef short bf16x8 __attribute__((ext_vector_type(8)));
typedef __bf16 bf16x2_t __attribute__((ext_vector_type(2)));
#define LDS_WAIT() asm volatile("s_waitcnt lgkmcnt(0)" ::: "memory")
#define VM_WAIT() asm volatile("s_waitcnt vmcnt(0)" ::: "memory")
__device__ __forceinline__ unsigned f2bf(float f) { unsigned u = __builtin_bit_cast(unsigned, f); return (u + 0x7fffu + ((u >> 16) & 1u)) >> 16; }
__device__ __forceinline__ unsigned pk2(float lo, float hi) { return f2bf(lo) | (f2bf(hi) << 16); }
__device__ __forceinline__ float bflo(unsigned w) { return __builtin_bit_cast(float, w << 16); }
__device__ __forceinline__ float bfhi(unsigned w) { return __builtin_bit_cast(float, w & 0xffff0000u); }
__device__ __forceinline__ float dot2bf(unsigned a, unsigned b, float c) { return __builtin_amdgcn_fdot2_f32_bf16(__builtin_bit_cast(bf16x2_t, a), __builtin_bit_cast(bf16x2_t, b), c, false); }
__device__ __forceinline__ float gelu_f(float v) {
    const float av = __builtin_fabsf(v), d = av * 0.2316418882f + 1.0f, t = __builtin_amdgcn_rcpf(d);
    float q = t * 0.5307027145f + (-0.7265760135f); q = q * t + 0.7107068705f; q = q * t + (-0.142248368f); q = q * t + 0.127414796f; q = q * t;
    const float e = __builtin_amdgcn_exp2f((v * v) * (-0.72134752044f));
    const float m = v * (q * e); return v < 0.f ? m : v - m;
}
#define WDPP(v, ctrl) __builtin_bit_cast(float, __builtin_amdgcn_update_dpp(0, __builtin_bit_cast(int, (v)), (ctrl), 0xF, 0xF, true))
#define WRL(v, l) __builtin_bit_cast(float, __builtin_amdgcn_readlane(__builtin_bit_cast(int, (v)), (l)))
__device__ __forceinline__ float wave_sum(float v) {
    v += WDPP(v, 0xB1); v += WDPP(v, 0x4E); v += WDPP(v, 0x141); v += WDPP(v, 0x140);
    return (WRL(v, 0) + WRL(v, 16)) + (WRL(v, 32) + WRL(v, 48));
}
__device__ __forceinline__ float shfl_xor_lane(float v, int m, int lane) { return __builtin_bit_cast(float, __builtin_amdgcn_ds_bpermute((lane ^ m) << 2, __builtin_bit_cast(int, v))); }
__device__ __forceinline__ int shfl_idx_lane(int v, int src) { return __builtin_amdgcn_ds_bpermute(src << 2, v); }
#define SHFL_XOR(v, m) shfl_xor_lane((v), (m), lane)

#define XB_TMO      128
#define XB_XCNT(j)  (256  + 64 * (j))
#define XB_XSUB(j)  (1280 + 64 * (j))
#define XB_XGEN(j)  (2304 + 64 * (j))
#define XB_TOP      3328
#define XB_TOPGEN   3392
#define XCD_BAR_WORDS 3456
#define XB_SPIN_CAP (1u << 23)

__device__ __forceinline__ unsigned xb_ld(unsigned* p)              { return __hip_atomic_load(p, __ATOMIC_RELAXED, __HIP_MEMORY_SCOPE_AGENT); }
__device__ __forceinline__ unsigned xb_add(unsigned* p, unsigned v) { return __hip_atomic_fetch_add(p, v, __ATOMIC_RELAXED, __HIP_MEMORY_SCOPE_AGENT); }
__device__ __forceinline__ unsigned xb_xcc_id() { return (unsigned)__builtin_amdgcn_s_getreg((3 << 11) | 20) & 0xFu; }
#define XB_SPIN(cond, bar) do { unsigned _sp = 0; while (cond) { __builtin_amdgcn_s_sleep(1); \
    if ((++_sp & 255u) == 0u) { if (xb_ld(&(bar)[XB_TMO])) break; if (_sp > XB_SPIN_CAP) { atomicAdd(&(bar)[XB_TMO], 1u); break; } } } } while (0)

struct XcdBarrier { unsigned* bar; unsigned x; volatile LAS unsigned* st; int wave; };
__device__ __forceinline__ int lane_id() { int l; asm volatile("v_mbcnt_lo_u32_b32 %0, -1, 0\n\tv_mbcnt_hi_u32_b32 %0, -1, %0" : "=v"(l)); return l; }

__device__ __forceinline__ XcdBarrier xcd_barrier_post(unsigned* bar, volatile LAS unsigned* st) {
    XcdBarrier b; b.bar = bar; b.x = xb_xcc_id(); b.st = st; b.wave = __builtin_amdgcn_readfirstlane((int)(threadIdx.x >> 6));
    if (threadIdx.x == 0) (void)xb_add(&bar[XB_XCNT(b.x)], 1u);
    return b;
}
__device__ __forceinline__ void xcd_barrier_complete(unsigned* bar, unsigned x, unsigned& nloc, unsigned& nx) {
    const unsigned G = gridDim.x * gridDim.y * gridDim.z;
    unsigned sum, cnt, mine, sp = 0u;
    for (;;) {
        sum = 0u; cnt = 0u; mine = 0u;
#pragma unroll
        for (unsigned j = 0; j < 16; ++j) { const unsigned c = xb_ld(&bar[XB_XCNT(j)]); sum += c; cnt += (c > 0u) ? 1u : 0u; mine = (j == x) ? c : mine; }
        if (sum == G) break;
        __builtin_amdgcn_s_sleep(1);
        if ((++sp & 255u) == 0u) { if (xb_ld(&bar[XB_TMO])) break; if (sp > XB_SPIN_CAP) { atomicAdd(&bar[XB_TMO], 1u); break; } }
    }
    nloc = mine > 0u ? mine : 1u; nx = cnt > 0u ? cnt : 1u;
}
__device__ __forceinline__ void xcd_barrier(const XcdBarrier& b_in) {
    asm volatile("s_waitcnt vmcnt(0)" ::: "memory");
    __syncthreads();
    if (b_in.wave == 0 && lane_id() == 0) {
        XcdBarrier b = b_in; asm volatile("" : "+s"(b.x)); asm volatile("" : "+s"(b.bar));
        unsigned* bar = b.bar;
        __builtin_amdgcn_s_waitcnt(0);
        unsigned nloc = b.st[0], nx = b.st[1];
        if (nloc == 0u) { xcd_barrier_complete(bar, b.x, nloc, nx); b.st[0] = nloc; b.st[1] = nx; }
        const unsigned old = xb_add(&bar[XB_XSUB(b.x)], 1u);
        const unsigned gen = old / nloc;
        if (old + 1u == (gen + 1u) * nloc) {
            __builtin_amdgcn_fence(__ATOMIC_RELEASE, "agent");
            asm volatile("s_waitcnt vmcnt(0)" ::: "memory");
            const unsigned og = xb_add(&bar[XB_TOP], 1u);
            const unsigned tg = og / nx;
            if (og + 1u == (tg + 1u) * nx) xb_add(&bar[XB_TOPGEN], 1u);
            else XB_SPIN(xb_ld(&bar[XB_TOPGEN]) == tg, bar);
            __builtin_amdgcn_fence(__ATOMIC_ACQUIRE, "agent");
            xb_add(&bar[XB_XGEN(b.x)], 1u);
            asm volatile("s_waitcnt vmcnt(0)" ::: "memory");
        } else {
            XB_SPIN(xb_ld(&bar[XB_XGEN(b.x)]) == gen, bar);
            __builtin_amdgcn_fence(__ATOMIC_ACQUIRE, "agent");
            asm volatile("s_waitcnt vmcnt(0)" ::: "memory");
        }
    }
    __syncthreads();
}

__device__ __forceinline__ void transpose_item(const float* W, int K, int N, bf16* WT, int row_off, LAS float* scr, int item, int lane) {
    const int nblk = N / 32, kb = item / nblk, nb = item % nblk, k0 = 64 * kb, n0 = 32 * nb;
#pragma unroll 8
    for (int i = 0; i < 32; ++i) { const int kk = 2 * i + (lane >> 5); scr[kk * 33 + (lane & 31)] = W[(size_t)(k0 + kk) * N + n0 + (lane & 31)]; }
    LDS_WAIT(); asm volatile("" ::: "memory");
    const int c = lane & 7;
#pragma unroll
    for (int j = 0; j < 4; ++j) { const int n = (lane >> 3) + 8 * j; const LAS float* s = scr + (8 * c) * 33 + n;
        v4u o; o.x = pk2(s[0 * 33], s[1 * 33]); o.y = pk2(s[2 * 33], s[3 * 33]); o.z = pk2(s[4 * 33], s[5 * 33]); o.w = pk2(s[6 * 33], s[7 * 33]);
        *(v4u*)(WT + (size_t)(row_off + n0 + n) * K + k0 + 8 * c) = o; }
    LDS_WAIT(); asm volatile("" ::: "memory");
}
__device__ __forceinline__ void transpose_item8(const float* W, int K, int N, unsigned char* WT, int row_off, LAS float* scr, int item, int lane) {
    const int nblk = N / 32, kb = item / nblk, nb = item % nblk, k0 = 64 * kb, n0 = 32 * nb;
#pragma unroll 8
    for (int i = 0; i < 32; ++i) { const int kk = 2 * i + (lane >> 5); scr[kk * 33 + (lane & 31)] = W[(size_t)(k0 + kk) * N + n0 + (lane & 31)]; }
    LDS_WAIT(); asm volatile("" ::: "memory");
    const int c = lane & 7;
#pragma unroll
    for (int j = 0; j < 4; ++j) { const int n = (lane >> 3) + 8 * j; const LAS float* sp = scr + (8 * c) * 33 + n;
        int a = 0, b = 0;
        a = __builtin_amdgcn_cvt_pk_fp8_f32(sp[0 * 33] * W8S, sp[1 * 33] * W8S, a, false); a = __builtin_amdgcn_cvt_pk_fp8_f32(sp[2 * 33] * W8S, sp[3 * 33] * W8S, a, true);
        b = __builtin_amdgcn_cvt_pk_fp8_f32(sp[4 * 33] * W8S, sp[5 * 33] * W8S, b, false); b = __builtin_amdgcn_cvt_pk_fp8_f32(sp[6 * 33] * W8S, sp[7 * 33] * W8S, b, true);
        v2u o; o.x = (unsigned)a; o.y = (unsigned)b;
        *(v2u*)(WT + (size_t)(row_off + n0 + n) * K + k0 + 8 * c) = o; }
    LDS_WAIT(); asm volatile("" ::: "memory");
}
__device__ __forceinline__ void transpose_item8b(const float* W, int K, int N, unsigned char* WT, int row_off, LAS unsigned* scr, int item, int lane) {
    const int nblk = N / 64, kb = item / nblk, nb = item % nblk, k0 = 128 * kb, n0 = 64 * nb;
    const int r4 = lane >> 4, l15 = lane & 15;
    f32x4 v[32];
#pragma unroll
    for (int i = 0; i < 32; ++i) v[i] = *(const __attribute__((address_space(1))) f32x4*)(W + (size_t)(k0 + 32 * r4 + i) * N + n0 + 4 * l15);
#pragma unroll
    for (int i4 = 0; i4 < 8; ++i4) {
        const f32x4 q0 = v[4 * i4] * W8S, q1 = v[4 * i4 + 1] * W8S, q2 = v[4 * i4 + 2] * W8S, q3 = v[4 * i4 + 3] * W8S;
        int a0 = 0, a1 = 0, a2 = 0, a3 = 0;
        a0 = __builtin_amdgcn_cvt_pk_fp8_f32(q0.x, q1.x, a0, false); a0 = __builtin_amdgcn_cvt_pk_fp8_f32(q2.x, q3.x, a0, true);
        a1 = __builtin_amdgcn_cvt_pk_fp8_f32(q0.y, q1.y, a1, false); a1 = __builtin_amdgcn_cvt_pk_fp8_f32(q2.y, q3.y, a1, true);
        a2 = __builtin_amdgcn_cvt_pk_fp8_f32(q0.z, q1.z, a2, false); a2 = __builtin_amdgcn_cvt_pk_fp8_f32(q2.z, q3.z, a2, true);
        a3 = __builtin_amdgcn_cvt_pk_fp8_f32(q0.w, q1.w, a3, false); a3 = __builtin_amdgcn_cvt_pk_fp8_f32(q2.w, q3.w, a3, true);
        LAS unsigned* rowp = scr + (8 * r4 + i4) * 64;
        rowp[(4 * l15 + 0 + r4) & 63] = (unsigned)a0; rowp[(4 * l15 + 1 + r4) & 63] = (unsigned)a1; rowp[(4 * l15 + 2 + r4) & 63] = (unsigned)a2; rowp[(4 * l15 + 3 + r4) & 63] = (unsigned)a3; }
    LDS_WAIT(); asm volatile("" ::: "memory");
    unsigned char* orow = WT + (size_t)(row_off + n0 + lane) * K + k0;
#pragma unroll
    for (int q = 0; q < 8; ++q) { v4u o;
        o.x = scr[(4 * q + 0) * 64 + ((lane + (q >> 1)) & 63)]; o.y = scr[(4 * q + 1) * 64 + ((lane + (q >> 1)) & 63)]; o.z = scr[(4 * q + 2) * 64 + ((lane + (q >> 1)) & 63)]; o.w = scr[(4 * q + 3) * 64 + ((lane + (q >> 1)) & 63)];
        *(__attribute__((address_space(1))) v4u*)(orow + 16 * q) = o; }
    LDS_WAIT(); asm volatile("" ::: "memory");
}
__device__ __forceinline__ void transpose_mat8b(const float* W, int K, int N, unsigned char* WT, int row_off, LAS unsigned* scr, int gw, int NGW, int lane, int& woff) {
    const int nit = (K / 128) * (N / 64);
    int sgw = gw - woff % NGW; if (sgw < 0) sgw += NGW;
    for (int it = sgw; it < nit; it += NGW) transpose_item8b(W, K, N, WT, row_off, scr, it, lane);
    woff += nit;
}
__device__ __forceinline__ void transpose_mat8(const float* W, int K, int N, unsigned char* WT, int row_off, LAS float* scr, int gw, int NGW, int lane) {
    const int nit = (K / 64) * (N / 32);
    for (int it = gw; it < nit; it += NGW) transpose_item8(W, K, N, WT, row_off, scr, it, lane);
}
__device__ __forceinline__ void transpose_mat(const float* W, int K, int N, bf16* WT, int row_off, LAS float* scr, int gw, int NGW, int lane) {
    const int nit = (K / 64) * (N / 32);
    for (int it = gw; it < nit; it += NGW) transpose_item(W, K, N, WT, row_off, scr, it, lane);
}
__device__ __forceinline__ void cvt_rows(const float* src, bf16* dst, size_t n, size_t gtid, size_t gthreads) {
    size_t i = gtid * 8;
    for (; i + 3 * gthreads * 8 < n; i += gthreads * 32) {
        f32x4 a[4], b[4];
#pragma unroll
        for (int u = 0; u < 4; ++u) { a[u] = *(const __attribute__((address_space(1))) f32x4*)(src + i + u * gthreads * 8); b[u] = *(const __attribute__((address_space(1))) f32x4*)(src + i + u * gthreads * 8 + 4); }
#pragma unroll
        for (int u = 0; u < 4; ++u) { v4u o; o.x = pk2(a[u].x, a[u].y); o.y = pk2(a[u].z, a[u].w); o.z = pk2(b[u].x, b[u].y); o.w = pk2(b[u].z, b[u].w);
            *(__attribute__((address_space(1))) v4u*)(dst + i + u * gthreads * 8) = o; }
    }
    for (; i < n; i += gthreads * 8) {
        const f32x4 a = *(const f32x4*)(src + i), b = *(const f32x4*)(src + i + 4);
        v4u o; o.x = pk2(a.x, a.y); o.y = pk2(a.z, a.w); o.z = pk2(b.x, b.y); o.w = pk2(b.z, b.w);
        *(v4u*)(dst + i) = o;
    }
}


#define GAS __attribute__((address_space(1)))
typedef unsigned char u8;
typedef float f32x2 __attribute__((ext_vector_type(2)));
constexpr float TU_SCALE = 64.f, TV_SCALE = 4.f;
__device__ __forceinline__ v4u gld16(const void* p) { return *(const GAS v4u*)p; }
__device__ __forceinline__ void cvt_rows_fp8(const float* src, u8* dst, size_t n, float scale, size_t gtid, size_t gthreads) {
    for (size_t i = gtid * 16; i < n; i += gthreads * 16) {
        const GAS f32x4* p = (const GAS f32x4*)(src + i);
        const f32x4 a = p[0] * scale, b = p[1] * scale, c = p[2] * scale, d = p[3] * scale;
        int w0 = 0, w1 = 0, w2 = 0, w3 = 0;
        w0 = __builtin_amdgcn_cvt_pk_fp8_f32(a.x, a.y, w0, false); w0 = __builtin_amdgcn_cvt_pk_fp8_f32(a.z, a.w, w0, true);
        w1 = __builtin_amdgcn_cvt_pk_fp8_f32(b.x, b.y, w1, false); w1 = __builtin_amdgcn_cvt_pk_fp8_f32(b.z, b.w, w1, true);
        w2 = __builtin_amdgcn_cvt_pk_fp8_f32(c.x, c.y, w2, false); w2 = __builtin_amdgcn_cvt_pk_fp8_f32(c.z, c.w, w2, true);
        w3 = __builtin_amdgcn_cvt_pk_fp8_f32(d.x, d.y, w3, false); w3 = __builtin_amdgcn_cvt_pk_fp8_f32(d.z, d.w, w3, true);
        v4u o; o.x = (unsigned)w0; o.y = (unsigned)w1; o.z = (unsigned)w2; o.w = (unsigned)w3;
        *(GAS v4u*)(dst + i) = o;
    }
}

template <bool X4 = false>
__device__ __forceinline__ void ln_phase(bf16* S, const float* g, const float* b, int gw, int NGW, int lane, unsigned char* f8 = nullptr, unsigned char* f8b = nullptr, float* stats = nullptr) {
    for (int m = gw; m < M; m += NGW) {
        bf16* row = S + (size_t)m * D + 8 * lane;
        float v[32]; float s = 0.f;
#pragma unroll
        for (int j = 0; j < 4; ++j) { const v4u w = *(const GAS v4u*)(row + 512 * j);
            v[8 * j + 0] = bflo(w.x); v[8 * j + 1] = bfhi(w.x); v[8 * j + 2] = bflo(w.y); v[8 * j + 3] = bfhi(w.y); v[8 * j + 4] = bflo(w.z); v[8 * j + 5] = bfhi(w.z); v[8 * j + 6] = bflo(w.w); v[8 * j + 7] = bfhi(w.w); }
#pragma unroll
        for (int i = 0; i < 32; ++i) s += v[i];
        const float mean = wave_sum(s) * (1.f / D); float s2 = 0.f;
#pragma unroll
        for (int i = 0; i < 32; ++i) { v[i] -= mean; s2 += v[i] * v[i]; }
        const float rstd = 1.f / sqrtf(wave_sum(s2) * (1.f / D) + LN_EPS);
        if constexpr (X4) { if (lane == 0) *(GAS f32x2*)(stats + 2 * (size_t)m) = (f32x2){mean, rstd}; }
#pragma unroll
        for (int j = 0; j < 4; ++j) { const float* gp = g + 512 * j + 8 * lane; const float* bp = b + 512 * j + 8 * lane;
            const f32x4 g0 = *(const GAS f32x4*)gp, g1 = *(const GAS f32x4*)(gp + 4), b0 = *(const GAS f32x4*)bp, b1 = *(const GAS f32x4*)(bp + 4);
            v4u w; w.x = pk2(v[8 * j + 0] * rstd * g0.x + b0.x, v[8 * j + 1] * rstd * g0.y + b0.y); w.y = pk2(v[8 * j + 2] * rstd * g0.z + b0.z, v[8 * j + 3] * rstd * g0.w + b0.w);
            w.z = pk2(v[8 * j + 4] * rstd * g1.x + b1.x, v[8 * j + 5] * rstd * g1.y + b1.y); w.w = pk2(v[8 * j + 6] * rstd * g1.z + b1.z, v[8 * j + 7] * rstd * g1.w + b1.w);
            if constexpr (!X4) *(GAS v4u*)(row + 512 * j) = w;
            if constexpr (X4) {
                const float y0 = v[8 * j + 0] * rstd * g0.x + b0.x, y1 = v[8 * j + 1] * rstd * g0.y + b0.y, y2 = v[8 * j + 2] * rstd * g0.z + b0.z, y3 = v[8 * j + 3] * rstd * g0.w + b0.w;
                const float y4 = v[8 * j + 4] * rstd * g1.x + b1.x, y5 = v[8 * j + 5] * rstd * g1.y + b1.y, y6 = v[8 * j + 6] * rstd * g1.z + b1.z, y7 = v[8 * j + 7] * rstd * g1.w + b1.w;
                unsigned wh = 0u; wh = __builtin_amdgcn_cvt_scalef32_pk_fp4_f32(wh, y0, y1, 1.0f, 0); wh = __builtin_amdgcn_cvt_scalef32_pk_fp4_f32(wh, y2, y3, 1.0f, 1);
                wh = __builtin_amdgcn_cvt_scalef32_pk_fp4_f32(wh, y4, y5, 1.0f, 2); wh = __builtin_amdgcn_cvt_scalef32_pk_fp4_f32(wh, y6, y7, 1.0f, 3);
                const f32x2 h01 = __builtin_amdgcn_cvt_scalef32_pk_f32_fp4(wh, 1.0f, 0), h23 = __builtin_amdgcn_cvt_scalef32_pk_f32_fp4(wh, 1.0f, 1), h45 = __builtin_amdgcn_cvt_scalef32_pk_f32_fp4(wh, 1.0f, 2), h67 = __builtin_amdgcn_cvt_scalef32_pk_f32_fp4(wh, 1.0f, 3);
                unsigned wl = 0u; wl = __builtin_amdgcn_cvt_scalef32_pk_fp4_f32(wl, (y0 - h01.x) * 8.f, (y1 - h01.y) * 8.f, 1.0f, 0); wl = __builtin_amdgcn_cvt_scalef32_pk_fp4_f32(wl, (y2 - h23.x) * 8.f, (y3 - h23.y) * 8.f, 1.0f, 1);
                wl = __builtin_amdgcn_cvt_scalef32_pk_fp4_f32(wl, (y4 - h45.x) * 8.f, (y5 - h45.y) * 8.f, 1.0f, 2); wl = __builtin_amdgcn_cvt_scalef32_pk_fp4_f32(wl, (y6 - h67.x) * 8.f, (y7 - h67.y) * 8.f, 1.0f, 3);
                unsigned char* xq = f8 + (size_t)m * 2048 + 256 * j + 4 * lane;
                *(GAS unsigned*)xq = wh; *(GAS unsigned*)(xq + 1024) = wl;
                int a8 = 0, b8 = 0;
                a8 = __builtin_amdgcn_cvt_pk_fp8_f32(y0, y1, a8, false); a8 = __builtin_amdgcn_cvt_pk_fp8_f32(y2, y3, a8, true);
                b8 = __builtin_amdgcn_cvt_pk_fp8_f32(y4, y5, b8, false); b8 = __builtin_amdgcn_cvt_pk_fp8_f32(y6, y7, b8, true);
                v2u o8; o8.x = (unsigned)a8; o8.y = (unsigned)b8; *(GAS v2u*)(f8b + (size_t)m * D + 512 * j + 8 * lane) = o8; }
            else if (f8 != nullptr) { int a8 = 0, b8 = 0;
                a8 = __builtin_amdgcn_cvt_pk_fp8_f32(v[8 * j + 0] * rstd * g0.x + b0.x, v[8 * j + 1] * rstd * g0.y + b0.y, a8, false); a8 = __builtin_amdgcn_cvt_pk_fp8_f32(v[8 * j + 2] * rstd * g0.z + b0.z, v[8 * j + 3] * rstd * g0.w + b0.w, a8, true);
                b8 = __builtin_amdgcn_cvt_pk_fp8_f32(v[8 * j + 4] * rstd * g1.x + b1.x, v[8 * j + 5] * rstd * g1.y + b1.y, b8, false); b8 = __builtin_amdgcn_cvt_pk_fp8_f32(v[8 * j + 6] * rstd * g1.z + b1.z, v[8 * j + 7] * rstd * g1.w + b1.w, b8, true);
                v2u o8; o8.x = (unsigned)a8; o8.y = (unsigned)b8; *(GAS v2u*)(f8 + (size_t)m * D + 512 * j + 8 * lane) = o8; } }
    }
}

__device__ __forceinline__ void pool_phase(const bf16* U, unsigned char* P, int gw, int NGW, int lane) {
    for (int it = gw; it < (M / 64) * 4; it += NGW) {
        const int g = it & 3, t0 = (it >> 2) * 64, w = 2 << g, col = g * 512 + 8 * lane;
        const int s0 = t0 & (SEQ - 1);
        float a[8];
#pragma unroll
        for (int i = 0; i < 8; ++i) a[i] = 0.f;
        const bf16* base = U + (size_t)t0 * D + col;
        const int nb = (s0 < w - 1) ? s0 : (w - 1);
        for (int r = 1; r <= nb; ++r) { const v4u x = *(const GAS v4u*)(base - (size_t)r * D);
            a[0] += bflo(x.x); a[1] += bfhi(x.x); a[2] += bflo(x.y); a[3] += bfhi(x.y); a[4] += bflo(x.z); a[5] += bfhi(x.z); a[6] += bflo(x.w); a[7] += bfhi(x.w); }
#pragma unroll 4
        for (int t = 0; t < 64; ++t) {
            const int s = s0 + t;
            const v4u cur = *(const GAS v4u*)(base + (size_t)t * D);
            a[0] += bflo(cur.x); a[1] += bfhi(cur.x); a[2] += bflo(cur.y); a[3] += bfhi(cur.y); a[4] += bflo(cur.z); a[5] += bfhi(cur.z); a[6] += bflo(cur.w); a[7] += bfhi(cur.w);
            const int n = (s + 1 < w) ? (s + 1) : w;
            const float inv = 1.f / (float)n;
            int w0 = 0, w1 = 0;
            w0 = __builtin_amdgcn_cvt_pk_fp8_f32(a[0] * inv - bflo(cur.x), a[1] * inv - bfhi(cur.x), w0, false); w0 = __builtin_amdgcn_cvt_pk_fp8_f32(a[2] * inv - bflo(cur.y), a[3] * inv - bfhi(cur.y), w0, true);
            w1 = __builtin_amdgcn_cvt_pk_fp8_f32(a[4] * inv - bflo(cur.z), a[5] * inv - bfhi(cur.z), w1, false); w1 = __builtin_amdgcn_cvt_pk_fp8_f32(a[6] * inv - bflo(cur.w), a[7] * inv - bfhi(cur.w), w1, true);
            v2u o; o.x = (unsigned)w0; o.y = (unsigned)w1;
            *(GAS v2u*)(P + (size_t)(t0 + t) * D + col) = o;
            if (s + 1 >= w) { const v4u x = *(const GAS v4u*)(base + (size_t)(t + 1 - w) * D);
                a[0] -= bflo(x.x); a[1] -= bfhi(x.x); a[2] -= bflo(x.y); a[3] -= bfhi(x.y); a[4] -= bflo(x.z); a[5] -= bfhi(x.z); a[6] -= bflo(x.w); a[7] -= bfhi(x.w); }
        }
    }
}

typedef __bf16 bf16x2v __attribute__((ext_vector_type(2)));
__device__ __forceinline__ unsigned cvtpk(float lo, float hi) { const f32x2 v = {lo, hi}; return __builtin_bit_cast(unsigned, __builtin_convertvector(v, bf16x2v)); }
constexpr int SSM_L = 1664, SSM_L3 = SEQ - 3 * SSM_L;
static_assert(SSM_L % 64 == 0 && SSM_L3 % 64 == 0 && SSM_L3 > 0, "segments");
template <bool WR>
__device__ __forceinline__ void ssm_block16m(const bf16x8 ua, const bf16x8 (&BbR)[4], const bf16x8 (&BbI)[4], LAS unsigned char* bubuf, LAS unsigned char* hbuf, const f32x2 ar2, const f32x2 ai2, f32x2& h2, int p, int lane) {
    f32x4 dr[4], di[4];
    const f32x4 z = {0.f, 0.f, 0.f, 0.f};
    __builtin_amdgcn_sched_barrier(0);
    asm volatile("s_nop 15\n\ts_nop 15\n\ts_nop 15\n\ts_nop 15" ::: "memory");
    __builtin_amdgcn_sched_barrier(0);
#pragma unroll
    for (int pt = 0; pt < 4; ++pt) { dr[pt] = __builtin_amdgcn_mfma_f32_16x16x32_bf16(ua, BbR[pt], z, 0, 0, 0); di[pt] = __builtin_amdgcn_mfma_f32_16x16x32_bf16(ua, BbI[pt], z, 0, 0, 0); }
    __builtin_amdgcn_sched_barrier(0);
    asm volatile("s_nop 15\n\ts_nop 15\n\ts_nop 15\n\ts_nop 15\n\ts_nop 15\n\ts_nop 15\n\ts_nop 15\n\ts_nop 15" ::: "memory");
    __builtin_amdgcn_sched_barrier(0);
#pragma unroll
    for (int pt = 0; pt < 4; ++pt)
#pragma unroll
        for (int r = 0; r < 4; ++r) *(LAS f32x2*)(bubuf + (4 * (lane >> 4) + r) * 528 + (16 * pt + (lane & 15)) * 8) = (f32x2){dr[pt][r], di[pt][r]};
    LDS_WAIT();
#pragma unroll
    for (int l = 0; l < 16; ++l) {
        const f32x2 bu = *(const LAS f32x2*)(bubuf + l * 528 + p * 8);
        float tx, ty, nx, ny; const float hx = h2.x, hy = h2.y, bux = bu.x, buy = bu.y, arx = ar2.x, aix = ai2.x, aiy = ai2.y;
        asm("v_fma_f32 %0, %1, %2, %3" : "=v"(tx) : "v"(arx), "v"(hx), "v"(bux));
        asm("v_fma_f32 %0, %1, %2, %3" : "=v"(ty) : "v"(arx), "v"(hy), "v"(buy));
        asm("v_fma_f32 %0, %1, %2, %3" : "=v"(nx) : "v"(aix), "v"(hy), "v"(tx));
        asm("v_fma_f32 %0, %1, %2, %3" : "=v"(ny) : "v"(aiy), "v"(hx), "v"(ty));
        h2 = (f32x2){nx, ny};
        if (WR) *(LAS unsigned*)(hbuf + l * 272 + 4 * p) = cvtpk(h2.x, h2.y);
    }
}
__device__ __forceinline__ void ssm_phase_m(const bf16* U, unsigned char* Y, const float* ssmp,
                                          const float* c_re, const float* c_im, const float* d_skip, LAS unsigned char* lds, int vcu, int G, int wave, int lane) {
    LAS unsigned char* hbuf = lds + wave * 16384;
    LAS unsigned char* ebuf = lds + wave * 16384 + 4352;
    LAS unsigned char* bubuf = lds + wave * 16384 + 4864;
    const int ntask = BATCH * 128 * 4;
    for (int tb = vcu * NWAVES; tb < ntask; tb += G * NWAVES) {
        const int task = tb + wave, seg = (wave + 3 * (wave >> 2)) & 3, g = (task >> 2) & 127, b = task >> 9, p = lane;
        const float* pp_ = ssmp + (size_t)(g * 64 + p) * 34;
        const float ar = pp_[0], ai = pp_[1];
        const int cc = lane & 15, kg = lane >> 4;
        bf16x8 BbR[4], BbI[4];
#pragma unroll
        for (int pt = 0; pt < 4; ++pt) { const float* q_ = ssmp + (size_t)(g * 64 + 16 * pt + cc) * 34 + 8 * (kg & 1);
            v4u tr, ti; tr.x = cvtpk(q_[2], q_[3]); tr.y = cvtpk(q_[4], q_[5]); tr.z = cvtpk(q_[6], q_[7]); tr.w = cvtpk(q_[8], q_[9]);
            ti.x = cvtpk(q_[18], q_[19]); ti.y = cvtpk(q_[20], q_[21]); ti.z = cvtpk(q_[22], q_[23]); ti.w = cvtpk(q_[24], q_[25]);
            if (kg >= 2) { tr = (v4u){0u, 0u, 0u, 0u}; ti = (v4u){0u, 0u, 0u, 0u}; }
            BbR[pt] = __builtin_bit_cast(bf16x8, tr); BbI[pt] = __builtin_bit_cast(bf16x8, ti); }
        const int tstart = seg * SSM_L, tlen = (seg == 3) ? SSM_L3 : SSM_L;
        const bf16* ub = U + ((size_t)b * SEQ + tstart) * D + g * 16;
        const bf16* ua_p = ub + (size_t)(lane & 15) * D + 8 * (kg & 1);
        unsigned char* yb = Y + ((size_t)b * SEQ + tstart) * D + g * 16;
        const f32x2 ar2 = {ar, ar}, ai2 = {-ai, ai};
        f32x2 h2 = {0.f, 0.f};
        const v4u zero4 = {0u, 0u, 0u, 0u};
        if (seg < 3) {
            v4u pre[4];
#pragma unroll
            for (int i = 0; i < 4; ++i) pre[i] = *(const GAS v4u*)(ua_p + (size_t)(16 * i) * D);
            for (int t0 = 0; t0 < SSM_L; t0 += 64) {
                v4u cur[4];
#pragma unroll
                for (int i = 0; i < 4; ++i) cur[i] = (kg < 2) ? pre[i] : zero4;
                if (t0 + 64 < SSM_L) {
#pragma unroll
                    for (int i = 0; i < 4; ++i) pre[i] = *(const GAS v4u*)(ua_p + (size_t)(t0 + 64 + 16 * i) * D); }
#pragma unroll
                for (int blk = 0; blk < 4; ++blk) { ssm_block16m<false>(__builtin_bit_cast(bf16x8, cur[blk]), BbR, BbI, bubuf, hbuf, ar2, ai2, h2, p, lane); LDS_WAIT(); }
            }
            *(LAS f32x2*)(ebuf + 8 * p) = h2;
        }
        LDS_WAIT();
        __syncthreads();
        {
            f32x2 pw = {1.f, 0.f}, base = {ar, ai};
#pragma unroll 1
            for (int bit = SSM_L; bit > 0; bit >>= 1) {
                if (bit & 1) pw = (f32x2){pw.x * base.x - pw.y * base.y, pw.x * base.y + pw.y * base.x};
                base = (f32x2){base.x * base.x - base.y * base.y, 2.f * base.x * base.y};
            }
            LAS unsigned char* e0 = lds + (wave & 4) * 16384 + 4352;
            f32x2 sst = {0.f, 0.f};
            for (int j = 0; j < seg; ++j) { const f32x2 e = *(const LAS f32x2*)(e0 + ((j + (wave >> 2)) & 3) * 16384 + 8 * p);
                sst = (f32x2){pw.x * sst.x - pw.y * sst.y + e.x, pw.x * sst.y + pw.y * sst.x + e.y}; }
            h2 = sst;
        }
        bf16x8 cB[4];
#pragma unroll
        for (int ks = 0; ks < 4; ++ks) { unsigned w[4];
#pragma unroll
            for (int jj = 0; jj < 4; ++jj) { const int k = 32 * ks + 8 * (lane >> 4) + 2 * jj, pp = k >> 1;
                w[jj] = cvtpk(c_re[(g * 16 + cc) * 64 + pp], -c_im[(g * 16 + cc) * 64 + pp]); }
            v4u t; t.x = w[0]; t.y = w[1]; t.z = w[2]; t.w = w[3]; cB[ks] = __builtin_bit_cast(bf16x8, t); }
        const float dd = d_skip[g * 16 + cc];
        {
            v4u pre[4];
#pragma unroll
            for (int i = 0; i < 4; ++i) pre[i] = *(const GAS v4u*)(ua_p + (size_t)(16 * i) * D);
            for (int t0 = 0; t0 < tlen; t0 += 64) {
                v4u cur[4];
#pragma unroll
                for (int i = 0; i < 4; ++i) cur[i] = (kg < 2) ? pre[i] : zero4;
                if (t0 + 64 < tlen) {
#pragma unroll
                    for (int i = 0; i < 4; ++i) pre[i] = *(const GAS v4u*)(ua_p + (size_t)(t0 + 64 + 16 * i) * D); }
#pragma unroll
                for (int blk = 0; blk < 4; ++blk) {
                    unsigned short uq[4];
#pragma unroll
                    for (int r = 0; r < 4; ++r) uq[r] = *(const GAS unsigned short*)(ub + (size_t)(t0 + 16 * blk + 4 * (lane >> 4) + r) * D + cc);
                    ssm_block16m<true>(__builtin_bit_cast(bf16x8, cur[blk]), BbR, BbI, bubuf, hbuf, ar2, ai2, h2, p, lane);
                    LDS_WAIT();
                    f32x4 acc = (f32x4){0.f, 0.f, 0.f, 0.f};
#pragma unroll
                    for (int ks = 0; ks < 4; ++ks) { const bf16x8 a = *(const LAS bf16x8*)(hbuf + (lane & 15) * 272 + 16 * (lane >> 4) + 64 * ks);
                        acc = __builtin_amdgcn_mfma_f32_16x16x32_bf16(a, cB[ks], acc, 0, 0, 0); }
#pragma unroll
                    for (int r = 0; r < 4; ++r) { const int l = 4 * (lane >> 4) + r;
                        const float uu = __builtin_bit_cast(float, (unsigned)uq[r] << 16);
                        const float y = acc[r] + dd * uu;
                        *(GAS unsigned char*)(yb + (size_t)(t0 + 16 * blk + l) * D + cc) = (unsigned char)(__builtin_amdgcn_cvt_pk_fp8_f32(gelu_f(y), 0.f, 0, false) & 0xff); }
                    LDS_WAIT();
                }
            }
        }
        __syncthreads();
    }
}

__device__ __forceinline__ void attn_tile(const bf16* Kbh, const bf16* Vbh, const LAS float* rbh, int kp0, bool has_next, int qpos, int hl, int lane,
                                          const bf16x8 (&kc)[8], bf16x8 (&kn)[8], const bf16x8 (&qf)[8], f32x16 (&o)[4], float& mrun, float& lrun) {
    bf16x8 vf[8];
    { const bf16* vp = Vbh + (size_t)(kp0 >> 5) * 4096 + (size_t)lane * 8;
#pragma unroll
      for (int q = 0; q < 8; ++q) vf[q] = *(const GAS bf16x8*)(vp + 512 * q); }
    if (has_next) { const bf16* kp = Kbh + (size_t)((kp0 >> 5) + 1) * 4096 + (size_t)lane * 8;
#pragma unroll
      for (int ks = 0; ks < 8; ++ks) kn[ks] = *(const GAS bf16x8*)(kp + 512 * ks); }
    __builtin_amdgcn_sched_barrier(0);
    f32x16 s;
#pragma unroll
    for (int i = 0; i < 16; ++i) s[i] = 0.f;
#pragma unroll
    for (int ks = 0; ks < 8; ++ks) s = __builtin_amdgcn_mfma_f32_32x32x16_bf16(kc[ks], qf[ks], s, 0, 0, 0);
    float tmax = -1e30f;
#pragma unroll
    for (int i = 0; i < 16; ++i) { const int kpos = kp0 + (i & 3) + 8 * (i >> 2) + 4 * hl; int rel = qpos - kpos; rel = rel > 128 ? 128 : rel; s[i] += rbh[rel + 128]; tmax = fmaxf(tmax, s[i]); }
    tmax = fmaxf(tmax, SHFL_XOR(tmax, 32));
    const float mnew = fmaxf(mrun, tmax), alpha = __builtin_amdgcn_exp2f(mrun - mnew);
    float rs = 0.f;
#pragma unroll
    for (int i = 0; i < 16; ++i) { s[i] = __builtin_amdgcn_exp2f(s[i] - mnew); rs += s[i]; }
    rs += SHFL_XOR(rs, 32);
    lrun = lrun * alpha + rs; mrun = mnew;
    bf16x8 pf[2];
#pragma unroll
    for (int sidx = 0; sidx < 2; ++sidx) { v4u t; t.x = cvtpk(s[8 * sidx + 0], s[8 * sidx + 1]); t.y = cvtpk(s[8 * sidx + 2], s[8 * sidx + 3]);
        t.z = cvtpk(s[8 * sidx + 4], s[8 * sidx + 5]); t.w = cvtpk(s[8 * sidx + 6], s[8 * sidx + 7]); pf[sidx] = __builtin_bit_cast(bf16x8, t); }
#pragma unroll
    for (int dt = 0; dt < 4; ++dt) {
#pragma unroll
        for (int i = 0; i < 16; ++i) o[dt][i] *= alpha;
#pragma unroll
        for (int sidx = 0; sidx < 2; ++sidx) o[dt] = __builtin_amdgcn_mfma_f32_32x32x16_bf16(vf[2 * dt + sidx], pf[sidx], o[dt], 0, 0, 0);
    }
}
__device__ __forceinline__ void attn_phase(const bf16* QO, const bf16* Kb, const bf16* VT, unsigned char* O8, const LAS float* rb, int gw, int NGW, int lane) {
    const int r32 = lane & 31, hl = lane >> 5;
    for (int task = gw; task < BATCH * 16 * 128 * 2; task += NGW) {
        const int half = task & 1, c = (task >> 1) & 127, h = (task >> 8) & 15, b = task >> 12;
        const int qpos = 64 * c + 32 * half + r32;
        const size_t qrow = (size_t)b * SEQ + qpos;
        bf16x8 qf[8];
        const size_t bh256 = (size_t)(b * 16 + h) * 256;
        { const bf16* qt = QO + ((bh256 + 2 * c + half) * 8) * 512 + (size_t)lane * 8;
#pragma unroll
          for (int ks = 0; ks < 8; ++ks) qf[ks] = *(const GAS bf16x8*)(qt + ks * 512); }
        f32x16 o[4];
#pragma unroll
        for (int dt = 0; dt < 4; ++dt)
#pragma unroll
            for (int i = 0; i < 16; ++i) o[dt][i] = 0.f;
        float mrun = -1e30f, lrun = 0.f;
        const LAS float* rbh = rb + h * 257;
        const bf16* Kbh = Kb + bh256 * 4096; const bf16* Vbh = VT + bh256 * 4096;
        int kt0 = 16 - 2 * c; if (kt0 < 0) kt0 = 0;
        bf16x8 kA[8], kB[8];
        { const bf16* kp = Kbh + (size_t)((64 * c - 512 + 32 * kt0) >> 5) * 4096 + (size_t)lane * 8;
#pragma unroll
          for (int ks = 0; ks < 8; ++ks) kA[ks] = *(const GAS bf16x8*)(kp + 512 * ks); }
        for (int kt = kt0; kt < 18; kt += 2) {
            const int kp0 = 64 * c - 512 + 32 * kt;
            attn_tile(Kbh, Vbh, rbh, kp0, true, qpos, hl, lane, kA, kB, qf, o, mrun, lrun);
            attn_tile(Kbh, Vbh, rbh, kp0 + 32, kt + 2 < 18, qpos, hl, lane, kB, kA, qf, o, mrun, lrun);
        }
        const float inv = O8S / lrun;
        unsigned char* op = O8 + qrow * D + h * 128 + 4 * hl;
#pragma unroll
        for (int dt = 0; dt < 4; ++dt)
#pragma unroll
            for (int rq = 0; rq < 4; ++rq) { int w = 0; w = __builtin_amdgcn_cvt_pk_fp8_f32(o[dt][4 * rq + 0] * inv, o[dt][4 * rq + 1] * inv, w, false); w = __builtin_amdgcn_cvt_pk_fp8_f32(o[dt][4 * rq + 2] * inv, o[dt][4 * rq + 3] * inv, w, true);
                *(int*)(op + 32 * dt + 8 * rq) = w; }
    }
}

__device__ __forceinline__ void attn_a_qk(f32x16& s, const bf16x8 (&kc)[8], const bf16x8 (&qh)[8]) {
#pragma unroll
    for (int i = 0; i < 16; ++i) s[i] = 0.f;
#pragma unroll
    for (int ks = 0; ks < 8; ++ks) s = __builtin_amdgcn_mfma_f32_32x32x16_bf16(kc[ks], qh[ks], s, 0, 0, 0);
}
__device__ __forceinline__ void attn_a_half(f32x16& s, const LAS float* rbh, int kp0, int qbase, int r32, int hl, int lane, float& mrun, float& lrun, LAS unsigned char* pw, LAS float* aw) {
    const int qpos = qbase + r32; float tmax = -1e30f;
    if (qbase - (kp0 + 31) >= 128) { const float cb = rbh[256];
#pragma unroll
        for (int i = 0; i < 16; ++i) { s[i] += cb; tmax = fmaxf(tmax, s[i]); } }
    else {
#pragma unroll
        for (int i = 0; i < 16; ++i) { const int kpos = kp0 + (i & 3) + 8 * (i >> 2) + 4 * hl; int rel = qpos - kpos; rel = rel > 128 ? 128 : rel; s[i] += rbh[rel + 128]; tmax = fmaxf(tmax, s[i]); } }
    tmax = fmaxf(tmax, SHFL_XOR(tmax, 32));
    const float mnew = fmaxf(mrun, tmax), alpha = __builtin_amdgcn_exp2f(mrun - mnew);
    float rs = 0.f;
#pragma unroll
    for (int i = 0; i < 16; ++i) { s[i] = __builtin_amdgcn_exp2f(s[i] - mnew); rs += s[i]; }
    rs += SHFL_XOR(rs, 32);
    lrun = lrun * alpha + rs; mrun = mnew;
    v4u t0, t1; t0.x = cvtpk(s[0], s[1]); t0.y = cvtpk(s[2], s[3]); t0.z = cvtpk(s[4], s[5]); t0.w = cvtpk(s[6], s[7]);
    t1.x = cvtpk(s[8], s[9]); t1.y = cvtpk(s[10], s[11]); t1.z = cvtpk(s[12], s[13]); t1.w = cvtpk(s[14], s[15]);
    *(LAS v4u*)pw = t0; *(LAS v4u*)(pw + 16) = t1; *aw = alpha;
}
__device__ __forceinline__ void attn_b_half(const bf16x8 (&vc)[8], f32x16 (&oh)[4], const LAS unsigned char* pr, const LAS float* ar) {
    const v4u p0 = *(const LAS v4u*)pr, p1 = *(const LAS v4u*)(pr + 16); const float al = *ar;
    const bf16x8 pf0 = __builtin_bit_cast(bf16x8, p0), pf1 = __builtin_bit_cast(bf16x8, p1);
#pragma unroll
    for (int dt = 0; dt < 4; ++dt) {
#pragma unroll
        for (int i = 0; i < 16; ++i) oh[dt][i] *= al;
        oh[dt] = __builtin_amdgcn_mfma_f32_32x32x16_bf16(vc[2 * dt], pf0, oh[dt], 0, 0, 0); oh[dt] = __builtin_amdgcn_mfma_f32_32x32x16_bf16(vc[2 * dt + 1], pf1, oh[dt], 0, 0, 0); }
}
__device__ __forceinline__ void attn_ld8(bf16x8 (&d)[8], const bf16* p) {
#pragma unroll
    for (int q = 0; q < 8; ++q) d[q] = *(const GAS bf16x8*)(p + 512 * q);
}
__device__ __forceinline__ void attn_phase_split(const bf16* QO, const bf16* Kb, const bf16* VT, unsigned char* O8, const LAS float* rb, LAS unsigned char* xch, int vcu, int G, int wave, int lane) {
    const int r32 = lane & 31, hl = lane >> 5;
    const int pr = wave & 3, role = wave >> 2;
    LAS unsigned char* xp = xch + pr * 9728;
    LAS unsigned char* pl = xp + lane * 32; LAS float* al = (LAS float*)(xp + 8192) + lane;
    for (int batch = vcu; batch < BATCH * 16 * 128 * 2 / 8; batch += G) {
        const int T0 = batch * 8, c0 = (T0 >> 1) & 127, h = (T0 >> 8) & 15, b = T0 >> 12, c = c0 + pr;
        const size_t bh256 = (size_t)(b * 16 + h) * 256;
        const bf16* Kl = Kb + bh256 * 4096 + (size_t)lane * 8; const bf16* Vl = VT + bh256 * 4096 + (size_t)lane * 8;
        const LAS float* rbh = rb + h * 257;
        int kt0 = 16 - 2 * c; if (kt0 < 0) kt0 = 0;
        const int kbase = 64 * c - 512, tb = kbase >> 5;
        if (role == 0) {
            bf16x8 q0[8], q1[8];
            attn_ld8(q0, QO + ((bh256 + 2 * c + 0) * 8) * 512 + (size_t)lane * 8); attn_ld8(q1, QO + ((bh256 + 2 * c + 1) * 8) * 512 + (size_t)lane * 8);
            float mrun0 = -1e30f, mrun1 = -1e30f, lrun0 = 0.f, lrun1 = 0.f;
            bf16x8 kc[8];
            attn_ld8(kc, Kl + (size_t)(tb + kt0) * 4096);
            for (int t = 0; t < 18; ++t) {
                if (t >= kt0) { f32x16 s0, s1;
                    attn_a_qk(s0, kc, q0); attn_a_qk(s1, kc, q1);
                    __builtin_amdgcn_sched_barrier(0);
                    if (t + 1 < 18) attn_ld8(kc, Kl + (size_t)(tb + t + 1) * 4096);
                    __builtin_amdgcn_sched_barrier(0);
                    const int so = (t & 1) * 4096, ao = (t & 1) * 128;
                    attn_a_half(s0, rbh, kbase + 32 * t, 64 * c, r32, hl, lane, mrun0, lrun0, pl + so, al + ao);
                    attn_a_half(s1, rbh, kbase + 32 * t, 64 * c + 32, r32, hl, lane, mrun1, lrun1, pl + so + 2048, al + ao + 64); }
                if (t == 17) { *(LAS float*)(xp + 9216 + lane * 4) = lrun0; *(LAS float*)(xp + 9216 + 256 + lane * 4) = lrun1; }
                LDS_WAIT(); __syncthreads();
            }
            __syncthreads();
        } else {
            f32x16 oA[4], oB[4];
#pragma unroll
            for (int dt = 0; dt < 4; ++dt)
#pragma unroll
                for (int i = 0; i < 16; ++i) { oA[dt][i] = 0.f; oB[dt][i] = 0.f; }
            bf16x8 vc[8];
            attn_ld8(vc, Vl + (size_t)(tb + kt0) * 4096);
            __syncthreads();
            for (int t = 0; t < 18; ++t) {
                if (t >= kt0) { const int so = (t & 1) * 4096, ao = (t & 1) * 128;
                    attn_b_half(vc, oA, pl + so, al + ao); attn_b_half(vc, oB, pl + so + 2048, al + ao + 64);
                    __builtin_amdgcn_sched_barrier(0);
                    if (t + 1 < 18) attn_ld8(vc, Vl + (size_t)(tb + t + 1) * 4096); }
                LDS_WAIT(); __syncthreads();
            }
            {   const float lf0 = *(const LAS float*)(xp + 9216 + lane * 4), lf1 = *(const LAS float*)(xp + 9216 + 256 + lane * 4);
                const float inv0 = O8S / lf0, inv1 = O8S / lf1;
                unsigned char* op0 = O8 + ((size_t)b * SEQ + 64 * c + r32) * D + h * 128 + 4 * hl; unsigned char* op1 = op0 + (size_t)32 * D;
#pragma unroll
                for (int dt = 0; dt < 4; ++dt)
#pragma unroll
                    for (int rq = 0; rq < 4; ++rq) { int w = 0; w = __builtin_amdgcn_cvt_pk_fp8_f32(oA[dt][4 * rq + 0] * inv0, oA[dt][4 * rq + 1] * inv0, w, false); w = __builtin_amdgcn_cvt_pk_fp8_f32(oA[dt][4 * rq + 2] * inv0, oA[dt][4 * rq + 3] * inv0, w, true);
                        *(int*)(op0 + 32 * dt + 8 * rq) = w;
                        int w2 = 0; w2 = __builtin_amdgcn_cvt_pk_fp8_f32(oB[dt][4 * rq + 0] * inv1, oB[dt][4 * rq + 1] * inv1, w2, false); w2 = __builtin_amdgcn_cvt_pk_fp8_f32(oB[dt][4 * rq + 2] * inv1, oB[dt][4 * rq + 3] * inv1, w2, true);
                        *(int*)(op1 + 32 * dt + 8 * rq) = w2; }
            }
        }
        __syncthreads();
    }
}

#define INS16(L, x) do { _Pragma("unroll") for (int _j = 15; _j >= 1; --_j) L[_j] = __builtin_amdgcn_fmed3f(L[_j - 1], L[_j], (x)); L[0] = fmaxf(L[0], (x)); } while (0)
__device__ __forceinline__ void peer_select_phase(const bf16* Q, const LAS unsigned char* skl  , int* idx_out, float* gate_out, int gw, int NGW, int lane) {
    const int r = lane & 31, half = lane >> 5;
    for (int it = gw; it < M / 4; it += NGW) {
        const int t = 4 * it + (r >> 3), hh = r & 7;
        float L[2][16];
#pragma unroll
        for (int s = 0; s < 2; ++s) {
#pragma unroll
            for (int j = 0; j < 16; ++j) L[s][j] = -3.0e38f;
            bf16x8 qf[8];
            const bf16* qp = Q + (size_t)t * D + hh * 256 + s * 128 + 8 * half;
#pragma unroll
            for (int ks = 0; ks < 8; ++ks) qf[ks] = *(const bf16x8*)(qp + 16 * ks);
#pragma unroll 1
            for (int nt = 0; nt < 4; ++nt) {
                f32x16 sc;
#pragma unroll
                for (int i = 0; i < 16; ++i) sc[i] = 0.f;
                const LAS unsigned char* kp = skl + (size_t)(s * 128 + 32 * nt + r) * 272 + 16 * half;
#pragma unroll
                for (int ks = 0; ks < 8; ++ks) { const bf16x8 kf = *(const LAS bf16x8*)(kp + 32 * ks); sc = __builtin_amdgcn_mfma_f32_32x32x16_bf16(kf, qf[ks], sc, 0, 0, 0); }
#pragma unroll
                for (int i = 0; i < 16; ++i) { const unsigned n = 32 * nt + (i & 3) + 8 * (i >> 2) + 4 * half;
                    const float sv = sc[i];
                    const float x = __builtin_bit_cast(float, (__builtin_bit_cast(unsigned, sv) & ~127u) | n);
                    INS16(L[s], x); }
            }
        }
        float mine[16], oth[16];
#pragma unroll
        for (int j = 0; j < 16; ++j) { const float o0 = SHFL_XOR(L[0][j], 32), o1 = SHFL_XOR(L[1][j], 32); mine[j] = half ? L[1][j] : L[0][j]; oth[j] = half ? o1 : o0; }
#pragma unroll
        for (int j = 0; j < 16; ++j) { const float x = oth[j]; INS16(mine, x); }
        float A[16], B[16];
#pragma unroll
        for (int j = 0; j < 16; ++j) { const float o = SHFL_XOR(mine[j], 32); A[j] = half ? o : mine[j]; B[j] = half ? mine[j] : o; }
        float T[16];
#pragma unroll
        for (int j = 0; j < 16; ++j) T[j] = -3.0e38f;
#pragma unroll
        for (int a = 0; a < 16; ++a)
#pragma unroll
            for (int bq = 0; bq < 16; ++bq) if ((a + 1) * (bq + 1) <= 16) { const float x = A[a] + B[bq]; INS16(T, x); }
        const float tau = T[15], mx = T[0];
        float den = 0.f;
#pragma unroll
        for (int j = 0; j < 16; ++j) den += __builtin_amdgcn_exp2f((T[j] - mx) * LOG2E);
        const float rden = 1.f / den;
        int cnt = 0;
        const size_t ob = (size_t)t * 128 + hh * 16;
#pragma unroll
        for (int a = 0; a < 16; ++a)
#pragma unroll
            for (int bq = 0; bq < 16; ++bq) if ((a + 1) * (bq + 1) <= 16) {
                const float x = A[a] + B[bq];
                if (x >= tau && cnt < 16) {
                    if (half == 0) idx_out[ob + cnt] = (int)(((__builtin_bit_cast(unsigned, A[a]) & 127u) << 7) | (__builtin_bit_cast(unsigned, B[bq]) & 127u));
                    else gate_out[ob + cnt] = __builtin_amdgcn_exp2f((x - mx) * LOG2E) * rden;
                    ++cnt;
                }
            }
    }
}

__device__ __forceinline__ void peer_gather_phase(float* hio, bf16* hb, const int* idx, const float* gate, const bf16* TU, const bf16* TV, const float* lg, const float* lb, int gw, int NGW, int lane) {
    for (int m = gw; m < M; m += NGW) {
        v4u xr[4];
#pragma unroll
        for (int j = 0; j < 4; ++j) xr[j] = *(const v4u*)(hb + (size_t)m * D + 512 * j + 8 * lane);
        const int i0 = idx[(size_t)m * 128 + lane], i1 = idx[(size_t)m * 128 + 64 + lane];
        float y[32];
#pragma unroll
        for (int i = 0; i < 32; ++i) y[i] = 0.f;
#ifdef DBG_NO_PEER
        for (int hb_ = 0; hb_ < 0; ++hb_) {
#else
        for (int hb_ = 0; hb_ < 8; ++hb_) {
#endif
            float part[16];
            const int isel = (hb_ < 4) ? i0 : i1;
#pragma unroll
            for (int kk = 0; kk < 16; ++kk) {
                const int e = __builtin_amdgcn_readlane(isel, ((hb_ & 3) << 4) + kk);
                const bf16* up = TU + (size_t)e * D + 8 * lane;
                float acc = 0.f;
#pragma unroll
                for (int j = 0; j < 4; ++j) { const v4u w = *(const v4u*)(up + 512 * j);
                    acc = dot2bf(w.x, xr[j].x, acc); acc = dot2bf(w.y, xr[j].y, acc); acc = dot2bf(w.z, xr[j].z, acc); acc = dot2bf(w.w, xr[j].w, acc); }
                part[kk] = acc;
            }
#pragma unroll
            for (int kk = 0; kk < 16; ++kk) { part[kk] += SHFL_XOR(part[kk], 32); part[kk] += SHFL_XOR(part[kk], 16); }
            {
                const bool b3 = (lane & 8) != 0, b2 = (lane & 4) != 0, b1 = (lane & 2) != 0, b0 = (lane & 1) != 0;
#pragma unroll
                for (int i = 0; i < 8; ++i) { const float send = b3 ? part[i] : part[i + 8], keep = b3 ? part[i + 8] : part[i]; part[i] = keep + SHFL_XOR(send, 8); }
#pragma unroll
                for (int i = 0; i < 4; ++i) { const float send = b2 ? part[i] : part[i + 4], keep = b2 ? part[i + 4] : part[i]; part[i] = keep + SHFL_XOR(send, 4); }
#pragma unroll
                for (int i = 0; i < 2; ++i) { const float send = b1 ? part[i] : part[i + 2], keep = b1 ? part[i + 2] : part[i]; part[i] = keep + SHFL_XOR(send, 2); }
                { const float send = b0 ? part[0] : part[1], keep = b0 ? part[1] : part[0]; part[0] = keep + SHFL_XOR(send, 1); }
            }
            const float gt = gate[(size_t)m * 128 + hb_ * 16 + (lane & 15)];
            const float act = gelu_f(part[0]) * gt;
            const unsigned actb = f2bf(act);
#pragma unroll
            for (int kk = 0; kk < 16; ++kk) {
                const int e = __builtin_amdgcn_readlane(isel, ((hb_ & 3) << 4) + kk);
                const unsigned ab = (unsigned)__builtin_amdgcn_readlane((int)actb, kk);
                const unsigned alo = ab, ahi = ab << 16;
                const bf16* vp = TV + (size_t)e * D + 8 * lane;
#pragma unroll
                for (int j = 0; j < 4; ++j) { const v4u w = *(const v4u*)(vp + 512 * j);
                    y[8 * j + 0] = dot2bf(w.x, alo, y[8 * j + 0]); y[8 * j + 1] = dot2bf(w.x, ahi, y[8 * j + 1]);
                    y[8 * j + 2] = dot2bf(w.y, alo, y[8 * j + 2]); y[8 * j + 3] = dot2bf(w.y, ahi, y[8 * j + 3]);
                    y[8 * j + 4] = dot2bf(w.z, alo, y[8 * j + 4]); y[8 * j + 5] = dot2bf(w.z, ahi, y[8 * j + 5]);
                    y[8 * j + 6] = dot2bf(w.w, alo, y[8 * j + 6]); y[8 * j + 7] = dot2bf(w.w, ahi, y[8 * j + 7]); }
            }
        }
        float* row = hio + (size_t)m * D + 8 * lane;
        float s = 0.f;
#pragma unroll
        for (int j = 0; j < 4; ++j) { const f32x4 a = *(const f32x4*)(row + 512 * j), b = *(const f32x4*)(row + 512 * j + 4);
            y[8 * j + 0] += DN_ALPHA * a.x; y[8 * j + 1] += DN_ALPHA * a.y; y[8 * j + 2] += DN_ALPHA * a.z; y[8 * j + 3] += DN_ALPHA * a.w;
            y[8 * j + 4] += DN_ALPHA * b.x; y[8 * j + 5] += DN_ALPHA * b.y; y[8 * j + 6] += DN_ALPHA * b.z; y[8 * j + 7] += DN_ALPHA * b.w; }
#pragma unroll
        for (int i = 0; i < 32; ++i) s += y[i];
        const float mean = wave_sum(s) * (1.f / D); float s2 = 0.f;
#pragma unroll
        for (int i = 0; i < 32; ++i) { y[i] -= mean; s2 += y[i] * y[i]; }
        const float rstd = 1.f / sqrtf(wave_sum(s2) * (1.f / D) + LN_EPS);
#pragma unroll
        for (int j = 0; j < 4; ++j) { const float* gp = lg + 512 * j + 8 * lane; const float* bp = lb + 512 * j + 8 * lane;
            const f32x4 g0 = *(const f32x4*)gp, g1 = *(const f32x4*)(gp + 4), b0 = *(const f32x4*)bp, b1 = *(const f32x4*)(bp + 4);
            f32x4 o0, o1; o0.x = y[8 * j + 0] * rstd * g0.x + b0.x; o0.y = y[8 * j + 1] * rstd * g0.y + b0.y; o0.z = y[8 * j + 2] * rstd * g0.z + b0.z; o0.w = y[8 * j + 3] * rstd * g0.w + b0.w;
            o1.x = y[8 * j + 4] * rstd * g1.x + b1.x; o1.y = y[8 * j + 5] * rstd * g1.y + b1.y; o1.z = y[8 * j + 6] * rstd * g1.z + b1.z; o1.w = y[8 * j + 7] * rstd * g1.w + b1.w;
            *(f32x4*)(row + 512 * j) = o0; *(f32x4*)(row + 512 * j + 4) = o1;
            v4u w; w.x = pk2(o0.x, o0.y); w.y = pk2(o0.z, o0.w); w.z = pk2(o1.x, o1.y); w.w = pk2(o1.z, o1.w);
            *(v4u*)(hb + (size_t)m * D + 512 * j + 8 * lane) = w; }
    }
}


__device__ __forceinline__ float udot8(const v4u (&w)[2], const f32x2 (&x2)[16]) {
    f32x2 a0 = {0.f, 0.f}, a1 = {0.f, 0.f};
#pragma unroll
    for (int j = 0; j < 2; ++j) {
        const unsigned d0 = w[j].x, d1 = w[j].y, d2 = w[j].z, d3 = w[j].w;
        a0 = __builtin_elementwise_fma(__builtin_amdgcn_cvt_pk_f32_fp8((int)d0, false), x2[8 * j + 0], a0); a1 = __builtin_elementwise_fma(__builtin_amdgcn_cvt_pk_f32_fp8((int)d0, true), x2[8 * j + 1], a1);
        a0 = __builtin_elementwise_fma(__builtin_amdgcn_cvt_pk_f32_fp8((int)d1, false), x2[8 * j + 2], a0); a1 = __builtin_elementwise_fma(__builtin_amdgcn_cvt_pk_f32_fp8((int)d1, true), x2[8 * j + 3], a1);
        a0 = __builtin_elementwise_fma(__builtin_amdgcn_cvt_pk_f32_fp8((int)d2, false), x2[8 * j + 4], a0); a1 = __builtin_elementwise_fma(__builtin_amdgcn_cvt_pk_f32_fp8((int)d2, true), x2[8 * j + 5], a1);
        a0 = __builtin_elementwise_fma(__builtin_amdgcn_cvt_pk_f32_fp8((int)d3, false), x2[8 * j + 6], a0); a1 = __builtin_elementwise_fma(__builtin_amdgcn_cvt_pk_f32_fp8((int)d3, true), x2[8 * j + 7], a1);
    }
    return (a0.x + a0.y) + (a1.x + a1.y);
}
__device__ __forceinline__ void vacc8(const v4u (&w)[2], const f32x2 a2, f32x2 (&y2)[16]) {
#pragma unroll
    for (int j = 0; j < 2; ++j) {
        const unsigned d0 = w[j].x, d1 = w[j].y, d2 = w[j].z, d3 = w[j].w;
        y2[8 * j + 0] = __builtin_elementwise_fma(__builtin_amdgcn_cvt_pk_f32_fp8((int)d0, false), a2, y2[8 * j + 0]); y2[8 * j + 1] = __builtin_elementwise_fma(__builtin_amdgcn_cvt_pk_f32_fp8((int)d0, true), a2, y2[8 * j + 1]);
        y2[8 * j + 2] = __builtin_elementwise_fma(__builtin_amdgcn_cvt_pk_f32_fp8((int)d1, false), a2, y2[8 * j + 2]); y2[8 * j + 3] = __builtin_elementwise_fma(__builtin_amdgcn_cvt_pk_f32_fp8((int)d1, true), a2, y2[8 * j + 3]);
        y2[8 * j + 4] = __builtin_elementwise_fma(__builtin_amdgcn_cvt_pk_f32_fp8((int)d2, false), a2, y2[8 * j + 4]); y2[8 * j + 5] = __builtin_elementwise_fma(__builtin_amdgcn_cvt_pk_f32_fp8((int)d2, true), a2, y2[8 * j + 5]);
        y2[8 * j + 6] = __builtin_elementwise_fma(__builtin_amdgcn_cvt_pk_f32_fp8((int)d3, false), a2, y2[8 * j + 6]); y2[8 * j + 7] = __builtin_elementwise_fma(__builtin_amdgcn_cvt_pk_f32_fp8((int)d3, true), a2, y2[8 * j + 7]);
    }
}
#define ROWLD8(dst, base, e) do { const u8* _p = (base) + (size_t)(e) * D + 16 * lane; dst[0] = gld16(_p); dst[1] = gld16(_p + 1024); } while (0)
__device__ __forceinline__ void peer_gather_fp8(float* hio, bf16* hb, float* hio_w, bf16* hb_w, const int* idx, const float* gate, const u8* TU8, const u8* TV8, const float* lg, const float* lb, int gw, int NGW, int lane_in) {
    for (int m = gw; m < M; m += NGW) {
        int lane = lane_in; asm volatile("" : "+v"(lane));
        float* row = hio + (size_t)m * D + 16 * lane;
        f32x2 x2[16];
#pragma unroll
        for (int j = 0; j < 2; ++j)
#pragma unroll
            for (int q = 0; q < 4; ++q) { const f32x4 t = *(const GAS f32x4*)(row + 1024 * j + 4 * q); x2[8 * j + 2 * q] = (f32x2){t.x, t.y}; x2[8 * j + 2 * q + 1] = (f32x2){t.z, t.w}; }
        const int i0 = *(const GAS int*)(idx + (size_t)m * 128 + lane), i1 = *(const GAS int*)(idx + (size_t)m * 128 + 64 + lane);
        f32x2 y2[16];
#pragma unroll
        for (int i = 0; i < 16; ++i) y2[i] = (f32x2){0.f, 0.f};
        v4u buf[4][2];
#pragma unroll
        for (int q = 0; q < 4; ++q) { const int e = __builtin_amdgcn_readlane(i0, q); ROWLD8(buf[q], TU8, e); }
        for (int hb_ = 0; hb_ < 8; ++hb_) {
            const int isel = (hb_ < 4) ? i0 : i1, inext = (hb_ + 1 < 4) ? i0 : i1;
            const int lb0 = (hb_ & 3) << 4, lbn = ((hb_ + 1) & 3) << 4;
            const float gt = *(const GAS float*)(gate + (size_t)m * 128 + hb_ * 16 + (lane & 15));
            float part[16];
#pragma unroll
            for (int kk = 0; kk < 16; ++kk) {
                part[kk] = udot8(buf[kk & 3], x2);
                if (kk + 4 < 16) { const int e = __builtin_amdgcn_readlane(isel, lb0 + kk + 4); ROWLD8(buf[kk & 3], TU8, e); }
                else { const int e = __builtin_amdgcn_readlane(isel, lb0 + kk + 4 - 16); ROWLD8(buf[kk & 3], TV8, e); }
                __builtin_amdgcn_sched_barrier(0);
            }
#pragma unroll
            for (int kk = 0; kk < 16; ++kk) { part[kk] += SHFL_XOR(part[kk], 32); part[kk] += SHFL_XOR(part[kk], 16); }
            {
                const bool b3 = (lane & 8) != 0, b2 = (lane & 4) != 0, b1 = (lane & 2) != 0, b0 = (lane & 1) != 0;
#pragma unroll
                for (int i = 0; i < 8; ++i) { const float send = b3 ? part[i] : part[i + 8], keep = b3 ? part[i + 8] : part[i]; part[i] = keep + SHFL_XOR(send, 8); }
#pragma unroll
                for (int i = 0; i < 4; ++i) { const float send = b2 ? part[i] : part[i + 4], keep = b2 ? part[i + 4] : part[i]; part[i] = keep + SHFL_XOR(send, 4); }
#pragma unroll
                for (int i = 0; i < 2; ++i) { const float send = b1 ? part[i] : part[i + 2], keep = b1 ? part[i + 2] : part[i]; part[i] = keep + SHFL_XOR(send, 2); }
                { const float send = b0 ? part[0] : part[1], keep = b0 ? part[1] : part[0]; part[0] = keep + SHFL_XOR(send, 1); }
            }
            const float act = gelu_f(part[0] * (1.f / TU_SCALE)) * gt * (1.f / TV_SCALE);
            const int acti = __builtin_bit_cast(int, act);
#pragma unroll
            for (int kk = 0; kk < 16; ++kk) {
                const float a = __builtin_bit_cast(float, __builtin_amdgcn_readlane(acti, kk));
                vacc8(buf[kk & 3], (f32x2){a, a}, y2);
                if (kk + 4 < 16) { const int e = __builtin_amdgcn_readlane(isel, lb0 + kk + 4); ROWLD8(buf[kk & 3], TV8, e); }
                else if (hb_ < 7) { const int e = __builtin_amdgcn_readlane(inext, lbn + kk + 4 - 16); ROWLD8(buf[kk & 3], TU8, e); }
                __builtin_amdgcn_sched_barrier(0);
            }
        }
        float s = 0.f;
#pragma unroll
        for (int i = 0; i < 16; ++i) { y2[i] = y2[i] + x2[i] * DN_ALPHA; s += y2[i].x + y2[i].y; }
        const float mean = wave_sum(s) * (1.f / D); float s2 = 0.f;
#pragma unroll
        for (int i = 0; i < 16; ++i) { y2[i] = y2[i] - mean; s2 += y2[i].x * y2[i].x + y2[i].y * y2[i].y; }
        const float rstd = 1.f / sqrtf(wave_sum(s2) * (1.f / D) + LN_EPS);
#pragma unroll
        for (int j = 0; j < 2; ++j)
#pragma unroll
            for (int q = 0; q < 4; ++q) { const int off = 1024 * j + 16 * lane + 4 * q;
                const f32x4 g4 = *(const GAS f32x4*)(lg + off), b4 = *(const GAS f32x4*)(lb + off);
                const f32x2 ya = y2[8 * j + 2 * q], yb = y2[8 * j + 2 * q + 1];
                f32x4 o; o.x = ya.x * rstd * g4.x + b4.x; o.y = ya.y * rstd * g4.y + b4.y; o.z = yb.x * rstd * g4.z + b4.z; o.w = yb.y * rstd * g4.w + b4.w;
                *(GAS f32x4*)(hio_w + (size_t)m * D + off) = o;
                v2u w; w.x = pk2(o.x, o.y); w.y = pk2(o.z, o.w); *(GAS v2u*)(hb_w + (size_t)m * D + off) = w; }
    }
}


__device__ __forceinline__ float wave_max(float v) {
    v = fmaxf(v, WDPP(v, 0xB1)); v = fmaxf(v, WDPP(v, 0x4E)); v = fmaxf(v, WDPP(v, 0x141)); v = fmaxf(v, WDPP(v, 0x140));
    return fmaxf(fmaxf(WRL(v, 0), WRL(v, 16)), fmaxf(WRL(v, 32), WRL(v, 48)));
}
__device__ __forceinline__ void cvt_rows_fp4(const float* src, u8* dst, float* scales, int nrows, int gw, int NGW, int lane) {
    for (int r0 = gw; r0 < nrows; r0 += 4 * NGW) {
        f32x4 v[4][8];
#pragma unroll
        for (int u = 0; u < 4; ++u) { const GAS f32x4* p = (const GAS f32x4*)(src + (size_t)(r0 + u * NGW) * D + 4 * lane);
#pragma unroll
            for (int q = 0; q < 8; ++q) v[u][q] = p[64 * q]; }
#pragma unroll
        for (int u = 0; u < 4; ++u) { const int r = r0 + u * NGW; float mx = 0.f;
#pragma unroll
            for (int q = 0; q < 8; ++q) mx = fmaxf(mx, fmaxf(fmaxf(__builtin_fabsf(v[u][q].x), __builtin_fabsf(v[u][q].y)), fmaxf(__builtin_fabsf(v[u][q].z), __builtin_fabsf(v[u][q].w))));
            mx = wave_max(mx);
            const float inv = mx > 0.f ? 6.f / mx : 0.f;
            const int lay = r / NEXP, e = r % NEXP;
#pragma unroll
            for (int q = 0; q < 8; ++q) { unsigned t = 0u; const f32x4 a = v[u][q] * inv;
                t = __builtin_amdgcn_cvt_scalef32_pk_fp4_f32(t, a.x, a.y, 1.0f, 0); t = __builtin_amdgcn_cvt_scalef32_pk_fp4_f32(t, a.z, a.w, 1.0f, 1);
                *(GAS unsigned short*)(dst + (((size_t)lay * 8 + q) * NEXP + e) * 128 + 2 * lane) = (unsigned short)(t & 0xffffu); }
            if (lane == 0) scales[r] = mx * (1.f / 6.f); }
    }
}
__device__ __forceinline__ float udot4(const v4u w, const f32x2 (&x2)[16]) {
    f32x2 a0 = {0.f, 0.f}, a1 = {0.f, 0.f};
    const unsigned d0 = w.x, d1 = w.y, d2 = w.z, d3 = w.w;
#define UD4(dw, k) a0 = __builtin_elementwise_fma(__builtin_amdgcn_cvt_scalef32_pk_f32_fp4(dw, 1.0f, 0), x2[4 * (k) + 0], a0); a1 = __builtin_elementwise_fma(__builtin_amdgcn_cvt_scalef32_pk_f32_fp4(dw, 1.0f, 1), x2[4 * (k) + 1], a1); \
                   a0 = __builtin_elementwise_fma(__builtin_amdgcn_cvt_scalef32_pk_f32_fp4(dw, 1.0f, 2), x2[4 * (k) + 2], a0); a1 = __builtin_elementwise_fma(__builtin_amdgcn_cvt_scalef32_pk_f32_fp4(dw, 1.0f, 3), x2[4 * (k) + 3], a1);
    UD4(d0, 0) UD4(d1, 1) UD4(d2, 2) UD4(d3, 3)
#undef UD4
    return (a0.x + a0.y) + (a1.x + a1.y);
}
__device__ __forceinline__ void vacc4(const v4u w, const f32x2 a2, f32x2 (&y2)[16]) {
    const unsigned d0 = w.x, d1 = w.y, d2 = w.z, d3 = w.w;
#define VA4(dw, k) y2[4 * (k) + 0] = __builtin_elementwise_fma(__builtin_amdgcn_cvt_scalef32_pk_f32_fp4(dw, 1.0f, 0), a2, y2[4 * (k) + 0]); y2[4 * (k) + 1] = __builtin_elementwise_fma(__builtin_amdgcn_cvt_scalef32_pk_f32_fp4(dw, 1.0f, 1), a2, y2[4 * (k) + 1]); \
                   y2[4 * (k) + 2] = __builtin_elementwise_fma(__builtin_amdgcn_cvt_scalef32_pk_f32_fp4(dw, 1.0f, 2), a2, y2[4 * (k) + 2]); y2[4 * (k) + 3] = __builtin_elementwise_fma(__builtin_amdgcn_cvt_scalef32_pk_f32_fp4(dw, 1.0f, 3), a2, y2[4 * (k) + 3]);
    VA4(d0, 0) VA4(d1, 1) VA4(d2, 2) VA4(d3, 3)
#undef VA4
}
#define ROWLD4(dst, base, e) do { dst = gld16((base) + (size_t)(e) * 1024 + 16 * lane); } while (0)
__device__ __forceinline__ void peer_gather_fp4(float* hio, bf16* hb, float* hio_w, bf16* hb_w, const int* idx, const float* gate, const u8* TU4, const u8* TV4, const float* SU, const float* SV,
                                                const float* lg, const float* lb, int gw, int NGW, int lane_in) {
    for (int m = gw; m < M; m += NGW) {
        int lane = lane_in; asm volatile("" : "+v"(lane));
        const float* row = hio + (size_t)m * D + 32 * lane;
        f32x2 x2[16];
#pragma unroll
        for (int q = 0; q < 8; ++q) { const f32x4 t = *(const GAS f32x4*)(row + 4 * q); x2[2 * q] = (f32x2){t.x, t.y}; x2[2 * q + 1] = (f32x2){t.z, t.w}; }
        const int i0 = *(const GAS int*)(idx + (size_t)m * 128 + lane), i1 = *(const GAS int*)(idx + (size_t)m * 128 + 64 + lane);
        f32x2 y2[16];
#pragma unroll
        for (int i = 0; i < 16; ++i) y2[i] = (f32x2){0.f, 0.f};
        v4u buf[8];
#pragma unroll
        for (int q = 0; q < 8; ++q) { const int e = __builtin_amdgcn_readlane(i0, q); ROWLD4(buf[q], TU4, e); }
        for (int hb_ = 0; hb_ < 8; ++hb_) {
            const int isel = (hb_ < 4) ? i0 : i1, inext = (hb_ + 1 < 4) ? i0 : i1;
            const int lb0 = (hb_ & 3) << 4, lbn = ((hb_ + 1) & 3) << 4;
            const float gt = *(const GAS float*)(gate + (size_t)m * 128 + hb_ * 16 + (lane & 15));
            const int ek = shfl_idx_lane(isel, lb0 + (lane & 15));
            const float su = *(const GAS float*)(SU + ek), sv = *(const GAS float*)(SV + ek);
            float part[16];
#pragma unroll
            for (int kk = 0; kk < 16; ++kk) {
                part[kk] = udot4(buf[kk & 7], x2);
                if (kk + 8 < 16) { const int e = __builtin_amdgcn_readlane(isel, lb0 + kk + 8); ROWLD4(buf[kk & 7], TU4, e); }
                else { const int e = __builtin_amdgcn_readlane(isel, lb0 + kk + 8 - 16); ROWLD4(buf[kk & 7], TV4, e); }
                __builtin_amdgcn_sched_barrier(0);
            }
#pragma unroll
            for (int kk = 0; kk < 16; ++kk) { part[kk] += SHFL_XOR(part[kk], 32); part[kk] += SHFL_XOR(part[kk], 16); }
            {
                const bool b3 = (lane & 8) != 0, b2 = (lane & 4) != 0, b1 = (lane & 2) != 0, b0 = (lane & 1) != 0;
#pragma unroll
                for (int i = 0; i < 8; ++i) { const float send = b3 ? part[i] : part[i + 8], keep = b3 ? part[i + 8] : part[i]; part[i] = keep + SHFL_XOR(send, 8); }
#pragma unroll
                for (int i = 0; i < 4; ++i) { const float send = b2 ? part[i] : part[i + 4], keep = b2 ? part[i + 4] : part[i]; part[i] = keep + SHFL_XOR(send, 4); }
#pragma unroll
                for (int i = 0; i < 2; ++i) { const float send = b1 ? part[i] : part[i + 2], keep = b1 ? part[i + 2] : part[i]; part[i] = keep + SHFL_XOR(send, 2); }
                { const float send = b0 ? part[0] : part[1], keep = b0 ? part[1] : part[0]; part[0] = keep + SHFL_XOR(send, 1); }
            }
            const float act = gelu_f(part[0] * su) * gt * sv;
            const int acti = __builtin_bit_cast(int, act);
#pragma unroll
            for (int kk = 0; kk < 16; ++kk) {
                const float a = __builtin_bit_cast(float, __builtin_amdgcn_readlane(acti, kk));
                vacc4(buf[kk & 7], (f32x2){a, a}, y2);
                if (kk + 8 < 16) { const int e = __builtin_amdgcn_readlane(isel, lb0 + kk + 8); ROWLD4(buf[kk & 7], TV4, e); }
                else if (hb_ < 7) { const int e = __builtin_amdgcn_readlane(inext, lbn + kk + 8 - 16); ROWLD4(buf[kk & 7], TU4, e); }
                __builtin_amdgcn_sched_barrier(0);
            }
        }
        float s = 0.f;
#pragma unroll
        for (int i = 0; i < 16; ++i) { y2[i] = y2[i] + x2[i] * DN_ALPHA; s += y2[i].x + y2[i].y; }
        const float mean = wave_sum(s) * (1.f / D); float s2 = 0.f;
#pragma unroll
        for (int i = 0; i < 16; ++i) { y2[i] = y2[i] - mean; s2 += y2[i].x * y2[i].x + y2[i].y * y2[i].y; }
        const float rstd = 1.f / sqrtf(wave_sum(s2) * (1.f / D) + LN_EPS);
#pragma unroll
        for (int q = 0; q < 8; ++q) { const int off = 32 * lane + 4 * q;
            const f32x4 g4 = *(const GAS f32x4*)(lg + off), b4 = *(const GAS f32x4*)(lb + off);
            const f32x2 ya = y2[2 * q], yb = y2[2 * q + 1];
            f32x4 o; o.x = ya.x * rstd * g4.x + b4.x; o.y = ya.y * rstd * g4.y + b4.y; o.z = yb.x * rstd * g4.z + b4.z; o.w = yb.y * rstd * g4.w + b4.w;
            *(GAS f32x4*)(hio_w + (size_t)m * D + off) = o;
            v2u w; w.x = pk2(o.x, o.y); w.y = pk2(o.z, o.w); *(GAS v2u*)(hb_w + (size_t)m * D + off) = w; }
    }
}


typedef _Float16 h16x2 __attribute__((ext_vector_type(2)));
#define CVT_H2_FP4(dw, b) __builtin_bit_cast(h16x2, __builtin_amdgcn_cvt_scalef32_pk_f16_fp4(dw, 1.0f, b))
__device__ __forceinline__ float udot4h(const v4u w, const h16x2 (&xh)[16]) {
    h16x2 a0 = {(_Float16)0.f, (_Float16)0.f}, a1 = {(_Float16)0.f, (_Float16)0.f};
    const unsigned d0 = w.x, d1 = w.y, d2 = w.z, d3 = w.w;
#define UD4H(dw, k) a0 = __builtin_elementwise_fma(CVT_H2_FP4(dw, 0), xh[4 * (k) + 0], a0); a1 = __builtin_elementwise_fma(CVT_H2_FP4(dw, 1), xh[4 * (k) + 1], a1); \
                    a0 = __builtin_elementwise_fma(CVT_H2_FP4(dw, 2), xh[4 * (k) + 2], a0); a1 = __builtin_elementwise_fma(CVT_H2_FP4(dw, 3), xh[4 * (k) + 3], a1);
    UD4H(d0, 0) UD4H(d1, 1) UD4H(d2, 2) UD4H(d3, 3)
#undef UD4H
    return ((float)a0.x + (float)a0.y) + ((float)a1.x + (float)a1.y);
}
__device__ __forceinline__ void vacc4h(const v4u w, const h16x2 a2, h16x2 (&yh)[16]) {
    const unsigned d0 = w.x, d1 = w.y, d2 = w.z, d3 = w.w;
#define VA4H(dw, k) yh[4 * (k) + 0] = __builtin_elementwise_fma(CVT_H2_FP4(dw, 0), a2, yh[4 * (k) + 0]); yh[4 * (k) + 1] = __builtin_elementwise_fma(CVT_H2_FP4(dw, 1), a2, yh[4 * (k) + 1]); \
                    yh[4 * (k) + 2] = __builtin_elementwise_fma(CVT_H2_FP4(dw, 2), a2, yh[4 * (k) + 2]); yh[4 * (k) + 3] = __builtin_elementwise_fma(CVT_H2_FP4(dw, 3), a2, yh[4 * (k) + 3]);
    VA4H(d0, 0) VA4H(d1, 1) VA4H(d2, 2) VA4H(d3, 3)
#undef VA4H
}

#define DPP_ADD(v, ctrl) ((v) + __builtin_bit_cast(float, __builtin_amdgcn_update_dpp(0, __builtin_bit_cast(int, (v)), (ctrl), 0xF, 0xF, true)))
#define LOAD_II16(dst, mm) do { const GAS v4u* _ip = (const GAS v4u*)(idx + (size_t)(mm) * 128 + 16 * eg); const v4u _a = _ip[0], _b = _ip[1], _c = _ip[2], _d = _ip[3]; \
    dst[0] = _a.x; dst[1] = _a.y; dst[2] = _a.z; dst[3] = _a.w; dst[4] = _b.x; dst[5] = _b.y; dst[6] = _b.z; dst[7] = _b.w; dst[8] = _c.x; dst[9] = _c.y; dst[10] = _c.z; dst[11] = _c.w; dst[12] = _d.x; dst[13] = _d.y; dst[14] = _d.z; dst[15] = _d.w; } while (0)
typedef int v8i_m __attribute__((ext_vector_type(8)));
#define U_QADD(keep, send, ctrl) ((keep) + __builtin_bit_cast(float, __builtin_amdgcn_update_dpp(0, __builtin_bit_cast(int, (send)), (ctrl), 0xF, 0xF, true)))
__device__ __forceinline__ void u_step(const u8* x4, const int* idx, const u8* tab, float* Ps, int m, int mn, int mnn, int eg, int aoff, int xoff, bool xval, bool b0, bool b1, int poff, int sc1, int scb,
                                       const v4u (&bufC)[16], const v4u& xC, const unsigned (&idxN)[16], v4u (&bufN)[16], v4u& xN, unsigned (&idxNN)[16]) {
#pragma unroll
    for (int t = 0; t < 16; ++t) bufN[t] = gld16(tab + (size_t)idxN[t] * 128 + aoff);
    xN = gld16(x4 + (size_t)mn * 2048 + xoff);
    LOAD_II16(idxNN, mnn);
    __builtin_amdgcn_sched_barrier(0);
    const v8i_m bx = {xval ? (int)xC.x : 0, xval ? (int)xC.y : 0, xval ? (int)xC.z : 0, xval ? (int)xC.w : 0, 0, 0, 0, 0};
    f32x4 acc[16];
#pragma unroll
    for (int t = 0; t < 16; ++t) { const v8i_m a8 = {(int)bufC[t].x, (int)bufC[t].y, (int)bufC[t].z, (int)bufC[t].w, 0, 0, 0, 0};
        acc[t] = __builtin_amdgcn_mfma_scale_f32_16x16x128_f8f6f4(a8, bx, (f32x4){0.f, 0.f, 0.f, 0.f}, 4, 4, 0, sc1, 0, scb); }
    float v[16];
#pragma unroll
    for (int t = 0; t < 16; ++t) { const float lo = b0 ? acc[t].y : acc[t].x, hi = b0 ? acc[t].w : acc[t].z; const float vv = b1 ? hi : lo; v[t] = U_QADD(vv, vv, 0x128); }
    float w[8];
#pragma unroll
    for (int i = 0; i < 8; ++i) { const float send = b0 ? v[i] : v[i + 8], keep = b0 ? v[i + 8] : v[i]; w[i] = U_QADD(keep, send, 0xB1); }
    f32x4 z;
#pragma unroll
    for (int i = 0; i < 4; ++i) { const float send = b1 ? w[i] : w[i + 4], keep = b1 ? w[i + 4] : w[i]; z[i] = U_QADD(keep, send, 0x4E); }
    if (poff >= 0) { const h16x2 zl = {(_Float16)z[0], (_Float16)z[1]}, zh = {(_Float16)z[2], (_Float16)z[3]};
        *(GAS v2u*)((_Float16*)Ps + (size_t)m * 128 + poff) = (v2u){__builtin_bit_cast(unsigned, zl), __builtin_bit_cast(unsigned, zh)}; }
    __builtin_amdgcn_sched_barrier(0);
}
__device__ __forceinline__ void peer_u_pass(const u8* x4, const int* idx, const u8* TUl, float* P, int bx, int G, int wave, int lane_in) {
    const int s = bx & 7, cu = bx >> 3, nW = (G >> 3) * NWAVES;
    const u8* tab = TUl + (size_t)s * NEXP * 128;
    float* Ps = (float*)((_Float16*)P + (size_t)s * M * 128);
    int lane = lane_in; asm volatile("" : "+v"(lane));
    const int n = lane & 15, kg = lane >> 4;
    const int eg = 2 * (n >> 2) + (kg >> 1);
    const int aoff = 16 * (4 * (kg & 1) + (n & 3));
    const int xoff = 128 * s + aoff + ((n & 8) ? 1024 : 0);
    const bool xval = (kg >> 1) == ((n >> 2) & 1);
    const bool b0 = (lane & 1) != 0, b1 = (lane & 2) != 0;
    const int poff = (n < 8) ? 16 * (2 * kg + (n >> 2)) + (b0 ? 8 : 0) + (b1 ? 4 : 0) : -1;
    const int m0 = cu * NWAVES + wave;
    int sc1 = 0x7F7F7F7F, sc8 = (n & 8) ? 0x7C7C7C7C : 0x7F7F7F7F; asm volatile("" : "+v"(sc1), "+v"(sc8));
    unsigned iiX[16], iiY[16]; v4u bufA[16], bufB[16]; v4u xA, xB;
    {   LOAD_II16(iiY, m0);
#pragma unroll
        for (int t = 0; t < 16; ++t) bufA[t] = gld16(tab + (size_t)iiY[t] * 128 + aoff);
        xA = gld16(x4 + (size_t)m0 * 2048 + xoff);
        const int m1 = (m0 + nW < M) ? m0 + nW : m0; LOAD_II16(iiX, m1); }
#define CLAMPM(x) (((x) < M) ? (x) : m0)
    for (int m = m0; m < M; m += 2 * nW) {
        u_step(x4, idx, tab, Ps, m, CLAMPM(m + nW), CLAMPM(m + 2 * nW), eg, aoff, xoff, xval, b0, b1, poff, sc1, sc8, bufA, xA, iiX, bufB, xB, iiY);
        u_step(x4, idx, tab, Ps, m + nW, CLAMPM(m + 2 * nW), CLAMPM(m + 3 * nW), eg, aoff, xoff, xval, b0, b1, poff, sc1, sc8, bufB, xB, iiY, bufA, xA, iiX);
    }
}
__device__ __forceinline__ void peer_act_phase(const float* P, const int* idx, float* gate, const float* SU, const float* SV, int gw, int NGW, int lane) {
    for (int m = gw; m < M; m += NGW) {
#pragma unroll
        for (int h = 0; h < 2; ++h) { const int k = 64 * h + lane;
            float z = 0.f;
#pragma unroll
            for (int sl = 0; sl < 8; ++sl) z += (float)*(const GAS _Float16*)((const _Float16*)P + ((size_t)sl * M + m) * 128 + k);
            const int e = *(const GAS int*)(idx + (size_t)m * 128 + k);
            const float su = *(const GAS float*)(SU + e), sv = *(const GAS float*)(SV + e), gt = *(const GAS float*)(gate + (size_t)m * 128 + k);
            *(GAS float*)(gate + (size_t)m * 128 + k) = gelu_f(z * su) * gt * sv; }
    }
}
#define LOAD_AA16(dst, mm) do { const GAS f32x4* _ap = (const GAS f32x4*)(act + (size_t)(mm) * 128 + 16 * eg); const f32x4 _a = _ap[0], _b = _ap[1], _c = _ap[2], _d = _ap[3]; \
    dst[0] = _a.x; dst[1] = _a.y; dst[2] = _a.z; dst[3] = _a.w; dst[4] = _b.x; dst[5] = _b.y; dst[6] = _b.z; dst[7] = _b.w; dst[8] = _c.x; dst[9] = _c.y; dst[10] = _c.z; dst[11] = _c.w; dst[12] = _d.x; dst[13] = _d.y; dst[14] = _d.z; dst[15] = _d.w; } while (0)
__device__ __forceinline__ void v_step(bf16* hio, const int* idx, const float* act, const u8* tab, const float* stats, const f32x4 lg, const f32x4 lb, int m, int mn, int mnn, int lane, int c, int eg, int coff, bool b0,
                                       const v4u (&bufC)[16], const float (&aaC)[16], const unsigned (&idxN)[16], v4u (&bufN)[16], float (&aaN)[16], unsigned (&idxNN)[16]) {
#pragma unroll
    for (int g = 0; g < 16; ++g) bufN[g] = gld16(tab + (size_t)idxN[g] * 128 + 16 * c);
    LOAD_AA16(aaN, mn);
    LOAD_II16(idxNN, mnn);
    bf16* op = hio + (size_t)m * D + coff;
    const v2u xw = *(const GAS v2u*)op;
    const f32x2 st = *(const GAS f32x2*)(stats + 2 * (size_t)m);
    __builtin_amdgcn_sched_barrier(0);
    h16x2 y2[16];
#pragma unroll
    for (int i = 0; i < 16; ++i) y2[i] = (h16x2){(_Float16)0.f, (_Float16)0.f};
#pragma unroll
    for (int g = 0; g < 16; ++g) { const _Float16 a = (_Float16)aaC[g]; vacc4h(bufC[g], (h16x2){a, a}, y2); }
#pragma unroll
    for (int i = 0; i < 8; ++i) { const h16x2 send = b0 ? y2[i] : y2[i + 8], keep = b0 ? y2[i + 8] : y2[i];
        y2[i] = keep + __builtin_bit_cast(h16x2, __builtin_amdgcn_update_dpp(0, __builtin_bit_cast(int, send), 0x128, 0xF, 0xF, true)); }
#pragma unroll
    for (int i = 0; i < 4; ++i) { const auto sw = __builtin_amdgcn_permlane16_swap(__builtin_bit_cast(unsigned, y2[i]), __builtin_bit_cast(unsigned, y2[i + 4]), false, false);
        const unsigned s0 = sw[0], s1 = sw[1]; y2[i] = __builtin_bit_cast(h16x2, s0) + __builtin_bit_cast(h16x2, s1); }
#pragma unroll
    for (int i = 0; i < 2; ++i) { const auto sw = __builtin_amdgcn_permlane32_swap(__builtin_bit_cast(unsigned, y2[i]), __builtin_bit_cast(unsigned, y2[i + 2]), false, false);
        const unsigned s0 = sw[0], s1 = sw[1]; y2[i] = __builtin_bit_cast(h16x2, s0) + __builtin_bit_cast(h16x2, s1); }
    const float x0 = (bflo(xw.x) - st.x) * st.y * lg.x + lb.x, x1 = (bfhi(xw.x) - st.x) * st.y * lg.y + lb.y, x2 = (bflo(xw.y) - st.x) * st.y * lg.z + lb.z, x3 = (bfhi(xw.y) - st.x) * st.y * lg.w + lb.w;
    v2u o; o.x = pk2(x0 * DN_ALPHA + (float)y2[0].x, x1 * DN_ALPHA + (float)y2[0].y); o.y = pk2(x2 * DN_ALPHA + (float)y2[1].x, x3 * DN_ALPHA + (float)y2[1].y);
    *(GAS v2u*)op = o;
    __builtin_amdgcn_sched_barrier(0);
}
__device__ __forceinline__ void peer_v_pass(bf16* hio, const int* idx, const float* act, const u8* TVl, const float* stats, const float* lng, const float* lnb, int bx, int G, int wave, int lane_in) {
    const int s = bx & 7, cu = bx >> 3, nW = (G >> 3) * NWAVES;
    const u8* tab = TVl + (size_t)s * NEXP * 128;
    int lane = lane_in; asm volatile("" : "+v"(lane));
    const int c = lane & 7, eg = lane >> 3;
    const bool b0 = (lane & 8) != 0, b1 = (lane & 16) != 0, b2 = (lane & 32) != 0;
    const int coff = 256 * s + 32 * c + (b0 ? 16 : 0) + (b1 ? 8 : 0) + (b2 ? 4 : 0);
    const int m0 = cu * NWAVES + wave;
    const f32x4 lg = *(const GAS f32x4*)(lng + coff), lb = *(const GAS f32x4*)(lnb + coff);
    unsigned iiX[16], iiY[16]; v4u bufA[16], bufB[16]; float aaA[16], aaB[16];
    {   LOAD_II16(iiY, m0);
#pragma unroll
        for (int g = 0; g < 16; ++g) bufA[g] = gld16(tab + (size_t)iiY[g] * 128 + 16 * c);
        LOAD_AA16(aaA, m0);
        const int m1 = (m0 + nW < M) ? m0 + nW : m0; LOAD_II16(iiX, m1); }
    for (int m = m0; m < M; m += 2 * nW) {
        v_step(hio, idx, act, tab, stats, lg, lb, m, CLAMPM(m + nW), CLAMPM(m + 2 * nW), lane, c, eg, coff, b0, bufA, aaA, iiX, bufB, aaB, iiY);
        v_step(hio, idx, act, tab, stats, lg, lb, m + nW, CLAMPM(m + 2 * nW), CLAMPM(m + 3 * nW), lane, c, eg, coff, b0, bufB, aaB, iiY, bufA, aaA, iiX);
    }
}

constexpr int N_SLOTS = 11;
struct Args { const float* in[31]; float* out; unsigned char* ws; int slot, layer, pad0, pad1; };

constexpr int TAB_OFF = MISC_OFF + 128;
__device__ __forceinline__ void store_tab(const Args& a, LAS unsigned char* lds) {
    if (threadIdx.x == 0) { LAS unsigned long long* t = (LAS unsigned long long*)(lds + TAB_OFF);
#pragma unroll
        for (int i = 0; i < 31; ++i) t[i] = (unsigned long long)a.in[i];
        t[31] = (unsigned long long)a.out; t[32] = (unsigned long long)a.ws; }
    __syncthreads();
}
struct Tab { unsigned tab;
    __device__ __forceinline__ unsigned long long raw(int k) const { const v2u v = *(const LAS v2u*)(tab + 8 * k);
        return ((unsigned long long)(unsigned)__builtin_amdgcn_readfirstlane((int)v.y) << 32) | (unsigned)__builtin_amdgcn_readfirstlane((int)v.x); }
    __device__ __forceinline__ const float* in(int k) const { return (const float*)raw(k); }
};
#define ARG_IN(k) T_.in(k)

template <int SLOT>
__device__ __forceinline__ void run_slot(LAS unsigned char* lds, int layer, int wave_s) {
    int tid = wave_s * 64 + lane_id(); asm volatile("" : "+v"(tid));
    Tab T_; T_.tab = (unsigned)(unsigned long long)(lds + TAB_OFF); asm volatile("" : "+s"(T_.tab));
    unsigned char* ws = (unsigned char*)T_.raw(32);
    const int lane = tid & 63, wave = __builtin_amdgcn_readfirstlane(tid >> 6);
    const int G = gridDim.x; const int bx = blockIdx.x; const int vcu = (G % 8 == 0) ? (bx % 8) * (G / 8) + bx / 8 : bx;
    const int gw = vcu * NWAVES + wave, NGW = G * NWAVES;
    const int gtid = vcu * (NWAVES * 64) + tid, gthreads = G * NWAVES * 64;
    const int kind = layer % 3, jj = layer / 3;
    float* hout = (float*)T_.raw(31);
    bf16* HB0 = (bf16*)(ws + WS_HB0); bf16* HB1 = (bf16*)(ws + WS_HB1);
    bf16* T1 = (bf16*)(ws + WS_T1); bf16* T2 = (bf16*)(ws + WS_T2); bf16* T3 = (bf16*)(ws + WS_T3);
    int* IDX = (int*)(ws + WS_IDX); float* GATE = (float*)(ws + WS_GATE);
    bf16* TU = (bf16*)(ws + WS_TU); bf16* TV = (bf16*)(ws + WS_TV); bf16* PB = (bf16*)(ws + WS_PB); bf16* SKB = (bf16*)(ws + WS_SK);
    bf16* Sin = (layer & 1) ? HB1 : HB0;
    bf16* Sout = (layer & 1) ? HB0 : HB1;

    if constexpr (SLOT == 0) {
        LAS float* scr = (LAS float*)(lds + wave * 16384); LAS unsigned* scr8 = (LAS unsigned*)(lds + wave * 16384); int woff = 0;
        for (int j = 0; j < 2; ++j) {
            transpose_mat8b(ARG_IN(6) + (size_t)j * D * D, D, D, ws + W_POOL_IN + (size_t)j * D * D, 0, scr8, gw, NGW, lane, woff);
            for (int g = 0; g < 4; ++g) transpose_mat8b(ARG_IN(7) + (size_t)(j * 4 + g) * 512 * 512, 512, 512, ws + W_POOL_GRP + (size_t)j * D * 512, g * 512, scr8, gw, NGW, lane, woff);
            transpose_mat8b(ARG_IN(9) + (size_t)j * D * D, D, D, ws + W_POOL_OUT + (size_t)j * D * D, 0, scr8, gw, NGW, lane, woff);
        }
        transpose_mat8b(ARG_IN(10), D, D, ws + W_SSM_IN, 0, scr8, gw, NGW, lane, woff);
        transpose_mat8b(ARG_IN(19), D, D, ws + W_SSM_GLU, 0, scr8, gw, NGW, lane, woff);
        transpose_mat8b(ARG_IN(20), D, D, ws + W_SSM_OUT, 0, scr8, gw, NGW, lane, woff);
        transpose_mat8b(ARG_IN(21), D, 3 * D, ws + W_ATTN_QKV, 0, scr8, gw, NGW, lane, woff);
        transpose_mat8b(ARG_IN(23), D, D, ws + W_ATTN_OUT, 0, scr8, gw, NGW, lane, woff);
        for (int i = 0; i < DEPTH; ++i) {
            transpose_mat8b(ARG_IN(24) + (size_t)i * D * D, D, D, ws + W_PEER_Q + (size_t)i * D * D, 0, scr8, gw, NGW, lane, woff);
            transpose_mat8b(ARG_IN(29) + (size_t)i * D * D, D, D, ws + W_PLE_GATE + (size_t)i * D * D, 0, scr8, gw, NGW, lane, woff);
            transpose_mat(ARG_IN(28) + (size_t)i * PLE * D, PLE, D, (bf16*)(ws + W_PLE_PROJ) + (size_t)i * PLE * D, 0, scr, gw, NGW, lane);
        }
        cvt_rows_fp4(ARG_IN(26), (u8*)TU, (float*)(ws + WS_SU), DEPTH * NEXP, gw, NGW, lane);
        cvt_rows_fp4(ARG_IN(27), (u8*)TV, (float*)(ws + WS_SV), DEPTH * NEXP, gw, NGW, lane);
        cvt_rows(ARG_IN(1), PB, (size_t)DEPTH * M * PLE, (size_t)gtid, (size_t)gthreads);
        cvt_rows(ARG_IN(25), SKB, (size_t)DEPTH * 2 * 128 * 128, (size_t)gtid, (size_t)gthreads);
        {
            const float* xs = ARG_IN(0); unsigned char* s8 = ws + WS_S8;
            const size_t gs = (size_t)gthreads * 8;
            for (size_t i0 = (size_t)gtid * 8; i0 < (size_t)M * D; i0 += 4 * gs) {
                f32x4 a[4], b[4];
#pragma unroll
                for (int u = 0; u < 4; ++u) { a[u] = *(const GAS f32x4*)(xs + i0 + u * gs); b[u] = *(const GAS f32x4*)(xs + i0 + u * gs + 4); }
#pragma unroll
                for (int u = 0; u < 4; ++u) { const size_t i = i0 + u * gs;
                    v4u o; o.x = pk2(a[u].x, a[u].y); o.y = pk2(a[u].z, a[u].w); o.z = pk2(b[u].x, b[u].y); o.w = pk2(b[u].z, b[u].w);
                    *(GAS v4u*)(HB0 + i) = o;
                    int w0 = 0, w1 = 0;
                    w0 = __builtin_amdgcn_cvt_pk_fp8_f32(a[u].x, a[u].y, w0, false); w0 = __builtin_amdgcn_cvt_pk_fp8_f32(a[u].z, a[u].w, w0, true);
                    w1 = __builtin_amdgcn_cvt_pk_fp8_f32(b[u].x, b[u].y, w1, false); w1 = __builtin_amdgcn_cvt_pk_fp8_f32(b[u].z, b[u].w, w1, true);
                    v2u o8; o8.x = (unsigned)w0; o8.y = (unsigned)w1; *(GAS v2u*)(s8 + i) = o8; } } }
        {
            const float* lam_re = ARG_IN(11); const float* lam_im = ARG_IN(12); const float* log_step = ARG_IN(13); const float* b_re = ARG_IN(14); const float* b_im = ARG_IN(15);
            float* ssmp = (float*)(ws + WS_SSMP);
            for (int i = gtid; i < 128 * 64; i += gthreads) { const int g = i >> 6;
                const float lr = lam_re[i], li = lam_im[i], dt = expf(log_step[g]);
                const float mag = expf(dt * lr), ar = mag * cosf(dt * li), ai = mag * sinf(dt * li);
                const float den = lr * lr + li * li;
                const float kr = ((ar - 1.f) * lr + ai * li) / den, ki = (ai * lr - (ar - 1.f) * li) / den;
                float* o = ssmp + (size_t)i * 34; o[0] = ar; o[1] = ai;
                for (int c = 0; c < 16; ++c) { const float br = b_re[i * 16 + c], bi = b_im[i * 16 + c]; o[2 + c] = kr * br - ki * bi; o[18 + c] = kr * bi + ki * br; } }
        }
    }
    if constexpr (SLOT == 1) {
        pg8::StaticOrder S;
        if (kind == 2) {
            pg8::Gemm g{(const bf16*)(ws + WS_S8), (const bf16*)(ws + W_ATTN_QKV), M, 3 * D, D / 2, D / 2, 0}; S.init(M, 3 * D, G, bx);
            pg8::EpiBf16 E{T1, D, nullptr, D, (size_t)(WS_T2 - WS_T1) / 2, ATTN_QSCALE, nullptr, 1.f / W8S};
            pg8::gemm_phase<pg8::EpiBf16, true>(lds, g, S, E, tid);
        } else {
            const unsigned char* W = (kind == 0) ? ws + W_POOL_IN + (size_t)jj * D * D : ws + W_SSM_IN;
            pg8::Gemm g{(const bf16*)(ws + WS_S8), (const bf16*)W, M, D, D / 2, D / 2, 0}; S.init(M, D, G, bx);
            pg8::EpiBf16 E{T1, D, nullptr, 0, 0, 1.f, nullptr, 1.f / W8S};
            pg8::gemm_phase<pg8::EpiBf16, true>(lds, g, S, E, tid);
        }
    }
    if constexpr (SLOT == 2) {
        if (kind == 0) pool_phase(T1, (u8*)T2, gw, NGW, lane);
        else if (kind == 1) ssm_phase_m(T1, (u8*)T2, (const float*)(ws + WS_SSMP), ARG_IN(16), ARG_IN(17), ARG_IN(18), lds, vcu, G, wave, lane);
        else {
            LAS float* rb = (LAS float*)lds;
            for (int i = tid; i < 16 * 257; i += NWAVES * 64) rb[i] = ARG_IN(22)[i] * LOG2E;
            __syncthreads();
            attn_phase_split(T1, T2, T3, ws + WS_X8, rb, lds + 32768, vcu, G, wave, lane);
            __syncthreads();
        }
    }
    if constexpr (SLOT == 3) {
        pg8::StaticOrder S; S.init(M, D, G, bx);
        if (kind == 0) {
            pg8::Gemm g{(const bf16*)T2, (const bf16*)(ws + W_POOL_GRP + (size_t)jj * D * 512), M, D, 256, D / 2, 2};
            pg8::EpiF8 E{(unsigned char*)T1, D, ARG_IN(8) + (size_t)jj * D, 1.f / W8S};
            pg8::gemm_phase<pg8::EpiF8, true>(lds, g, S, E, tid);
        } else if (kind == 1) {
            pg8::Gemm g{(const bf16*)T2, (const bf16*)(ws + W_SSM_GLU), M, D, D / 2, D / 2, 0};
            pg8::EpiGlu8 E{(const unsigned char*)T2, (unsigned char*)T1, D, 1.f / W8S};
            pg8::gemm_phase<pg8::EpiGlu8, true>(lds, g, S, E, tid);
        }
    }
    if constexpr (SLOT == 4) {
        const unsigned char* W = (kind == 0) ? ws + W_POOL_OUT + (size_t)jj * D * D : (kind == 1) ? ws + W_SSM_OUT : ws + W_ATTN_OUT;
        pg8::Gemm g{(kind == 2) ? (const bf16*)(ws + WS_X8) : (const bf16*)T1, (const bf16*)W, M, D, D / 2, D / 2, 0}; pg8::StaticOrder S; S.init(M, D, G, bx);
        pg8::EpiRes E{Sin, Sin, D, DN_ALPHA, (kind == 2) ? 1.f / (W8S * O8S) : 1.f / W8S};
        pg8::gemm_phase<pg8::EpiRes, true>(lds, g, S, E, tid);
    }
    if constexpr (SLOT == 5) ln_phase<true>(Sin, ARG_IN(2) + (size_t)layer * D, ARG_IN(3) + (size_t)layer * D, gw, NGW, lane, ws + WS_X8, ws + WS_S8, (float*)(ws + WS_STATS));
    if constexpr (SLOT == 6) {
        { pg8::Gemm g{(const bf16*)(ws + WS_S8), (const bf16*)(ws + W_PEER_Q + (size_t)layer * D * D), M, D, D / 2, D / 2, 0}; pg8::StaticOrder S; S.init(M, D, G, bx);
          pg8::EpiBf16 E{T1, D, nullptr, 0, 0, 1.f, nullptr, 1.f / W8S};
          pg8::gemm_phase<pg8::EpiBf16, true>(lds, g, S, E, tid); }
    }
    if constexpr (SLOT == 14) {
        __syncthreads();
        { pg8::Gemm g{PB + (size_t)layer * M * PLE, (const bf16*)(ws + W_PLE_PROJ) + (size_t)layer * PLE * D, M, D, PLE, PLE, 0}; pg8::StaticOrder S; S.init(M, D, G, bx);
          pg8::EpiF8 E{(unsigned char*)T3, D, nullptr, 8.f};
          pg8::gemm_phase<pg8::EpiF8>(lds, g, S, E, tid); }
    }
    if constexpr (SLOT == 7) {
        const bf16* sk = SKB + (size_t)layer * 2 * 128 * 128;
        for (int i = tid; i < 256 * 16; i += NWAVES * 64) { const int rowi = i >> 4, ch = i & 15; *(LAS v4u*)(lds + rowi * 272 + ch * 16) = *(const v4u*)(sk + rowi * 128 + ch * 8); }
        __syncthreads();
        peer_select_phase(T1, lds, IDX, GATE, gw, NGW, lane);
        __syncthreads();
    }
    if constexpr (SLOT == 8) peer_u_pass(ws + WS_X8, IDX, (const u8*)TU + (size_t)layer * NEXP * 1024, (float*)T2, bx, G, wave, lane);
    if constexpr (SLOT == 11) peer_act_phase((const float*)T2, IDX, GATE, (const float*)(ws + WS_SU) + layer * NEXP, (const float*)(ws + WS_SV) + layer * NEXP, gw, NGW, lane);
    if constexpr (SLOT == 12) peer_v_pass(Sin, IDX, GATE, (const u8*)TV + (size_t)layer * NEXP * 1024, (const float*)(ws + WS_STATS), ARG_IN(2) + (size_t)layer * D, ARG_IN(3) + (size_t)layer * D, bx, G, wave, lane);
    if constexpr (SLOT == 13) ln_phase(Sin, ARG_IN(4) + (size_t)layer * D, ARG_IN(5) + (size_t)layer * D, gw, NGW, lane, ws + WS_X8);
    if constexpr (SLOT == 10) {
        pg8::Gemm g{(const bf16*)(ws + WS_X8), (const bf16*)(ws + W_PLE_GATE + (size_t)layer * D * D), M, D, D / 2, D / 2, 0}; pg8::StaticOrder S; S.init(M, D, G, bx);
        pg8::EpiPle E{Sin, (const unsigned char*)T3, Sout, ws + WS_S8, (layer == DEPTH - 1) ? hout : nullptr, ARG_IN(30) + (size_t)layer * D, D, 1.f / W8S};
        pg8::gemm_phase<pg8::EpiPle, true>(lds, g, S, E, tid);
    }
}

template <int SLOT>
__global__ void __launch_bounds__(NWAVES * 64, 2) mk_slot(Args args) {
    extern __shared__ __attribute__((aligned(16))) unsigned char lds_raw[];
    store_tab(args, (LAS unsigned char*)lds_raw);
    run_slot<SLOT>((LAS unsigned char*)lds_raw, args.layer, __builtin_amdgcn_readfirstlane((int)(threadIdx.x >> 6)));
}

#if !MK_PER_PHASE
__global__ void __launch_bounds__(NWAVES * 64, 2) mk_fwd(Args args) {
    extern __shared__ __attribute__((aligned(16))) unsigned char lds_raw[];
    LAS unsigned char* lds = (LAS unsigned char*)lds_raw;
    volatile LAS unsigned* MISC = (volatile LAS unsigned*)(lds + MISC_OFF);
    for (int u = threadIdx.x; u < (LDS_BYTES - LDSCTL_OFF) / 4; u += NWAVES * 64) ((LAS unsigned*)(lds + LDSCTL_OFF))[u] = 0u;
    __syncthreads();
    store_tab(args, lds);
    const XcdBarrier bar = xcd_barrier_post((unsigned*)(args.ws + WS_CTL) + CW_BAR, MISC + 8);
    run_slot<0>(lds, 0, bar.wave); xcd_barrier(bar);
    for (int layer = 0; layer < DEPTH; ++layer) {
        run_slot<1>(lds, layer, bar.wave); xcd_barrier(bar);
        run_slot<2>(lds, layer, bar.wave); xcd_barrier(bar);
        if (layer % 3 != 2) { run_slot<3>(lds, layer, bar.wave); xcd_barrier(bar); }
        run_slot<4>(lds, layer, bar.wave); xcd_barrier(bar);
        run_slot<5>(lds, layer, bar.wave); xcd_barrier(bar);
        run_slot<6>(lds, layer, bar.wave); run_slot<14>(lds, layer, bar.wave); xcd_barrier(bar);
        run_slot<7>(lds, layer, bar.wave); xcd_barrier(bar);
        run_slot<8>(lds, layer, bar.wave); xcd_barrier(bar);
        run_slot<11>(lds, layer, bar.wave); xcd_barrier(bar);
        run_slot<12>(lds, layer, bar.wave); xcd_barrier(bar);
        run_slot<13>(lds, layer, bar.wave); xcd_barrier(bar);
        run_slot<10>(lds, layer, bar.wave); if (layer + 1 < DEPTH) xcd_barrier(bar);
    }
}
#endif

template <int SLOT> static void launch_slot(const Args& a0, int layer, int grid, hipStream_t stream) {
    static bool attr_done = false;
    if (!attr_done) { (void)hipFuncSetAttribute((const void*)mk_slot<SLOT>, hipFuncAttributeMaxDynamicSharedMemorySize, LDS_BYTES); attr_done = true; }
    Args a = a0; a.slot = SLOT; a.layer = layer;
    hipLaunchKernelGGL(mk_slot<SLOT>, dim3(grid), dim3(NWAVES * 64), LDS_BYTES, stream, a);
}

extern "C" void kernel_launch(void* const* d_in, const int* in_sizes, int n_in, void* d_out, int out_size, void* d_ws, size_t ws_size, hipStream_t stream) {
    static int grid = 0;
    if (grid == 0) {
        if (n_in != 31 || out_size != M * D || ws_size < WS_END) { fprintf(stderr, "kernel_launch: unexpected shapes (n_in %d out %d ws %zu)\n", n_in, out_size, ws_size); grid = -1; return; }
        int dev = 0, cus = 0, per_cu = 0;
        if (hipGetDevice(&dev) != hipSuccess || hipDeviceGetAttribute(&cus, hipDeviceAttributeMultiprocessorCount, dev) != hipSuccess) { grid = -1; return; }
#if !MK_PER_PHASE
        if (hipFuncSetAttribute((const void*)mk_fwd, hipFuncAttributeMaxDynamicSharedMemorySize, LDS_BYTES) != hipSuccess) { fprintf(stderr, "kernel_launch: hipFuncSetAttribute failed\n"); grid = -1; return; }
        if (hipOccupancyMaxActiveBlocksPerMultiprocessor(&per_cu, (const void*)mk_fwd, NWAVES * 64, LDS_BYTES) != hipSuccess || per_cu < 1) { fprintf(stderr, "kernel_launch: occupancy query says %d\n", per_cu); }
        (void)hipGetLastError();
#endif
        (void)per_cu;
        grid = cus;
    }
    if (grid < 0) return;
    Args a{};
    for (int i = 0; i < 31; ++i) a.in[i] = (const float*)d_in[i];
    a.out = (float*)d_out; a.ws = (unsigned char*)d_ws;
#if MK_PER_PHASE
    launch_slot<0>(a, 0, grid, stream);
    for (int layer = 0; layer < DEPTH; ++layer) {
        launch_slot<1>(a, layer, grid, stream); launch_slot<2>(a, layer, grid, stream);
        if (layer % 3 != 2) launch_slot<3>(a, layer, grid, stream);
        launch_slot<4>(a, layer, grid, stream); launch_slot<5>(a, layer, grid, stream); launch_slot<6>(a, layer, grid, stream); launch_slot<14>(a, layer, grid, stream); launch_slot<7>(a, layer, grid, stream);
        launch_slot<8>(a, layer, grid, stream); launch_slot<11>(a, layer, grid, stream); launch_slot<12>(a, layer, grid, stream); launch_slot<13>(a, layer, grid, stream); launch_slot<10>(a, layer, grid, stream);
    }
#else
    if (hipMemsetAsync((char*)d_ws + WS_CTL, 0, CTL_ZERO_BYTES, stream) != hipSuccess) return;
    hipLaunchKernelGGL(mk_fwd, dim3(grid), dim3(NWAVES * 64), LDS_BYTES, stream, a);
#endif
}
```

```cpp
#include <hip/hip_runtime.h>
#include <cstdio>
#include <cstdint>

#ifndef MK_PER_PHASE
#define MK_PER_PHASE 0
#endif

namespace pg8 {
#define PG8_LAS __attribute__((address_space(3)))
typedef unsigned short bf16_t;
typedef short bf16x8 __attribute__((ext_vector_type(8)));
typedef float f32x4 __attribute__((ext_vector_type(4)));
typedef unsigned u32x4 __attribute__((ext_vector_type(4)));
constexpr int BM = 256, BK = 64, HALF = 128, HTB = HALF * BK * 2, STAGE_BYTES = 8 * HTB, NXCD = 8, WGM = 8;

__host__ __device__ __forceinline__ int lds_byte(int r, int c) { const int st = (r >> 4) * 2 + (c >> 5), rr = r & 15, cc = c & 31, ob = rr * 64 + cc * 2; return st * 1024 + (ob ^ (((ob >> 9) & 1) << 5)); }
__host__ __device__ __forceinline__ int lds_byte8(int r, int c) { const int st = (r >> 4) * 2 + (c >> 5), rr = r & 15, cc = c & 31, ob = rr * 64 + cc * 2; return st * 1024 + (ob ^ (((ob >> 9) & 1) << 5) ^ (((ob >> 8) & 1) << 4)); }
__host__ __device__ __forceinline__ void stage_rc8(int b, int& R, int& C) { const int st = b / 1024, sb = b % 1024, swz = sb ^ (((sb >> 9) & 1) << 5) ^ (((sb >> 8) & 1) << 4); R = (st >> 1) * 16 + swz / 64; C = (st & 1) * 32 + (swz % 64) / 2; }
__host__ __device__ __forceinline__ void stage_rc(int b, int& R, int& C) { const int st = b / 1024, sb = b % 1024, swz = sb ^ (((sb >> 9) & 1) << 5); R = (st >> 1) * 16 + swz / 64; C = (st & 1) * 32 + (swz % 64) / 2; }
__host__ __device__ __forceinline__ int perm32(int rho) { const int n = rho >> 4, i = rho & 15; return 8 * (i >> 2) + 4 * n + (i & 3); }
__host__ __device__ __forceinline__ int perm32f8(int rho) { return 16 * ((rho >> 2) & 1) + (rho & 3) + 4 * (rho >> 3); }

__device__ __forceinline__ int lane_now() { int l; asm volatile("v_mbcnt_lo_u32_b32 %0, -1, 0\n\tv_mbcnt_hi_u32_b32 %0, -1, %0" : "=v"(l)); return l; }
struct Unit { int pm, pn; };
struct Gemm { const bf16_t* A; const bf16_t* Bt; int M, N, K, lda, agrp; };

struct StaticOrder {
    int nM, nN, nwg, G, c;
    __host__ __device__ void init(int M, int N, int G_, int c_) { nM = M / BM; nN = N / BM; nwg = nM * nN; G = G_; c = c_; }
    __host__ __device__ bool next(int i, Unit& u) const {
        const long L = (long)i * G + c; if (L >= nwg) return false;
        int wgid = (int)L; { const int q = nwg / NXCD, r = nwg % NXCD, xcd = wgid % NXCD, off = wgid / NXCD; wgid = (xcd < r ? xcd * (q + 1) : r * (q + 1) + (xcd - r) * q) + off; }
        const int nig = WGM * nN, gid = wgid / nig, fm = gid * WGM, gsz = (nM - fm) < WGM ? (nM - fm) : WGM;
        u.pm = fm + ((wgid % nig) % gsz); u.pn = (wgid % nig) / gsz; return true;
    }
};

__device__ __forceinline__ unsigned cvt_pk_bf16(float lo, float hi) { unsigned r; asm volatile("v_cvt_pk_bf16_f32 %0, %1, %2" : "=v"(r) : "v"(lo), "v"(hi)); return r; }
__device__ __forceinline__ float bf_lo(unsigned w) { return __builtin_bit_cast(float, w << 16); }
__device__ __forceinline__ float bf_hi(unsigned w) { return __builtin_bit_cast(float, w & 0xffff0000u); }
__device__ __forceinline__ float sigmoid_f(float x) { return __builtin_amdgcn_rcpf(1.f + __builtin_amdgcn_exp2f(-1.4426950408889634f * x)); }
#ifdef DBG_PLE_HALF
__device__ __forceinline__ float sigmoid_p(float x) { return 0.5f; }
#else
__device__ __forceinline__ float sigmoid_p(float x) { return sigmoid_f(x); }
#endif

typedef int v8i_t __attribute__((ext_vector_type(8)));
typedef unsigned u32x2 __attribute__((ext_vector_type(2)));
typedef float f32x16 __attribute__((ext_vector_type(16)));
typedef float f32x2_ __attribute__((ext_vector_type(2)));
__device__ __forceinline__ u32x2 pack8_fp8(const f32x4 v0, const f32x4 v1) {
    int a = 0, b = 0;
    a = __builtin_amdgcn_cvt_pk_fp8_f32(v0[0], v0[1], a, false); a = __builtin_amdgcn_cvt_pk_fp8_f32(v0[2], v0[3], a, true);
    b = __builtin_amdgcn_cvt_pk_fp8_f32(v1[0], v1[1], b, false); b = __builtin_amdgcn_cvt_pk_fp8_f32(v1[2], v1[3], b, true);
    return (u32x2){(unsigned)a, (unsigned)b};
}
__device__ __forceinline__ u32x4 pack8_bf16(const f32x4 v0, const f32x4 v1) { u32x4 w; w.x = cvt_pk_bf16(v0[0], v0[1]); w.y = cvt_pk_bf16(v0[2], v0[3]); w.z = cvt_pk_bf16(v1[0], v1[1]); w.w = cvt_pk_bf16(v1[2], v1[3]); return w; }
struct EpiBf16 {
    bf16_t* O; int ldc; const float* cscale; int split_cols; size_t split_stride; float scale0; bf16_t* VT; float oscale;
    __device__ __forceinline__ void chunk(int row, int col, f32x4 v0, f32x4 v1) const {
        if (cscale) { v0 = v0 * *(const f32x4*)(cscale + col); v1 = v1 * *(const f32x4*)(cscale + col + 4); }
        if (!split_cols) { *(u32x4*)(O + (size_t)row * ldc + col) = pack8_bf16(v0 * oscale, v1 * oscale); return; }
        const int t = col / split_cols, c = col - t * split_cols, hd = c >> 7, d = c & 127, b = row >> 13, sq = row & 8191;
        const float sc = (t == 0) ? oscale * scale0 : oscale;
        const u32x4 w = pack8_bf16(v0 * sc, v1 * sc);
        bf16_t* base = O + (size_t)t * split_stride;
        const size_t bh = (size_t)(b * 16 + hd) * 256 + (sq >> 5);
        if (t < 2) *(u32x4*)(base + ((bh * 8 + (d >> 4)) * 512) + (size_t)((sq & 31) + 32 * ((d >> 3) & 1)) * 8) = w;
        else { const int kk = sq & 31, k16 = kk & 15; bf16_t* p = base + ((((bh * 4 + (d >> 5)) * 2 + (kk >> 4)) * 512) + (size_t)((d & 31) + 32 * ((k16 >> 2) & 1)) * 8) + (k16 & 3) + 4 * (k16 >> 3);
            p[0] = (bf16_t)(w.x & 0xffffu); p[8] = (bf16_t)(w.x >> 16); p[16] = (bf16_t)(w.y & 0xffffu); p[24] = (bf16_t)(w.y >> 16);
            p[32] = (bf16_t)(w.z & 0xffffu); p[40] = (bf16_t)(w.z >> 16); p[48] = (bf16_t)(w.w & 0xffffu); p[56] = (bf16_t)(w.w >> 16); }
    }
};
struct EpiF8 {
    unsigned char* O; int ldc; const float* cscale; float oscale;
    __device__ __forceinline__ void chunk(int row, int col, f32x4 v0, f32x4 v1) const {
        if (cscale) { v0 = v0 * *(const f32x4*)(cscale + col); v1 = v1 * *(const f32x4*)(cscale + col + 4); }
        *(u32x2*)(O + (size_t)row * ldc + col) = pack8_fp8(v0 * oscale, v1 * oscale);
    }
};
#define PG8_GAS __attribute__((address_space(1)))
struct EpiGlu8 {
    const unsigned char* Gin; unsigned char* O; int ld; float oscale;
    typedef u32x2 Pre;
    __device__ __forceinline__ Pre pre(int row, int col) const { return *(const PG8_GAS u32x2*)(Gin + (size_t)row * ld + col); }
    __device__ __forceinline__ void fin(int row, int col, f32x4 a0, f32x4 a1, const Pre g) const {
        const size_t ro = (size_t)row * ld + col; a0 = a0 * oscale; a1 = a1 * oscale;
        const unsigned gx = g.x, gy = g.y;
        const f32x2_ g01 = __builtin_amdgcn_cvt_pk_f32_fp8((int)gx, false), g23 = __builtin_amdgcn_cvt_pk_f32_fp8((int)gx, true), g45 = __builtin_amdgcn_cvt_pk_f32_fp8((int)gy, false), g67 = __builtin_amdgcn_cvt_pk_f32_fp8((int)gy, true);
        const f32x4 o0 = {g01.x * sigmoid_f(a0[0]), g01.y * sigmoid_f(a0[1]), g23.x * sigmoid_f(a0[2]), g23.y * sigmoid_f(a0[3])};
        const f32x4 o1 = {g45.x * sigmoid_f(a1[0]), g45.y * sigmoid_f(a1[1]), g67.x * sigmoid_f(a1[2]), g67.y * sigmoid_f(a1[3])};
        *(PG8_GAS u32x2*)(O + ro) = pack8_fp8(o0, o1);
    }
};
struct EpiRes {
    const bf16_t* hres; bf16_t* out; int ld; float alpha; float mscale;
    typedef u32x4 Pre;
    __device__ __forceinline__ Pre pre(int row, int col) const { return *(const PG8_GAS u32x4*)(hres + (size_t)row * ld + col); }
    __device__ __forceinline__ void fin(int row, int col, f32x4 a0, f32x4 a1, const Pre h) const {
        const size_t ro = (size_t)row * ld + col; a0 = a0 * mscale; a1 = a1 * mscale;
        const f32x4 o0 = {bf_lo(h.x) * alpha + a0[0], bf_hi(h.x) * alpha + a0[1], bf_lo(h.y) * alpha + a0[2], bf_hi(h.y) * alpha + a0[3]};
        const f32x4 o1 = {bf_lo(h.z) * alpha + a1[0], bf_hi(h.z) * alpha + a1[1], bf_lo(h.w) * alpha + a1[2], bf_hi(h.w) * alpha + a1[3]};
        *(PG8_GAS u32x4*)(out + ro) = pack8_bf16(o0, o1);
    }
};
struct EpiPle {
    const bf16_t* hin; const unsigned char* proj; bf16_t* hob; unsigned char* ho8; float* fout; const float* bias; int ld; float oscale;
    struct Pre { u32x2 pj8; u32x4 hh; f32x4 b0, b1; };
    __device__ __forceinline__ Pre pre(int row, int col) const { const size_t ro = (size_t)row * ld + col; Pre p; p.pj8 = *(const PG8_GAS u32x2*)(proj + ro); p.hh = *(const PG8_GAS u32x4*)(hin + ro);
        p.b0 = *(const PG8_GAS f32x4*)(bias + col); p.b1 = *(const PG8_GAS f32x4*)(bias + col + 4); return p; }
    __device__ __forceinline__ void fin(int row, int col, f32x4 a0, f32x4 a1, const Pre& p) const {
        const size_t ro = (size_t)row * ld + col; const u32x2 pj8 = p.pj8; const u32x4 hh = p.hh;
        const unsigned pjx = pj8.x, pjy = pj8.y;
        const f32x2_ q01 = __builtin_amdgcn_cvt_pk_f32_fp8((int)pjx, false), q23 = __builtin_amdgcn_cvt_pk_f32_fp8((int)pjx, true), q45 = __builtin_amdgcn_cvt_pk_f32_fp8((int)pjy, false), q67 = __builtin_amdgcn_cvt_pk_f32_fp8((int)pjy, true);
        const float pjs = 1.f / 8.f;
        const float p0 = q01.x * pjs, p1 = q01.y * pjs, p2 = q23.x * pjs, p3 = q23.y * pjs, p4 = q45.x * pjs, p5 = q45.y * pjs, p6 = q67.x * pjs, p7 = q67.y * pjs;
        a0 = a0 * oscale + p.b0; a1 = a1 * oscale + p.b1;
        f32x4 h0, h1;
        h0[0] = bf_lo(hh.x) + sigmoid_p(a0[0]) * p0; h0[1] = bf_hi(hh.x) + sigmoid_p(a0[1]) * p1; h0[2] = bf_lo(hh.y) + sigmoid_p(a0[2]) * p2; h0[3] = bf_hi(hh.y) + sigmoid_p(a0[3]) * p3;
        h1[0] = bf_lo(hh.z) + sigmoid_p(a1[0]) * p4; h1[1] = bf_hi(hh.z) + sigmoid_p(a1[1]) * p5; h1[2] = bf_lo(hh.w) + sigmoid_p(a1[2]) * p6; h1[3] = bf_hi(hh.w) + sigmoid_p(a1[3]) * p7;
        if (fout != nullptr) { *(PG8_GAS f32x4*)(fout + ro) = h0; *(PG8_GAS f32x4*)(fout + ro + 4) = h1; }
        else { *(PG8_GAS u32x4*)(hob + ro) = pack8_bf16(h0, h1); *(PG8_GAS u32x2*)(ho8 + ro) = pack8_fp8(h0, h1); }
    }
};

template <class E, class = void> struct HasPre { static constexpr bool value = false; };
template <class E> struct HasPre<E, decltype((void)sizeof(typename E::Pre))> { static constexpr bool value = true; };
template <class Epi, bool F8 = false>
__device__ __forceinline__ void gemm_phase(PG8_LAS unsigned char* lds, const Gemm g, const StaticOrder& S, const Epi& E, const int tid) {
    const int wid = __builtin_amdgcn_readfirstlane(tid >> 6), lane = tid & 63, wr = wid >> 2, wc = wid & 3, fr = lane & 15, fq = lane >> 4;
    const int K = g.K, nt = K / BK, lda = g.lda;
    unsigned voffA[2], voffB[2];
#pragma unroll
    for (int i = 0; i < 2; ++i) { int R, C; if (F8) stage_rc8(tid * 16 + i * 8192, R, C); else stage_rc(tid * 16 + i * 8192, R, C); const int Rb = (R & ~31) + (F8 ? perm32f8(R & 31) : perm32(R & 31));
        voffA[i] = (unsigned)(R * lda + C) * 2u; voffB[i] = (unsigned)(Rb * K + C) * 2u; }
    const size_t kstep = (size_t)(BK * 2);
    const size_t hstepA = (size_t)HALF * lda * 2, hstepB = (size_t)HALF * K * 2;
    const size_t tstepA = 2 * hstepA, tstepB = 2 * hstepB;
    const unsigned ldsw = (unsigned)wid * 1024u;
    const int l31 = lane & 31, h32 = lane >> 5;
    const int aoff = F8 ? lds_byte8(wr * 64 + l31, 16 * h32) : lds_byte(wr * 64 + fr, fq * 8);
    const int boff = F8 ? lds_byte8(wc * 32 + l31, 16 * h32) : lds_byte(wc * 32 + fr, fq * 8);
    const int aoffx = aoff ^ 16, boffx = boff ^ 16;
#define PG8_SA(b, h) (((b) * 2 + (h)) * HTB)
#define PG8_SB(b, h) ((4 + (b) * 2 + (h)) * HTB)
#define PG8_STAGE(bufoff, gbase, voff) do { _Pragma("unroll") for (int _i = 0; _i < 2; ++_i) \
        __builtin_amdgcn_global_load_lds((const unsigned*)((const char*)(gbase) + (voff)[_i]), (PG8_LAS unsigned*)(lds + (bufoff) + ldsw + _i * 8192), 16, 0, 0); } while (0)
#define PG8_LD32(dst, off, offx) do { typedef int _v4i __attribute__((ext_vector_type(4))); const _v4i _lo = *(const PG8_LAS _v4i*)(lds + (off)), _hi = *(const PG8_LAS _v4i*)(lds + (offx)); \
        dst = __builtin_shufflevector(_lo, _hi, 0, 1, 2, 3, 4, 5, 6, 7); } while (0)
#define PG8_LDA(dst, b, h) do { if constexpr (F8) { _Pragma("unroll") for (int m2 = 0; m2 < 2; ++m2) _Pragma("unroll") for (int ks = 0; ks < 2; ++ks) PG8_LD32(dst##8[m2][ks], PG8_SA(b, h) + aoff + m2 * 4096 + ks * 1024, PG8_SA(b, h) + aoffx + m2 * 4096 + ks * 1024); } \
        else { _Pragma("unroll") for (int m = 0; m < 4; ++m) _Pragma("unroll") for (int k = 0; k < 2; ++k) dst[m][k] = *(const PG8_LAS bf16x8*)(lds + PG8_SA(b, h) + aoff + m * 2048 + k * 1024); } } while (0)
#define PG8_LDB(dst, b, h) do { if constexpr (F8) { _Pragma("unroll") for (int ks = 0; ks < 2; ++ks) PG8_LD32(dst##8[ks], PG8_SB(b, h) + boff + ks * 1024, PG8_SB(b, h) + boffx + ks * 1024); } \
        else { _Pragma("unroll") for (int n = 0; n < 2; ++n) _Pragma("unroll") for (int k = 0; k < 2; ++k) dst[n][k] = *(const PG8_LAS bf16x8*)(lds + PG8_SB(b, h) + boff + n * 2048 + k * 1024); } } while (0)
#define PG8_MMA(ai, bj, At, Bt) do { __builtin_amdgcn_s_setprio(1); \
        if constexpr (F8) { _Pragma("unroll") for (int m2 = 0; m2 < 2; ++m2) _Pragma("unroll") for (int ks = 0; ks < 2; ++ks) \
            acc32[ai][bj][m2] = __builtin_amdgcn_mfma_scale_f32_32x32x64_f8f6f4(Bt##8[ks], At##8[m2][ks], acc32[ai][bj][m2], 0, 0, 0, 0, 0, 0); } \
        else { _Pragma("unroll") for (int m = 0; m < 4; ++m) _Pragma("unroll") for (int n = 0; n < 2; ++n) _Pragma("unroll") for (int k = 0; k < 2; ++k) \
            acc[ai][bj][m][n] = __builtin_amdgcn_mfma_f32_16x16x32_bf16(Bt[n][k], At[m][k], acc[ai][bj][m][n], 0, 0, 0); } \
        __builtin_amdgcn_s_setprio(0); } while (0)
#define PG8_WAIT_V(n) asm volatile("s_waitcnt vmcnt(" #n ")" ::: "memory")
#define PG8_WAIT_L(n) asm volatile("s_waitcnt lgkmcnt(" #n ")" ::: "memory")
#define PG8_BAR __builtin_amdgcn_s_barrier()
#define PG8_SCHED __builtin_amdgcn_sched_barrier(0)
#define PG8_ACOL(u) ((g.agrp > 0) ? (size_t)((u).pn / g.agrp) * (size_t)K * 2 : (size_t)0)
    Unit cur, nxt; int ui = 0;
    if (!S.next(0, cur)) return;
    f32x4 acc[2][2][4][2];
#pragma unroll
    for (int a = 0; a < 2; ++a)
#pragma unroll
        for (int b = 0; b < 2; ++b)
#pragma unroll
            for (int m = 0; m < 4; ++m)
#pragma unroll
                for (int n = 0; n < 2; ++n) acc[a][b][m][n] = (f32x4){0.f, 0.f, 0.f, 0.f};
    bf16x8 At[4][2], B0[2][2], B1[2][2];
    v8i_t At8[2][2], B08[2], B18[2];
    f32x16 acc32[2][2][2];
#pragma unroll
    for (int a = 0; a < 2; ++a)
#pragma unroll
        for (int b = 0; b < 2; ++b)
#pragma unroll
            for (int m2 = 0; m2 < 2; ++m2)
#pragma unroll
                for (int i = 0; i < 16; ++i) acc32[a][b][m2][i] = 0.f;
    const char* cA = (const char*)g.A + (size_t)cur.pm * tstepA + PG8_ACOL(cur); const char* cB = (const char*)g.Bt + (size_t)cur.pn * tstepB;
    PG8_STAGE(PG8_SB(0, 0), cB, voffB); PG8_STAGE(PG8_SB(0, 1), cB + hstepB, voffB); PG8_STAGE(PG8_SA(0, 0), cA, voffA); PG8_STAGE(PG8_SA(0, 1), cA + hstepA, voffA);
    if (wr == 1) PG8_BAR;
    PG8_WAIT_V(2); PG8_BAR;
    PG8_STAGE(PG8_SB(1, 0), cB + kstep, voffB); PG8_STAGE(PG8_SA(1, 0), cA + kstep, voffA); PG8_STAGE(PG8_SB(1, 1), cB + hstepB + kstep, voffB);
    PG8_WAIT_V(6); PG8_BAR;
    for (;;) {
        const bool has_next = S.next(ui + 1, nxt);
        const char* nA = has_next ? (const char*)g.A + (size_t)nxt.pm * tstepA + PG8_ACOL(nxt) : cA; const char* nB = has_next ? (const char*)g.Bt + (size_t)nxt.pn * tstepB : cB;
        for (int t = 0; t < nt; t += 2) {
            const bool last = (t == nt - 2);
            const char* a1 = cA + (size_t)(t + 1) * kstep;
            const char* a2 = last ? nA : cA + (size_t)(t + 2) * kstep; const char* b2 = last ? nB : cB + (size_t)(t + 2) * kstep;
            const char* a3 = a2 + kstep; const char* b3 = b2 + kstep;
            PG8_LDB(B0, 0, 0); PG8_LDB(B1, 0, 1); PG8_SCHED; PG8_LDA(At, 0, 0); PG8_STAGE(PG8_SA(1, 1), a1 + hstepA, voffA);
            PG8_WAIT_V(8); PG8_WAIT_L(0); PG8_BAR; PG8_MMA(0, 0, At, B0); PG8_MMA(0, 1, At, B1); PG8_BAR; PG8_SCHED;
            PG8_LDA(At, 0, 1); PG8_STAGE(PG8_SB(0, 0), b2, voffB); PG8_STAGE(PG8_SB(0, 1), b2 + hstepB, voffB); PG8_STAGE(PG8_SA(0, 0), a2, voffA);
            PG8_WAIT_V(8); PG8_WAIT_L(0); PG8_BAR; PG8_MMA(1, 0, At, B0); PG8_MMA(1, 1, At, B1); PG8_BAR; PG8_SCHED;
            PG8_LDB(B0, 1, 0); PG8_LDB(B1, 1, 1); PG8_SCHED; PG8_LDA(At, 1, 0); PG8_STAGE(PG8_SA(0, 1), a2 + hstepA, voffA);
            PG8_WAIT_V(8); PG8_WAIT_L(0); PG8_BAR; PG8_MMA(0, 0, At, B0); PG8_MMA(0, 1, At, B1); PG8_BAR; PG8_SCHED;
            PG8_LDA(At, 1, 1); PG8_STAGE(PG8_SB(1, 0), b3, voffB); PG8_STAGE(PG8_SB(1, 1), b3 + hstepB, voffB); PG8_STAGE(PG8_SA(1, 0), a3, voffA);
            PG8_WAIT_V(8); PG8_WAIT_L(0); PG8_BAR; PG8_MMA(1, 0, At, B0); PG8_MMA(1, 1, At, B1); PG8_BAR; PG8_SCHED;
        }
        if (wr == 0) PG8_BAR;
        if constexpr (F8) {
            const int lnE = lane_now(); const int rowF = cur.pm * BM + wr * 64 + (lnE & 31), colF = cur.pn * BM + wc * 32 + 16 * (lnE >> 5);
            if constexpr (HasPre<Epi>::value) {
#pragma unroll
                for (int a = 0; a < 2; ++a)
#pragma unroll
                    for (int m2 = 0; m2 < 2; ++m2) { const int rowG = rowF + a * HALF + 32 * m2;
                        typename Epi::Pre pq[4];
#pragma unroll
                        for (int b = 0; b < 2; ++b) { pq[2 * b] = E.pre(rowG, colF + b * HALF); pq[2 * b + 1] = E.pre(rowG, colF + b * HALF + 8); }
                        __builtin_amdgcn_sched_barrier(0);
#pragma unroll
                        for (int b = 0; b < 2; ++b) { const f32x16 v = acc32[a][b][m2];
                            E.fin(rowG, colF + b * HALF, (f32x4){v[0], v[1], v[2], v[3]}, (f32x4){v[4], v[5], v[6], v[7]}, pq[2 * b]);
                            E.fin(rowG, colF + b * HALF + 8, (f32x4){v[8], v[9], v[10], v[11]}, (f32x4){v[12], v[13], v[14], v[15]}, pq[2 * b + 1]);
#pragma unroll
                            for (int i = 0; i < 16; ++i) acc32[a][b][m2][i] = 0.f; }
                        __builtin_amdgcn_sched_barrier(0); }
            } else {
#pragma unroll
            for (int a = 0; a < 2; ++a)
#pragma unroll
                for (int m2 = 0; m2 < 2; ++m2)
#pragma unroll
                    for (int b = 0; b < 2; ++b) { const f32x16 v = acc32[a][b][m2];
                        E.chunk(rowF + a * HALF + 32 * m2, colF + b * HALF, (f32x4){v[0], v[1], v[2], v[3]}, (f32x4){v[4], v[5], v[6], v[7]});
                        E.chunk(rowF + a * HALF + 32 * m2, colF + b * HALF + 8, (f32x4){v[8], v[9], v[10], v[11]}, (f32x4){v[12], v[13], v[14], v[15]});
#pragma unroll
                        for (int i = 0; i < 16; ++i) acc32[a][b][m2][i] = 0.f; }
            }
        } else {
            const int lnE = lane_now(); const int row0 = cur.pm * BM + wr * 64 + (lnE & 15), col0 = cur.pn * BM + wc * 32 + 8 * (lnE >> 4);
#pragma unroll
            for (int a = 0; a < 2; ++a)
#pragma unroll
                for (int m = 0; m < 4; ++m)
#pragma unroll
                    for (int b = 0; b < 2; ++b) E.chunk(row0 + a * HALF + m * 16, col0 + b * HALF, acc[a][b][m][0], acc[a][b][m][1]);
        }
        if (!has_next) break;
#pragma unroll
        for (int a = 0; a < 2; ++a)
#pragma unroll
            for (int b = 0; b < 2; ++b)
#pragma unroll
                for (int m = 0; m < 4; ++m)
#pragma unroll
                    for (int n = 0; n < 2; ++n) acc[a][b][m][n] = (f32x4){0.f, 0.f, 0.f, 0.f};
        cur = nxt; cA = nA; cB = nB; ++ui;
        if (wr == 1) PG8_BAR;
    }
    PG8_WAIT_V(0);
    PG8_BAR;
#undef PG8_SA
#undef PG8_SB
#undef PG8_STAGE
#undef PG8_LDA
#undef PG8_LD32
#undef PG8_LDB
#undef PG8_MMA
#undef PG8_WAIT_V
#undef PG8_WAIT_L
#undef PG8_BAR
#undef PG8_SCHED
#undef PG8_ACOL
}
}

constexpr int NWAVES = 8;
constexpr int D = 2048, BATCH = 4, SEQ = 8192, DEPTH = 4, M = BATCH * SEQ;
constexpr int NEXP = 16384, PLE = 256;
constexpr float LN_EPS = 1e-5f;
constexpr float DN_ALPHA = 1.681792830507429f;
constexpr float LOG2E = 1.4426950408889634f;
constexpr float ATTN_QSCALE = 0.08838834764831845f * LOG2E;
constexpr float W8S = 64.f, O8S = 16.f;

constexpr size_t MiB = 1u << 20;
constexpr size_t WS_CTL = 0, CTL_ZERO_BYTES = 1 * MiB;
constexpr size_t WS_STATS = WS_CTL + 512 * 1024;
constexpr size_t WS_W = 1 * MiB;
constexpr size_t W_POOL_IN = WS_W, W_POOL_GRP = W_POOL_IN + 16 * MiB, W_POOL_OUT = W_POOL_GRP + 4 * MiB;
constexpr size_t W_SSM_IN = W_POOL_OUT + 16 * MiB, W_SSM_GLU = W_SSM_IN + 8 * MiB, W_SSM_OUT = W_SSM_GLU + 8 * MiB;
constexpr size_t W_ATTN_QKV = W_SSM_OUT + 8 * MiB, W_ATTN_OUT = W_ATTN_QKV + 24 * MiB;
constexpr size_t W_PEER_Q = W_ATTN_OUT + 8 * MiB, W_PLE_GATE = W_PEER_Q + 32 * MiB, W_PLE_PROJ = W_PLE_GATE + 32 * MiB;
constexpr size_t WS_SK = W_PLE_PROJ + 4 * MiB;
constexpr size_t WS_TU = WS_SK + 1 * MiB;
constexpr size_t WS_TV = WS_TU + 256 * MiB;
constexpr size_t WS_PB = WS_TV + 256 * MiB;
constexpr size_t WS_HB0 = WS_PB + 64 * MiB, WS_HB1 = WS_HB0 + 128 * MiB;
constexpr size_t WS_T1 = WS_HB1 + 128 * MiB, WS_T2 = WS_T1 + 128 * MiB, WS_T3 = WS_T2 + 128 * MiB;
constexpr size_t WS_IDX = WS_T3 + 128 * MiB, WS_GATE = WS_IDX + 16 * MiB;
constexpr size_t WS_SSMP = WS_GATE + 16 * MiB;
constexpr size_t WS_SU = WS_SSMP + 2 * MiB, WS_SV = WS_SU + 1 * MiB;
constexpr size_t WS_S8 = WS_SV + 1 * MiB;
constexpr size_t WS_X8 = WS_S8 + 64 * MiB;
constexpr size_t WS_END = WS_X8 + 64 * MiB;
static_assert(WS_END <= 2048 * MiB, "d_ws map");
constexpr int CW_BAR = 4096;

constexpr int RING_BYTES = 131072;
constexpr int LDSCTL_OFF = RING_BYTES, MISC_OFF = LDSCTL_OFF + 320;
constexpr int LDS_BYTES = 147456;

#define LAS __attribute__((address_space(3)))
typedef unsigned short bf16;
typedef unsigned v4u __attribute__((ext_vector_type(4)));
typedef unsigned v2u __attribute__((ext_vector_type(2)));
typedef float f32x4 __attribute__((ext_vector_type(4)));
typedef float f32x16 __attribute__((ext_vector_type(16)));
typedef short bf16x8 __attribute__((ext_vector_type(8)));
typedef __bf16 bf16x2_t __attribute__((ext_vector_type(2)));
#define LDS_WAIT() asm volatile("s_waitcnt lgkmcnt(0)" ::: "memory")
#define VM_WAIT() asm volatile("s_waitcnt vmcnt(0)" ::: "memory")
__device__ __forceinline__ unsigned f2bf(float f) { unsigned u = __builtin_bit_cast(unsigned, f); return (u + 0x7fffu + ((u >> 16) & 1u)) >> 16; }
__device__ __forceinline__ unsigned pk2(float lo, float hi) { return f2bf(lo) | (f2bf(hi) << 16); }
__device__ __forceinline__ float bflo(unsigned w) { return __builtin_bit_cast(float, w << 16); }
__device__ __forceinline__ float bfhi(unsigned w) { return __builtin_bit_cast(float, w & 0xffff0000u); }
__device__ __forceinline__ float dot2bf(unsigned a, unsigned b, float c) { return __builtin_amdgcn_fdot2_f32_bf16(__builtin_bit_cast(bf16x2_t, a), __builtin_bit_cast(bf16x2_t, b), c, false); }
__device__ __forceinline__ float gelu_f(float v) {
    const float av = __builtin_fabsf(v), d = av * 0.2316418882f + 1.0f, t = __builtin_amdgcn_rcpf(d);
    float q = t * 0.5307027145f + (-0.7265760135f); q = q * t + 0.7107068705f; q = q * t + (-0.142248368f); q = q * t + 0.127414796f; q = q * t;
    const float e = __builtin_amdgcn_exp2f((v * v) * (-0.72134752044f));
    const float m = v * (q * e); return v < 0.f ? m : v - m;
}
#define WDPP(v, ctrl) __builtin_bit_cast(float, __builtin_amdgcn_update_dpp(0, __builtin_bit_cast(int, (v)), (ctrl), 0xF, 0xF, true))
#define WRL(v, l) __builtin_bit_cast(float, __builtin_amdgcn_readlane(__builtin_bit_cast(int, (v)), (l)))
__device__ __forceinline__ float wave_sum(float v) {
    v += WDPP(v, 0xB1); v += WDPP(v, 0x4E); v += WDPP(v, 0x141); v += WDPP(v, 0x140);
    return (WRL(v, 0) + WRL(v, 16)) + (WRL(v, 32) + WRL(v, 48));
}
__device__ __forceinline__ float shfl_xor_lane(float v, int m, int lane) { return __builtin_bit_cast(float, __builtin_amdgcn_ds_bpermute((lane ^ m) << 2, __builtin_bit_cast(int, v))); }
__device__ __forceinline__ int shfl_idx_lane(int v, int src) { return __builtin_amdgcn_ds_bpermute(src << 2, v); }
#define SHFL_XOR(v, m) shfl_xor_lane((v), (m), lane)

#define XB_TMO      128
#define XB_XCNT(j)  (256  + 64 * (j))
#define XB_XSUB(j)  (1280 + 64 * (j))
#define XB_XGEN(j)  (2304 + 64 * (j))
#define XB_TOP      3328
#define XB_TOPGEN   3392
#define XCD_BAR_WORDS 3456
#define XB_SPIN_CAP (1u << 23)

__device__ __forceinline__ unsigned xb_ld(unsigned* p)              { return __hip_atomic_load(p, __ATOMIC_RELAXED, __HIP_MEMORY_SCOPE_AGENT); }
__device__ __forceinline__ unsigned xb_add(unsigned* p, unsigned v) { return __hip_atomic_fetch_add(p, v, __ATOMIC_RELAXED, __HIP_MEMORY_SCOPE_AGENT); }
__device__ __forceinline__ unsigned xb_xcc_id() { return (unsigned)__builtin_amdgcn_s_getreg((3 << 11) | 20) & 0xFu; }
#define XB_SPIN(cond, bar) do { unsigned _sp = 0; while (cond) { __builtin_amdgcn_s_sleep(1); \
    if ((++_sp & 255u) == 0u) { if (xb_ld(&(bar)[XB_TMO])) break; if (_sp > XB_SPIN_CAP) { atomicAdd(&(bar)[XB_TMO], 1u); break; } } } } while (0)

struct XcdBarrier { unsigned* bar; unsigned x; volatile LAS unsigned* st; int wave; };
__device__ __forceinline__ int lane_id() { int l; asm volatile("v_mbcnt_lo_u32_b32 %0, -1, 0\n\tv_mbcnt_hi_u32_b32 %0, -1, %0" : "=v"(l)); return l; }

__device__ __forceinline__ XcdBarrier xcd_barrier_post(unsigned* bar, volatile LAS unsigned* st) {
    XcdBarrier b; b.bar = bar; b.x = xb_xcc_id(); b.st = st; b.wave = __builtin_amdgcn_readfirstlane((int)(threadIdx.x >> 6));
    if (threadIdx.x == 0) (void)xb_add(&bar[XB_XCNT(b.x)], 1u);
    return b;
}
__device__ __forceinline__ void xcd_barrier_complete(unsigned* bar, unsigned x, unsigned& nloc, unsigned& nx) {
    const unsigned G = gridDim.x * gridDim.y * gridDim.z;
    unsigned sum, cnt, mine, sp = 0u;
    for (;;) {
        sum = 0u; cnt = 0u; mine = 0u;
#pragma unroll
        for (unsigned j = 0; j < 16; ++j) { const unsigned c = xb_ld(&bar[XB_XCNT(j)]); sum += c; cnt += (c > 0u) ? 1u : 0u; mine = (j == x) ? c : mine; }
        if (sum == G) break;
        __builtin_amdgcn_s_sleep(1);
        if ((++sp & 255u) == 0u) { if (xb_ld(&bar[XB_TMO])) break; if (sp > XB_SPIN_CAP) { atomicAdd(&bar[XB_TMO], 1u); break; } }
    }
    nloc = mine > 0u ? mine : 1u; nx = cnt > 0u ? cnt : 1u;
}
__device__ __forceinline__ void xcd_barrier(const XcdBarrier& b_in) {
    asm volatile("s_waitcnt vmcnt(0)" ::: "memory");
    __syncthreads();
    if (b_in.wave == 0 && lane_id() == 0) {
        XcdBarrier b = b_in; asm volatile("" : "+s"(b.x)); asm volatile("" : "+s"(b.bar));
        unsigned* bar = b.bar;
        __builtin_amdgcn_s_waitcnt(0);
        unsigned nloc = b.st[0], nx = b.st[1];
        if (nloc == 0u) { xcd_barrier_complete(bar, b.x, nloc, nx); b.st[0] = nloc; b.st[1] = nx; }
        const unsigned old = xb_add(&bar[XB_XSUB(b.x)], 1u);
        const unsigned gen = old / nloc;
        if (old + 1u == (gen + 1u) * nloc) {
            __builtin_amdgcn_fence(__ATOMIC_RELEASE, "agent");
            asm volatile("s_waitcnt vmcnt(0)" ::: "memory");
            const unsigned og = xb_add(&bar[XB_TOP], 1u);
            const unsigned tg = og / nx;
            if (og + 1u == (tg + 1u) * nx) xb_add(&bar[XB_TOPGEN], 1u);
            else XB_SPIN(xb_ld(&bar[XB_TOPGEN]) == tg, bar);
            __builtin_amdgcn_fence(__ATOMIC_ACQUIRE, "agent");
            xb_add(&bar[XB_XGEN(b.x)], 1u);
            asm volatile("s_waitcnt vmcnt(0)" ::: "memory");
        } else {
            XB_SPIN(xb_ld(&bar[XB_XGEN(b.x)]) == gen, bar);
            __builtin_amdgcn_fence(__ATOMIC_ACQUIRE, "agent");
            asm volatile("s_waitcnt vmcnt(0)" ::: "memory");
        }
    }
    __syncthreads();
}

__device__ __forceinline__ void transpose_item(const float* W, int K, int N, bf16* WT, int row_off, LAS float* scr, int item, int lane) {
    const int nblk = N / 32, kb = item / nblk, nb = item % nblk, k0 = 64 * kb, n0 = 32 * nb;
    const __attribute__((address_space(1))) float* Wg = (const __attribute__((address_space(1))) float*)W + (size_t)(k0 + (lane >> 5)) * N + n0 + (lane & 31);
    float v[32];
#pragma unroll
    for (int i = 0; i < 32; ++i) v[i] = Wg[(size_t)(2 * i) * N];
#pragma unroll
    for (int i = 0; i < 32; ++i) scr[(2 * i + (lane >> 5)) * 33 + (lane & 31)] = v[i];
    LDS_WAIT(); asm volatile("" ::: "memory");
    const int c = lane & 7;
#pragma unroll
    for (int j = 0; j < 4; ++j) { const int n = (lane >> 3) + 8 * j; const LAS float* s = scr + (8 * c) * 33 + n;
        v4u o; o.x = pk2(s[0 * 33], s[1 * 33]); o.y = pk2(s[2 * 33], s[3 * 33]); o.z = pk2(s[4 * 33], s[5 * 33]); o.w = pk2(s[6 * 33], s[7 * 33]);
        *(v4u*)(WT + (size_t)(row_off + n0 + n) * K + k0 + 8 * c) = o; }
    LDS_WAIT(); asm volatile("" ::: "memory");
}
__device__ __forceinline__ void transpose_item8(const float* W, int K, int N, unsigned char* WT, int row_off, LAS float* scr, int item, int lane) {
    const int nblk = N / 32, kb = item / nblk, nb = item % nblk, k0 = 64 * kb, n0 = 32 * nb;
#pragma unroll 8
    for (int i = 0; i < 32; ++i) { const int kk = 2 * i + (lane >> 5); scr[kk * 33 + (lane & 31)] = W[(size_t)(k0 + kk) * N + n0 + (lane & 31)]; }
    LDS_WAIT(); asm volatile("" ::: "memory");
    const int c = lane & 7;
#pragma unroll
    for (int j = 0; j < 4; ++j) { const int n = (lane >> 3) + 8 * j; const LAS float* sp = scr + (8 * c) * 33 + n;
        int a = 0, b = 0;
        a = __builtin_amdgcn_cvt_pk_fp8_f32(sp[0 * 33] * W8S, sp[1 * 33] * W8S, a, false); a = __builtin_amdgcn_cvt_pk_fp8_f32(sp[2 * 33] * W8S, sp[3 * 33] * W8S, a, true);
        b = __builtin_amdgcn_cvt_pk_fp8_f32(sp[4 * 33] * W8S, sp[5 * 33] * W8S, b, false); b = __builtin_amdgcn_cvt_pk_fp8_f32(sp[6 * 33] * W8S, sp[7 * 33] * W8S, b, true);
        v2u o; o.x = (unsigned)a; o.y = (unsigned)b;
        *(v2u*)(WT + (size_t)(row_off + n0 + n) * K + k0 + 8 * c) = o; }
    LDS_WAIT(); asm volatile("" ::: "memory");
}
__device__ __forceinline__ void transpose_item8b(const float* W, int K, int N, unsigned char* WT, int row_off, LAS unsigned* scr, int item, int lane) {
    const int nblk = N / 64, kb = item / nblk, nb = item % nblk, k0 = 128 * kb, n0 = 64 * nb;
    const int r4 = lane >> 4, l15 = lane & 15;
    f32x4 v[32];
#pragma unroll
    for (int i = 0; i < 32; ++i) v[i] = *(const __attribute__((address_space(1))) f32x4*)(W + (size_t)(k0 + 32 * r4 + i) * N + n0 + 4 * l15);
#pragma unroll
    for (int i4 = 0; i4 < 8; ++i4) {
        const f32x4 q0 = v[4 * i4] * W8S, q1 = v[4 * i4 + 1] * W8S, q2 = v[4 * i4 + 2] * W8S, q3 = v[4 * i4 + 3] * W8S;
        int a0 = 0, a1 = 0, a2 = 0, a3 = 0;
        a0 = __builtin_amdgcn_cvt_pk_fp8_f32(q0.x, q1.x, a0, false); a0 = __builtin_amdgcn_cvt_pk_fp8_f32(q2.x, q3.x, a0, true);
        a1 = __builtin_amdgcn_cvt_pk_fp8_f32(q0.y, q1.y, a1, false); a1 = __builtin_amdgcn_cvt_pk_fp8_f32(q2.y, q3.y, a1, true);
        a2 = __builtin_amdgcn_cvt_pk_fp8_f32(q0.z, q1.z, a2, false); a2 = __builtin_amdgcn_cvt_pk_fp8_f32(q2.z, q3.z, a2, true);
        a3 = __builtin_amdgcn_cvt_pk_fp8_f32(q0.w, q1.w, a3, false); a3 = __builtin_amdgcn_cvt_pk_fp8_f32(q2.w, q3.w, a3, true);
        LAS unsigned* rowp = scr + (8 * r4 + i4) * 64;
        rowp[(4 * l15 + 0 + r4) & 63] = (unsigned)a0; rowp[(4 * l15 + 1 + r4) & 63] = (unsigned)a1; rowp[(4 * l15 + 2 + r4) & 63] = (unsigned)a2; rowp[(4 * l15 + 3 + r4) & 63] = (unsigned)a3; }
    LDS_WAIT(); asm volatile("" ::: "memory");
    unsigned char* orow = WT + (size_t)(row_off + n0 + lane) * K + k0;
#pragma unroll
    for (int q = 0; q < 8; ++q) { v4u o;
        o.x = scr[(4 * q + 0) * 64 + ((lane + (q >> 1)) & 63)]; o.y = scr[(4 * q + 1) * 64 + ((lane + (q >> 1)) & 63)]; o.z = scr[(4 * q + 2) * 64 + ((lane + (q >> 1)) & 63)]; o.w = scr[(4 * q + 3) * 64 + ((lane + (q >> 1)) & 63)];
        *(__attribute__((address_space(1))) v4u*)(orow + 16 * q) = o; }
    LDS_WAIT(); asm volatile("" ::: "memory");
}
__device__ __forceinline__ void transpose_mat8b(const float* W, int K, int N, unsigned char* WT, int row_off, LAS unsigned* scr, int gw, int NGW, int lane, int& woff) {
    const int nit = (K / 128) * (N / 64);
    int sgw = gw - woff % NGW; if (sgw < 0) sgw += NGW;
    for (int it = sgw; it < nit; it += NGW) transpose_item8b(W, K, N, WT, row_off, scr, it, lane);
    woff += nit;
}
__device__ __forceinline__ void transpose_mat8(const float* W, int K, int N, unsigned char* WT, int row_off, LAS float* scr, int gw, int NGW, int lane) {
    const int nit = (K / 64) * (N / 32);
    for (int it = gw; it < nit; it += NGW) transpose_item8(W, K, N, WT, row_off, scr, it, lane);
}
__device__ __forceinline__ void transpose_mat(const float* W, int K, int N, bf16* WT, int row_off, LAS float* scr, int gw, int NGW, int lane, int& woff) {
    const int nit = (K / 64) * (N / 32);
    int sgw = gw - woff % NGW; if (sgw < 0) sgw += NGW;
    for (int it = sgw; it < nit; it += NGW) transpose_item(W, K, N, WT, row_off, scr, it, lane);
    woff += nit;
}
__device__ __forceinline__ void cvt_rows(const float* src, bf16* dst, size_t n, size_t gtid, size_t gthreads) {
    size_t i = gtid * 8;
    for (; i + 3 * gthreads * 8 < n; i += gthreads * 32) {
        f32x4 a[4], b[4];
#pragma unroll
        for (int u = 0; u < 4; ++u) { a[u] = *(const __attribute__((address_space(1))) f32x4*)(src + i + u * gthreads * 8); b[u] = *(const __attribute__((address_space(1))) f32x4*)(src + i + u * gthreads * 8 + 4); }
#pragma unroll
        for (int u = 0; u < 4; ++u) { v4u o; o.x = pk2(a[u].x, a[u].y); o.y = pk2(a[u].z, a[u].w); o.z = pk2(b[u].x, b[u].y); o.w = pk2(b[u].z, b[u].w);
            *(__attribute__((address_space(1))) v4u*)(dst + i + u * gthreads * 8) = o; }
    }
    for (; i < n; i += gthreads * 8) {
        const f32x4 a = *(const f32x4*)(src + i), b = *(const f32x4*)(src + i + 4);
        v4u o; o.x = pk2(a.x, a.y); o.y = pk2(a.z, a.w); o.z = pk2(b.x, b.y); o.w = pk2(b.z, b.w);
        *(v4u*)(dst + i) = o;
    }
}


#define GAS __attribute__((address_space(1)))
typedef unsigned char u8;
typedef float f32x2 __attribute__((ext_vector_type(2)));
constexpr float TU_SCALE = 64.f, TV_SCALE = 4.f;
__device__ __forceinline__ v4u gld16(const void* p) { return *(const GAS v4u*)p; }
__device__ __forceinline__ void cvt_rows_fp8(const float* src, u8* dst, size_t n, float scale, size_t gtid, size_t gthreads) {
    for (size_t i = gtid * 16; i < n; i += gthreads * 16) {
        const GAS f32x4* p = (const GAS f32x4*)(src + i);
        const f32x4 a = p[0] * scale, b = p[1] * scale, c = p[2] * scale, d = p[3] * scale;
        int w0 = 0, w1 = 0, w2 = 0, w3 = 0;
        w0 = __builtin_amdgcn_cvt_pk_fp8_f32(a.x, a.y, w0, false); w0 = __builtin_amdgcn_cvt_pk_fp8_f32(a.z, a.w, w0, true);
        w1 = __builtin_amdgcn_cvt_pk_fp8_f32(b.x, b.y, w1, false); w1 = __builtin_amdgcn_cvt_pk_fp8_f32(b.z, b.w, w1, true);
        w2 = __builtin_amdgcn_cvt_pk_fp8_f32(c.x, c.y, w2, false); w2 = __builtin_amdgcn_cvt_pk_fp8_f32(c.z, c.w, w2, true);
        w3 = __builtin_amdgcn_cvt_pk_fp8_f32(d.x, d.y, w3, false); w3 = __builtin_amdgcn_cvt_pk_fp8_f32(d.z, d.w, w3, true);
        v4u o; o.x = (unsigned)w0; o.y = (unsigned)w1; o.z = (unsigned)w2; o.w = (unsigned)w3;
        *(GAS v4u*)(dst + i) = o;
    }
}

template <bool X4 = false>
__device__ __forceinline__ void ln_phase(bf16* S, const float* g, const float* b, int gw, int NGW, int lane, unsigned char* f8 = nullptr, unsigned char* f8b = nullptr, float* stats = nullptr) {
    for (int m = gw; m < M; m += NGW) {
        bf16* row = S + (size_t)m * D + 8 * lane;
        float v[32]; float s = 0.f;
#pragma unroll
        for (int j = 0; j < 4; ++j) { const v4u w = *(const GAS v4u*)(row + 512 * j);
            v[8 * j + 0] = bflo(w.x); v[8 * j + 1] = bfhi(w.x); v[8 * j + 2] = bflo(w.y); v[8 * j + 3] = bfhi(w.y); v[8 * j + 4] = bflo(w.z); v[8 * j + 5] = bfhi(w.z); v[8 * j + 6] = bflo(w.w); v[8 * j + 7] = bfhi(w.w); }
#pragma unroll
        for (int i = 0; i < 32; ++i) s += v[i];
        const float mean = wave_sum(s) * (1.f / D); float s2 = 0.f;
#pragma unroll
        for (int i = 0; i < 32; ++i) { v[i] -= mean; s2 += v[i] * v[i]; }
        const float rstd = 1.f / sqrtf(wave_sum(s2) * (1.f / D) + LN_EPS);
        if constexpr (X4) { if (lane == 0) *(GAS f32x2*)(stats + 2 * (size_t)m) = (f32x2){mean, rstd}; }
#pragma unroll
        for (int j = 0; j < 4; ++j) { const float* gp = g + 512 * j + 8 * lane; const float* bp = b + 512 * j + 8 * lane;
            const f32x4 g0 = *(const GAS f32x4*)gp, g1 = *(const GAS f32x4*)(gp + 4), b0 = *(const GAS f32x4*)bp, b1 = *(const GAS f32x4*)(bp + 4);
            v4u w; w.x = pk2(v[8 * j + 0] * rstd * g0.x + b0.x, v[8 * j + 1] * rstd * g0.y + b0.y); w.y = pk2(v[8 * j + 2] * rstd * g0.z + b0.z, v[8 * j + 3] * rstd * g0.w + b0.w);
            w.z = pk2(v[8 * j + 4] * rstd * g1.x + b1.x, v[8 * j + 5] * rstd * g1.y + b1.y); w.w = pk2(v[8 * j + 6] * rstd * g1.z + b1.z, v[8 * j + 7] * rstd * g1.w + b1.w);
            if constexpr (!X4) *(GAS v4u*)(row + 512 * j) = w;
            if constexpr (X4) {
                const float y0 = v[8 * j + 0] * rstd * g0.x + b0.x, y1 = v[8 * j + 1] * rstd * g0.y + b0.y, y2 = v[8 * j + 2] * rstd * g0.z + b0.z, y3 = v[8 * j + 3] * rstd * g0.w + b0.w;
                const float y4 = v[8 * j + 4] * rstd * g1.x + b1.x, y5 = v[8 * j + 5] * rstd * g1.y + b1.y, y6 = v[8 * j + 6] * rstd * g1.z + b1.z, y7 = v[8 * j + 7] * rstd * g1.w + b1.w;
                unsigned wh = 0u; wh = __builtin_amdgcn_cvt_scalef32_pk_fp4_f32(wh, y0, y1, 1.0f, 0); wh = __builtin_amdgcn_cvt_scalef32_pk_fp4_f32(wh, y2, y3, 1.0f, 1);
                wh = __builtin_amdgcn_cvt_scalef32_pk_fp4_f32(wh, y4, y5, 1.0f, 2); wh = __builtin_amdgcn_cvt_scalef32_pk_fp4_f32(wh, y6, y7, 1.0f, 3);
                const f32x2 h01 = __builtin_amdgcn_cvt_scalef32_pk_f32_fp4(wh, 1.0f, 0), h23 = __builtin_amdgcn_cvt_scalef32_pk_f32_fp4(wh, 1.0f, 1), h45 = __builtin_amdgcn_cvt_scalef32_pk_f32_fp4(wh, 1.0f, 2), h67 = __builtin_amdgcn_cvt_scalef32_pk_f32_fp4(wh, 1.0f, 3);
                unsigned wl = 0u; wl = __builtin_amdgcn_cvt_scalef32_pk_fp4_f32(wl, (y0 - h01.x) * 8.f, (y1 - h01.y) * 8.f, 1.0f, 0); wl = __builtin_amdgcn_cvt_scalef32_pk_fp4_f32(wl, (y2 - h23.x) * 8.f, (y3 - h23.y) * 8.f, 1.0f, 1);
                wl = __builtin_amdgcn_cvt_scalef32_pk_fp4_f32(wl, (y4 - h45.x) * 8.f, (y5 - h45.y) * 8.f, 1.0f, 2); wl = __builtin_amdgcn_cvt_scalef32_pk_fp4_f32(wl, (y6 - h67.x) * 8.f, (y7 - h67.y) * 8.f, 1.0f, 3);
                unsigned char* xq = f8 + (size_t)m * 2048 + 256 * j + 4 * lane;
                *(GAS unsigned*)xq = wh; *(GAS unsigned*)(xq + 1024) = wl;
                int a8 = 0, b8 = 0;
                a8 = __builtin_amdgcn_cvt_pk_fp8_f32(y0, y1, a8, false); a8 = __builtin_amdgcn_cvt_pk_fp8_f32(y2, y3, a8, true);
                b8 = __builtin_amdgcn_cvt_pk_fp8_f32(y4, y5, b8, false); b8 = __builtin_amdgcn_cvt_pk_fp8_f32(y6, y7, b8, true);
                v2u o8; o8.x = (unsigned)a8; o8.y = (unsigned)b8; *(GAS v2u*)(f8b + (size_t)m * D + 512 * j + 8 * lane) = o8; }
            else if (f8 != nullptr) { int a8 = 0, b8 = 0;
                a8 = __builtin_amdgcn_cvt_pk_fp8_f32(v[8 * j + 0] * rstd * g0.x + b0.x, v[8 * j + 1] * rstd * g0.y + b0.y, a8, false); a8 = __builtin_amdgcn_cvt_pk_fp8_f32(v[8 * j + 2] * rstd * g0.z + b0.z, v[8 * j + 3] * rstd * g0.w + b0.w, a8, true);
                b8 = __builtin_amdgcn_cvt_pk_fp8_f32(v[8 * j + 4] * rstd * g1.x + b1.x, v[8 * j + 5] * rstd * g1.y + b1.y, b8, false); b8 = __builtin_amdgcn_cvt_pk_fp8_f32(v[8 * j + 6] * rstd * g1.z + b1.z, v[8 * j + 7] * rstd * g1.w + b1.w, b8, true);
                v2u o8; o8.x = (unsigned)a8; o8.y = (unsigned)b8; *(GAS v2u*)(f8 + (size_t)m * D + 512 * j + 8 * lane) = o8; } }
    }
}

__device__ __forceinline__ void pool_phase(const bf16* U, unsigned char* P, int gw, int NGW, int lane) {
    for (int it = gw; it < (M / 64) * 4; it += NGW) {
        const int g = it & 3, t0 = (it >> 2) * 64, w = 2 << g, col = g * 512 + 8 * lane;
        const int s0 = t0 & (SEQ - 1);
        float a[8];
#pragma unroll
        for (int i = 0; i < 8; ++i) a[i] = 0.f;
        const bf16* base = U + (size_t)t0 * D + col;
        const int nb = (s0 < w - 1) ? s0 : (w - 1);
        for (int r = 1; r <= nb; ++r) { const v4u x = *(const GAS v4u*)(base - (size_t)r * D);
            a[0] += bflo(x.x); a[1] += bfhi(x.x); a[2] += bflo(x.y); a[3] += bfhi(x.y); a[4] += bflo(x.z); a[5] += bfhi(x.z); a[6] += bflo(x.w); a[7] += bfhi(x.w); }
#pragma unroll 4
        for (int t = 0; t < 64; ++t) {
            const int s = s0 + t;
            const v4u cur = *(const GAS v4u*)(base + (size_t)t * D);
            a[0] += bflo(cur.x); a[1] += bfhi(cur.x); a[2] += bflo(cur.y); a[3] += bfhi(cur.y); a[4] += bflo(cur.z); a[5] += bfhi(cur.z); a[6] += bflo(cur.w); a[7] += bfhi(cur.w);
            const int n = (s + 1 < w) ? (s + 1) : w;
            const float inv = 1.f / (float)n;
            int w0 = 0, w1 = 0;
            w0 = __builtin_amdgcn_cvt_pk_fp8_f32(a[0] * inv - bflo(cur.x), a[1] * inv - bfhi(cur.x), w0, false); w0 = __builtin_amdgcn_cvt_pk_fp8_f32(a[2] * inv - bflo(cur.y), a[3] * inv - bfhi(cur.y), w0, true);
            w1 = __builtin_amdgcn_cvt_pk_fp8_f32(a[4] * inv - bflo(cur.z), a[5] * inv - bfhi(cur.z), w1, false); w1 = __builtin_amdgcn_cvt_pk_fp8_f32(a[6] * inv - bflo(cur.w), a[7] * inv - bfhi(cur.w), w1, true);
            v2u o; o.x = (unsigned)w0; o.y = (unsigned)w1;
            *(GAS v2u*)(P + (size_t)(t0 + t) * D + col) = o;
            if (s + 1 >= w) { const v4u x = *(const GAS v4u*)(base + (size_t)(t + 1 - w) * D);
                a[0] -= bflo(x.x); a[1] -= bfhi(x.x); a[2] -= bflo(x.y); a[3] -= bfhi(x.y); a[4] -= bflo(x.z); a[5] -= bfhi(x.z); a[6] -= bflo(x.w); a[7] -= bfhi(x.w); }
        }
    }
}

typedef __bf16 bf16x2v __attribute__((ext_vector_type(2)));
__device__ __forceinline__ unsigned cvtpk(float lo, float hi) { const f32x2 v = {lo, hi}; return __builtin_bit_cast(unsigned, __builtin_convertvector(v, bf16x2v)); }
constexpr int SSM_L = 1664, SSM_L3 = SEQ - 3 * SSM_L;
static_assert(SSM_L % 64 == 0 && SSM_L3 % 64 == 0 && SSM_L3 > 0, "segments");
template <bool WR>
__device__ __forceinline__ void ssm_block16m(const bf16x8 ua, const bf16x8 (&BbR)[4], const bf16x8 (&BbI)[4], LAS unsigned char* bubuf, LAS unsigned char* hbuf, const f32x2 ar2, const f32x2 ai2, f32x2& h2, int p, int lane) {
    f32x4 dr[4], di[4];
    const f32x4 z = {0.f, 0.f, 0.f, 0.f};
    __builtin_amdgcn_sched_barrier(0);
    asm volatile("s_nop 15\n\ts_nop 15\n\ts_nop 15\n\ts_nop 15" ::: "memory");
    __builtin_amdgcn_sched_barrier(0);
#pragma unroll
    for (int pt = 0; pt < 4; ++pt) { dr[pt] = __builtin_amdgcn_mfma_f32_16x16x32_bf16(ua, BbR[pt], z, 0, 0, 0); di[pt] = __builtin_amdgcn_mfma_f32_16x16x32_bf16(ua, BbI[pt], z, 0, 0, 0); }
    __builtin_amdgcn_sched_barrier(0);
    asm volatile("s_nop 15\n\ts_nop 15\n\ts_nop 15\n\ts_nop 15\n\ts_nop 15\n\ts_nop 15\n\ts_nop 15\n\ts_nop 15" ::: "memory");
    __builtin_amdgcn_sched_barrier(0);
#pragma unroll
    for (int pt = 0; pt < 4; ++pt)
#pragma unroll
        for (int r = 0; r < 4; ++r) *(LAS f32x2*)(bubuf + (4 * (lane >> 4) + r) * 528 + (16 * pt + (lane & 15)) * 8) = (f32x2){dr[pt][r], di[pt][r]};
    LDS_WAIT();
#pragma unroll
    for (int l = 0; l < 16; ++l) {
        const f32x2 bu = *(const LAS f32x2*)(bubuf + l * 528 + p * 8);
        float tx, ty, nx, ny; const float hx = h2.x, hy = h2.y, bux = bu.x, buy = bu.y, arx = ar2.x, aix = ai2.x, aiy = ai2.y;
        asm("v_fma_f32 %0, %1, %2, %3" : "=v"(tx) : "v"(arx), "v"(hx), "v"(bux));
        asm("v_fma_f32 %0, %1, %2, %3" : "=v"(ty) : "v"(arx), "v"(hy), "v"(buy));
        asm("v_fma_f32 %0, %1, %2, %3" : "=v"(nx) : "v"(aix), "v"(hy), "v"(tx));
        asm("v_fma_f32 %0, %1, %2, %3" : "=v"(ny) : "v"(aiy), "v"(hx), "v"(ty));
        h2 = (f32x2){nx, ny};
        if (WR) *(LAS unsigned*)(hbuf + l * 272 + 4 * p) = cvtpk(h2.x, h2.y);
    }
}
__device__ __forceinline__ void ssm_phase_m(const bf16* U, unsigned char* Y, const float* ssmp,
                                          const float* c_re, const float* c_im, const float* d_skip, LAS unsigned char* lds, int vcu, int G, int wave, int lane) {
    LAS unsigned char* hbuf = lds + wave * 16384;
    LAS unsigned char* ebuf = lds + wave * 16384 + 4352;
    LAS unsigned char* bubuf = lds + wave * 16384 + 4864;
    const int ntask = BATCH * 128 * 4;
    for (int tb = vcu * NWAVES; tb < ntask; tb += G * NWAVES) {
        const int task = tb + wave, seg = (wave + 3 * (wave >> 2)) & 3, g = (task >> 2) & 127, b = task >> 9, p = lane;
        const float* pp_ = ssmp + (size_t)(g * 64 + p) * 34;
        const float ar = pp_[0], ai = pp_[1];
        const int cc = lane & 15, kg = lane >> 4;
        bf16x8 BbR[4], BbI[4];
#pragma unroll
        for (int pt = 0; pt < 4; ++pt) { const float* q_ = ssmp + (size_t)(g * 64 + 16 * pt + cc) * 34 + 8 * (kg & 1);
            v4u tr, ti; tr.x = cvtpk(q_[2], q_[3]); tr.y = cvtpk(q_[4], q_[5]); tr.z = cvtpk(q_[6], q_[7]); tr.w = cvtpk(q_[8], q_[9]);
            ti.x = cvtpk(q_[18], q_[19]); ti.y = cvtpk(q_[20], q_[21]); ti.z = cvtpk(q_[22], q_[23]); ti.w = cvtpk(q_[24], q_[25]);
            if (kg >= 2) { tr = (v4u){0u, 0u, 0u, 0u}; ti = (v4u){0u, 0u, 0u, 0u}; }
            BbR[pt] = __builtin_bit_cast(bf16x8, tr); BbI[pt] = __builtin_bit_cast(bf16x8, ti); }
        const int tstart = seg * SSM_L, tlen = (seg == 3) ? SSM_L3 : SSM_L;
        const bf16* ub = U + ((size_t)b * SEQ + tstart) * D + g * 16;
        const bf16* ua_p = ub + (size_t)(lane & 15) * D + 8 * (kg & 1);
        unsigned char* yb = Y + ((size_t)b * SEQ + tstart) * D + g * 16;
        const f32x2 ar2 = {ar, ar}, ai2 = {-ai, ai};
        f32x2 h2 = {0.f, 0.f};
        const v4u zero4 = {0u, 0u, 0u, 0u};
        if (seg < 3) {
            v4u pre[4];
#pragma unroll
            for (int i = 0; i < 4; ++i) pre[i] = *(const GAS v4u*)(ua_p + (size_t)(16 * i) * D);
            for (int t0 = 0; t0 < SSM_L; t0 += 64) {
                v4u cur[4];
#pragma unroll
                for (int i = 0; i < 4; ++i) cur[i] = (kg < 2) ? pre[i] : zero4;
                if (t0 + 64 < SSM_L) {
#pragma unroll
                    for (int i = 0; i < 4; ++i) pre[i] = *(const GAS v4u*)(ua_p + (size_t)(t0 + 64 + 16 * i) * D); }
#pragma unroll
                for (int blk = 0; blk < 4; ++blk) { ssm_block16m<false>(__builtin_bit_cast(bf16x8, cur[blk]), BbR, BbI, bubuf, hbuf, ar2, ai2, h2, p, lane); LDS_WAIT(); }
            }
            *(LAS f32x2*)(ebuf + 8 * p) = h2;
        }
        LDS_WAIT();
        __syncthreads();
        {
            f32x2 pw = {1.f, 0.f}, base = {ar, ai};
#pragma unroll 1
            for (int bit = SSM_L; bit > 0; bit >>= 1) {
                if (bit & 1) pw = (f32x2){pw.x * base.x - pw.y * base.y, pw.x * base.y + pw.y * base.x};
                base = (f32x2){base.x * base.x - base.y * base.y, 2.f * base.x * base.y};
            }
            LAS unsigned char* e0 = lds + (wave & 4) * 16384 + 4352;
            f32x2 sst = {0.f, 0.f};
            for (int j = 0; j < seg; ++j) { const f32x2 e = *(const LAS f32x2*)(e0 + ((j + (wave >> 2)) & 3) * 16384 + 8 * p);
                sst = (f32x2){pw.x * sst.x - pw.y * sst.y + e.x, pw.x * sst.y + pw.y * sst.x + e.y}; }
            h2 = sst;
        }
        bf16x8 cB[4];
#pragma unroll
        for (int ks = 0; ks < 4; ++ks) { unsigned w[4];
#pragma unroll
            for (int jj = 0; jj < 4; ++jj) { const int k = 32 * ks + 8 * (lane >> 4) + 2 * jj, pp = k >> 1;
                w[jj] = cvtpk(c_re[(g * 16 + cc) * 64 + pp], -c_im[(g * 16 + cc) * 64 + pp]); }
            v4u t; t.x = w[0]; t.y = w[1]; t.z = w[2]; t.w = w[3]; cB[ks] = __builtin_bit_cast(bf16x8, t); }
        const float dd = d_skip[g * 16 + cc];
        {
            v4u pre[4];
#pragma unroll
            for (int i = 0; i < 4; ++i) pre[i] = *(const GAS v4u*)(ua_p + (size_t)(16 * i) * D);
            for (int t0 = 0; t0 < tlen; t0 += 64) {
                v4u cur[4];
#pragma unroll
                for (int i = 0; i < 4; ++i) cur[i] = (kg < 2) ? pre[i] : zero4;
                if (t0 + 64 < tlen) {
#pragma unroll
                    for (int i = 0; i < 4; ++i) pre[i] = *(const GAS v4u*)(ua_p + (size_t)(t0 + 64 + 16 * i) * D); }
#pragma unroll
                for (int blk = 0; blk < 4; ++blk) {
                    unsigned short uq[4];
#pragma unroll
                    for (int r = 0; r < 4; ++r) uq[r] = *(const GAS unsigned short*)(ub + (size_t)(t0 + 16 * blk + 4 * (lane >> 4) + r) * D + cc);
                    ssm_block16m<true>(__builtin_bit_cast(bf16x8, cur[blk]), BbR, BbI, bubuf, hbuf, ar2, ai2, h2, p, lane);
                    LDS_WAIT();
                    f32x4 acc = (f32x4){0.f, 0.f, 0.f, 0.f};
#pragma unroll
                    for (int ks = 0; ks < 4; ++ks) { const bf16x8 a = *(const LAS bf16x8*)(hbuf + (lane & 15) * 272 + 16 * (lane >> 4) + 64 * ks);
                        acc = __builtin_amdgcn_mfma_f32_16x16x32_bf16(a, cB[ks], acc, 0, 0, 0); }
#pragma unroll
                    for (int r = 0; r < 4; ++r) { const int l = 4 * (lane >> 4) + r;
                        const float uu = __builtin_bit_cast(float, (unsigned)uq[r] << 16);
                        const float y = acc[r] + dd * uu;
                        *(GAS unsigned char*)(yb + (size_t)(t0 + 16 * blk + l) * D + cc) = (unsigned char)(__builtin_amdgcn_cvt_pk_fp8_f32(gelu_f(y), 0.f, 0, false) & 0xff); }
                    LDS_WAIT();
                }
            }
        }
        __syncthreads();
    }
}

__device__ __forceinline__ void attn_tile(const bf16* Kbh, const bf16* Vbh, const LAS float* rbh, int kp0, bool has_next, int qpos, int hl, int lane,
                                          const bf16x8 (&kc)[8], bf16x8 (&kn)[8], const bf16x8 (&qf)[8], f32x16 (&o)[4], float& mrun, float& lrun) {
    bf16x8 vf[8];
    { const bf16* vp = Vbh + (size_t)(kp0 >> 5) * 4096 + (size_t)lane * 8;
#pragma unroll
      for (int q = 0; q < 8; ++q) vf[q] = *(const GAS bf16x8*)(vp + 512 * q); }
    if (has_next) { const bf16* kp = Kbh + (size_t)((kp0 >> 5) + 1) * 4096 + (size_t)lane * 8;
#pragma unroll
      for (int ks = 0; ks < 8; ++ks) kn[ks] = *(const GAS bf16x8*)(kp + 512 * ks); }
    __builtin_amdgcn_sched_barrier(0);
    f32x16 s;
#pragma unroll
    for (int i = 0; i < 16; ++i) s[i] = 0.f;
#pragma unroll
    for (int ks = 0; ks < 8; ++ks) s = __builtin_amdgcn_mfma_f32_32x32x16_bf16(kc[ks], qf[ks], s, 0, 0, 0);
    float tmax = -1e30f;
#pragma unroll
    for (int i = 0; i < 16; ++i) { const int kpos = kp0 + (i & 3) + 8 * (i >> 2) + 4 * hl; int rel = qpos - kpos; rel = rel > 128 ? 128 : rel; s[i] += rbh[rel + 128]; tmax = fmaxf(tmax, s[i]); }
    tmax = fmaxf(tmax, SHFL_XOR(tmax, 32));
    const float mnew = fmaxf(mrun, tmax), alpha = __builtin_amdgcn_exp2f(mrun - mnew);
    float rs = 0.f;
#pragma unroll
    for (int i = 0; i < 16; ++i) { s[i] = __builtin_amdgcn_exp2f(s[i] - mnew); rs += s[i]; }
    rs += SHFL_XOR(rs, 32);
    lrun = lrun * alpha + rs; mrun = mnew;
    bf16x8 pf[2];
#pragma unroll
    for (int sidx = 0; sidx < 2; ++sidx) { v4u t; t.x = cvtpk(s[8 * sidx + 0], s[8 * sidx + 1]); t.y = cvtpk(s[8 * sidx + 2], s[8 * sidx + 3]);
        t.z = cvtpk(s[8 * sidx + 4], s[8 * sidx + 5]); t.w = cvtpk(s[8 * sidx + 6], s[8 * sidx + 7]); pf[sidx] = __builtin_bit_cast(bf16x8, t); }
#pragma unroll
    for (int dt = 0; dt < 4; ++dt) {
#pragma unroll
        for (int i = 0; i < 16; ++i) o[dt][i] *= alpha;
#pragma unroll
        for (int sidx = 0; sidx < 2; ++sidx) o[dt] = __builtin_amdgcn_mfma_f32_32x32x16_bf16(vf[2 * dt + sidx], pf[sidx], o[dt], 0, 0, 0);
    }
}
__device__ __forceinline__ void attn_phase(const bf16* QO, const bf16* Kb, const bf16* VT, unsigned char* O8, const LAS float* rb, int gw, int NGW, int lane) {
    const int r32 = lane & 31, hl = lane >> 5;
    for (int task = gw; task < BATCH * 16 * 128 * 2; task += NGW) {
        const int half = task & 1, c = (task >> 1) & 127, h = (task >> 8) & 15, b = task >> 12;
        const int qpos = 64 * c + 32 * half + r32;
        const size_t qrow = (size_t)b * SEQ + qpos;
        bf16x8 qf[8];
        const size_t bh256 = (size_t)(b * 16 + h) * 256;
        { const bf16* qt = QO + ((bh256 + 2 * c + half) * 8) * 512 + (size_t)lane * 8;
#pragma unroll
          for (int ks = 0; ks < 8; ++ks) qf[ks] = *(const GAS bf16x8*)(qt + ks * 512); }
        f32x16 o[4];
#pragma unroll
        for (int dt = 0; dt < 4; ++dt)
#pragma unroll
            for (int i = 0; i < 16; ++i) o[dt][i] = 0.f;
        float mrun = -1e30f, lrun = 0.f;
        const LAS float* rbh = rb + h * 257;
        const bf16* Kbh = Kb + bh256 * 4096; const bf16* Vbh = VT + bh256 * 4096;
        int kt0 = 16 - 2 * c; if (kt0 < 0) kt0 = 0;
        bf16x8 kA[8], kB[8];
        { const bf16* kp = Kbh + (size_t)((64 * c - 512 + 32 * kt0) >> 5) * 4096 + (size_t)lane * 8;
#pragma unroll
          for (int ks = 0; ks < 8; ++ks) kA[ks] = *(const GAS bf16x8*)(kp + 512 * ks); }
        for (int kt = kt0; kt < 18; kt += 2) {
            const int kp0 = 64 * c - 512 + 32 * kt;
            attn_tile(Kbh, Vbh, rbh, kp0, true, qpos, hl, lane, kA, kB, qf, o, mrun, lrun);
            attn_tile(Kbh, Vbh, rbh, kp0 + 32, kt + 2 < 18, qpos, hl, lane, kB, kA, qf, o, mrun, lrun);
        }
        const float inv = O8S / lrun;
        unsigned char* op = O8 + qrow * D + h * 128 + 4 * hl;
#pragma unroll
        for (int dt = 0; dt < 4; ++dt)
#pragma unroll
            for (int rq = 0; rq < 4; ++rq) { int w = 0; w = __builtin_amdgcn_cvt_pk_fp8_f32(o[dt][4 * rq + 0] * inv, o[dt][4 * rq + 1] * inv, w, false); w = __builtin_amdgcn_cvt_pk_fp8_f32(o[dt][4 * rq + 2] * inv, o[dt][4 * rq + 3] * inv, w, true);
                *(int*)(op + 32 * dt + 8 * rq) = w; }
    }
}

__device__ __forceinline__ void attn_a_qk(f32x16& s, const bf16x8 (&kc)[8], const bf16x8 (&qh)[8]) {
#pragma unroll
    for (int i = 0; i < 16; ++i) s[i] = 0.f;
#pragma unroll
    for (int ks = 0; ks < 8; ++ks) s = __builtin_amdgcn_mfma_f32_32x32x16_bf16(kc[ks], qh[ks], s, 0, 0, 0);
}
__device__ __forceinline__ void attn_a_half(f32x16& s, const LAS float* rbh, int kp0, int qbase, int r32, int hl, int lane, float& mrun, float& lrun, LAS unsigned char* pw, LAS float* aw) {
    const int qpos = qbase + r32; float tmax = -1e30f;
    if (qbase - (kp0 + 31) >= 128) { const float cb = rbh[256];
#pragma unroll
        for (int i = 0; i < 16; ++i) { s[i] += cb; tmax = fmaxf(tmax, s[i]); } }
    else {
#pragma unroll
        for (int i = 0; i < 16; ++i) { const int kpos = kp0 + (i & 3) + 8 * (i >> 2) + 4 * hl; int rel = qpos - kpos; rel = rel > 128 ? 128 : rel; s[i] += rbh[rel + 128]; tmax = fmaxf(tmax, s[i]); } }
    tmax = fmaxf(tmax, SHFL_XOR(tmax, 32));
    const float mnew = fmaxf(mrun, tmax), alpha = __builtin_amdgcn_exp2f(mrun - mnew);
    float rs = 0.f;
#pragma unroll
    for (int i = 0; i < 16; ++i) { s[i] = __builtin_amdgcn_exp2f(s[i] - mnew); rs += s[i]; }
    rs += SHFL_XOR(rs, 32);
    lrun = lrun * alpha + rs; mrun = mnew;
    v4u t0, t1; t0.x = cvtpk(s[0], s[1]); t0.y = cvtpk(s[2], s[3]); t0.z = cvtpk(s[4], s[5]); t0.w = cvtpk(s[6], s[7]);
    t1.x = cvtpk(s[8], s[9]); t1.y = cvtpk(s[10], s[11]); t1.z = cvtpk(s[12], s[13]); t1.w = cvtpk(s[14], s[15]);
    *(LAS v4u*)pw = t0; *(LAS v4u*)(pw + 16) = t1; *aw = alpha;
}
__device__ __forceinline__ void attn_b_half(const bf16x8 (&vc)[8], f32x16 (&oh)[4], const LAS unsigned char* pr, const LAS float* ar) {
    const v4u p0 = *(const LAS v4u*)pr, p1 = *(const LAS v4u*)(pr + 16); const float al = *ar;
    const bf16x8 pf0 = __builtin_bit_cast(bf16x8, p0), pf1 = __builtin_bit_cast(bf16x8, p1);
#pragma unroll
    for (int dt = 0; dt < 4; ++dt) {
#pragma unroll
        for (int i = 0; i < 16; ++i) oh[dt][i] *= al;
        oh[dt] = __builtin_amdgcn_mfma_f32_32x32x16_bf16(vc[2 * dt], pf0, oh[dt], 0, 0, 0); oh[dt] = __builtin_amdgcn_mfma_f32_32x32x16_bf16(vc[2 * dt + 1], pf1, oh[dt], 0, 0, 0); }
}
__device__ __forceinline__ void attn_ld8(bf16x8 (&d)[8], const bf16* p) {
#pragma unroll
    for (int q = 0; q < 8; ++q) d[q] = *(const GAS bf16x8*)(p + 512 * q);
}
__device__ __forceinline__ void attn_phase_split(const bf16* QO, const bf16* Kb, const bf16* VT, unsigned char* O8, const LAS float* rb, LAS unsigned char* xch, int vcu, int G, int wave, int lane) {
    const int r32 = lane & 31, hl = lane >> 5;
    const int pr = wave & 3, role = wave >> 2;
    LAS unsigned char* xp = xch + pr * 9728;
    LAS unsigned char* pl = xp + lane * 32; LAS float* al = (LAS float*)(xp + 8192) + lane;
    for (int batch = vcu; batch < BATCH * 16 * 128 * 2 / 8; batch += G) {
        const int T0 = batch * 8, c0 = (T0 >> 1) & 127, h = (T0 >> 8) & 15, b = T0 >> 12, c = c0 + pr;
        const size_t bh256 = (size_t)(b * 16 + h) * 256;
        const bf16* Kl = Kb + bh256 * 4096 + (size_t)lane * 8; const bf16* Vl = VT + bh256 * 4096 + (size_t)lane * 8;
        const LAS float* rbh = rb + h * 257;
        int kt0 = 16 - 2 * c; if (kt0 < 0) kt0 = 0;
        const int kbase = 64 * c - 512, tb = kbase >> 5;
        if (role == 0) {
            bf16x8 q0[8], q1[8];
            attn_ld8(q0, QO + ((bh256 + 2 * c + 0) * 8) * 512 + (size_t)lane * 8); attn_ld8(q1, QO + ((bh256 + 2 * c + 1) * 8) * 512 + (size_t)lane * 8);
            float mrun0 = -1e30f, mrun1 = -1e30f, lrun0 = 0.f, lrun1 = 0.f;
            bf16x8 kc[8];
            attn_ld8(kc, Kl + (size_t)(tb + kt0) * 4096);
            for (int t = 0; t < 18; ++t) {
                if (t >= kt0) { f32x16 s0, s1;
                    attn_a_qk(s0, kc, q0); attn_a_qk(s1, kc, q1);
                    __builtin_amdgcn_sched_barrier(0);
                    if (t + 1 < 18) attn_ld8(kc, Kl + (size_t)(tb + t + 1) * 4096);
                    __builtin_amdgcn_sched_barrier(0);
                    const int so = (t & 1) * 4096, ao = (t & 1) * 128;
                    attn_a_half(s0, rbh, kbase + 32 * t, 64 * c, r32, hl, lane, mrun0, lrun0, pl + so, al + ao);
                    attn_a_half(s1, rbh, kbase + 32 * t, 64 * c + 32, r32, hl, lane, mrun1, lrun1, pl + so + 2048, al + ao + 64); }
                if (t == 17) { *(LAS float*)(xp + 9216 + lane * 4) = lrun0; *(LAS float*)(xp + 9216 + 256 + lane * 4) = lrun1; }
                LDS_WAIT(); __syncthreads();
            }
            __syncthreads();
        } else {
            f32x16 oA[4], oB[4];
#pragma unroll
            for (int dt = 0; dt < 4; ++dt)
#pragma unroll
                for (int i = 0; i < 16; ++i) { oA[dt][i] = 0.f; oB[dt][i] = 0.f; }
            bf16x8 vc[8];
            attn_ld8(vc, Vl + (size_t)(tb + kt0) * 4096);
            __syncthreads();
            for (int t = 0; t < 18; ++t) {
                if (t >= kt0) { const int so = (t & 1) * 4096, ao = (t & 1) * 128;
                    attn_b_half(vc, oA, pl + so, al + ao); attn_b_half(vc, oB, pl + so + 2048, al + ao + 64);
                    __builtin_amdgcn_sched_barrier(0);
                    if (t + 1 < 18) attn_ld8(vc, Vl + (size_t)(tb + t + 1) * 4096); }
                LDS_WAIT(); __syncthreads();
            }
            {   const float lf0 = *(const LAS float*)(xp + 9216 + lane * 4), lf1 = *(const LAS float*)(xp + 9216 + 256 + lane * 4);
                const float inv0 = O8S / lf0, inv1 = O8S / lf1;
                unsigned char* op0 = O8 + ((size_t)b * SEQ + 64 * c + r32) * D + h * 128 + 4 * hl; unsigned char* op1 = op0 + (size_t)32 * D;
#pragma unroll
                for (int dt = 0; dt < 4; ++dt)
#pragma unroll
                    for (int rq = 0; rq < 4; ++rq) { int w = 0; w = __builtin_amdgcn_cvt_pk_fp8_f32(oA[dt][4 * rq + 0] * inv0, oA[dt][4 * rq + 1] * inv0, w, false); w = __builtin_amdgcn_cvt_pk_fp8_f32(oA[dt][4 * rq + 2] * inv0, oA[dt][4 * rq + 3] * inv0, w, true);
                        *(int*)(op0 + 32 * dt + 8 * rq) = w;
                        int w2 = 0; w2 = __builtin_amdgcn_cvt_pk_fp8_f32(oB[dt][4 * rq + 0] * inv1, oB[dt][4 * rq + 1] * inv1, w2, false); w2 = __builtin_amdgcn_cvt_pk_fp8_f32(oB[dt][4 * rq + 2] * inv1, oB[dt][4 * rq + 3] * inv1, w2, true);
                        *(int*)(op1 + 32 * dt + 8 * rq) = w2; }
            }
        }
        __syncthreads();
    }
}

#define INS16(L, x) do { _Pragma("unroll") for (int _j = 15; _j >= 1; --_j) L[_j] = __builtin_amdgcn_fmed3f(L[_j - 1], L[_j], (x)); L[0] = fmaxf(L[0], (x)); } while (0)
__device__ __forceinline__ void peer_select_phase(const bf16* Q, const LAS unsigned char* skl  , int* idx_out, float* gate_out, int gw, int NGW, int lane) {
    const int r = lane & 31, half = lane >> 5;
    for (int it = gw; it < M / 4; it += NGW) {
        const int t = 4 * it + (r >> 3), hh = r & 7;
        float L[2][16];
#pragma unroll
        for (int s = 0; s < 2; ++s) {
#pragma unroll
            for (int j = 0; j < 16; ++j) L[s][j] = -3.0e38f;
            bf16x8 qf[8];
            const bf16* qp = Q + (size_t)t * D + hh * 256 + s * 128 + 8 * half;
#pragma unroll
            for (int ks = 0; ks < 8; ++ks) qf[ks] = *(const bf16x8*)(qp + 16 * ks);
#pragma unroll 1
            for (int nt = 0; nt < 4; ++nt) {
                f32x16 sc;
#pragma unroll
                for (int i = 0; i < 16; ++i) sc[i] = 0.f;
                const LAS unsigned char* kp = skl + (size_t)(s * 128 + 32 * nt + r) * 272 + 16 * half;
#pragma unroll
                for (int ks = 0; ks < 8; ++ks) { const bf16x8 kf = *(const LAS bf16x8*)(kp + 32 * ks); sc = __builtin_amdgcn_mfma_f32_32x32x16_bf16(kf, qf[ks], sc, 0, 0, 0); }
#pragma unroll
                for (int i = 0; i < 16; ++i) { const unsigned n = 32 * nt + (i & 3) + 8 * (i >> 2) + 4 * half;
                    const float sv = sc[i];
                    const float x = __builtin_bit_cast(float, (__builtin_bit_cast(unsigned, sv) & ~127u) | n);
                    INS16(L[s], x); }
            }
        }
        float mine[16], oth[16];
#pragma unroll
        for (int j = 0; j < 16; ++j) { const float o0 = SHFL_XOR(L[0][j], 32), o1 = SHFL_XOR(L[1][j], 32); mine[j] = half ? L[1][j] : L[0][j]; oth[j] = half ? o1 : o0; }
#pragma unroll
        for (int j = 0; j < 16; ++j) { const float x = oth[j]; INS16(mine, x); }
        float A[16], B[16];
#pragma unroll
        for (int j = 0; j < 16; ++j) { const float o = SHFL_XOR(mine[j], 32); A[j] = half ? o : mine[j]; B[j] = half ? mine[j] : o; }
        float T[16];
#pragma unroll
        for (int j = 0; j < 16; ++j) T[j] = -3.0e38f;
#pragma unroll
        for (int a = 0; a < 16; ++a)
#pragma unroll
            for (int bq = 0; bq < 16; ++bq) if ((a + 1) * (bq + 1) <= 16) { const float x = A[a] + B[bq]; INS16(T, x); }
        const float tau = T[15], mx = T[0];
        float den = 0.f;
#pragma unroll
        for (int j = 0; j < 16; ++j) den += __builtin_amdgcn_exp2f((T[j] - mx) * LOG2E);
        const float rden = 1.f / den;
        int cnt = 0;
        const size_t ob = (size_t)t * 128 + hh * 16;
#pragma unroll
        for (int a = 0; a < 16; ++a)
#pragma unroll
            for (int bq = 0; bq < 16; ++bq) if ((a + 1) * (bq + 1) <= 16) {
                const float x = A[a] + B[bq];
                if (x >= tau && cnt < 16) {
                    if (half == 0) idx_out[ob + cnt] = (int)(((__builtin_bit_cast(unsigned, A[a]) & 127u) << 7) | (__builtin_bit_cast(unsigned, B[bq]) & 127u));
                    else gate_out[ob + cnt] = __builtin_amdgcn_exp2f((x - mx) * LOG2E) * rden;
                    ++cnt;
                }
            }
    }
}

__device__ __forceinline__ void peer_gather_phase(float* hio, bf16* hb, const int* idx, const float* gate, const bf16* TU, const bf16* TV, const float* lg, const float* lb, int gw, int NGW, int lane) {
    for (int m = gw; m < M; m += NGW) {
        v4u xr[4];
#pragma unroll
        for (int j = 0; j < 4; ++j) xr[j] = *(const v4u*)(hb + (size_t)m * D + 512 * j + 8 * lane);
        const int i0 = idx[(size_t)m * 128 + lane], i1 = idx[(size_t)m * 128 + 64 + lane];
        float y[32];
#pragma unroll
        for (int i = 0; i < 32; ++i) y[i] = 0.f;
#ifdef DBG_NO_PEER
        for (int hb_ = 0; hb_ < 0; ++hb_) {
#else
        for (int hb_ = 0; hb_ < 8; ++hb_) {
#endif
            float part[16];
            const int isel = (hb_ < 4) ? i0 : i1;
#pragma unroll
            for (int kk = 0; kk < 16; ++kk) {
                const int e = __builtin_amdgcn_readlane(isel, ((hb_ & 3) << 4) + kk);
                const bf16* up = TU + (size_t)e * D + 8 * lane;
                float acc = 0.f;
#pragma unroll
                for (int j = 0; j < 4; ++j) { const v4u w = *(const v4u*)(up + 512 * j);
                    acc = dot2bf(w.x, xr[j].x, acc); acc = dot2bf(w.y, xr[j].y, acc); acc = dot2bf(w.z, xr[j].z, acc); acc = dot2bf(w.w, xr[j].w, acc); }
                part[kk] = acc;
            }
#pragma unroll
            for (int kk = 0; kk < 16; ++kk) { part[kk] += SHFL_XOR(part[kk], 32); part[kk] += SHFL_XOR(part[kk], 16); }
            {
                const bool b3 = (lane & 8) != 0, b2 = (lane & 4) != 0, b1 = (lane & 2) != 0, b0 = (lane & 1) != 0;
#pragma unroll
                for (int i = 0; i < 8; ++i) { const float send = b3 ? part[i] : part[i + 8], keep = b3 ? part[i + 8] : part[i]; part[i] = keep + SHFL_XOR(send, 8); }
#pragma unroll
                for (int i = 0; i < 4; ++i) { const float send = b2 ? part[i] : part[i + 4], keep = b2 ? part[i + 4] : part[i]; part[i] = keep + SHFL_XOR(send, 4); }
#pragma unroll
                for (int i = 0; i < 2; ++i) { const float send = b1 ? part[i] : part[i + 2], keep = b1 ? part[i + 2] : part[i]; part[i] = keep + SHFL_XOR(send, 2); }
                { const float send = b0 ? part[0] : part[1], keep = b0 ? part[1] : part[0]; part[0] = keep + SHFL_XOR(send, 1); }
            }
            const float gt = gate[(size_t)m * 128 + hb_ * 16 + (lane & 15)];
            const float act = gelu_f(part[0]) * gt;
            const unsigned actb = f2bf(act);
#pragma unroll
            for (int kk = 0; kk < 16; ++kk) {
                const int e = __builtin_amdgcn_readlane(isel, ((hb_ & 3) << 4) + kk);
                const unsigned ab = (unsigned)__builtin_amdgcn_readlane((int)actb, kk);
                const unsigned alo = ab, ahi = ab << 16;
                const bf16* vp = TV + (size_t)e * D + 8 * lane;
#pragma unroll
                for (int j = 0; j < 4; ++j) { const v4u w = *(const v4u*)(vp + 512 * j);
                    y[8 * j + 0] = dot2bf(w.x, alo, y[8 * j + 0]); y[8 * j + 1] = dot2bf(w.x, ahi, y[8 * j + 1]);
                    y[8 * j + 2] = dot2bf(w.y, alo, y[8 * j + 2]); y[8 * j + 3] = dot2bf(w.y, ahi, y[8 * j + 3]);
                    y[8 * j + 4] = dot2bf(w.z, alo, y[8 * j + 4]); y[8 * j + 5] = dot2bf(w.z, ahi, y[8 * j + 5]);
                    y[8 * j + 6] = dot2bf(w.w, alo, y[8 * j + 6]); y[8 * j + 7] = dot2bf(w.w, ahi, y[8 * j + 7]); }
            }
        }
        float* row = hio + (size_t)m * D + 8 * lane;
        float s = 0.f;
#pragma unroll
        for (int j = 0; j < 4; ++j) { const f32x4 a = *(const f32x4*)(row + 512 * j), b = *(const f32x4*)(row + 512 * j + 4);
            y[8 * j + 0] += DN_ALPHA * a.x; y[8 * j + 1] += DN_ALPHA * a.y; y[8 * j + 2] += DN_ALPHA * a.z; y[8 * j + 3] += DN_ALPHA * a.w;
            y[8 * j + 4] += DN_ALPHA * b.x; y[8 * j + 5] += DN_ALPHA * b.y; y[8 * j + 6] += DN_ALPHA * b.z; y[8 * j + 7] += DN_ALPHA * b.w; }
#pragma unroll
        for (int i = 0; i < 32; ++i) s += y[i];
        const float mean = wave_sum(s) * (1.f / D); float s2 = 0.f;
#pragma unroll
        for (int i = 0; i < 32; ++i) { y[i] -= mean; s2 += y[i] * y[i]; }
        const float rstd = 1.f / sqrtf(wave_sum(s2) * (1.f / D) + LN_EPS);
#pragma unroll
        for (int j = 0; j < 4; ++j) { const float* gp = lg + 512 * j + 8 * lane; const float* bp = lb + 512 * j + 8 * lane;
            const f32x4 g0 = *(const f32x4*)gp, g1 = *(const f32x4*)(gp + 4), b0 = *(const f32x4*)bp, b1 = *(const f32x4*)(bp + 4);
            f32x4 o0, o1; o0.x = y[8 * j + 0] * rstd * g0.x + b0.x; o0.y = y[8 * j + 1] * rstd * g0.y + b0.y; o0.z = y[8 * j + 2] * rstd * g0.z + b0.z; o0.w = y[8 * j + 3] * rstd * g0.w + b0.w;
            o1.x = y[8 * j + 4] * rstd * g1.x + b1.x; o1.y = y[8 * j + 5] * rstd * g1.y + b1.y; o1.z = y[8 * j + 6] * rstd * g1.z + b1.z; o1.w = y[8 * j + 7] * rstd * g1.w + b1.w;
            *(f32x4*)(row + 512 * j) = o0; *(f32x4*)(row + 512 * j + 4) = o1;
            v4u w; w.x = pk2(o0.x, o0.y); w.y = pk2(o0.z, o0.w); w.z = pk2(o1.x, o1.y); w.w = pk2(o1.z, o1.w);
            *(v4u*)(hb + (size_t)m * D + 512 * j + 8 * lane) = w; }
    }
}


__device__ __forceinline__ float udot8(const v4u (&w)[2], const f32x2 (&x2)[16]) {
    f32x2 a0 = {0.f, 0.f}, a1 = {0.f, 0.f};
#pragma unroll
    for (int j = 0; j < 2; ++j) {
        const unsigned d0 = w[j].x, d1 = w[j].y, d2 = w[j].z, d3 = w[j].w;
        a0 = __builtin_elementwise_fma(__builtin_amdgcn_cvt_pk_f32_fp8((int)d0, false), x2[8 * j + 0], a0); a1 = __builtin_elementwise_fma(__builtin_amdgcn_cvt_pk_f32_fp8((int)d0, true), x2[8 * j + 1], a1);
        a0 = __builtin_elementwise_fma(__builtin_amdgcn_cvt_pk_f32_fp8((int)d1, false), x2[8 * j + 2], a0); a1 = __builtin_elementwise_fma(__builtin_amdgcn_cvt_pk_f32_fp8((int)d1, true), x2[8 * j + 3], a1);
        a0 = __builtin_elementwise_fma(__builtin_amdgcn_cvt_pk_f32_fp8((int)d2, false), x2[8 * j + 4], a0); a1 = __builtin_elementwise_fma(__builtin_amdgcn_cvt_pk_f32_fp8((int)d2, true), x2[8 * j + 5], a1);
        a0 = __builtin_elementwise_fma(__builtin_amdgcn_cvt_pk_f32_fp8((int)d3, false), x2[8 * j + 6], a0); a1 = __builtin_elementwise_fma(__builtin_amdgcn_cvt_pk_f32_fp8((int)d3, true), x2[8 * j + 7], a1);
    }
    return (a0.x + a0.y) + (a1.x + a1.y);
}
__device__ __forceinline__ void vacc8(const v4u (&w)[2], const f32x2 a2, f32x2 (&y2)[16]) {
#pragma unroll
    for (int j = 0; j < 2; ++j) {
        const unsigned d0 = w[j].x, d1 = w[j].y, d2 = w[j].z, d3 = w[j].w;
        y2[8 * j + 0] = __builtin_elementwise_fma(__builtin_amdgcn_cvt_pk_f32_fp8((int)d0, false), a2, y2[8 * j + 0]); y2[8 * j + 1] = __builtin_elementwise_fma(__builtin_amdgcn_cvt_pk_f32_fp8((int)d0, true), a2, y2[8 * j + 1]);
        y2[8 * j + 2] = __builtin_elementwise_fma(__builtin_amdgcn_cvt_pk_f32_fp8((int)d1, false), a2, y2[8 * j + 2]); y2[8 * j + 3] = __builtin_elementwise_fma(__builtin_amdgcn_cvt_pk_f32_fp8((int)d1, true), a2, y2[8 * j + 3]);
        y2[8 * j + 4] = __builtin_elementwise_fma(__builtin_amdgcn_cvt_pk_f32_fp8((int)d2, false), a2, y2[8 * j + 4]); y2[8 * j + 5] = __builtin_elementwise_fma(__builtin_amdgcn_cvt_pk_f32_fp8((int)d2, true), a2, y2[8 * j + 5]);
        y2[8 * j + 6] = __builtin_elementwise_fma(__builtin_amdgcn_cvt_pk_f32_fp8((int)d3, false), a2, y2[8 * j + 6]); y2[8 * j + 7] = __builtin_elementwise_fma(__builtin_amdgcn_cvt_pk_f32_fp8((int)d3, true), a2, y2[8 * j + 7]);
    }
}
#define ROWLD8(dst, base, e) do { const u8* _p = (base) + (size_t)(e) * D + 16 * lane; dst[0] = gld16(_p); dst[1] = gld16(_p + 1024); } while (0)
__device__ __forceinline__ void peer_gather_fp8(float* hio, bf16* hb, float* hio_w, bf16* hb_w, const int* idx, const float* gate, const u8* TU8, const u8* TV8, const float* lg, const float* lb, int gw, int NGW, int lane_in) {
    for (int m = gw; m < M; m += NGW) {
        int lane = lane_in; asm volatile("" : "+v"(lane));
        float* row = hio + (size_t)m * D + 16 * lane;
        f32x2 x2[16];
#pragma unroll
        for (int j = 0; j < 2; ++j)
#pragma unroll
            for (int q = 0; q < 4; ++q) { const f32x4 t = *(const GAS f32x4*)(row + 1024 * j + 4 * q); x2[8 * j + 2 * q] = (f32x2){t.x, t.y}; x2[8 * j + 2 * q + 1] = (f32x2){t.z, t.w}; }
        const int i0 = *(const GAS int*)(idx + (size_t)m * 128 + lane), i1 = *(const GAS int*)(idx + (size_t)m * 128 + 64 + lane);
        f32x2 y2[16];
#pragma unroll
        for (int i = 0; i < 16; ++i) y2[i] = (f32x2){0.f, 0.f};
        v4u buf[4][2];
#pragma unroll
        for (int q = 0; q < 4; ++q) { const int e = __builtin_amdgcn_readlane(i0, q); ROWLD8(buf[q], TU8, e); }
        for (int hb_ = 0; hb_ < 8; ++hb_) {
            const int isel = (hb_ < 4) ? i0 : i1, inext = (hb_ + 1 < 4) ? i0 : i1;
            const int lb0 = (hb_ & 3) << 4, lbn = ((hb_ + 1) & 3) << 4;
            const float gt = *(const GAS float*)(gate + (size_t)m * 128 + hb_ * 16 + (lane & 15));
            float part[16];
#pragma unroll
            for (int kk = 0; kk < 16; ++kk) {
                part[kk] = udot8(buf[kk & 3], x2);
                if (kk + 4 < 16) { const int e = __builtin_amdgcn_readlane(isel, lb0 + kk + 4); ROWLD8(buf[kk & 3], TU8, e); }
                else { const int e = __builtin_amdgcn_readlane(isel, lb0 + kk + 4 - 16); ROWLD8(buf[kk & 3], TV8, e); }
                __builtin_amdgcn_sched_barrier(0);
            }
#pragma unroll
            for (int kk = 0; kk < 16; ++kk) { part[kk] += SHFL_XOR(part[kk], 32); part[kk] += SHFL_XOR(part[kk], 16); }
            {
                const bool b3 = (lane & 8) != 0, b2 = (lane & 4) != 0, b1 = (lane & 2) != 0, b0 = (lane & 1) != 0;
#pragma unroll
                for (int i = 0; i < 8; ++i) { const float send = b3 ? part[i] : part[i + 8], keep = b3 ? part[i + 8] : part[i]; part[i] = keep + SHFL_XOR(send, 8); }
#pragma unroll
                for (int i = 0; i < 4; ++i) { const float send = b2 ? part[i] : part[i + 4], keep = b2 ? part[i + 4] : part[i]; part[i] = keep + SHFL_XOR(send, 4); }
#pragma unroll
                for (int i = 0; i < 2; ++i) { const float send = b1 ? part[i] : part[i + 2], keep = b1 ? part[i + 2] : part[i]; part[i] = keep + SHFL_XOR(send, 2); }
                { const float send = b0 ? part[0] : part[1], keep = b0 ? part[1] : part[0]; part[0] = keep + SHFL_XOR(send, 1); }
            }
            const float act = gelu_f(part[0] * (1.f / TU_SCALE)) * gt * (1.f / TV_SCALE);
            const int acti = __builtin_bit_cast(int, act);
#pragma unroll
            for (int kk = 0; kk < 16; ++kk) {
                const float a = __builtin_bit_cast(float, __builtin_amdgcn_readlane(acti, kk));
                vacc8(buf[kk & 3], (f32x2){a, a}, y2);
                if (kk + 4 < 16) { const int e = __builtin_amdgcn_readlane(isel, lb0 + kk + 4); ROWLD8(buf[kk & 3], TV8, e); }
                else if (hb_ < 7) { const int e = __builtin_amdgcn_readlane(inext, lbn + kk + 4 - 16); ROWLD8(buf[kk & 3], TU8, e); }
                __builtin_amdgcn_sched_barrier(0);
            }
        }
        float s = 0.f;
#pragma unroll
        for (int i = 0; i < 16; ++i) { y2[i] = y2[i] + x2[i] * DN_ALPHA; s += y2[i].x + y2[i].y; }
        const float mean = wave_sum(s) * (1.f / D); float s2 = 0.f;
#pragma unroll
        for (int i = 0; i < 16; ++i) { y2[i] = y2[i] - mean; s2 += y2[i].x * y2[i].x + y2[i].y * y2[i].y; }
        const float rstd = 1.f / sqrtf(wave_sum(s2) * (1.f / D) + LN_EPS);
#pragma unroll
        for (int j = 0; j < 2; ++j)
#pragma unroll
            for (int q = 0; q < 4; ++q) { const int off = 1024 * j + 16 * lane + 4 * q;
                const f32x4 g4 = *(const GAS f32x4*)(lg + off), b4 = *(const GAS f32x4*)(lb + off);
                const f32x2 ya = y2[8 * j + 2 * q], yb = y2[8 * j + 2 * q + 1];
                f32x4 o; o.x = ya.x * rstd * g4.x + b4.x; o.y = ya.y * rstd * g4.y + b4.y; o.z = yb.x * rstd * g4.z + b4.z; o.w = yb.y * rstd * g4.w + b4.w;
                *(GAS f32x4*)(hio_w + (size_t)m * D + off) = o;
                v2u w; w.x = pk2(o.x, o.y); w.y = pk2(o.z, o.w); *(GAS v2u*)(hb_w + (size_t)m * D + off) = w; }
    }
}


__device__ __forceinline__ float wave_max(float v) {
    v = fmaxf(v, WDPP(v, 0xB1)); v = fmaxf(v, WDPP(v, 0x4E)); v = fmaxf(v, WDPP(v, 0x141)); v = fmaxf(v, WDPP(v, 0x140));
    return fmaxf(fmaxf(WRL(v, 0), WRL(v, 16)), fmaxf(WRL(v, 32), WRL(v, 48)));
}
__device__ __forceinline__ void cvt_rows_fp4(const float* src, u8* dst, float* scales, int nrows, int gw, int NGW, int lane) {
    for (int r0 = gw; r0 < nrows; r0 += 4 * NGW) {
        f32x4 v[4][8];
#pragma unroll
        for (int u = 0; u < 4; ++u) { const GAS f32x4* p = (const GAS f32x4*)(src + (size_t)(r0 + u * NGW) * D + 4 * lane);
#pragma unroll
            for (int q = 0; q < 8; ++q) v[u][q] = p[64 * q]; }
#pragma unroll
        for (int u = 0; u < 4; ++u) { const int r = r0 + u * NGW; float mx = 0.f;
#pragma unroll
            for (int q = 0; q < 8; ++q) mx = fmaxf(mx, fmaxf(fmaxf(__builtin_fabsf(v[u][q].x), __builtin_fabsf(v[u][q].y)), fmaxf(__builtin_fabsf(v[u][q].z), __builtin_fabsf(v[u][q].w))));
            mx = wave_max(mx);
            const float inv = mx > 0.f ? 6.f / mx : 0.f;
            const int lay = r / NEXP, e = r % NEXP;
#pragma unroll
            for (int q = 0; q < 8; ++q) { unsigned t = 0u; const f32x4 a = v[u][q] * inv;
                t = __builtin_amdgcn_cvt_scalef32_pk_fp4_f32(t, a.x, a.y, 1.0f, 0); t = __builtin_amdgcn_cvt_scalef32_pk_fp4_f32(t, a.z, a.w, 1.0f, 1);
                *(GAS unsigned short*)(dst + (((size_t)lay * 8 + q) * NEXP + e) * 128 + 2 * lane) = (unsigned short)(t & 0xffffu); }
            if (lane == 0) scales[r] = mx * (1.f / 6.f); }
    }
}
__device__ __forceinline__ float udot4(const v4u w, const f32x2 (&x2)[16]) {
    f32x2 a0 = {0.f, 0.f}, a1 = {0.f, 0.f};
    const unsigned d0 = w.x, d1 = w.y, d2 = w.z, d3 = w.w;
#define UD4(dw, k) a0 = __builtin_elementwise_fma(__builtin_amdgcn_cvt_scalef32_pk_f32_fp4(dw, 1.0f, 0), x2[4 * (k) + 0], a0); a1 = __builtin_elementwise_fma(__builtin_amdgcn_cvt_scalef32_pk_f32_fp4(dw, 1.0f, 1), x2[4 * (k) + 1], a1); \
                   a0 = __builtin_elementwise_fma(__builtin_amdgcn_cvt_scalef32_pk_f32_fp4(dw, 1.0f, 2), x2[4 * (k) + 2], a0); a1 = __builtin_elementwise_fma(__builtin_amdgcn_cvt_scalef32_pk_f32_fp4(dw, 1.0f, 3), x2[4 * (k) + 3], a1);
    UD4(d0, 0) UD4(d1, 1) UD4(d2, 2) UD4(d3, 3)
#undef UD4
    return (a0.x + a0.y) + (a1.x + a1.y);
}
__device__ __forceinline__ void vacc4(const v4u w, const f32x2 a2, f32x2 (&y2)[16]) {
    const unsigned d0 = w.x, d1 = w.y, d2 = w.z, d3 = w.w;
#define VA4(dw, k) y2[4 * (k) + 0] = __builtin_elementwise_fma(__builtin_amdgcn_cvt_scalef32_pk_f32_fp4(dw, 1.0f, 0), a2, y2[4 * (k) + 0]); y2[4 * (k) + 1] = __builtin_elementwise_fma(__builtin_amdgcn_cvt_scalef32_pk_f32_fp4(dw, 1.0f, 1), a2, y2[4 * (k) + 1]); \
                   y2[4 * (k) + 2] = __builtin_elementwise_fma(__builtin_amdgcn_cvt_scalef32_pk_f32_fp4(dw, 1.0f, 2), a2, y2[4 * (k) + 2]); y2[4 * (k) + 3] = __builtin_elementwise_fma(__builtin_amdgcn_cvt_scalef32_pk_f32_fp4(dw, 1.0f, 3), a2, y2[4 * (k) + 3]);
    VA4(d0, 0) VA4(d1, 1) VA4(d2, 2) VA4(d3, 3)
#undef VA4
}
#define ROWLD4(dst, base, e) do { dst = gld16((base) + (size_t)(e) * 1024 + 16 * lane); } while (0)
__device__ __forceinline__ void peer_gather_fp4(float* hio, bf16* hb, float* hio_w, bf16* hb_w, const int* idx, const float* gate, const u8* TU4, const u8* TV4, const float* SU, const float* SV,
                                                const float* lg, const float* lb, int gw, int NGW, int lane_in) {
    for (int m = gw; m < M; m += NGW) {
        int lane = lane_in; asm volatile("" : "+v"(lane));
        const float* row = hio + (size_t)m * D + 32 * lane;
        f32x2 x2[16];
#pragma unroll
        for (int q = 0; q < 8; ++q) { const f32x4 t = *(const GAS f32x4*)(row + 4 * q); x2[2 * q] = (f32x2){t.x, t.y}; x2[2 * q + 1] = (f32x2){t.z, t.w}; }
        const int i0 = *(const GAS int*)(idx + (size_t)m * 128 + lane), i1 = *(const GAS int*)(idx + (size_t)m * 128 + 64 + lane);
        f32x2 y2[16];
#pragma unroll
        for (int i = 0; i < 16; ++i) y2[i] = (f32x2){0.f, 0.f};
        v4u buf[8];
#pragma unroll
        for (int q = 0; q < 8; ++q) { const int e = __builtin_amdgcn_readlane(i0, q); ROWLD4(buf[q], TU4, e); }
        for (int hb_ = 0; hb_ < 8; ++hb_) {
            const int isel = (hb_ < 4) ? i0 : i1, inext = (hb_ + 1 < 4) ? i0 : i1;
            const int lb0 = (hb_ & 3) << 4, lbn = ((hb_ + 1) & 3) << 4;
            const float gt = *(const GAS float*)(gate + (size_t)m * 128 + hb_ * 16 + (lane & 15));
            const int ek = shfl_idx_lane(isel, lb0 + (lane & 15));
            const float su = *(const GAS float*)(SU + ek), sv = *(const GAS float*)(SV + ek);
            float part[16];
#pragma unroll
            for (int kk = 0; kk < 16; ++kk) {
                part[kk] = udot4(buf[kk & 7], x2);
                if (kk + 8 < 16) { const int e = __builtin_amdgcn_readlane(isel, lb0 + kk + 8); ROWLD4(buf[kk & 7], TU4, e); }
                else { const int e = __builtin_amdgcn_readlane(isel, lb0 + kk + 8 - 16); ROWLD4(buf[kk & 7], TV4, e); }
                __builtin_amdgcn_sched_barrier(0);
            }
#pragma unroll
            for (int kk = 0; kk < 16; ++kk) { part[kk] += SHFL_XOR(part[kk], 32); part[kk] += SHFL_XOR(part[kk], 16); }
            {
                const bool b3 = (lane & 8) != 0, b2 = (lane & 4) != 0, b1 = (lane & 2) != 0, b0 = (lane & 1) != 0;
#pragma unroll
                for (int i = 0; i < 8; ++i) { const float send = b3 ? part[i] : part[i + 8], keep = b3 ? part[i + 8] : part[i]; part[i] = keep + SHFL_XOR(send, 8); }
#pragma unroll
                for (int i = 0; i < 4; ++i) { const float send = b2 ? part[i] : part[i + 4], keep = b2 ? part[i + 4] : part[i]; part[i] = keep + SHFL_XOR(send, 4); }
#pragma unroll
                for (int i = 0; i < 2; ++i) { const float send = b1 ? part[i] : part[i + 2], keep = b1 ? part[i + 2] : part[i]; part[i] = keep + SHFL_XOR(send, 2); }
                { const float send = b0 ? part[0] : part[1], keep = b0 ? part[1] : part[0]; part[0] = keep + SHFL_XOR(send, 1); }
            }
            const float act = gelu_f(part[0] * su) * gt * sv;
            const int acti = __builtin_bit_cast(int, act);
#pragma unroll
            for (int kk = 0; kk < 16; ++kk) {
                const float a = __builtin_bit_cast(float, __builtin_amdgcn_readlane(acti, kk));
                vacc4(buf[kk & 7], (f32x2){a, a}, y2);
                if (kk + 8 < 16) { const int e = __builtin_amdgcn_readlane(isel, lb0 + kk + 8); ROWLD4(buf[kk & 7], TV4, e); }
                else if (hb_ < 7) { const int e = __builtin_amdgcn_readlane(inext, lbn + kk + 8 - 16); ROWLD4(buf[kk & 7], TU4, e); }
                __builtin_amdgcn_sched_barrier(0);
            }
        }
        float s = 0.f;
#pragma unroll
        for (int i = 0; i < 16; ++i) { y2[i] = y2[i] + x2[i] * DN_ALPHA; s += y2[i].x + y2[i].y; }
        const float mean = wave_sum(s) * (1.f / D); float s2 = 0.f;
#pragma unroll
        for (int i = 0; i < 16; ++i) { y2[i] = y2[i] - mean; s2 += y2[i].x * y2[i].x + y2[i].y * y2[i].y; }
        const float rstd = 1.f / sqrtf(wave_sum(s2) * (1.f / D) + LN_EPS);
#pragma unroll
        for (int q = 0; q < 8; ++q) { const int off = 32 * lane + 4 * q;
            const f32x4 g4 = *(const GAS f32x4*)(lg + off), b4 = *(const GAS f32x4*)(lb + off);
            const f32x2 ya = y2[2 * q], yb = y2[2 * q + 1];
            f32x4 o; o.x = ya.x * rstd * g4.x + b4.x; o.y = ya.y * rstd * g4.y + b4.y; o.z = yb.x * rstd * g4.z + b4.z; o.w = yb.y * rstd * g4.w + b4.w;
            *(GAS f32x4*)(hio_w + (size_t)m * D + off) = o;
            v2u w; w.x = pk2(o.x, o.y); w.y = pk2(o.z, o.w); *(GAS v2u*)(hb_w + (size_t)m * D + off) = w; }
    }
}


typedef _Float16 h16x2 __attribute__((ext_vector_type(2)));
#define CVT_H2_FP4(dw, b) __builtin_bit_cast(h16x2, __builtin_amdgcn_cvt_scalef32_pk_f16_fp4(dw, 1.0f, b))
__device__ __forceinline__ float udot4h(const v4u w, const h16x2 (&xh)[16]) {
    h16x2 a0 = {(_Float16)0.f, (_Float16)0.f}, a1 = {(_Float16)0.f, (_Float16)0.f};
    const unsigned d0 = w.x, d1 = w.y, d2 = w.z, d3 = w.w;
#define UD4H(dw, k) a0 = __builtin_elementwise_fma(CVT_H2_FP4(dw, 0), xh[4 * (k) + 0], a0); a1 = __builtin_elementwise_fma(CVT_H2_FP4(dw, 1), xh[4 * (k) + 1], a1); \
                    a0 = __builtin_elementwise_fma(CVT_H2_FP4(dw, 2), xh[4 * (k) + 2], a0); a1 = __builtin_elementwise_fma(CVT_H2_FP4(dw, 3), xh[4 * (k) + 3], a1);
    UD4H(d0, 0) UD4H(d1, 1) UD4H(d2, 2) UD4H(d3, 3)
#undef UD4H
    return ((float)a0.x + (float)a0.y) + ((float)a1.x + (float)a1.y);
}
__device__ __forceinline__ void vacc4h(const v4u w, const h16x2 a2, h16x2 (&yh)[16]) {
    const unsigned d0 = w.x, d1 = w.y, d2 = w.z, d3 = w.w;
#define VA4H(dw, k) yh[4 * (k) + 0] = __builtin_elementwise_fma(CVT_H2_FP4(dw, 0), a2, yh[4 * (k) + 0]); yh[4 * (k) + 1] = __builtin_elementwise_fma(CVT_H2_FP4(dw, 1), a2, yh[4 * (k) + 1]); \
                    yh[4 * (k) + 2] = __builtin_elementwise_fma(CVT_H2_FP4(dw, 2), a2, yh[4 * (k) + 2]); yh[4 * (k) + 3] = __builtin_elementwise_fma(CVT_H2_FP4(dw, 3), a2, yh[4 * (k) + 3]);
    VA4H(d0, 0) VA4H(d1, 1) VA4H(d2, 2) VA4H(d3, 3)
#undef VA4H
}

#define DPP_ADD(v, ctrl) ((v) + __builtin_bit_cast(float, __builtin_amdgcn_update_dpp(0, __builtin_bit_cast(int, (v)), (ctrl), 0xF, 0xF, true)))
#define LOAD_II16(dst, mm) do { const GAS v4u* _ip = (const GAS v4u*)(idx + (size_t)(mm) * 128 + 16 * eg); const v4u _a = _ip[0], _b = _ip[1], _c = _ip[2], _d = _ip[3]; \
    dst[0] = _a.x; dst[1] = _a.y; dst[2] = _a.z; dst[3] = _a.w; dst[4] = _b.x; dst[5] = _b.y; dst[6] = _b.z; dst[7] = _b.w; dst[8] = _c.x; dst[9] = _c.y; dst[10] = _c.z; dst[11] = _c.w; dst[12] = _d.x; dst[13] = _d.y; dst[14] = _d.z; dst[15] = _d.w; } while (0)
typedef int v8i_m __attribute__((ext_vector_type(8)));
#define U_QADD(keep, send, ctrl) ((keep) + __builtin_bit_cast(float, __builtin_amdgcn_update_dpp(0, __builtin_bit_cast(int, (send)), (ctrl), 0xF, 0xF, true)))
__device__ __forceinline__ void u_step(const u8* x4, const int* idx, const u8* tab, float* Ps, int m, int mn, int mnn, int eg, int aoff, int xoff, bool xval, bool b0, bool b1, int poff, int sc1, int scb,
                                       const v4u (&bufC)[16], const v4u& xC, const unsigned (&idxN)[16], v4u (&bufN)[16], v4u& xN, unsigned (&idxNN)[16]) {
#pragma unroll
    for (int t = 0; t < 16; ++t) bufN[t] = gld16(tab + (size_t)idxN[t] * 128 + aoff);
    xN = gld16(x4 + (size_t)mn * 2048 + xoff);
    LOAD_II16(idxNN, mnn);
    __builtin_amdgcn_sched_barrier(0);
    const v8i_m bx = {xval ? (int)xC.x : 0, xval ? (int)xC.y : 0, xval ? (int)xC.z : 0, xval ? (int)xC.w : 0, 0, 0, 0, 0};
    f32x4 acc[16];
#pragma unroll
    for (int t = 0; t < 16; ++t) { const v8i_m a8 = {(int)bufC[t].x, (int)bufC[t].y, (int)bufC[t].z, (int)bufC[t].w, 0, 0, 0, 0};
        acc[t] = __builtin_amdgcn_mfma_scale_f32_16x16x128_f8f6f4(a8, bx, (f32x4){0.f, 0.f, 0.f, 0.f}, 4, 4, 0, sc1, 0, scb); }
    float v[16];
#pragma unroll
    for (int t = 0; t < 16; ++t) { const float lo = b0 ? acc[t].y : acc[t].x, hi = b0 ? acc[t].w : acc[t].z; const float vv = b1 ? hi : lo; v[t] = U_QADD(vv, vv, 0x128); }
    float w[8];
#pragma unroll
    for (int i = 0; i < 8; ++i) { const float send = b0 ? v[i] : v[i + 8], keep = b0 ? v[i + 8] : v[i]; w[i] = U_QADD(keep, send, 0xB1); }
    f32x4 z;
#pragma unroll
    for (int i = 0; i < 4; ++i) { const float send = b1 ? w[i] : w[i + 4], keep = b1 ? w[i + 4] : w[i]; z[i] = U_QADD(keep, send, 0x4E); }
    if (poff >= 0) { const h16x2 zl = {(_Float16)z[0], (_Float16)z[1]}, zh = {(_Float16)z[2], (_Float16)z[3]};
        *(GAS v2u*)((_Float16*)Ps + (size_t)m * 128 + poff) = (v2u){__builtin_bit_cast(unsigned, zl), __builtin_bit_cast(unsigned, zh)}; }
    __builtin_amdgcn_sched_barrier(0);
}
__device__ __forceinline__ void peer_u_pass(const u8* x4, const int* idx, const u8* TUl, float* P, int bx, int G, int wave, int lane_in) {
    const int s = bx & 7, cu = bx >> 3, nW = (G >> 3) * NWAVES;
    const u8* tab = TUl + (size_t)s * NEXP * 128;
    float* Ps = (float*)((_Float16*)P + (size_t)s * M * 128);
    int lane = lane_in; asm volatile("" : "+v"(lane));
    const int n = lane & 15, kg = lane >> 4;
    const int eg = 2 * (n >> 2) + (kg >> 1);
    const int aoff = 16 * (4 * (kg & 1) + (n & 3));
    const int xoff = 128 * s + aoff + ((n & 8) ? 1024 : 0);
    const bool xval = (kg >> 1) == ((n >> 2) & 1);
    const bool b0 = (lane & 1) != 0, b1 = (lane & 2) != 0;
    const int poff = (n < 8) ? 16 * (2 * kg + (n >> 2)) + (b0 ? 8 : 0) + (b1 ? 4 : 0) : -1;
    const int m0 = cu * NWAVES + wave;
    int sc1 = 0x7F7F7F7F, sc8 = (n & 8) ? 0x7C7C7C7C : 0x7F7F7F7F; asm volatile("" : "+v"(sc1), "+v"(sc8));
    unsigned iiX[16], iiY[16]; v4u bufA[16], bufB[16]; v4u xA, xB;
    {   LOAD_II16(iiY, m0);
#pragma unroll
        for (int t = 0; t < 16; ++t) bufA[t] = gld16(tab + (size_t)iiY[t] * 128 + aoff);
        xA = gld16(x4 + (size_t)m0 * 2048 + xoff);
        const int m1 = (m0 + nW < M) ? m0 + nW : m0; LOAD_II16(iiX, m1); }
#define CLAMPM(x) (((x) < M) ? (x) : m0)
    for (int m = m0; m < M; m += 2 * nW) {
        u_step(x4, idx, tab, Ps, m, CLAMPM(m + nW), CLAMPM(m + 2 * nW), eg, aoff, xoff, xval, b0, b1, poff, sc1, sc8, bufA, xA, iiX, bufB, xB, iiY);
        u_step(x4, idx, tab, Ps, m + nW, CLAMPM(m + 2 * nW), CLAMPM(m + 3 * nW), eg, aoff, xoff, xval, b0, b1, poff, sc1, sc8, bufB, xB, iiY, bufA, xA, iiX);
    }
}
__device__ __forceinline__ void peer_act_phase(const float* P, const int* idx, float* gate, const float* SU, const float* SV, int gw, int NGW, int lane) {
    for (int m = gw; m < M; m += NGW) {
#pragma unroll
        for (int h = 0; h < 2; ++h) { const int k = 64 * h + lane;
            float z = 0.f;
#pragma unroll
            for (int sl = 0; sl < 8; ++sl) z += (float)*(const GAS _Float16*)((const _Float16*)P + ((size_t)sl * M + m) * 128 + k);
            const int e = *(const GAS int*)(idx + (size_t)m * 128 + k);
            const float su = *(const GAS float*)(SU + e), sv = *(const GAS float*)(SV + e), gt = *(const GAS float*)(gate + (size_t)m * 128 + k);
            *(GAS float*)(gate + (size_t)m * 128 + k) = gelu_f(z * su) * gt * sv; }
    }
}
#define LOAD_AA16(dst, mm) do { const GAS f32x4* _ap = (const GAS f32x4*)(act + (size_t)(mm) * 128 + 16 * eg); const f32x4 _a = _ap[0], _b = _ap[1], _c = _ap[2], _d = _ap[3]; \
    dst[0] = _a.x; dst[1] = _a.y; dst[2] = _a.z; dst[3] = _a.w; dst[4] = _b.x; dst[5] = _b.y; dst[6] = _b.z; dst[7] = _b.w; dst[8] = _c.x; dst[9] = _c.y; dst[10] = _c.z; dst[11] = _c.w; dst[12] = _d.x; dst[13] = _d.y; dst[14] = _d.z; dst[15] = _d.w; } while (0)
__device__ __forceinline__ void v_step(bf16* hio, const int* idx, const float* act, const u8* tab, const float* stats, const f32x4 lg, const f32x4 lb, int m, int mn, int mnn, int lane, int c, int eg, int coff, bool b0,
                                       const v4u (&bufC)[16], const float (&aaC)[16], const unsigned (&idxN)[16], v4u (&bufN)[16], float (&aaN)[16], unsigned (&idxNN)[16]) {
#pragma unroll
    for (int g = 0; g < 16; ++g) bufN[g] = gld16(tab + (size_t)idxN[g] * 128 + 16 * c);
    LOAD_AA16(aaN, mn);
    LOAD_II16(idxNN, mnn);
    bf16* op = hio + (size_t)m * D + coff;
    const v2u xw = *(const GAS v2u*)op;
    const f32x2 st = *(const GAS f32x2*)(stats + 2 * (size_t)m);
    __builtin_amdgcn_sched_barrier(0);
    h16x2 y2[16];
#pragma unroll
    for (int i = 0; i < 16; ++i) y2[i] = (h16x2){(_Float16)0.f, (_Float16)0.f};
#pragma unroll
    for (int g = 0; g < 16; ++g) { const _Float16 a = (_Float16)aaC[g]; vacc4h(bufC[g], (h16x2){a, a}, y2); }
#pragma unroll
    for (int i = 0; i < 8; ++i) { const h16x2 send = b0 ? y2[i] : y2[i + 8], keep = b0 ? y2[i + 8] : y2[i];
        y2[i] = keep + __builtin_bit_cast(h16x2, __builtin_amdgcn_update_dpp(0, __builtin_bit_cast(int, send), 0x128, 0xF, 0xF, true)); }
#pragma unroll
    for (int i = 0; i < 4; ++i) { const auto sw = __builtin_amdgcn_permlane16_swap(__builtin_bit_cast(unsigned, y2[i]), __builtin_bit_cast(unsigned, y2[i + 4]), false, false);
        const unsigned s0 = sw[0], s1 = sw[1]; y2[i] = __builtin_bit_cast(h16x2, s0) + __builtin_bit_cast(h16x2, s1); }
#pragma unroll
    for (int i = 0; i < 2; ++i) { const auto sw = __builtin_amdgcn_permlane32_swap(__builtin_bit_cast(unsigned, y2[i]), __builtin_bit_cast(unsigned, y2[i + 2]), false, false);
        const unsigned s0 = sw[0], s1 = sw[1]; y2[i] = __builtin_bit_cast(h16x2, s0) + __builtin_bit_cast(h16x2, s1); }
    const float x0 = (bflo(xw.x) - st.x) * st.y * lg.x + lb.x, x1 = (bfhi(xw.x) - st.x) * st.y * lg.y + lb.y, x2 = (bflo(xw.y) - st.x) * st.y * lg.z + lb.z, x3 = (bfhi(xw.y) - st.x) * st.y * lg.w + lb.w;
    v2u o; o.x = pk2(x0 * DN_ALPHA + (float)y2[0].x, x1 * DN_ALPHA + (float)y2[0].y); o.y = pk2(x2 * DN_ALPHA + (float)y2[1].x, x3 * DN_ALPHA + (float)y2[1].y);
    *(GAS v2u*)op = o;
    __builtin_amdgcn_sched_barrier(0);
}
__device__ __forceinline__ void peer_v_pass(bf16* hio, const int* idx, const float* act, const u8* TVl, const float* stats, const float* lng, const float* lnb, int bx, int G, int wave, int lane_in) {
    const int s = bx & 7, cu = bx >> 3, nW = (G >> 3) * NWAVES;
    const u8* tab = TVl + (size_t)s * NEXP * 128;
    int lane = lane_in; asm volatile("" : "+v"(lane));
    const int c = lane & 7, eg = lane >> 3;
    const bool b0 = (lane & 8) != 0, b1 = (lane & 16) != 0, b2 = (lane & 32) != 0;
    const int coff = 256 * s + 32 * c + (b0 ? 16 : 0) + (b1 ? 8 : 0) + (b2 ? 4 : 0);
    const int m0 = cu * NWAVES + wave;
    const f32x4 lg = *(const GAS f32x4*)(lng + coff), lb = *(const GAS f32x4*)(lnb + coff);
    unsigned iiX[16], iiY[16]; v4u bufA[16], bufB[16]; float aaA[16], aaB[16];
    {   LOAD_II16(iiY, m0);
#pragma unroll
        for (int g = 0; g < 16; ++g) bufA[g] = gld16(tab + (size_t)iiY[g] * 128 + 16 * c);
        LOAD_AA16(aaA, m0);
        const int m1 = (m0 + nW < M) ? m0 + nW : m0; LOAD_II16(iiX, m1); }
    for (int m = m0; m < M; m += 2 * nW) {
        v_step(hio, idx, act, tab, stats, lg, lb, m, CLAMPM(m + nW), CLAMPM(m + 2 * nW), lane, c, eg, coff, b0, bufA, aaA, iiX, bufB, aaB, iiY);
        v_step(hio, idx, act, tab, stats, lg, lb, m + nW, CLAMPM(m + 2 * nW), CLAMPM(m + 3 * nW), lane, c, eg, coff, b0, bufB, aaB, iiY, bufA, aaA, iiX);
    }
}

constexpr int N_SLOTS = 11;
struct Args { const float* in[31]; float* out; unsigned char* ws; int slot, layer, pad0, pad1; };

constexpr int TAB_OFF = MISC_OFF + 128;
__device__ __forceinline__ void store_tab(const Args& a, LAS unsigned char* lds) {
    if (threadIdx.x == 0) { LAS unsigned long long* t = (LAS unsigned long long*)(lds + TAB_OFF);
#pragma unroll
        for (int i = 0; i < 31; ++i) t[i] = (unsigned long long)a.in[i];
        t[31] = (unsigned long long)a.out; t[32] = (unsigned long long)a.ws; }
    __syncthreads();
}
struct Tab { unsigned tab;
    __device__ __forceinline__ unsigned long long raw(int k) const { const v2u v = *(const LAS v2u*)(tab + 8 * k);
        return ((unsigned long long)(unsigned)__builtin_amdgcn_readfirstlane((int)v.y) << 32) | (unsigned)__builtin_amdgcn_readfirstlane((int)v.x); }
    __device__ __forceinline__ const float* in(int k) const { return (const float*)raw(k); }
};
#define ARG_IN(k) T_.in(k)

template <int SLOT>
__device__ __forceinline__ void run_slot(LAS unsigned char* lds, int layer, int wave_s) {
    int tid = wave_s * 64 + lane_id(); asm volatile("" : "+v"(tid));
    Tab T_; T_.tab = (unsigned)(unsigned long long)(lds + TAB_OFF); asm volatile("" : "+s"(T_.tab));
    unsigned char* ws = (unsigned char*)T_.raw(32);
    const int lane = tid & 63, wave = __builtin_amdgcn_readfirstlane(tid >> 6);
    const int G = gridDim.x; const int bx = blockIdx.x; const int vcu = (G % 8 == 0) ? (bx % 8) * (G / 8) + bx / 8 : bx;
    const int gw = vcu * NWAVES + wave, NGW = G * NWAVES;
    const int gtid = vcu * (NWAVES * 64) + tid, gthreads = G * NWAVES * 64;
    const int kind = layer % 3, jj = layer / 3;
    float* hout = (float*)T_.raw(31);
    bf16* HB0 = (bf16*)(ws + WS_HB0); bf16* HB1 = (bf16*)(ws + WS_HB1);
    bf16* T1 = (bf16*)(ws + WS_T1); bf16* T2 = (bf16*)(ws + WS_T2); bf16* T3 = (bf16*)(ws + WS_T3);
    int* IDX = (int*)(ws + WS_IDX); float* GATE = (float*)(ws + WS_GATE);
    bf16* TU = (bf16*)(ws + WS_TU); bf16* TV = (bf16*)(ws + WS_TV); bf16* PB = (bf16*)(ws + WS_PB); bf16* SKB = (bf16*)(ws + WS_SK);
    bf16* Sin = (layer & 1) ? HB1 : HB0;
    bf16* Sout = (layer & 1) ? HB0 : HB1;

    if constexpr (SLOT == 0) {
        LAS float* scr = (LAS float*)(lds + wave * 16384); LAS unsigned* scr8 = (LAS unsigned*)(lds + wave * 16384); int woff = 0;
        for (int j = 0; j < 2; ++j) {
            transpose_mat8b(ARG_IN(6) + (size_t)j * D * D, D, D, ws + W_POOL_IN + (size_t)j * D * D, 0, scr8, gw, NGW, lane, woff);
            for (int g = 0; g < 4; ++g) transpose_mat8b(ARG_IN(7) + (size_t)(j * 4 + g) * 512 * 512, 512, 512, ws + W_POOL_GRP + (size_t)j * D * 512, g * 512, scr8, gw, NGW, lane, woff);
            transpose_mat8b(ARG_IN(9) + (size_t)j * D * D, D, D, ws + W_POOL_OUT + (size_t)j * D * D, 0, scr8, gw, NGW, lane, woff);
        }
        transpose_mat8b(ARG_IN(10), D, D, ws + W_SSM_IN, 0, scr8, gw, NGW, lane, woff);
        transpose_mat8b(ARG_IN(19), D, D, ws + W_SSM_GLU, 0, scr8, gw, NGW, lane, woff);
        transpose_mat8b(ARG_IN(20), D, D, ws + W_SSM_OUT, 0, scr8, gw, NGW, lane, woff);
        transpose_mat8b(ARG_IN(21), D, 3 * D, ws + W_ATTN_QKV, 0, scr8, gw, NGW, lane, woff);
        transpose_mat8b(ARG_IN(23), D, D, ws + W_ATTN_OUT, 0, scr8, gw, NGW, lane, woff);
        for (int i = 0; i < DEPTH; ++i) {
            transpose_mat8b(ARG_IN(24) + (size_t)i * D * D, D, D, ws + W_PEER_Q + (size_t)i * D * D, 0, scr8, gw, NGW, lane, woff);
            transpose_mat8b(ARG_IN(29) + (size_t)i * D * D, D, D, ws + W_PLE_GATE + (size_t)i * D * D, 0, scr8, gw, NGW, lane, woff);
            transpose_mat(ARG_IN(28) + (size_t)i * PLE * D, PLE, D, (bf16*)(ws + W_PLE_PROJ) + (size_t)i * PLE * D, 0, scr, gw, NGW, lane, woff);
        }
        cvt_rows_fp4(ARG_IN(26), (u8*)TU, (float*)(ws + WS_SU), DEPTH * NEXP, gw, NGW, lane);
        cvt_rows_fp4(ARG_IN(27), (u8*)TV, (float*)(ws + WS_SV), DEPTH * NEXP, gw, NGW, lane);
        cvt_rows(ARG_IN(1), PB, (size_t)DEPTH * M * PLE, (size_t)gtid, (size_t)gthreads);
        cvt_rows(ARG_IN(25), SKB, (size_t)DEPTH * 2 * 128 * 128, (size_t)gtid, (size_t)gthreads);
        {
            const float* xs = ARG_IN(0); unsigned char* s8 = ws + WS_S8;
            const size_t gs = (size_t)gthreads * 8;
            for (size_t i0 = (size_t)gtid * 8; i0 < (size_t)M * D; i0 += 4 * gs) {
                f32x4 a[4], b[4];
#pragma unroll
                for (int u = 0; u < 4; ++u) { a[u] = *(const GAS f32x4*)(xs + i0 + u * gs); b[u] = *(const GAS f32x4*)(xs + i0 + u * gs + 4); }
#pragma unroll
                for (int u = 0; u < 4; ++u) { const size_t i = i0 + u * gs;
                    v4u o; o.x = pk2(a[u].x, a[u].y); o.y = pk2(a[u].z, a[u].w); o.z = pk2(b[u].x, b[u].y); o.w = pk2(b[u].z, b[u].w);
                    *(GAS v4u*)(HB0 + i) = o;
                    int w0 = 0, w1 = 0;
                    w0 = __builtin_amdgcn_cvt_pk_fp8_f32(a[u].x, a[u].y, w0, false); w0 = __builtin_amdgcn_cvt_pk_fp8_f32(a[u].z, a[u].w, w0, true);
                    w1 = __builtin_amdgcn_cvt_pk_fp8_f32(b[u].x, b[u].y, w1, false); w1 = __builtin_amdgcn_cvt_pk_fp8_f32(b[u].z, b[u].w, w1, true);
                    v2u o8; o8.x = (unsigned)w0; o8.y = (unsigned)w1; *(GAS v2u*)(s8 + i) = o8; } } }
        {
            const float* lam_re = ARG_IN(11); const float* lam_im = ARG_IN(12); const float* log_step = ARG_IN(13); const float* b_re = ARG_IN(14); const float* b_im = ARG_IN(15);
            float* ssmp = (float*)(ws + WS_SSMP);
            for (int i = gtid; i < 128 * 64; i += gthreads) { const int g = i >> 6;
                const float lr = lam_re[i], li = lam_im[i], dt = expf(log_step[g]);
                const float mag = expf(dt * lr), ar = mag * cosf(dt * li), ai = mag * sinf(dt * li);
                const float den = lr * lr + li * li;
                const float kr = ((ar - 1.f) * lr + ai * li) / den, ki = (ai * lr - (ar - 1.f) * li) / den;
                float* o = ssmp + (size_t)i * 34; o[0] = ar; o[1] = ai;
                for (int c = 0; c < 16; ++c) { const float br = b_re[i * 16 + c], bi = b_im[i * 16 + c]; o[2 + c] = kr * br - ki * bi; o[18 + c] = kr * bi + ki * br; } }
        }
    }
    if constexpr (SLOT == 1) {
        pg8::StaticOrder S;
        if (kind == 2) {
            pg8::Gemm g{(const bf16*)(ws + WS_S8), (const bf16*)(ws + W_ATTN_QKV), M, 3 * D, D / 2, D / 2, 0}; S.init(M, 3 * D, G, bx);
            pg8::EpiBf16 E{T1, D, nullptr, D, (size_t)(WS_T2 - WS_T1) / 2, ATTN_QSCALE, nullptr, 1.f / W8S};
            pg8::gemm_phase<pg8::EpiBf16, true>(lds, g, S, E, tid);
        } else {
            const unsigned char* W = (kind == 0) ? ws + W_POOL_IN + (size_t)jj * D * D : ws + W_SSM_IN;
            pg8::Gemm g{(const bf16*)(ws + WS_S8), (const bf16*)W, M, D, D / 2, D / 2, 0}; S.init(M, D, G, bx);
            pg8::EpiBf16 E{T1, D, nullptr, 0, 0, 1.f, nullptr, 1.f / W8S};
            pg8::gemm_phase<pg8::EpiBf16, true>(lds, g, S, E, tid);
        }
    }
    if constexpr (SLOT == 2) {
        if (kind == 0) pool_phase(T1, (u8*)T2, gw, NGW, lane);
        else if (kind == 1) ssm_phase_m(T1, (u8*)T2, (const float*)(ws + WS_SSMP), ARG_IN(16), ARG_IN(17), ARG_IN(18), lds, vcu, G, wave, lane);
        else {
            LAS float* rb = (LAS float*)lds;
            for (int i = tid; i < 16 * 257; i += NWAVES * 64) rb[i] = ARG_IN(22)[i] * LOG2E;
            __syncthreads();
            attn_phase_split(T1, T2, T3, ws + WS_X8, rb, lds + 32768, vcu, G, wave, lane);
            __syncthreads();
        }
    }
    if constexpr (SLOT == 3) {
        pg8::StaticOrder S; S.init(M, D, G, bx);
        if (kind == 0) {
            pg8::Gemm g{(const bf16*)T2, (const bf16*)(ws + W_POOL_GRP + (size_t)jj * D * 512), M, D, 256, D / 2, 2};
            pg8::EpiF8 E{(unsigned char*)T1, D, ARG_IN(8) + (size_t)jj * D, 1.f / W8S};
            pg8::gemm_phase<pg8::EpiF8, true>(lds, g, S, E, tid);
        } else if (kind == 1) {
            pg8::Gemm g{(const bf16*)T2, (const bf16*)(ws + W_SSM_GLU), M, D, D / 2, D / 2, 0};
            pg8::EpiGlu8 E{(const unsigned char*)T2, (unsigned char*)T1, D, 1.f / W8S};
            pg8::gemm_phase<pg8::EpiGlu8, true>(lds, g, S, E, tid);
        }
    }
    if constexpr (SLOT == 4) {
        const unsigned char* W = (kind == 0) ? ws + W_POOL_OUT + (size_t)jj * D * D : (kind == 1) ? ws + W_SSM_OUT : ws + W_ATTN_OUT;
        pg8::Gemm g{(kind == 2) ? (const bf16*)(ws + WS_X8) : (const bf16*)T1, (const bf16*)W, M, D, D / 2, D / 2, 0}; pg8::StaticOrder S; S.init(M, D, G, bx);
        pg8::EpiRes E{Sin, Sin, D, DN_ALPHA, (kind == 2) ? 1.f / (W8S * O8S) : 1.f / W8S};
        pg8::gemm_phase<pg8::EpiRes, true>(lds, g, S, E, tid);
    }
    if constexpr (SLOT == 5) ln_phase<true>(Sin, ARG_IN(2) + (size_t)layer * D, ARG_IN(3) + (size_t)layer * D, gw, NGW, lane, ws + WS_X8, ws + WS_S8, (float*)(ws + WS_STATS));
    if constexpr (SLOT == 6) {
        { pg8::Gemm g{(const bf16*)(ws + WS_S8), (const bf16*)(ws + W_PEER_Q + (size_t)layer * D * D), M, D, D / 2, D / 2, 0}; pg8::StaticOrder S; S.init(M, D, G, bx);
          pg8::EpiBf16 E{T1, D, nullptr, 0, 0, 1.f, nullptr, 1.f / W8S};
          pg8::gemm_phase<pg8::EpiBf16, true>(lds, g, S, E, tid); }
    }
    if constexpr (SLOT == 14) {
        __syncthreads();
        { pg8::Gemm g{PB + (size_t)layer * M * PLE, (const bf16*)(ws + W_PLE_PROJ) + (size_t)layer * PLE * D, M, D, PLE, PLE, 0}; pg8::StaticOrder S; S.init(M, D, G, bx);
          pg8::EpiF8 E{(unsigned char*)T3, D, nullptr, 8.f};
          pg8::gemm_phase<pg8::EpiF8>(lds, g, S, E, tid); }
    }
    if constexpr (SLOT == 7) {
        const bf16* sk = SKB + (size_t)layer * 2 * 128 * 128;
        for (int i = tid; i < 256 * 16; i += NWAVES * 64) { const int rowi = i >> 4, ch = i & 15; *(LAS v4u*)(lds + rowi * 272 + ch * 16) = *(const v4u*)(sk + rowi * 128 + ch * 8); }
        __syncthreads();
        peer_select_phase(T1, lds, IDX, GATE, gw, NGW, lane);
        __syncthreads();
    }
    if constexpr (SLOT == 8) peer_u_pass(ws + WS_X8, IDX, (const u8*)TU + (size_t)layer * NEXP * 1024, (float*)T2, bx, G, wave, lane);
    if constexpr (SLOT == 11) peer_act_phase((const float*)T2, IDX, GATE, (const float*)(ws + WS_SU) + layer * NEXP, (const float*)(ws + WS_SV) + layer * NEXP, gw, NGW, lane);
    if constexpr (SLOT == 12) peer_v_pass(Sin, IDX, GATE, (const u8*)TV + (size_t)layer * NEXP * 1024, (const float*)(ws + WS_STATS), ARG_IN(2) + (size_t)layer * D, ARG_IN(3) + (size_t)layer * D, bx, G, wave, lane);
    if constexpr (SLOT == 13) ln_phase(Sin, ARG_IN(4) + (size_t)layer * D, ARG_IN(5) + (size_t)layer * D, gw, NGW, lane, ws + WS_X8);
    if constexpr (SLOT == 10) {
        pg8::Gemm g{(const bf16*)(ws + WS_X8), (const bf16*)(ws + W_PLE_GATE + (size_t)layer * D * D), M, D, D / 2, D / 2, 0}; pg8::StaticOrder S; S.init(M, D, G, bx);
        pg8::EpiPle E{Sin, (const unsigned char*)T3, Sout, ws + WS_S8, (layer == DEPTH - 1) ? hout : nullptr, ARG_IN(30) + (size_t)layer * D, D, 1.f / W8S};
        pg8::gemm_phase<pg8::EpiPle, true>(lds, g, S, E, tid);
    }
}

template <int SLOT>
__global__ void __launch_bounds__(NWAVES * 64, 2) mk_slot(Args args) {
    extern __shared__ __attribute__((aligned(16))) unsigned char lds_raw[];
    store_tab(args, (LAS unsigned char*)lds_raw);
    run_slot<SLOT>((LAS unsigned char*)lds_raw, args.layer, __builtin_amdgcn_readfirstlane((int)(threadIdx.x >> 6)));
}

#if !MK_PER_PHASE
__global__ void __launch_bounds__(NWAVES * 64, 2) mk_fwd(Args args) {
    extern __shared__ __attribute__((aligned(16))) unsigned char lds_raw[];
    LAS unsigned char* lds = (LAS unsigned char*)lds_raw;
    volatile LAS unsigned* MISC = (volatile LAS unsigned*)(lds + MISC_OFF);
    for (int u = threadIdx.x; u < (LDS_BYTES - LDSCTL_OFF) / 4; u += NWAVES * 64) ((LAS unsigned*)(lds + LDSCTL_OFF))[u] = 0u;
    __syncthreads();
    store_tab(args, lds);
    const XcdBarrier bar = xcd_barrier_post((unsigned*)(args.ws + WS_CTL) + CW_BAR, MISC + 8);
    run_slot<0>(lds, 0, bar.wave); xcd_barrier(bar);
    for (int layer = 0; layer < DEPTH; ++layer) {
        run_slot<1>(lds, layer, bar.wave); xcd_barrier(bar);
        run_slot<2>(lds, layer, bar.wave); xcd_barrier(bar);
        if (layer % 3 != 2) { run_slot<3>(lds, layer, bar.wave); xcd_barrier(bar); }
        run_slot<4>(lds, layer, bar.wave); xcd_barrier(bar);
        run_slot<5>(lds, layer, bar.wave); xcd_barrier(bar);
        run_slot<6>(lds, layer, bar.wave); run_slot<14>(lds, layer, bar.wave); xcd_barrier(bar);
        run_slot<7>(lds, layer, bar.wave); xcd_barrier(bar);
        run_slot<8>(lds, layer, bar.wave); xcd_barrier(bar);
        run_slot<11>(lds, layer, bar.wave); xcd_barrier(bar);
        run_slot<12>(lds, layer, bar.wave); xcd_barrier(bar);
        run_slot<13>(lds, layer, bar.wave); xcd_barrier(bar);
        run_slot<10>(lds, layer, bar.wave); if (layer + 1 < DEPTH) xcd_barrier(bar);
    }
}
#endif

template <int SLOT> static void launch_slot(const Args& a0, int layer, int grid, hipStream_t stream) {
    static bool attr_done = false;
    if (!attr_done) { (void)hipFuncSetAttribute((const void*)mk_slot<SLOT>, hipFuncAttributeMaxDynamicSharedMemorySize, LDS_BYTES); attr_done = true; }
    Args a = a0; a.slot = SLOT; a.layer = layer;
    hipLaunchKernelGGL(mk_slot<SLOT>, dim3(grid), dim3(NWAVES * 64), LDS_BYTES, stream, a);
}

extern "C" void kernel_launch(void* const* d_in, const int* in_sizes, int n_in, void* d_out, int out_size, void* d_ws, size_t ws_size, hipStream_t stream) {
    static int grid = 0;
    if (grid == 0) {
        if (n_in != 31 || out_size != M * D || ws_size < WS_END) { fprintf(stderr, "kernel_launch: unexpected shapes (n_in %d out %d ws %zu)\n", n_in, out_size, ws_size); grid = -1; return; }
        int dev = 0, cus = 0, per_cu = 0;
        if (hipGetDevice(&dev) != hipSuccess || hipDeviceGetAttribute(&cus, hipDeviceAttributeMultiprocessorCount, dev) != hipSuccess) { grid = -1; return; }
#if !MK_PER_PHASE
        if (hipFuncSetAttribute((const void*)mk_fwd, hipFuncAttributeMaxDynamicSharedMemorySize, LDS_BYTES) != hipSuccess) { fprintf(stderr, "kernel_launch: hipFuncSetAttribute failed\n"); grid = -1; return; }
        if (hipOccupancyMaxActiveBlocksPerMultiprocessor(&per_cu, (const void*)mk_fwd, NWAVES * 64, LDS_BYTES) != hipSuccess || per_cu < 1) { fprintf(stderr, "kernel_launch: occupancy query says %d\n", per_cu); }
        (void)hipGetLastError();
#endif
        (void)per_cu;
        grid = cus;
    }
    if (grid < 0) return;
    Args a{};
    for (int i = 0; i < 31; ++i) a.in[i] = (const float*)d_in[i];
    a.out = (float*)d_out; a.ws = (unsigned char*)d_ws;
#if MK_PER_PHASE
    launch_slot<0>(a, 0, grid, stream);
    for (int layer = 0; layer < DEPTH; ++layer) {
        launch_slot<1>(a, layer, grid, stream); launch_slot<2>(a, layer, grid, stream);
        if (layer % 3 != 2) launch_slot<3>(a, layer, grid, stream);
        launch_slot<4>(a, layer, grid, stream); launch_slot<5>(a, layer, grid, stream); launch_slot<6>(a, layer, grid, stream); launch_slot<14>(a, layer, grid, stream); launch_slot<7>(a, layer, grid, stream);
        launch_slot<8>(a, layer, grid, stream); launch_slot<11>(a, layer, grid, stream); launch_slot<12>(a, layer, grid, stream); launch_slot<13>(a, layer, grid, stream); launch_slot<10>(a, layer, grid, stream);
    }
#else
    if (hipMemsetAsync((char*)d_ws + WS_CTL, 0, CTL_ZERO_BYTES, stream) != hipSuccess) return;
    hipLaunchKernelGGL(mk_fwd, dim3(grid), dim3(NWAVES * 64), LDS_BYTES, stream, a);
#endif
}
```

```cpp
#include <hip/hip_runtime.h>
#include <cstdio>
#include <cstdint>

#ifndef MK_PER_PHASE
#define MK_PER_PHASE 0
#endif

namespace pg8 {
#define PG8_LAS __attribute__((address_space(3)))
typedef unsigned short bf16_t;
typedef short bf16x8 __attribute__((ext_vector_type(8)));
typedef float f32x4 __attribute__((ext_vector_type(4)));
typedef unsigned u32x4 __attribute__((ext_vector_type(4)));
constexpr int BM = 256, BK = 64, HALF = 128, HTB = HALF * BK * 2, STAGE_BYTES = 8 * HTB, NXCD = 8, WGM = 8;

__host__ __device__ __forceinline__ int lds_byte(int r, int c) { const int st = (r >> 4) * 2 + (c >> 5), rr = r & 15, cc = c & 31, ob = rr * 64 + cc * 2; return st * 1024 + (ob ^ (((ob >> 9) & 1) << 5)); }
__host__ __device__ __forceinline__ int lds_byte8(int r, int c) { const int st = (r >> 4) * 2 + (c >> 5), rr = r & 15, cc = c & 31, ob = rr * 64 + cc * 2; return st * 1024 + (ob ^ (((ob >> 9) & 1) << 5) ^ (((ob >> 8) & 1) << 4)); }
__host__ __device__ __forceinline__ void stage_rc8(int b, int& R, int& C) { const int st = b / 1024, sb = b % 1024, swz = sb ^ (((sb >> 9) & 1) << 5) ^ (((sb >> 8) & 1) << 4); R = (st >> 1) * 16 + swz / 64; C = (st & 1) * 32 + (swz % 64) / 2; }
__host__ __device__ __forceinline__ void stage_rc(int b, int& R, int& C) { const int st = b / 1024, sb = b % 1024, swz = sb ^ (((sb >> 9) & 1) << 5); R = (st >> 1) * 16 + swz / 64; C = (st & 1) * 32 + (swz % 64) / 2; }
__host__ __device__ __forceinline__ int perm32(int rho) { const int n = rho >> 4, i = rho & 15; return 8 * (i >> 2) + 4 * n + (i & 3); }
__host__ __device__ __forceinline__ int perm32f8(int rho) { return 16 * ((rho >> 2) & 1) + (rho & 3) + 4 * (rho >> 3); }

__device__ __forceinline__ int lane_now() { int l; asm volatile("v_mbcnt_lo_u32_b32 %0, -1, 0\n\tv_mbcnt_hi_u32_b32 %0, -1, %0" : "=v"(l)); return l; }
struct Unit { int pm, pn; };
struct Gemm { const bf16_t* A; const bf16_t* Bt; int M, N, K, lda, agrp; };

struct StaticOrder {
    int nM, nN, nwg, G, c;
    __host__ __device__ void init(int M, int N, int G_, int c_) { nM = M / BM; nN = N / BM; nwg = nM * nN; G = G_; c = c_; }
    __host__ __device__ bool next(int i, Unit& u) const {
        const long L = (long)i * G + c; if (L >= nwg) return false;
        int wgid = (int)L; { const int q = nwg / NXCD, r = nwg % NXCD, xcd = wgid % NXCD, off = wgid / NXCD; wgid = (xcd < r ? xcd * (q + 1) : r * (q + 1) + (xcd - r) * q) + off; }
        const int nig = WGM * nN, gid = wgid / nig, fm = gid * WGM, gsz = (nM - fm) < WGM ? (nM - fm) : WGM;
        u.pm = fm + ((wgid % nig) % gsz); u.pn = (wgid % nig) / gsz; return true;
    }
};

__device__ __forceinline__ unsigned cvt_pk_bf16(float lo, float hi) { unsigned r; asm volatile("v_cvt_pk_bf16_f32 %0, %1, %2" : "=v"(r) : "v"(lo), "v"(hi)); return r; }
__device__ __forceinline__ float bf_lo(unsigned w) { return __builtin_bit_cast(float, w << 16); }
__device__ __forceinline__ float bf_hi(unsigned w) { return __builtin_bit_cast(float, w & 0xffff0000u); }
__device__ __forceinline__ float sigmoid_f(float x) { return __builtin_amdgcn_rcpf(1.f + __builtin_amdgcn_exp2f(-1.4426950408889634f * x)); }
#ifdef DBG_PLE_HALF
__device__ __forceinline__ float sigmoid_p(float x) { return 0.5f; }
#else
__device__ __forceinline__ float sigmoid_p(float x) { return sigmoid_f(x); }
#endif

typedef int v8i_t __attribute__((ext_vector_type(8)));
typedef unsigned u32x2 __attribute__((ext_vector_type(2)));
typedef float f32x16 __attribute__((ext_vector_type(16)));
typedef float f32x2_ __attribute__((ext_vector_type(2)));
__device__ __forceinline__ u32x2 pack8_fp8(const f32x4 v0, const f32x4 v1) {
    int a = 0, b = 0;
    a = __builtin_amdgcn_cvt_pk_fp8_f32(v0[0], v0[1], a, false); a = __builtin_amdgcn_cvt_pk_fp8_f32(v0[2], v0[3], a, true);
    b = __builtin_amdgcn_cvt_pk_fp8_f32(v1[0], v1[1], b, false); b = __builtin_amdgcn_cvt_pk_fp8_f32(v1[2], v1[3], b, true);
    return (u32x2){(unsigned)a, (unsigned)b};
}
__device__ __forceinline__ u32x4 pack8_bf16(const f32x4 v0, const f32x4 v1) { u32x4 w; w.x = cvt_pk_bf16(v0[0], v0[1]); w.y = cvt_pk_bf16(v0[2], v0[3]); w.z = cvt_pk_bf16(v1[0], v1[1]); w.w = cvt_pk_bf16(v1[2], v1[3]); return w; }
struct EpiBf16 {
    bf16_t* O; int ldc; const float* cscale; int split_cols; size_t split_stride; float scale0; bf16_t* VT; float oscale;
    __device__ __forceinline__ void chunk(int row, int col, f32x4 v0, f32x4 v1) const {
        if (cscale) { v0 = v0 * *(const f32x4*)(cscale + col); v1 = v1 * *(const f32x4*)(cscale + col + 4); }
        if (!split_cols) { *(u32x4*)(O + (size_t)row * ldc + col) = pack8_bf16(v0 * oscale, v1 * oscale); return; }
        const int t = col / split_cols, c = col - t * split_cols, hd = c >> 7, d = c & 127, b = row >> 13, sq = row & 8191;
        const float sc = (t == 0) ? oscale * scale0 : oscale;
        const u32x4 w = pack8_bf16(v0 * sc, v1 * sc);
        bf16_t* base = O + (size_t)t * split_stride;
        const size_t bh = (size_t)(b * 16 + hd) * 256 + (sq >> 5);
        if (t < 2) *(u32x4*)(base + ((bh * 8 + (d >> 4)) * 512) + (size_t)((sq & 31) + 32 * ((d >> 3) & 1)) * 8) = w;
        else { const int kk = sq & 31, k16 = kk & 15; bf16_t* p = base + ((((bh * 4 + (d >> 5)) * 2 + (kk >> 4)) * 512) + (size_t)((d & 31) + 32 * ((k16 >> 2) & 1)) * 8) + (k16 & 3) + 4 * (k16 >> 3);
            p[0] = (bf16_t)(w.x & 0xffffu); p[8] = (bf16_t)(w.x >> 16); p[16] = (bf16_t)(w.y & 0xffffu); p[24] = (bf16_t)(w.y >> 16);
            p[32] = (bf16_t)(w.z & 0xffffu); p[40] = (bf16_t)(w.z >> 16); p[48] = (bf16_t)(w.w & 0xffffu); p[56] = (bf16_t)(w.w >> 16); }
    }
};
struct EpiF8 {
    unsigned char* O; int ldc; const float* cscale; float oscale;
    __device__ __forceinline__ void chunk(int row, int col, f32x4 v0, f32x4 v1) const {
        if (cscale) { v0 = v0 * *(const f32x4*)(cscale + col); v1 = v1 * *(const f32x4*)(cscale + col + 4); }
        *(u32x2*)(O + (size_t)row * ldc + col) = pack8_fp8(v0 * oscale, v1 * oscale);
    }
    struct Pre { f32x4 c0, c1; };
    __device__ __forceinline__ Pre pre(int row, int col) const { Pre p; p.c0 = (f32x4){1.f, 1.f, 1.f, 1.f}; p.c1 = p.c0;
        if (cscale) { p.c0 = *(const __attribute__((address_space(1))) f32x4*)(cscale + col); p.c1 = *(const __attribute__((address_space(1))) f32x4*)(cscale + col + 4); } return p; }
    __device__ __forceinline__ void fin(int row, int col, f32x4 v0, f32x4 v1, const Pre& p) const {
        if (cscale) { v0 = v0 * p.c0; v1 = v1 * p.c1; }
        *(__attribute__((address_space(1))) u32x2*)(O + (size_t)row * ldc + col) = pack8_fp8(v0 * oscale, v1 * oscale);
    }
};
#define PG8_GAS __attribute__((address_space(1)))
struct EpiGlu8 {
    const unsigned char* Gin; unsigned char* O; int ld; float oscale;
    typedef u32x2 Pre;
    __device__ __forceinline__ Pre pre(int row, int col) const { return *(const PG8_GAS u32x2*)(Gin + (size_t)row * ld + col); }
    __device__ __forceinline__ void fin(int row, int col, f32x4 a0, f32x4 a1, const Pre g) const {
        const size_t ro = (size_t)row * ld + col; a0 = a0 * oscale; a1 = a1 * oscale;
        const unsigned gx = g.x, gy = g.y;
        const f32x2_ g01 = __builtin_amdgcn_cvt_pk_f32_fp8((int)gx, false), g23 = __builtin_amdgcn_cvt_pk_f32_fp8((int)gx, true), g45 = __builtin_amdgcn_cvt_pk_f32_fp8((int)gy, false), g67 = __builtin_amdgcn_cvt_pk_f32_fp8((int)gy, true);
        const f32x4 o0 = {g01.x * sigmoid_f(a0[0]), g01.y * sigmoid_f(a0[1]), g23.x * sigmoid_f(a0[2]), g23.y * sigmoid_f(a0[3])};
        const f32x4 o1 = {g45.x * sigmoid_f(a1[0]), g45.y * sigmoid_f(a1[1]), g67.x * sigmoid_f(a1[2]), g67.y * sigmoid_f(a1[3])};
        *(PG8_GAS u32x2*)(O + ro) = pack8_fp8(o0, o1);
    }
};
struct EpiRes {
    const bf16_t* hres; bf16_t* out; int ld; float alpha; float mscale;
    typedef u32x4 Pre;
    __device__ __forceinline__ Pre pre(int row, int col) const { return *(const PG8_GAS u32x4*)(hres + (size_t)row * ld + col); }
    __device__ __forceinline__ void fin(int row, int col, f32x4 a0, f32x4 a1, const Pre h) const {
        const size_t ro = (size_t)row * ld + col; a0 = a0 * mscale; a1 = a1 * mscale;
        const f32x4 o0 = {bf_lo(h.x) * alpha + a0[0], bf_hi(h.x) * alpha + a0[1], bf_lo(h.y) * alpha + a0[2], bf_hi(h.y) * alpha + a0[3]};
        const f32x4 o1 = {bf_lo(h.z) * alpha + a1[0], bf_hi(h.z) * alpha + a1[1], bf_lo(h.w) * alpha + a1[2], bf_hi(h.w) * alpha + a1[3]};
        *(PG8_GAS u32x4*)(out + ro) = pack8_bf16(o0, o1);
    }
};
struct EpiPle {
    const bf16_t* hin; const unsigned char* proj; bf16_t* hob; unsigned char* ho8; float* fout; const float* bias; int ld; float oscale;
    struct Pre { u32x2 pj8; u32x4 hh; f32x4 b0, b1; };
    __device__ __forceinline__ Pre pre(int row, int col) const { const size_t ro = (size_t)row * ld + col; Pre p; p.pj8 = *(const PG8_GAS u32x2*)(proj + ro); p.hh = *(const PG8_GAS u32x4*)(hin + ro);
        p.b0 = *(const PG8_GAS f32x4*)(bias + col); p.b1 = *(const PG8_GAS f32x4*)(bias + col + 4); return p; }
    __device__ __forceinline__ void fin(int row, int col, f32x4 a0, f32x4 a1, const Pre& p) const {
        const size_t ro = (size_t)row * ld + col; const u32x2 pj8 = p.pj8; const u32x4 hh = p.hh;
        const unsigned pjx = pj8.x, pjy = pj8.y;
        const f32x2_ q01 = __builtin_amdgcn_cvt_pk_f32_fp8((int)pjx, false), q23 = __builtin_amdgcn_cvt_pk_f32_fp8((int)pjx, true), q45 = __builtin_amdgcn_cvt_pk_f32_fp8((int)pjy, false), q67 = __builtin_amdgcn_cvt_pk_f32_fp8((int)pjy, true);
        const float pjs = 1.f / 8.f;
        const float p0 = q01.x * pjs, p1 = q01.y * pjs, p2 = q23.x * pjs, p3 = q23.y * pjs, p4 = q45.x * pjs, p5 = q45.y * pjs, p6 = q67.x * pjs, p7 = q67.y * pjs;
        a0 = a0 * oscale + p.b0; a1 = a1 * oscale + p.b1;
        f32x4 h0, h1;
        h0[0] = bf_lo(hh.x) + sigmoid_p(a0[0]) * p0; h0[1] = bf_hi(hh.x) + sigmoid_p(a0[1]) * p1; h0[2] = bf_lo(hh.y) + sigmoid_p(a0[2]) * p2; h0[3] = bf_hi(hh.y) + sigmoid_p(a0[3]) * p3;
        h1[0] = bf_lo(hh.z) + sigmoid_p(a1[0]) * p4; h1[1] = bf_hi(hh.z) + sigmoid_p(a1[1]) * p5; h1[2] = bf_lo(hh.w) + sigmoid_p(a1[2]) * p6; h1[3] = bf_hi(hh.w) + sigmoid_p(a1[3]) * p7;
        if (fout != nullptr) { *(PG8_GAS f32x4*)(fout + ro) = h0; *(PG8_GAS f32x4*)(fout + ro + 4) = h1; }
        else { *(PG8_GAS u32x4*)(hob + ro) = pack8_bf16(h0, h1); *(PG8_GAS u32x2*)(ho8 + ro) = pack8_fp8(h0, h1); }
    }
};

template <class E, class = void> struct HasPre { static constexpr bool value = false; };
template <class E> struct HasPre<E, decltype((void)sizeof(typename E::Pre))> { static constexpr bool value = true; };
template <class Epi, bool F8 = false>
__device__ __forceinline__ void gemm_phase(PG8_LAS unsigned char* lds, const Gemm g, const StaticOrder& S, const Epi& E, const int tid) {
    const int wid = __builtin_amdgcn_readfirstlane(tid >> 6), lane = tid & 63, wr = wid >> 2, wc = wid & 3, fr = lane & 15, fq = lane >> 4;
    const int K = g.K, nt = K / BK, lda = g.lda;
    unsigned voffA[2], voffB[2];
#pragma unroll
    for (int i = 0; i < 2; ++i) { int R, C; if (F8) stage_rc8(tid * 16 + i * 8192, R, C); else stage_rc(tid * 16 + i * 8192, R, C); const int Rb = (R & ~31) + (F8 ? perm32f8(R & 31) : perm32(R & 31));
        voffA[i] = (unsigned)(R * lda + C) * 2u; voffB[i] = (unsigned)(Rb * K + C) * 2u; }
    const size_t kstep = (size_t)(BK * 2);
    const size_t hstepA = (size_t)HALF * lda * 2, hstepB = (size_t)HALF * K * 2;
    const size_t tstepA = 2 * hstepA, tstepB = 2 * hstepB;
    const unsigned ldsw = (unsigned)wid * 1024u;
    const int l31 = lane & 31, h32 = lane >> 5;
    const int aoff = F8 ? lds_byte8(wr * 64 + l31, 16 * h32) : lds_byte(wr * 64 + fr, fq * 8);
    const int boff = F8 ? lds_byte8(wc * 32 + l31, 16 * h32) : lds_byte(wc * 32 + fr, fq * 8);
    const int aoffx = aoff ^ 16, boffx = boff ^ 16;
#define PG8_SA(b, h) (((b) * 2 + (h)) * HTB)
#define PG8_SB(b, h) ((4 + (b) * 2 + (h)) * HTB)
#define PG8_STAGE(bufoff, gbase, voff) do { _Pragma("unroll") for (int _i = 0; _i < 2; ++_i) \
        __builtin_amdgcn_global_load_lds((const unsigned*)((const char*)(gbase) + (voff)[_i]), (PG8_LAS unsigned*)(lds + (bufoff) + ldsw + _i * 8192), 16, 0, 0); } while (0)
#define PG8_LD32(dst, off, offx) do { typedef int _v4i __attribute__((ext_vector_type(4))); const _v4i _lo = *(const PG8_LAS _v4i*)(lds + (off)), _hi = *(const PG8_LAS _v4i*)(lds + (offx)); \
        dst = __builtin_shufflevector(_lo, _hi, 0, 1, 2, 3, 4, 5, 6, 7); } while (0)
#define PG8_LDA(dst, b, h) do { if constexpr (F8) { _Pragma("unroll") for (int m2 = 0; m2 < 2; ++m2) _Pragma("unroll") for (int ks = 0; ks < 2; ++ks) PG8_LD32(dst##8[m2][ks], PG8_SA(b, h) + aoff + m2 * 4096 + ks * 1024, PG8_SA(b, h) + aoffx + m2 * 4096 + ks * 1024); } \
        else { _Pragma("unroll") for (int m = 0; m < 4; ++m) _Pragma("unroll") for (int k = 0; k < 2; ++k) dst[m][k] = *(const PG8_LAS bf16x8*)(lds + PG8_SA(b, h) + aoff + m * 2048 + k * 1024); } } while (0)
#define PG8_LDB(dst, b, h) do { if constexpr (F8) { _Pragma("unroll") for (int ks = 0; ks < 2; ++ks) PG8_LD32(dst##8[ks], PG8_SB(b, h) + boff + ks * 1024, PG8_SB(b, h) + boffx + ks * 1024); } \
        else { _Pragma("unroll") for (int n = 0; n < 2; ++n) _Pragma("unroll") for (int k = 0; k < 2; ++k) dst[n][k] = *(const PG8_LAS bf16x8*)(lds + PG8_SB(b, h) + boff + n * 2048 + k * 1024); } } while (0)
#define PG8_MMA(ai, bj, At, Bt) do { __builtin_amdgcn_s_setprio(1); \
        if constexpr (F8) { _Pragma("unroll") for (int m2 = 0; m2 < 2; ++m2) _Pragma("unroll") for (int ks = 0; ks < 2; ++ks) \
            acc32[ai][bj][m2] = __builtin_amdgcn_mfma_scale_f32_32x32x64_f8f6f4(Bt##8[ks], At##8[m2][ks], acc32[ai][bj][m2], 0, 0, 0, 0, 0, 0); } \
        else { _Pragma("unroll") for (int m = 0; m < 4; ++m) _Pragma("unroll") for (int n = 0; n < 2; ++n) _Pragma("unroll") for (int k = 0; k < 2; ++k) \
            acc[ai][bj][m][n] = __builtin_amdgcn_mfma_f32_16x16x32_bf16(Bt[n][k], At[m][k], acc[ai][bj][m][n], 0, 0, 0); } \
        __builtin_amdgcn_s_setprio(0); } while (0)
#define PG8_WAIT_V(n) asm volatile("s_waitcnt vmcnt(" #n ")" ::: "memory")
#define PG8_WAIT_L(n) asm volatile("s_waitcnt lgkmcnt(" #n ")" ::: "memory")
#define PG8_BAR __builtin_amdgcn_s_barrier()
#define PG8_SCHED __builtin_amdgcn_sched_barrier(0)
#define PG8_ACOL(u) ((g.agrp > 0) ? (size_t)((u).pn / g.agrp) * (size_t)K * 2 : (size_t)0)
    Unit cur, nxt; int ui = 0;
    if (!S.next(0, cur)) return;
    f32x4 acc[2][2][4][2];
#pragma unroll
    for (int a = 0; a < 2; ++a)
#pragma unroll
        for (int b = 0; b < 2; ++b)
#pragma unroll
            for (int m = 0; m < 4; ++m)
#pragma unroll
                for (int n = 0; n < 2; ++n) acc[a][b][m][n] = (f32x4){0.f, 0.f, 0.f, 0.f};
    bf16x8 At[4][2], B0[2][2], B1[2][2];
    v8i_t At8[2][2], B08[2], B18[2];
    f32x16 acc32[2][2][2];
#pragma unroll
    for (int a = 0; a < 2; ++a)
#pragma unroll
        for (int b = 0; b < 2; ++b)
#pragma unroll
            for (int m2 = 0; m2 < 2; ++m2)
#pragma unroll
                for (int i = 0; i < 16; ++i) acc32[a][b][m2][i] = 0.f;
    const char* cA = (const char*)g.A + (size_t)cur.pm * tstepA + PG8_ACOL(cur); const char* cB = (const char*)g.Bt + (size_t)cur.pn * tstepB;
    PG8_STAGE(PG8_SB(0, 0), cB, voffB); PG8_STAGE(PG8_SB(0, 1), cB + hstepB, voffB); PG8_STAGE(PG8_SA(0, 0), cA, voffA); PG8_STAGE(PG8_SA(0, 1), cA + hstepA, voffA);
    if (wr == 1) PG8_BAR;
    PG8_WAIT_V(2); PG8_BAR;
    PG8_STAGE(PG8_SB(1, 0), cB + kstep, voffB); PG8_STAGE(PG8_SA(1, 0), cA + kstep, voffA); PG8_STAGE(PG8_SB(1, 1), cB + hstepB + kstep, voffB);
    PG8_WAIT_V(6); PG8_BAR;
    for (;;) {
        const bool has_next = S.next(ui + 1, nxt);
        const char* nA = has_next ? (const char*)g.A + (size_t)nxt.pm * tstepA + PG8_ACOL(nxt) : cA; const char* nB = has_next ? (const char*)g.Bt + (size_t)nxt.pn * tstepB : cB;
        for (int t = 0; t < nt; t += 2) {
            const bool last = (t == nt - 2);
            const char* a1 = cA + (size_t)(t + 1) * kstep;
            const char* a2 = last ? nA : cA + (size_t)(t + 2) * kstep; const char* b2 = last ? nB : cB + (size_t)(t + 2) * kstep;
            const char* a3 = a2 + kstep; const char* b3 = b2 + kstep;
            PG8_LDB(B0, 0, 0); PG8_LDB(B1, 0, 1); PG8_SCHED; PG8_LDA(At, 0, 0); PG8_STAGE(PG8_SA(1, 1), a1 + hstepA, voffA);
            PG8_WAIT_V(8); PG8_WAIT_L(0); PG8_BAR; PG8_MMA(0, 0, At, B0); PG8_MMA(0, 1, At, B1); PG8_BAR; PG8_SCHED;
            PG8_LDA(At, 0, 1); PG8_STAGE(PG8_SB(0, 0), b2, voffB); PG8_STAGE(PG8_SB(0, 1), b2 + hstepB, voffB); PG8_STAGE(PG8_SA(0, 0), a2, voffA);
            PG8_WAIT_V(8); PG8_WAIT_L(0); PG8_BAR; PG8_MMA(1, 0, At, B0); PG8_MMA(1, 1, At, B1); PG8_BAR; PG8_SCHED;
            PG8_LDB(B0, 1, 0); PG8_LDB(B1, 1, 1); PG8_SCHED; PG8_LDA(At, 1, 0); PG8_STAGE(PG8_SA(0, 1), a2 + hstepA, voffA);
            PG8_WAIT_V(8); PG8_WAIT_L(0); PG8_BAR; PG8_MMA(0, 0, At, B0); PG8_MMA(0, 1, At, B1); PG8_BAR; PG8_SCHED;
            PG8_LDA(At, 1, 1); PG8_STAGE(PG8_SB(1, 0), b3, voffB); PG8_STAGE(PG8_SB(1, 1), b3 + hstepB, voffB); PG8_STAGE(PG8_SA(1, 0), a3, voffA);
            PG8_WAIT_V(8); PG8_WAIT_L(0); PG8_BAR; PG8_MMA(1, 0, At, B0); PG8_MMA(1, 1, At, B1); PG8_BAR; PG8_SCHED;
        }
        if (wr == 0) PG8_BAR;
        if constexpr (F8) {
            const int lnE = lane_now(); const int rowF = cur.pm * BM + wr * 64 + (lnE & 31), colF = cur.pn * BM + wc * 32 + 16 * (lnE >> 5);
            if constexpr (HasPre<Epi>::value) {
#pragma unroll
                for (int a = 0; a < 2; ++a)
#pragma unroll
                    for (int m2 = 0; m2 < 2; ++m2) { const int rowG = rowF + a * HALF + 32 * m2;
                        typename Epi::Pre pq[4];
#pragma unroll
                        for (int b = 0; b < 2; ++b) { pq[2 * b] = E.pre(rowG, colF + b * HALF); pq[2 * b + 1] = E.pre(rowG, colF + b * HALF + 8); }
                        __builtin_amdgcn_sched_barrier(0);
#pragma unroll
                        for (int b = 0; b < 2; ++b) { const f32x16 v = acc32[a][b][m2];
                            E.fin(rowG, colF + b * HALF, (f32x4){v[0], v[1], v[2], v[3]}, (f32x4){v[4], v[5], v[6], v[7]}, pq[2 * b]);
                            E.fin(rowG, colF + b * HALF + 8, (f32x4){v[8], v[9], v[10], v[11]}, (f32x4){v[12], v[13], v[14], v[15]}, pq[2 * b + 1]);
#pragma unroll
                            for (int i = 0; i < 16; ++i) acc32[a][b][m2][i] = 0.f; }
                        __builtin_amdgcn_sched_barrier(0); }
            } else {
#pragma unroll
            for (int a = 0; a < 2; ++a)
#pragma unroll
                for (int m2 = 0; m2 < 2; ++m2)
#pragma unroll
                    for (int b = 0; b < 2; ++b) { const f32x16 v = acc32[a][b][m2];
                        E.chunk(rowF + a * HALF + 32 * m2, colF + b * HALF, (f32x4){v[0], v[1], v[2], v[3]}, (f32x4){v[4], v[5], v[6], v[7]});
                        E.chunk(rowF + a * HALF + 32 * m2, colF + b * HALF + 8, (f32x4){v[8], v[9], v[10], v[11]}, (f32x4){v[12], v[13], v[14], v[15]});
#pragma unroll
                        for (int i = 0; i < 16; ++i) acc32[a][b][m2][i] = 0.f; }
            }
        } else {
            const int lnE = lane_now(); const int row0 = cur.pm * BM + wr * 64 + (lnE & 15), col0 = cur.pn * BM + wc * 32 + 8 * (lnE >> 4);
#pragma unroll
            for (int a = 0; a < 2; ++a)
#pragma unroll
                for (int m = 0; m < 4; ++m)
#pragma unroll
                    for (int b = 0; b < 2; ++b) E.chunk(row0 + a * HALF + m * 16, col0 + b * HALF, acc[a][b][m][0], acc[a][b][m][1]);
        }
        if (!has_next) break;
#pragma unroll
        for (int a = 0; a < 2; ++a)
#pragma unroll
            for (int b = 0; b < 2; ++b)
#pragma unroll
                for (int m = 0; m < 4; ++m)
#pragma unroll
                    for (int n = 0; n < 2; ++n) acc[a][b][m][n] = (f32x4){0.f, 0.f, 0.f, 0.f};
        cur = nxt; cA = nA; cB = nB; ++ui;
        if (wr == 1) PG8_BAR;
    }
    PG8_WAIT_V(0);
    PG8_BAR;
#undef PG8_SA
#undef PG8_SB
#undef PG8_STAGE
#undef PG8_LDA
#undef PG8_LD32
#undef PG8_LDB
#undef PG8_MMA
#undef PG8_WAIT_V
#undef PG8_WAIT_L
#undef PG8_BAR
#undef PG8_SCHED
#undef PG8_ACOL
}
}

constexpr int NWAVES = 8;
constexpr int D = 2048, BATCH = 4, SEQ = 8192, DEPTH = 4, M = BATCH * SEQ;
constexpr int NEXP = 16384, PLE = 256;
constexpr float LN_EPS = 1e-5f;
constexpr float DN_ALPHA = 1.681792830507429f;
constexpr float LOG2E = 1.4426950408889634f;
constexpr float ATTN_QSCALE = 0.08838834764831845f * LOG2E;
constexpr float W8S = 64.f, O8S = 16.f;

constexpr size_t MiB = 1u << 20;
constexpr size_t WS_CTL = 0, CTL_ZERO_BYTES = 1 * MiB;
constexpr size_t WS_STATS = WS_CTL + 512 * 1024;
constexpr size_t WS_W = 1 * MiB;
constexpr size_t W_POOL_IN = WS_W, W_POOL_GRP = W_POOL_IN + 16 * MiB, W_POOL_OUT = W_POOL_GRP + 4 * MiB;
constexpr size_t W_SSM_IN = W_POOL_OUT + 16 * MiB, W_SSM_GLU = W_SSM_IN + 8 * MiB, W_SSM_OUT = W_SSM_GLU + 8 * MiB;
constexpr size_t W_ATTN_QKV = W_SSM_OUT + 8 * MiB, W_ATTN_OUT = W_ATTN_QKV + 24 * MiB;
constexpr size_t W_PEER_Q = W_ATTN_OUT + 8 * MiB, W_PLE_GATE = W_PEER_Q + 32 * MiB, W_PLE_PROJ = W_PLE_GATE + 32 * MiB;
constexpr size_t WS_SK = W_PLE_PROJ + 4 * MiB;
constexpr size_t WS_TU = WS_SK + 1 * MiB;
constexpr size_t WS_TV = WS_TU + 256 * MiB;
constexpr size_t WS_PB = WS_TV + 256 * MiB;
constexpr size_t WS_HB0 = WS_PB + 64 * MiB, WS_HB1 = WS_HB0 + 128 * MiB;
constexpr size_t WS_T1 = WS_HB1 + 128 * MiB, WS_T2 = WS_T1 + 128 * MiB, WS_T3 = WS_T2 + 128 * MiB;
constexpr size_t WS_IDX = WS_T3 + 128 * MiB, WS_GATE = WS_IDX + 16 * MiB;
constexpr size_t WS_SSMP = WS_GATE + 16 * MiB;
constexpr size_t WS_SU = WS_SSMP + 2 * MiB, WS_SV = WS_SU + 1 * MiB;
constexpr size_t WS_S8 = WS_SV + 1 * MiB;
constexpr size_t WS_X8 = WS_S8 + 64 * MiB;
constexpr size_t WS_END = WS_X8 + 64 * MiB;
static_assert(WS_END <= 2048 * MiB, "d_ws map");
constexpr int CW_BAR = 4096;

constexpr int RING_BYTES = 131072;
constexpr int LDSCTL_OFF = RING_BYTES, MISC_OFF = LDSCTL_OFF + 320;
constexpr int LDS_BYTES = 147456;

#define LAS __attribute__((address_space(3)))
typedef unsigned short bf16;
typedef unsigned v4u __attribute__((ext_vector_type(4)));
typedef unsigned v2u __attribute__((ext_vector_type(2)));
typedef float f32x4 __attribute__((ext_vector_type(4)));
typedef float f32x16 __attribute__((ext_vector_type(16)));
typedef short bf16x8 __attribute__((ext_vector_type(8)));
typedef __bf16 bf16x2_t __attribute__((ext_vector_type(2)));
#define LDS_WAIT() asm volatile("s_waitcnt lgkmcnt(0)" ::: "memory")
#define VM_WAIT() asm volatile("s_waitcnt vmcnt(0)" ::: "memory")
__device__ __forceinline__ unsigned f2bf(float f) { unsigned u = __builtin_bit_cast(unsigned, f); return (u + 0x7fffu + ((u >> 16) & 1u)) >> 16; }
__device__ __forceinline__ unsigned pk2(float lo, float hi) { return f2bf(lo) | (f2bf(hi) << 16); }
__device__ __forceinline__ float bflo(unsigned w) { return __builtin_bit_cast(float, w << 16); }
__device__ __forceinline__ float bfhi(unsigned w) { return __builtin_bit_cast(float, w & 0xffff0000u); }
__device__ __forceinline__ float dot2bf(unsigned a, unsigned b, float c) { return __builtin_amdgcn_fdot2_f32_bf16(__builtin_bit_cast(bf16x2_t, a), __builtin_bit_cast(bf16x2_t, b), c, false); }
__device__ __forceinline__ float gelu_f(float v) {
    const float av = __builtin_fabsf(v), d = av * 0.2316418882f + 1.0f, t = __builtin_amdgcn_rcpf(d);
    float q = t * 0.5307027145f + (-0.7265760135f); q = q * t + 0.7107068705f; q = q * t + (-0.142248368f); q = q * t + 0.127414796f; q = q * t;
    const float e = __builtin_amdgcn_exp2f((v * v) * (-0.72134752044f));
    const float m = v * (q * e); return v < 0.f ? m : v - m;
}
#define WDPP(v, ctrl) __builtin_bit_cast(float, __builtin_amdgcn_update_dpp(0, __builtin_bit_cast(int, (v)), (ctrl), 0xF, 0xF, true))
#define WRL(v, l) __builtin_bit_cast(float, __builtin_amdgcn_readlane(__builtin_bit_cast(int, (v)), (l)))
__device__ __forceinline__ float wave_sum(float v) {
    v += WDPP(v, 0xB1); v += WDPP(v, 0x4E); v += WDPP(v, 0x141); v += WDPP(v, 0x140);
    return (WRL(v, 0) + WRL(v, 16)) + (WRL(v, 32) + WRL(v, 48));
}
__device__ __forceinline__ float shfl_xor_lane(float v, int m, int lane) { return __builtin_bit_cast(float, __builtin_amdgcn_ds_bpermute((lane ^ m) << 2, __builtin_bit_cast(int, v))); }
__device__ __forceinline__ int shfl_idx_lane(int v, int src) { return __builtin_amdgcn_ds_bpermute(src << 2, v); }
#define SHFL_XOR(v, m) shfl_xor_lane((v), (m), lane)

#define XB_TMO      128
#define XB_XCNT(j)  (256  + 64 * (j))
#define XB_XSUB(j)  (1280 + 64 * (j))
#define XB_XGEN(j)  (2304 + 64 * (j))
#define XB_TOP      3328
#define XB_TOPGEN   3392
#define XCD_BAR_WORDS 3456
#define XB_SPIN_CAP (1u << 23)

__device__ __forceinline__ unsigned xb_ld(unsigned* p)              { return __hip_atomic_load(p, __ATOMIC_RELAXED, __HIP_MEMORY_SCOPE_AGENT); }
__device__ __forceinline__ unsigned xb_add(unsigned* p, unsigned v) { return __hip_atomic_fetch_add(p, v, __ATOMIC_RELAXED, __HIP_MEMORY_SCOPE_AGENT); }
__device__ __forceinline__ unsigned xb_xcc_id() { return (unsigned)__builtin_amdgcn_s_getreg((3 << 11) | 20) & 0xFu; }
#define XB_SPIN(cond, bar) do { unsigned _sp = 0; while (cond) { __builtin_amdgcn_s_sleep(1); \
    if ((++_sp & 255u) == 0u) { if (xb_ld(&(bar)[XB_TMO])) break; if (_sp > XB_SPIN_CAP) { atomicAdd(&(bar)[XB_TMO], 1u); break; } } } } while (0)

struct XcdBarrier { unsigned* bar; unsigned x; volatile LAS unsigned* st; int wave; };
__device__ __forceinline__ int lane_id() { int l; asm volatile("v_mbcnt_lo_u32_b32 %0, -1, 0\n\tv_mbcnt_hi_u32_b32 %0, -1, %0" : "=v"(l)); return l; }

__device__ __forceinline__ XcdBarrier xcd_barrier_post(unsigned* bar, volatile LAS unsigned* st) {
    XcdBarrier b; b.bar = bar; b.x = xb_xcc_id(); b.st = st; b.wave = __builtin_amdgcn_readfirstlane((int)(threadIdx.x >> 6));
    if (threadIdx.x == 0) (void)xb_add(&bar[XB_XCNT(b.x)], 1u);
    return b;
}
__device__ __forceinline__ void xcd_barrier_complete(unsigned* bar, unsigned x, unsigned& nloc, unsigned& nx) {
    const unsigned G = gridDim.x * gridDim.y * gridDim.z;
    unsigned sum, cnt, mine, sp = 0u;
    for (;;) {
        sum = 0u; cnt = 0u; mine = 0u;
#pragma unroll
        for (unsigned j = 0; j < 16; ++j) { const unsigned c = xb_ld(&bar[XB_XCNT(j)]); sum += c; cnt += (c > 0u) ? 1u : 0u; mine = (j == x) ? c : mine; }
        if (sum == G) break;
        __builtin_amdgcn_s_sleep(1);
        if ((++sp & 255u) == 0u) { if (xb_ld(&bar[XB_TMO])) break; if (sp > XB_SPIN_CAP) { atomicAdd(&bar[XB_TMO], 1u); break; } }
    }
    nloc = mine > 0u ? mine : 1u; nx = cnt > 0u ? cnt : 1u;
}
__device__ __forceinline__ void xcd_barrier(const XcdBarrier& b_in) {
    asm volatile("s_waitcnt vmcnt(0)" ::: "memory");
    __syncthreads();
    if (b_in.wave == 0 && lane_id() == 0) {
        XcdBarrier b = b_in; asm volatile("" : "+s"(b.x)); asm volatile("" : "+s"(b.bar));
        unsigned* bar = b.bar;
        __builtin_amdgcn_s_waitcnt(0);
        unsigned nloc = b.st[0], nx = b.st[1];
        if (nloc == 0u) { xcd_barrier_complete(bar, b.x, nloc, nx); b.st[0] = nloc; b.st[1] = nx; }
        const unsigned old = xb_add(&bar[XB_XSUB(b.x)], 1u);
        const unsigned gen = old / nloc;
        if (old + 1u == (gen + 1u) * nloc) {
            __builtin_amdgcn_fence(__ATOMIC_RELEASE, "agent");
            asm volatile("s_waitcnt vmcnt(0)" ::: "memory");
            const unsigned og = xb_add(&bar[XB_TOP], 1u);
            const unsigned tg = og / nx;
            if (og + 1u == (tg + 1u) * nx) xb_add(&bar[XB_TOPGEN], 1u);
            else XB_SPIN(xb_ld(&bar[XB_TOPGEN]) == tg, bar);
            __builtin_amdgcn_fence(__ATOMIC_ACQUIRE, "agent");
            xb_add(&bar[XB_XGEN(b.x)], 1u);
            asm volatile("s_waitcnt vmcnt(0)" ::: "memory");
        } else {
            XB_SPIN(xb_ld(&bar[XB_XGEN(b.x)]) == gen, bar);
            __builtin_amdgcn_fence(__ATOMIC_ACQUIRE, "agent");
            asm volatile("s_waitcnt vmcnt(0)" ::: "memory");
        }
    }
    __syncthreads();
}

__device__ __forceinline__ void transpose_item(const float* W, int K, int N, bf16* WT, int row_off, LAS float* scr, int item, int lane) {
    const int nblk = N / 32, kb = item / nblk, nb = item % nblk, k0 = 64 * kb, n0 = 32 * nb;
    const __attribute__((address_space(1))) float* Wg = (const __attribute__((address_space(1))) float*)W + (size_t)(k0 + (lane >> 5)) * N + n0 + (lane & 31);
    float v[32];
#pragma unroll
    for (int i = 0; i < 32; ++i) v[i] = Wg[(size_t)(2 * i) * N];
#pragma unroll
    for (int i = 0; i < 32; ++i) scr[(2 * i + (lane >> 5)) * 33 + (lane & 31)] = v[i];
    LDS_WAIT(); asm volatile("" ::: "memory");
    const int c = lane & 7;
#pragma unroll
    for (int j = 0; j < 4; ++j) { const int n = (lane >> 3) + 8 * j; const LAS float* s = scr + (8 * c) * 33 + n;
        v4u o; o.x = pk2(s[0 * 33], s[1 * 33]); o.y = pk2(s[2 * 33], s[3 * 33]); o.z = pk2(s[4 * 33], s[5 * 33]); o.w = pk2(s[6 * 33], s[7 * 33]);
        *(v4u*)(WT + (size_t)(row_off + n0 + n) * K + k0 + 8 * c) = o; }
    LDS_WAIT(); asm volatile("" ::: "memory");
}
__device__ __forceinline__ void transpose_item8(const float* W, int K, int N, unsigned char* WT, int row_off, LAS float* scr, int item, int lane) {
    const int nblk = N / 32, kb = item / nblk, nb = item % nblk, k0 = 64 * kb, n0 = 32 * nb;
#pragma unroll 8
    for (int i = 0; i < 32; ++i) { const int kk = 2 * i + (lane >> 5); scr[kk * 33 + (lane & 31)] = W[(size_t)(k0 + kk) * N + n0 + (lane & 31)]; }
    LDS_WAIT(); asm volatile("" ::: "memory");
    const int c = lane & 7;
#pragma unroll
    for (int j = 0; j < 4; ++j) { const int n = (lane >> 3) + 8 * j; const LAS float* sp = scr + (8 * c) * 33 + n;
        int a = 0, b = 0;
        a = __builtin_amdgcn_cvt_pk_fp8_f32(sp[0 * 33] * W8S, sp[1 * 33] * W8S, a, false); a = __builtin_amdgcn_cvt_pk_fp8_f32(sp[2 * 33] * W8S, sp[3 * 33] * W8S, a, true);
        b = __builtin_amdgcn_cvt_pk_fp8_f32(sp[4 * 33] * W8S, sp[5 * 33] * W8S, b, false); b = __builtin_amdgcn_cvt_pk_fp8_f32(sp[6 * 33] * W8S, sp[7 * 33] * W8S, b, true);
        v2u o; o.x = (unsigned)a; o.y = (unsigned)b;
        *(v2u*)(WT + (size_t)(row_off + n0 + n) * K + k0 + 8 * c) = o; }
    LDS_WAIT(); asm volatile("" ::: "memory");
}
__device__ __forceinline__ void transpose_item8b(const float* W, int K, int N, unsigned char* WT, int row_off, LAS unsigned* scr, int item, int lane) {
    const int nblk = N / 64, kb = item / nblk, nb = item % nblk, k0 = 128 * kb, n0 = 64 * nb;
    const int r4 = lane >> 4, l15 = lane & 15;
    f32x4 v[32];
#pragma unroll
    for (int i = 0; i < 32; ++i) v[i] = *(const __attribute__((address_space(1))) f32x4*)(W + (size_t)(k0 + 32 * r4 + i) * N + n0 + 4 * l15);
#pragma unroll
    for (int i4 = 0; i4 < 8; ++i4) {
        const f32x4 q0 = v[4 * i4] * W8S, q1 = v[4 * i4 + 1] * W8S, q2 = v[4 * i4 + 2] * W8S, q3 = v[4 * i4 + 3] * W8S;
        int a0 = 0, a1 = 0, a2 = 0, a3 = 0;
        a0 = __builtin_amdgcn_cvt_pk_fp8_f32(q0.x, q1.x, a0, false); a0 = __builtin_amdgcn_cvt_pk_fp8_f32(q2.x, q3.x, a0, true);
        a1 = __builtin_amdgcn_cvt_pk_fp8_f32(q0.y, q1.y, a1, false); a1 = __builtin_amdgcn_cvt_pk_fp8_f32(q2.y, q3.y, a1, true);
        a2 = __builtin_amdgcn_cvt_pk_fp8_f32(q0.z, q1.z, a2, false); a2 = __builtin_amdgcn_cvt_pk_fp8_f32(q2.z, q3.z, a2, true);
        a3 = __builtin_amdgcn_cvt_pk_fp8_f32(q0.w, q1.w, a3, false); a3 = __builtin_amdgcn_cvt_pk_fp8_f32(q2.w, q3.w, a3, true);
        LAS unsigned* rowp = scr + (8 * r4 + i4) * 64;
        rowp[(4 * l15 + 0 + r4) & 63] = (unsigned)a0; rowp[(4 * l15 + 1 + r4) & 63] = (unsigned)a1; rowp[(4 * l15 + 2 + r4) & 63] = (unsigned)a2; rowp[(4 * l15 + 3 + r4) & 63] = (unsigned)a3; }
    LDS_WAIT(); asm volatile("" ::: "memory");
    unsigned char* orow = WT + (size_t)(row_off + n0 + lane) * K + k0;
#pragma unroll
    for (int q = 0; q < 8; ++q) { v4u o;
        o.x = scr[(4 * q + 0) * 64 + ((lane + (q >> 1)) & 63)]; o.y = scr[(4 * q + 1) * 64 + ((lane + (q >> 1)) & 63)]; o.z = scr[(4 * q + 2) * 64 + ((lane + (q >> 1)) & 63)]; o.w = scr[(4 * q + 3) * 64 + ((lane + (q >> 1)) & 63)];
        *(__attribute__((address_space(1))) v4u*)(orow + 16 * q) = o; }
    LDS_WAIT(); asm volatile("" ::: "memory");
}
__device__ __forceinline__ void transpose_mat8b(const float* W, int K, int N, unsigned char* WT, int row_off, LAS unsigned* scr, int gw, int NGW, int lane, int& woff) {
    const int nit = (K / 128) * (N / 64);
    int sgw = gw - woff % NGW; if (sgw < 0) sgw += NGW;
    for (int it = sgw; it < nit; it += NGW) transpose_item8b(W, K, N, WT, row_off, scr, it, lane);
    woff += nit;
}
__device__ __forceinline__ void transpose_mat8(const float* W, int K, int N, unsigned char* WT, int row_off, LAS float* scr, int gw, int NGW, int lane) {
    const int nit = (K / 64) * (N / 32);
    for (int it = gw; it < nit; it += NGW) transpose_item8(W, K, N, WT, row_off, scr, it, lane);
}
__device__ __forceinline__ void transpose_mat(const float* W, int K, int N, bf16* WT, int row_off, LAS float* scr, int gw, int NGW, int lane, int& woff) {
    const int nit = (K / 64) * (N / 32);
    int sgw = gw - woff % NGW; if (sgw < 0) sgw += NGW;
    for (int it = sgw; it < nit; it += NGW) transpose_item(W, K, N, WT, row_off, scr, it, lane);
    woff += nit;
}
__device__ __forceinline__ void cvt_rows(const float* src, bf16* dst, size_t n, size_t gtid, size_t gthreads) {
    size_t i = gtid * 8;
    for (; i + 3 * gthreads * 8 < n; i += gthreads * 32) {
        f32x4 a[4], b[4];
#pragma unroll
        for (int u = 0; u < 4; ++u) { a[u] = *(const __attribute__((address_space(1))) f32x4*)(src + i + u * gthreads * 8); b[u] = *(const __attribute__((address_space(1))) f32x4*)(src + i + u * gthreads * 8 + 4); }
#pragma unroll
        for (int u = 0; u < 4; ++u) { v4u o; o.x = pk2(a[u].x, a[u].y); o.y = pk2(a[u].z, a[u].w); o.z = pk2(b[u].x, b[u].y); o.w = pk2(b[u].z, b[u].w);
            *(__attribute__((address_space(1))) v4u*)(dst + i + u * gthreads * 8) = o; }
    }
    for (; i < n; i += gthreads * 8) {
        const f32x4 a = *(const f32x4*)(src + i), b = *(const f32x4*)(src + i + 4);
        v4u o; o.x = pk2(a.x, a.y); o.y = pk2(a.z, a.w); o.z = pk2(b.x, b.y); o.w = pk2(b.z, b.w);
        *(v4u*)(dst + i) = o;
    }
}


#define GAS __attribute__((address_space(1)))
typedef unsigned char u8;
typedef float f32x2 __attribute__((ext_vector_type(2)));
constexpr float TU_SCALE = 64.f, TV_SCALE = 4.f;
__device__ __forceinline__ v4u gld16(const void* p) { return *(const GAS v4u*)p; }
__device__ __forceinline__ void cvt_rows_fp8(const float* src, u8* dst, size_t n, float scale, size_t gtid, size_t gthreads) {
    for (size_t i = gtid * 16; i < n; i += gthreads * 16) {
        const GAS f32x4* p = (const GAS f32x4*)(src + i);
        const f32x4 a = p[0] * scale, b = p[1] * scale, c = p[2] * scale, d = p[3] * scale;
        int w0 = 0, w1 = 0, w2 = 0, w3 = 0;
        w0 = __builtin_amdgcn_cvt_pk_fp8_f32(a.x, a.y, w0, false); w0 = __builtin_amdgcn_cvt_pk_fp8_f32(a.z, a.w, w0, true);
        w1 = __builtin_amdgcn_cvt_pk_fp8_f32(b.x, b.y, w1, false); w1 = __builtin_amdgcn_cvt_pk_fp8_f32(b.z, b.w, w1, true);
        w2 = __builtin_amdgcn_cvt_pk_fp8_f32(c.x, c.y, w2, false); w2 = __builtin_amdgcn_cvt_pk_fp8_f32(c.z, c.w, w2, true);
        w3 = __builtin_amdgcn_cvt_pk_fp8_f32(d.x, d.y, w3, false); w3 = __builtin_amdgcn_cvt_pk_fp8_f32(d.z, d.w, w3, true);
        v4u o; o.x = (unsigned)w0; o.y = (unsigned)w1; o.z = (unsigned)w2; o.w = (unsigned)w3;
        *(GAS v4u*)(dst + i) = o;
    }
}

template <bool X4 = false>
__device__ __forceinline__ void ln_phase(bf16* S, const float* g, const float* b, int gw, int NGW, int lane, unsigned char* f8 = nullptr, unsigned char* f8b = nullptr, float* stats = nullptr) {
    for (int m = gw; m < M; m += NGW) {
        bf16* row = S + (size_t)m * D + 8 * lane;
        float v[32]; float s = 0.f;
#pragma unroll
        for (int j = 0; j < 4; ++j) { const v4u w = *(const GAS v4u*)(row + 512 * j);
            v[8 * j + 0] = bflo(w.x); v[8 * j + 1] = bfhi(w.x); v[8 * j + 2] = bflo(w.y); v[8 * j + 3] = bfhi(w.y); v[8 * j + 4] = bflo(w.z); v[8 * j + 5] = bfhi(w.z); v[8 * j + 6] = bflo(w.w); v[8 * j + 7] = bfhi(w.w); }
#pragma unroll
        for (int i = 0; i < 32; ++i) s += v[i];
        const float mean = wave_sum(s) * (1.f / D); float s2 = 0.f;
#pragma unroll
        for (int i = 0; i < 32; ++i) { v[i] -= mean; s2 += v[i] * v[i]; }
        const float rstd = 1.f / sqrtf(wave_sum(s2) * (1.f / D) + LN_EPS);
        if constexpr (X4) { if (lane == 0) *(GAS f32x2*)(stats + 2 * (size_t)m) = (f32x2){mean, rstd}; }
#pragma unroll
        for (int j = 0; j < 4; ++j) { const float* gp = g + 512 * j + 8 * lane; const float* bp = b + 512 * j + 8 * lane;
            const f32x4 g0 = *(const GAS f32x4*)gp, g1 = *(const GAS f32x4*)(gp + 4), b0 = *(const GAS f32x4*)bp, b1 = *(const GAS f32x4*)(bp + 4);
            v4u w; w.x = pk2(v[8 * j + 0] * rstd * g0.x + b0.x, v[8 * j + 1] * rstd * g0.y + b0.y); w.y = pk2(v[8 * j + 2] * rstd * g0.z + b0.z, v[8 * j + 3] * rstd * g0.w + b0.w);
            w.z = pk2(v[8 * j + 4] * rstd * g1.x + b1.x, v[8 * j + 5] * rstd * g1.y + b1.y); w.w = pk2(v[8 * j + 6] * rstd * g1.z + b1.z, v[8 * j + 7] * rstd * g1.w + b1.w);
            if constexpr (!X4) *(GAS v4u*)(row + 512 * j) = w;
            if constexpr (X4) {
                const float y0 = v[8 * j + 0] * rstd * g0.x + b0.x, y1 = v[8 * j + 1] * rstd * g0.y + b0.y, y2 = v[8 * j + 2] * rstd * g0.z + b0.z, y3 = v[8 * j + 3] * rstd * g0.w + b0.w;
                const float y4 = v[8 * j + 4] * rstd * g1.x + b1.x, y5 = v[8 * j + 5] * rstd * g1.y + b1.y, y6 = v[8 * j + 6] * rstd * g1.z + b1.z, y7 = v[8 * j + 7] * rstd * g1.w + b1.w;
                unsigned wh = 0u; wh = __builtin_amdgcn_cvt_scalef32_pk_fp4_f32(wh, y0, y1, 1.0f, 0); wh = __builtin_amdgcn_cvt_scalef32_pk_fp4_f32(wh, y2, y3, 1.0f, 1);
                wh = __builtin_amdgcn_cvt_scalef32_pk_fp4_f32(wh, y4, y5, 1.0f, 2); wh = __builtin_amdgcn_cvt_scalef32_pk_fp4_f32(wh, y6, y7, 1.0f, 3);
                const f32x2 h01 = __builtin_amdgcn_cvt_scalef32_pk_f32_fp4(wh, 1.0f, 0), h23 = __builtin_amdgcn_cvt_scalef32_pk_f32_fp4(wh, 1.0f, 1), h45 = __builtin_amdgcn_cvt_scalef32_pk_f32_fp4(wh, 1.0f, 2), h67 = __builtin_amdgcn_cvt_scalef32_pk_f32_fp4(wh, 1.0f, 3);
                unsigned wl = 0u; wl = __builtin_amdgcn_cvt_scalef32_pk_fp4_f32(wl, (y0 - h01.x) * 8.f, (y1 - h01.y) * 8.f, 1.0f, 0); wl = __builtin_amdgcn_cvt_scalef32_pk_fp4_f32(wl, (y2 - h23.x) * 8.f, (y3 - h23.y) * 8.f, 1.0f, 1);
                wl = __builtin_amdgcn_cvt_scalef32_pk_fp4_f32(wl, (y4 - h45.x) * 8.f, (y5 - h45.y) * 8.f, 1.0f, 2); wl = __builtin_amdgcn_cvt_scalef32_pk_fp4_f32(wl, (y6 - h67.x) * 8.f, (y7 - h67.y) * 8.f, 1.0f, 3);
                unsigned char* xq = f8 + (size_t)m * 2048 + 256 * j + 4 * lane;
                *(GAS unsigned*)xq = wh; *(GAS unsigned*)(xq + 1024) = wl;
                int a8 = 0, b8 = 0;
                a8 = __builtin_amdgcn_cvt_pk_fp8_f32(y0, y1, a8, false); a8 = __builtin_amdgcn_cvt_pk_fp8_f32(y2, y3, a8, true);
                b8 = __builtin_amdgcn_cvt_pk_fp8_f32(y4, y5, b8, false); b8 = __builtin_amdgcn_cvt_pk_fp8_f32(y6, y7, b8, true);
                v2u o8; o8.x = (unsigned)a8; o8.y = (unsigned)b8; *(GAS v2u*)(f8b + (size_t)m * D + 512 * j + 8 * lane) = o8; }
            else if (f8 != nullptr) { int a8 = 0, b8 = 0;
                a8 = __builtin_amdgcn_cvt_pk_fp8_f32(v[8 * j + 0] * rstd * g0.x + b0.x, v[8 * j + 1] * rstd * g0.y + b0.y, a8, false); a8 = __builtin_amdgcn_cvt_pk_fp8_f32(v[8 * j + 2] * rstd * g0.z + b0.z, v[8 * j + 3] * rstd * g0.w + b0.w, a8, true);
                b8 = __builtin_amdgcn_cvt_pk_fp8_f32(v[8 * j + 4] * rstd * g1.x + b1.x, v[8 * j + 5] * rstd * g1.y + b1.y, b8, false); b8 = __builtin_amdgcn_cvt_pk_fp8_f32(v[8 * j + 6] * rstd * g1.z + b1.z, v[8 * j + 7] * rstd * g1.w + b1.w, b8, true);
                v2u o8; o8.x = (unsigned)a8; o8.y = (unsigned)b8; *(GAS v2u*)(f8 + (size_t)m * D + 512 * j + 8 * lane) = o8; } }
    }
}

__device__ __forceinline__ void pool_phase(const bf16* U, unsigned char* P, int gw, int NGW, int lane) {
    for (int it = gw; it < (M / 64) * 4; it += NGW) {
        const int g = it & 3, t0 = (it >> 2) * 64, w = 2 << g, col = g * 512 + 8 * lane;
        const int s0 = t0 & (SEQ - 1);
        float a[8];
#pragma unroll
        for (int i = 0; i < 8; ++i) a[i] = 0.f;
        const GAS bf16* base = (const GAS bf16*)U + (size_t)t0 * D + col;
        const int nb = (s0 < w - 1) ? s0 : (w - 1);
        {   v4u x[15];
#pragma unroll
            for (int r = 1; r <= 15; ++r) x[r - 1] = *(const GAS v4u*)(base - (ptrdiff_t)((r <= nb) ? r : 0) * D);
#pragma unroll
            for (int r = 1; r <= 15; ++r) if (r <= nb) { const v4u y = x[r - 1];
                a[0] += bflo(y.x); a[1] += bfhi(y.x); a[2] += bflo(y.y); a[3] += bfhi(y.y); a[4] += bflo(y.z); a[5] += bfhi(y.z); a[6] += bflo(y.w); a[7] += bfhi(y.w); }
        }
        for (int t = 0; t < 64; t += 8) {
            v4u cr[8], lv[8];
#pragma unroll
            for (int j = 0; j < 8; ++j) cr[j] = *(const GAS v4u*)(base + (ptrdiff_t)(t + j) * D);
#pragma unroll
            for (int j = 0; j < 8; ++j) { const int s = s0 + t + j; const int r = (s + 1 >= w) ? (t + j + 1 - w) : (t + j); lv[j] = *(const GAS v4u*)(base + (ptrdiff_t)r * D); }
            __builtin_amdgcn_sched_barrier(0);
#pragma unroll
            for (int j = 0; j < 8; ++j) {
                const int s = s0 + t + j;
                const v4u cur = cr[j];
                a[0] += bflo(cur.x); a[1] += bfhi(cur.x); a[2] += bflo(cur.y); a[3] += bfhi(cur.y); a[4] += bflo(cur.z); a[5] += bfhi(cur.z); a[6] += bflo(cur.w); a[7] += bfhi(cur.w);
                const int n = (s + 1 < w) ? (s + 1) : w;
                const float inv = 1.f / (float)n;
                int w0 = 0, w1 = 0;
                w0 = __builtin_amdgcn_cvt_pk_fp8_f32(a[0] * inv - bflo(cur.x), a[1] * inv - bfhi(cur.x), w0, false); w0 = __builtin_amdgcn_cvt_pk_fp8_f32(a[2] * inv - bflo(cur.y), a[3] * inv - bfhi(cur.y), w0, true);
                w1 = __builtin_amdgcn_cvt_pk_fp8_f32(a[4] * inv - bflo(cur.z), a[5] * inv - bfhi(cur.z), w1, false); w1 = __builtin_amdgcn_cvt_pk_fp8_f32(a[6] * inv - bflo(cur.w), a[7] * inv - bfhi(cur.w), w1, true);
                v2u o; o.x = (unsigned)w0; o.y = (unsigned)w1;
                *(GAS v2u*)(P + (size_t)(t0 + t + j) * D + col) = o;
                if (s + 1 >= w) { const v4u x = lv[j];
                    a[0] -= bflo(x.x); a[1] -= bfhi(x.x); a[2] -= bflo(x.y); a[3] -= bfhi(x.y); a[4] -= bflo(x.z); a[5] -= bfhi(x.z); a[6] -= bflo(x.w); a[7] -= bfhi(x.w); }
            }
            __builtin_amdgcn_sched_barrier(0);
        }
    }
}

typedef __bf16 bf16x2v __attribute__((ext_vector_type(2)));
__device__ __forceinline__ unsigned cvtpk(float lo, float hi) { const f32x2 v = {lo, hi}; return __builtin_bit_cast(unsigned, __builtin_convertvector(v, bf16x2v)); }
constexpr int SSM_L = 1664, SSM_L3 = SEQ - 3 * SSM_L;
static_assert(SSM_L % 64 == 0 && SSM_L3 % 64 == 0 && SSM_L3 > 0, "segments");
template <bool WR>
__device__ __forceinline__ void ssm_block16m(const bf16x8 ua, const bf16x8 (&BbR)[4], const bf16x8 (&BbI)[4], LAS unsigned char* bubuf, LAS unsigned char* hbuf, const f32x2 ar2, const f32x2 ai2, f32x2& h2, int p, int lane) {
    f32x4 dr[4], di[4];
    const f32x4 z = {0.f, 0.f, 0.f, 0.f};
    __builtin_amdgcn_sched_barrier(0);
    asm volatile("s_nop 15\n\ts_nop 15\n\ts_nop 15\n\ts_nop 15" ::: "memory");
    __builtin_amdgcn_sched_barrier(0);
#pragma unroll
    for (int pt = 0; pt < 4; ++pt) { dr[pt] = __builtin_amdgcn_mfma_f32_16x16x32_bf16(ua, BbR[pt], z, 0, 0, 0); di[pt] = __builtin_amdgcn_mfma_f32_16x16x32_bf16(ua, BbI[pt], z, 0, 0, 0); }
    __builtin_amdgcn_sched_barrier(0);
    asm volatile("s_nop 15\n\ts_nop 15\n\ts_nop 15\n\ts_nop 15\n\ts_nop 15\n\ts_nop 15\n\ts_nop 15\n\ts_nop 15" ::: "memory");
    __builtin_amdgcn_sched_barrier(0);
#pragma unroll
    for (int pt = 0; pt < 4; ++pt)
#pragma unroll
        for (int r = 0; r < 4; ++r) *(LAS f32x2*)(bubuf + (4 * (lane >> 4) + r) * 528 + (16 * pt + (lane & 15)) * 8) = (f32x2){dr[pt][r], di[pt][r]};
    LDS_WAIT();
#pragma unroll
    for (int l = 0; l < 16; ++l) {
        const f32x2 bu = *(const LAS f32x2*)(bubuf + l * 528 + p * 8);
        float tx, ty, nx, ny; const float hx = h2.x, hy = h2.y, bux = bu.x, buy = bu.y, arx = ar2.x, aix = ai2.x, aiy = ai2.y;
        asm("v_fma_f32 %0, %1, %2, %3" : "=v"(tx) : "v"(arx), "v"(hx), "v"(bux));
        asm("v_fma_f32 %0, %1, %2, %3" : "=v"(ty) : "v"(arx), "v"(hy), "v"(buy));
        asm("v_fma_f32 %0, %1, %2, %3" : "=v"(nx) : "v"(aix), "v"(hy), "v"(tx));
        asm("v_fma_f32 %0, %1, %2, %3" : "=v"(ny) : "v"(aiy), "v"(hx), "v"(ty));
        h2 = (f32x2){nx, ny};
        if (WR) *(LAS unsigned*)(hbuf + l * 272 + 4 * p) = cvtpk(h2.x, h2.y);
    }
}
__device__ __forceinline__ void ssm_phase_m(const bf16* U, unsigned char* Y, const float* ssmp,
                                          const float* c_re, const float* c_im, const float* d_skip, LAS unsigned char* lds, int vcu, int G, int wave, int lane) {
    LAS unsigned char* hbuf = lds + wave * 16384;
    LAS unsigned char* ebuf = lds + wave * 16384 + 4352;
    LAS unsigned char* bubuf = lds + wave * 16384 + 4864;
    const int ntask = BATCH * 128 * 4;
    for (int tb = vcu * NWAVES; tb < ntask; tb += G * NWAVES) {
        const int task = tb + wave, seg = (wave + 3 * (wave >> 2)) & 3, g = (task >> 2) & 127, b = task >> 9, p = lane;
        const float* pp_ = ssmp + (size_t)(g * 64 + p) * 34;
        const float ar = pp_[0], ai = pp_[1];
        const int cc = lane & 15, kg = lane >> 4;
        bf16x8 BbR[4], BbI[4];
#pragma unroll
        for (int pt = 0; pt < 4; ++pt) { const float* q_ = ssmp + (size_t)(g * 64 + 16 * pt + cc) * 34 + 8 * (kg & 1);
            v4u tr, ti; tr.x = cvtpk(q_[2], q_[3]); tr.y = cvtpk(q_[4], q_[5]); tr.z = cvtpk(q_[6], q_[7]); tr.w = cvtpk(q_[8], q_[9]);
            ti.x = cvtpk(q_[18], q_[19]); ti.y = cvtpk(q_[20], q_[21]); ti.z = cvtpk(q_[22], q_[23]); ti.w = cvtpk(q_[24], q_[25]);
            if (kg >= 2) { tr = (v4u){0u, 0u, 0u, 0u}; ti = (v4u){0u, 0u, 0u, 0u}; }
            BbR[pt] = __builtin_bit_cast(bf16x8, tr); BbI[pt] = __builtin_bit_cast(bf16x8, ti); }
        const int tstart = seg * SSM_L, tlen = (seg == 3) ? SSM_L3 : SSM_L;
        const bf16* ub = U + ((size_t)b * SEQ + tstart) * D + g * 16;
        const bf16* ua_p = ub + (size_t)(lane & 15) * D + 8 * (kg & 1);
        unsigned char* yb = Y + ((size_t)b * SEQ + tstart) * D + g * 16;
        const f32x2 ar2 = {ar, ar}, ai2 = {-ai, ai};
        f32x2 h2 = {0.f, 0.f};
        const v4u zero4 = {0u, 0u, 0u, 0u};
        if (seg < 3) {
            v4u pre[4];
#pragma unroll
            for (int i = 0; i < 4; ++i) pre[i] = *(const GAS v4u*)(ua_p + (size_t)(16 * i) * D);
            for (int t0 = 0; t0 < SSM_L; t0 += 64) {
                v4u cur[4];
#pragma unroll
                for (int i = 0; i < 4; ++i) cur[i] = (kg < 2) ? pre[i] : zero4;
                if (t0 + 64 < SSM_L) {
#pragma unroll
                    for (int i = 0; i < 4; ++i) pre[i] = *(const GAS v4u*)(ua_p + (size_t)(t0 + 64 + 16 * i) * D); }
#pragma unroll
                for (int blk = 0; blk < 4; ++blk) { ssm_block16m<false>(__builtin_bit_cast(bf16x8, cur[blk]), BbR, BbI, bubuf, hbuf, ar2, ai2, h2, p, lane); LDS_WAIT(); }
            }
            *(LAS f32x2*)(ebuf + 8 * p) = h2;
        }
        LDS_WAIT();
        __syncthreads();
        {
            f32x2 pw = {1.f, 0.f}, base = {ar, ai};
#pragma unroll 1
            for (int bit = SSM_L; bit > 0; bit >>= 1) {
                if (bit & 1) pw = (f32x2){pw.x * base.x - pw.y * base.y, pw.x * base.y + pw.y * base.x};
                base = (f32x2){base.x * base.x - base.y * base.y, 2.f * base.x * base.y};
            }
            LAS unsigned char* e0 = lds + (wave & 4) * 16384 + 4352;
            f32x2 sst = {0.f, 0.f};
            for (int j = 0; j < seg; ++j) { const f32x2 e = *(const LAS f32x2*)(e0 + ((j + (wave >> 2)) & 3) * 16384 + 8 * p);
                sst = (f32x2){pw.x * sst.x - pw.y * sst.y + e.x, pw.x * sst.y + pw.y * sst.x + e.y}; }
            h2 = sst;
        }
        bf16x8 cB[4];
#pragma unroll
        for (int ks = 0; ks < 4; ++ks) { unsigned w[4];
#pragma unroll
            for (int jj = 0; jj < 4; ++jj) { const int k = 32 * ks + 8 * (lane >> 4) + 2 * jj, pp = k >> 1;
                w[jj] = cvtpk(c_re[(g * 16 + cc) * 64 + pp], -c_im[(g * 16 + cc) * 64 + pp]); }
            v4u t; t.x = w[0]; t.y = w[1]; t.z = w[2]; t.w = w[3]; cB[ks] = __builtin_bit_cast(bf16x8, t); }
        const float dd = d_skip[g * 16 + cc];
        {
            v4u pre[4];
#pragma unroll
            for (int i = 0; i < 4; ++i) pre[i] = *(const GAS v4u*)(ua_p + (size_t)(16 * i) * D);
            for (int t0 = 0; t0 < tlen; t0 += 64) {
                v4u cur[4];
#pragma unroll
                for (int i = 0; i < 4; ++i) cur[i] = (kg < 2) ? pre[i] : zero4;
                if (t0 + 64 < tlen) {
#pragma unroll
                    for (int i = 0; i < 4; ++i) pre[i] = *(const GAS v4u*)(ua_p + (size_t)(t0 + 64 + 16 * i) * D); }
#pragma unroll
                for (int blk = 0; blk < 4; ++blk) {
                    unsigned short uq[4];
#pragma unroll
                    for (int r = 0; r < 4; ++r) uq[r] = *(const GAS unsigned short*)(ub + (size_t)(t0 + 16 * blk + 4 * (lane >> 4) + r) * D + cc);
                    ssm_block16m<true>(__builtin_bit_cast(bf16x8, cur[blk]), BbR, BbI, bubuf, hbuf, ar2, ai2, h2, p, lane);
                    LDS_WAIT();
                    f32x4 acc = (f32x4){0.f, 0.f, 0.f, 0.f};
#pragma unroll
                    for (int ks = 0; ks < 4; ++ks) { const bf16x8 a = *(const LAS bf16x8*)(hbuf + (lane & 15) * 272 + 16 * (lane >> 4) + 64 * ks);
                        acc = __builtin_amdgcn_mfma_f32_16x16x32_bf16(a, cB[ks], acc, 0, 0, 0); }
#pragma unroll
                    for (int r = 0; r < 4; ++r) { const int l = 4 * (lane >> 4) + r;
                        const float uu = __builtin_bit_cast(float, (unsigned)uq[r] << 16);
                        const float y = acc[r] + dd * uu;
                        *(GAS unsigned char*)(yb + (size_t)(t0 + 16 * blk + l) * D + cc) = (unsigned char)(__builtin_amdgcn_cvt_pk_fp8_f32(gelu_f(y), 0.f, 0, false) & 0xff); }
                    LDS_WAIT();
                }
            }
        }
        __syncthreads();
    }
}

__device__ __forceinline__ void attn_tile(const bf16* Kbh, const bf16* Vbh, const LAS float* rbh, int kp0, bool has_next, int qpos, int hl, int lane,
                                          const bf16x8 (&kc)[8], bf16x8 (&kn)[8], const bf16x8 (&qf)[8], f32x16 (&o)[4], float& mrun, float& lrun) {
    bf16x8 vf[8];
    { const bf16* vp = Vbh + (size_t)(kp0 >> 5) * 4096 + (size_t)lane * 8;
#pragma unroll
      for (int q = 0; q < 8; ++q) vf[q] = *(const GAS bf16x8*)(vp + 512 * q); }
    if (has_next) { const bf16* kp = Kbh + (size_t)((kp0 >> 5) + 1) * 4096 + (size_t)lane * 8;
#pragma unroll
      for (int ks = 0; ks < 8; ++ks) kn[ks] = *(const GAS bf16x8*)(kp + 512 * ks); }
    __builtin_amdgcn_sched_barrier(0);
    f32x16 s;
#pragma unroll
    for (int i = 0; i < 16; ++i) s[i] = 0.f;
#pragma unroll
    for (int ks = 0; ks < 8; ++ks) s = __builtin_amdgcn_mfma_f32_32x32x16_bf16(kc[ks], qf[ks], s, 0, 0, 0);
    float tmax = -1e30f;
#pragma unroll
    for (int i = 0; i < 16; ++i) { const int kpos = kp0 + (i & 3) + 8 * (i >> 2) + 4 * hl; int rel = qpos - kpos; rel = rel > 128 ? 128 : rel; s[i] += rbh[rel + 128]; tmax = fmaxf(tmax, s[i]); }
    tmax = fmaxf(tmax, SHFL_XOR(tmax, 32));
    const float mnew = fmaxf(mrun, tmax), alpha = __builtin_amdgcn_exp2f(mrun - mnew);
    float rs = 0.f;
#pragma unroll
    for (int i = 0; i < 16; ++i) { s[i] = __builtin_amdgcn_exp2f(s[i] - mnew); rs += s[i]; }
    rs += SHFL_XOR(rs, 32);
    lrun = lrun * alpha + rs; mrun = mnew;
    bf16x8 pf[2];
#pragma unroll
    for (int sidx = 0; sidx < 2; ++sidx) { v4u t; t.x = cvtpk(s[8 * sidx + 0], s[8 * sidx + 1]); t.y = cvtpk(s[8 * sidx + 2], s[8 * sidx + 3]);
        t.z = cvtpk(s[8 * sidx + 4], s[8 * sidx + 5]); t.w = cvtpk(s[8 * sidx + 6], s[8 * sidx + 7]); pf[sidx] = __builtin_bit_cast(bf16x8, t); }
#pragma unroll
    for (int dt = 0; dt < 4; ++dt) {
#pragma unroll
        for (int i = 0; i < 16; ++i) o[dt][i] *= alpha;
#pragma unroll
        for (int sidx = 0; sidx < 2; ++sidx) o[dt] = __builtin_amdgcn_mfma_f32_32x32x16_bf16(vf[2 * dt + sidx], pf[sidx], o[dt], 0, 0, 0);
    }
}
__device__ __forceinline__ void attn_phase(const bf16* QO, const bf16* Kb, const bf16* VT, unsigned char* O8, const LAS float* rb, int gw, int NGW, int lane) {
    const int r32 = lane & 31, hl = lane >> 5;
    for (int task = gw; task < BATCH * 16 * 128 * 2; task += NGW) {
        const int half = task & 1, c = (task >> 1) & 127, h = (task >> 8) & 15, b = task >> 12;
        const int qpos = 64 * c + 32 * half + r32;
        const size_t qrow = (size_t)b * SEQ + qpos;
        bf16x8 qf[8];
        const size_t bh256 = (size_t)(b * 16 + h) * 256;
        { const bf16* qt = QO + ((bh256 + 2 * c + half) * 8) * 512 + (size_t)lane * 8;
#pragma unroll
          for (int ks = 0; ks < 8; ++ks) qf[ks] = *(const GAS bf16x8*)(qt + ks * 512); }
        f32x16 o[4];
#pragma unroll
        for (int dt = 0; dt < 4; ++dt)
#pragma unroll
            for (int i = 0; i < 16; ++i) o[dt][i] = 0.f;
        float mrun = -1e30f, lrun = 0.f;
        const LAS float* rbh = rb + h * 257;
        const bf16* Kbh = Kb + bh256 * 4096; const bf16* Vbh = VT + bh256 * 4096;
        int kt0 = 16 - 2 * c; if (kt0 < 0) kt0 = 0;
        bf16x8 kA[8], kB[8];
        { const bf16* kp = Kbh + (size_t)((64 * c - 512 + 32 * kt0) >> 5) * 4096 + (size_t)lane * 8;
#pragma unroll
          for (int ks = 0; ks < 8; ++ks) kA[ks] = *(const GAS bf16x8*)(kp + 512 * ks); }
        for (int kt = kt0; kt < 18; kt += 2) {
            const int kp0 = 64 * c - 512 + 32 * kt;
            attn_tile(Kbh, Vbh, rbh, kp0, true, qpos, hl, lane, kA, kB, qf, o, mrun, lrun);
            attn_tile(Kbh, Vbh, rbh, kp0 + 32, kt + 2 < 18, qpos, hl, lane, kB, kA, qf, o, mrun, lrun);
        }
        const float inv = O8S / lrun;
        unsigned char* op = O8 + qrow * D + h * 128 + 4 * hl;
#pragma unroll
        for (int dt = 0; dt < 4; ++dt)
#pragma unroll
            for (int rq = 0; rq < 4; ++rq) { int w = 0; w = __builtin_amdgcn_cvt_pk_fp8_f32(o[dt][4 * rq + 0] * inv, o[dt][4 * rq + 1] * inv, w, false); w = __builtin_amdgcn_cvt_pk_fp8_f32(o[dt][4 * rq + 2] * inv, o[dt][4 * rq + 3] * inv, w, true);
                *(int*)(op + 32 * dt + 8 * rq) = w; }
    }
}

__device__ __forceinline__ void attn_a_qk(f32x16& s, const bf16x8 (&kc)[8], const bf16x8 (&qh)[8]) {
#pragma unroll
    for (int i = 0; i < 16; ++i) s[i] = 0.f;
#pragma unroll
    for (int ks = 0; ks < 8; ++ks) s = __builtin_amdgcn_mfma_f32_32x32x16_bf16(kc[ks], qh[ks], s, 0, 0, 0);
}
__device__ __forceinline__ void attn_a_half(f32x16& s, const LAS float* rbh, int kp0, int qbase, int r32, int hl, int lane, float& mrun, float& lrun, LAS unsigned char* pw, LAS float* aw) {
    const int qpos = qbase + r32; float tmax = -1e30f;
    if (qbase - (kp0 + 31) >= 128) { const float cb = rbh[256];
#pragma unroll
        for (int i = 0; i < 16; ++i) { s[i] += cb; tmax = fmaxf(tmax, s[i]); } }
    else {
#pragma unroll
        for (int i = 0; i < 16; ++i) { const int kpos = kp0 + (i & 3) + 8 * (i >> 2) + 4 * hl; int rel = qpos - kpos; rel = rel > 128 ? 128 : rel; s[i] += rbh[rel + 128]; tmax = fmaxf(tmax, s[i]); } }
    tmax = fmaxf(tmax, SHFL_XOR(tmax, 32));
    const float mnew = fmaxf(mrun, tmax), alpha = __builtin_amdgcn_exp2f(mrun - mnew);
    float rs = 0.f;
#pragma unroll
    for (int i = 0; i < 16; ++i) { s[i] = __builtin_amdgcn_exp2f(s[i] - mnew); rs += s[i]; }
    rs += SHFL_XOR(rs, 32);
    lrun = lrun * alpha + rs; mrun = mnew;
    v4u t0, t1; t0.x = cvtpk(s[0], s[1]); t0.y = cvtpk(s[2], s[3]); t0.z = cvtpk(s[4], s[5]); t0.w = cvtpk(s[6], s[7]);
    t1.x = cvtpk(s[8], s[9]); t1.y = cvtpk(s[10], s[11]); t1.z = cvtpk(s[12], s[13]); t1.w = cvtpk(s[14], s[15]);
    *(LAS v4u*)pw = t0; *(LAS v4u*)(pw + 16) = t1; *aw = alpha;
}
__device__ __forceinline__ void attn_b_half(const bf16x8 (&vc)[8], f32x16 (&oh)[4], const LAS unsigned char* pr, const LAS float* ar) {
    const v4u p0 = *(const LAS v4u*)pr, p1 = *(const LAS v4u*)(pr + 16); const float al = *ar;
    const bf16x8 pf0 = __builtin_bit_cast(bf16x8, p0), pf1 = __builtin_bit_cast(bf16x8, p1);
#pragma unroll
    for (int dt = 0; dt < 4; ++dt) {
#pragma unroll
        for (int i = 0; i < 16; ++i) oh[dt][i] *= al;
        oh[dt] = __builtin_amdgcn_mfma_f32_32x32x16_bf16(vc[2 * dt], pf0, oh[dt], 0, 0, 0); oh[dt] = __builtin_amdgcn_mfma_f32_32x32x16_bf16(vc[2 * dt + 1], pf1, oh[dt], 0, 0, 0); }
}
__device__ __forceinline__ void attn_ld8(bf16x8 (&d)[8], const bf16* p) {
#pragma unroll
    for (int q = 0; q < 8; ++q) d[q] = *(const GAS bf16x8*)(p + 512 * q);
}
__device__ __forceinline__ void attn_phase_split(const bf16* QO, const bf16* Kb, const bf16* VT, unsigned char* O8, const LAS float* rb, LAS unsigned char* xch, int vcu, int G, int wave, int lane) {
    const int r32 = lane & 31, hl = lane >> 5;
    const int pr = wave & 3, role = wave >> 2;
    LAS unsigned char* xp = xch + pr * 9728;
    LAS unsigned char* pl = xp + lane * 32; LAS float* al = (LAS float*)(xp + 8192) + lane;
    for (int batch = vcu; batch < BATCH * 16 * 128 * 2 / 8; batch += G) {
        const int T0 = batch * 8, c0 = (T0 >> 1) & 127, h = (T0 >> 8) & 15, b = T0 >> 12, c = c0 + pr;
        const size_t bh256 = (size_t)(b * 16 + h) * 256;
        const bf16* Kl = Kb + bh256 * 4096 + (size_t)lane * 8; const bf16* Vl = VT + bh256 * 4096 + (size_t)lane * 8;
        const LAS float* rbh = rb + h * 257;
        int kt0 = 16 - 2 * c; if (kt0 < 0) kt0 = 0;
        const int kbase = 64 * c - 512, tb = kbase >> 5;
        if (role == 0) {
            bf16x8 q0[8], q1[8];
            attn_ld8(q0, QO + ((bh256 + 2 * c + 0) * 8) * 512 + (size_t)lane * 8); attn_ld8(q1, QO + ((bh256 + 2 * c + 1) * 8) * 512 + (size_t)lane * 8);
            float mrun0 = -1e30f, mrun1 = -1e30f, lrun0 = 0.f, lrun1 = 0.f;
            bf16x8 kc[8];
            attn_ld8(kc, Kl + (size_t)(tb + kt0) * 4096);
            for (int t = 0; t < 18; ++t) {
                if (t >= kt0) { f32x16 s0, s1;
                    attn_a_qk(s0, kc, q0); attn_a_qk(s1, kc, q1);
                    __builtin_amdgcn_sched_barrier(0);
                    if (t + 1 < 18) attn_ld8(kc, Kl + (size_t)(tb + t + 1) * 4096);
                    __builtin_amdgcn_sched_barrier(0);
                    const int so = (t & 1) * 4096, ao = (t & 1) * 128;
                    attn_a_half(s0, rbh, kbase + 32 * t, 64 * c, r32, hl, lane, mrun0, lrun0, pl + so, al + ao);
                    attn_a_half(s1, rbh, kbase + 32 * t, 64 * c + 32, r32, hl, lane, mrun1, lrun1, pl + so + 2048, al + ao + 64); }
                if (t == 17) { *(LAS float*)(xp + 9216 + lane * 4) = lrun0; *(LAS float*)(xp + 9216 + 256 + lane * 4) = lrun1; }
                LDS_WAIT(); __syncthreads();
            }
            __syncthreads();
        } else {
            f32x16 oA[4], oB[4];
#pragma unroll
            for (int dt = 0; dt < 4; ++dt)
#pragma unroll
                for (int i = 0; i < 16; ++i) { oA[dt][i] = 0.f; oB[dt][i] = 0.f; }
            bf16x8 vc[8];
            attn_ld8(vc, Vl + (size_t)(tb + kt0) * 4096);
            __syncthreads();
            for (int t = 0; t < 18; ++t) {
                if (t >= kt0) { const int so = (t & 1) * 4096, ao = (t & 1) * 128;
                    attn_b_half(vc, oA, pl + so, al + ao); attn_b_half(vc, oB, pl + so + 2048, al + ao + 64);
                    __builtin_amdgcn_sched_barrier(0);
                    if (t + 1 < 18) attn_ld8(vc, Vl + (size_t)(tb + t + 1) * 4096); }
                LDS_WAIT(); __syncthreads();
            }
            {   const float lf0 = *(const LAS float*)(xp + 9216 + lane * 4), lf1 = *(const LAS float*)(xp + 9216 + 256 + lane * 4);
                const float inv0 = O8S / lf0, inv1 = O8S / lf1;
                unsigned char* op0 = O8 + ((size_t)b * SEQ + 64 * c + r32) * D + h * 128 + 4 * hl; unsigned char* op1 = op0 + (size_t)32 * D;
#pragma unroll
                for (int dt = 0; dt < 4; ++dt)
#pragma unroll
                    for (int rq = 0; rq < 4; ++rq) { int w = 0; w = __builtin_amdgcn_cvt_pk_fp8_f32(oA[dt][4 * rq + 0] * inv0, oA[dt][4 * rq + 1] * inv0, w, false); w = __builtin_amdgcn_cvt_pk_fp8_f32(oA[dt][4 * rq + 2] * inv0, oA[dt][4 * rq + 3] * inv0, w, true);
                        *(int*)(op0 + 32 * dt + 8 * rq) = w;
                        int w2 = 0; w2 = __builtin_amdgcn_cvt_pk_fp8_f32(oB[dt][4 * rq + 0] * inv1, oB[dt][4 * rq + 1] * inv1, w2, false); w2 = __builtin_amdgcn_cvt_pk_fp8_f32(oB[dt][4 * rq + 2] * inv1, oB[dt][4 * rq + 3] * inv1, w2, true);
                        *(int*)(op1 + 32 * dt + 8 * rq) = w2; }
            }
        }
        __syncthreads();
    }
}

#define INS16(L, x) do { _Pragma("unroll") for (int _j = 15; _j >= 1; --_j) L[_j] = __builtin_amdgcn_fmed3f(L[_j - 1], L[_j], (x)); L[0] = fmaxf(L[0], (x)); } while (0)
__device__ __forceinline__ void peer_select_phase(const bf16* Q, const LAS unsigned char* skl  , int* idx_out, float* gate_out, int gw, int NGW, int lane) {
    const int r = lane & 31, half = lane >> 5;
    for (int it = gw; it < M / 4; it += NGW) {
        const int t = 4 * it + (r >> 3), hh = r & 7;
        float L[2][16];
#pragma unroll
        for (int s = 0; s < 2; ++s) {
#pragma unroll
            for (int j = 0; j < 16; ++j) L[s][j] = -3.0e38f;
            bf16x8 qf[8];
            const bf16* qp = Q + (size_t)t * D + hh * 256 + s * 128 + 8 * half;
#pragma unroll
            for (int ks = 0; ks < 8; ++ks) qf[ks] = *(const bf16x8*)(qp + 16 * ks);
#pragma unroll 1
            for (int nt = 0; nt < 4; ++nt) {
                f32x16 sc;
#pragma unroll
                for (int i = 0; i < 16; ++i) sc[i] = 0.f;
                const LAS unsigned char* kp = skl + (size_t)(s * 128 + 32 * nt + r) * 272 + 16 * half;
#pragma unroll
                for (int ks = 0; ks < 8; ++ks) { const bf16x8 kf = *(const LAS bf16x8*)(kp + 32 * ks); sc = __builtin_amdgcn_mfma_f32_32x32x16_bf16(kf, qf[ks], sc, 0, 0, 0); }
#pragma unroll
                for (int i = 0; i < 16; ++i) { const unsigned n = 32 * nt + (i & 3) + 8 * (i >> 2) + 4 * half;
                    const float sv = sc[i];
                    const float x = __builtin_bit_cast(float, (__builtin_bit_cast(unsigned, sv) & ~127u) | n);
                    INS16(L[s], x); }
            }
        }
        float mine[16], oth[16];
#pragma unroll
        for (int j = 0; j < 16; ++j) { const float o0 = SHFL_XOR(L[0][j], 32), o1 = SHFL_XOR(L[1][j], 32); mine[j] = half ? L[1][j] : L[0][j]; oth[j] = half ? o1 : o0; }
#pragma unroll
        for (int j = 0; j < 16; ++j) { const float x = oth[j]; INS16(mine, x); }
        float A[16], B[16];
#pragma unroll
        for (int j = 0; j < 16; ++j) { const float o = SHFL_XOR(mine[j], 32); A[j] = half ? o : mine[j]; B[j] = half ? mine[j] : o; }
        float T[16];
#pragma unroll
        for (int j = 0; j < 16; ++j) T[j] = -3.0e38f;
#pragma unroll
        for (int a = 0; a < 16; ++a)
#pragma unroll
            for (int bq = 0; bq < 16; ++bq) if ((a + 1) * (bq + 1) <= 16) { const float x = A[a] + B[bq]; INS16(T, x); }
        const float tau = T[15], mx = T[0];
        float den = 0.f;
#pragma unroll
        for (int j = 0; j < 16; ++j) den += __builtin_amdgcn_exp2f((T[j] - mx) * LOG2E);
        const float rden = 1.f / den;
        int cnt = 0;
        const size_t ob = (size_t)t * 128 + hh * 16;
#pragma unroll
        for (int a = 0; a < 16; ++a)
#pragma unroll
            for (int bq = 0; bq < 16; ++bq) if ((a + 1) * (bq + 1) <= 16) {
                const float x = A[a] + B[bq];
                if (x >= tau && cnt < 16) {
                    if (half == 0) idx_out[ob + cnt] = (int)(((__builtin_bit_cast(unsigned, A[a]) & 127u) << 7) | (__builtin_bit_cast(unsigned, B[bq]) & 127u));
                    else gate_out[ob + cnt] = __builtin_amdgcn_exp2f((x - mx) * LOG2E) * rden;
                    ++cnt;
                }
            }
    }
}

__device__ __forceinline__ void peer_gather_phase(float* hio, bf16* hb, const int* idx, const float* gate, const bf16* TU, const bf16* TV, const float* lg, const float* lb, int gw, int NGW, int lane) {
    for (int m = gw; m < M; m += NGW) {
        v4u xr[4];
#pragma unroll
        for (int j = 0; j < 4; ++j) xr[j] = *(const v4u*)(hb + (size_t)m * D + 512 * j + 8 * lane);
        const int i0 = idx[(size_t)m * 128 + lane], i1 = idx[(size_t)m * 128 + 64 + lane];
        float y[32];
#pragma unroll
        for (int i = 0; i < 32; ++i) y[i] = 0.f;
#ifdef DBG_NO_PEER
        for (int hb_ = 0; hb_ < 0; ++hb_) {
#else
        for (int hb_ = 0; hb_ < 8; ++hb_) {
#endif
            float part[16];
            const int isel = (hb_ < 4) ? i0 : i1;
#pragma unroll
            for (int kk = 0; kk < 16; ++kk) {
                const int e = __builtin_amdgcn_readlane(isel, ((hb_ & 3) << 4) + kk);
                const bf16* up = TU + (size_t)e * D + 8 * lane;
                float acc = 0.f;
#pragma unroll
                for (int j = 0; j < 4; ++j) { const v4u w = *(const v4u*)(up + 512 * j);
                    acc = dot2bf(w.x, xr[j].x, acc); acc = dot2bf(w.y, xr[j].y, acc); acc = dot2bf(w.z, xr[j].z, acc); acc = dot2bf(w.w, xr[j].w, acc); }
                part[kk] = acc;
            }
#pragma unroll
            for (int kk = 0; kk < 16; ++kk) { part[kk] += SHFL_XOR(part[kk], 32); part[kk] += SHFL_XOR(part[kk], 16); }
            {
                const bool b3 = (lane & 8) != 0, b2 = (lane & 4) != 0, b1 = (lane & 2) != 0, b0 = (lane & 1) != 0;
#pragma unroll
                for (int i = 0; i < 8; ++i) { const float send = b3 ? part[i] : part[i + 8], keep = b3 ? part[i + 8] : part[i]; part[i] = keep + SHFL_XOR(send, 8); }
#pragma unroll
                for (int i = 0; i < 4; ++i) { const float send = b2 ? part[i] : part[i + 4], keep = b2 ? part[i + 4] : part[i]; part[i] = keep + SHFL_XOR(send, 4); }
#pragma unroll
                for (int i = 0; i < 2; ++i) { const float send = b1 ? part[i] : part[i + 2], keep = b1 ? part[i + 2] : part[i]; part[i] = keep + SHFL_XOR(send, 2); }
                { const float send = b0 ? part[0] : part[1], keep = b0 ? part[1] : part[0]; part[0] = keep + SHFL_XOR(send, 1); }
            }
            const float gt = gate[(size_t)m * 128 + hb_ * 16 + (lane & 15)];
            const float act = gelu_f(part[0]) * gt;
            const unsigned actb = f2bf(act);
#pragma unroll
            for (int kk = 0; kk < 16; ++kk) {
                const int e = __builtin_amdgcn_readlane(isel, ((hb_ & 3) << 4) + kk);
                const unsigned ab = (unsigned)__builtin_amdgcn_readlane((int)actb, kk);
                const unsigned alo = ab, ahi = ab << 16;
                const bf16* vp = TV + (size_t)e * D + 8 * lane;
#pragma unroll
                for (int j = 0; j < 4; ++j) { const v4u w = *(const v4u*)(vp + 512 * j);
                    y[8 * j + 0] = dot2bf(w.x, alo, y[8 * j + 0]); y[8 * j + 1] = dot2bf(w.x, ahi, y[8 * j + 1]);
                    y[8 * j + 2] = dot2bf(w.y, alo, y[8 * j + 2]); y[8 * j + 3] = dot2bf(w.y, ahi, y[8 * j + 3]);
                    y[8 * j + 4] = dot2bf(w.z, alo, y[8 * j + 4]); y[8 * j + 5] = dot2bf(w.z, ahi, y[8 * j + 5]);
                    y[8 * j + 6] = dot2bf(w.w, alo, y[8 * j + 6]); y[8 * j + 7] = dot2bf(w.w, ahi, y[8 * j + 7]); }
            }
        }
        float* row = hio + (size_t)m * D + 8 * lane;
        float s = 0.f;
#pragma unroll
        for (int j = 0; j < 4; ++j) { const f32x4 a = *(const f32x4*)(row + 512 * j), b = *(const f32x4*)(row + 512 * j + 4);
            y[8 * j + 0] += DN_ALPHA * a.x; y[8 * j + 1] += DN_ALPHA * a.y; y[8 * j + 2] += DN_ALPHA * a.z; y[8 * j + 3] += DN_ALPHA * a.w;
            y[8 * j + 4] += DN_ALPHA * b.x; y[8 * j + 5] += DN_ALPHA * b.y; y[8 * j + 6] += DN_ALPHA * b.z; y[8 * j + 7] += DN_ALPHA * b.w; }
#pragma unroll
        for (int i = 0; i < 32; ++i) s += y[i];
        const float mean = wave_sum(s) * (1.f / D); float s2 = 0.f;
#pragma unroll
        for (int i = 0; i < 32; ++i) { y[i] -= mean; s2 += y[i] * y[i]; }
        const float rstd = 1.f / sqrtf(wave_sum(s2) * (1.f / D) + LN_EPS);
#pragma unroll
        for (int j = 0; j < 4; ++j) { const float* gp = lg + 512 * j + 8 * lane; const float* bp = lb + 512 * j + 8 * lane;
            const f32x4 g0 = *(const f32x4*)gp, g1 = *(const f32x4*)(gp + 4), b0 = *(const f32x4*)bp, b1 = *(const f32x4*)(bp + 4);
            f32x4 o0, o1; o0.x = y[8 * j + 0] * rstd * g0.x + b0.x; o0.y = y[8 * j + 1] * rstd * g0.y + b0.y; o0.z = y[8 * j + 2] * rstd * g0.z + b0.z; o0.w = y[8 * j + 3] * rstd * g0.w + b0.w;
            o1.x = y[8 * j + 4] * rstd * g1.x + b1.x; o1.y = y[8 * j + 5] * rstd * g1.y + b1.y; o1.z = y[8 * j + 6] * rstd * g1.z + b1.z; o1.w = y[8 * j + 7] * rstd * g1.w + b1.w;
            *(f32x4*)(row + 512 * j) = o0; *(f32x4*)(row + 512 * j + 4) = o1;
            v4u w; w.x = pk2(o0.x, o0.y); w.y = pk2(o0.z, o0.w); w.z = pk2(o1.x, o1.y); w.w = pk2(o1.z, o1.w);
            *(v4u*)(hb + (size_t)m * D + 512 * j + 8 * lane) = w; }
    }
}


__device__ __forceinline__ float udot8(const v4u (&w)[2], const f32x2 (&x2)[16]) {
    f32x2 a0 = {0.f, 0.f}, a1 = {0.f, 0.f};
#pragma unroll
    for (int j = 0; j < 2; ++j) {
        const unsigned d0 = w[j].x, d1 = w[j].y, d2 = w[j].z, d3 = w[j].w;
        a0 = __builtin_elementwise_fma(__builtin_amdgcn_cvt_pk_f32_fp8((int)d0, false), x2[8 * j + 0], a0); a1 = __builtin_elementwise_fma(__builtin_amdgcn_cvt_pk_f32_fp8((int)d0, true), x2[8 * j + 1], a1);
        a0 = __builtin_elementwise_fma(__builtin_amdgcn_cvt_pk_f32_fp8((int)d1, false), x2[8 * j + 2], a0); a1 = __builtin_elementwise_fma(__builtin_amdgcn_cvt_pk_f32_fp8((int)d1, true), x2[8 * j + 3], a1);
        a0 = __builtin_elementwise_fma(__builtin_amdgcn_cvt_pk_f32_fp8((int)d2, false), x2[8 * j + 4], a0); a1 = __builtin_elementwise_fma(__builtin_amdgcn_cvt_pk_f32_fp8((int)d2, true), x2[8 * j + 5], a1);
        a0 = __builtin_elementwise_fma(__builtin_amdgcn_cvt_pk_f32_fp8((int)d3, false), x2[8 * j + 6], a0); a1 = __builtin_elementwise_fma(__builtin_amdgcn_cvt_pk_f32_fp8((int)d3, true), x2[8 * j + 7], a1);
    }
    return (a0.x + a0.y) + (a1.x + a1.y);
}
__device__ __forceinline__ void vacc8(const v4u (&w)[2], const f32x2 a2, f32x2 (&y2)[16]) {
#pragma unroll
    for (int j = 0; j < 2; ++j) {
        const unsigned d0 = w[j].x, d1 = w[j].y, d2 = w[j].z, d3 = w[j].w;
        y2[8 * j + 0] = __builtin_elementwise_fma(__builtin_amdgcn_cvt_pk_f32_fp8((int)d0, false), a2, y2[8 * j + 0]); y2[8 * j + 1] = __builtin_elementwise_fma(__builtin_amdgcn_cvt_pk_f32_fp8((int)d0, true), a2, y2[8 * j + 1]);
        y2[8 * j + 2] = __builtin_elementwise_fma(__builtin_amdgcn_cvt_pk_f32_fp8((int)d1, false), a2, y2[8 * j + 2]); y2[8 * j + 3] = __builtin_elementwise_fma(__builtin_amdgcn_cvt_pk_f32_fp8((int)d1, true), a2, y2[8 * j + 3]);
        y2[8 * j + 4] = __builtin_elementwise_fma(__builtin_amdgcn_cvt_pk_f32_fp8((int)d2, false), a2, y2[8 * j + 4]); y2[8 * j + 5] = __builtin_elementwise_fma(__builtin_amdgcn_cvt_pk_f32_fp8((int)d2, true), a2, y2[8 * j + 5]);
        y2[8 * j + 6] = __builtin_elementwise_fma(__builtin_amdgcn_cvt_pk_f32_fp8((int)d3, false), a2, y2[8 * j + 6]); y2[8 * j + 7] = __builtin_elementwise_fma(__builtin_amdgcn_cvt_pk_f32_fp8((int)d3, true), a2, y2[8 * j + 7]);
    }
}
#define ROWLD8(dst, base, e) do { const u8* _p = (base) + (size_t)(e) * D + 16 * lane; dst[0] = gld16(_p); dst[1] = gld16(_p + 1024); } while (0)
__device__ __forceinline__ void peer_gather_fp8(float* hio, bf16* hb, float* hio_w, bf16* hb_w, const int* idx, const float* gate, const u8* TU8, const u8* TV8, const float* lg, const float* lb, int gw, int NGW, int lane_in) {
    for (int m = gw; m < M; m += NGW) {
        int lane = lane_in; asm volatile("" : "+v"(lane));
        float* row = hio + (size_t)m * D + 16 * lane;
        f32x2 x2[16];
#pragma unroll
        for (int j = 0; j < 2; ++j)
#pragma unroll
            for (int q = 0; q < 4; ++q) { const f32x4 t = *(const GAS f32x4*)(row + 1024 * j + 4 * q); x2[8 * j + 2 * q] = (f32x2){t.x, t.y}; x2[8 * j + 2 * q + 1] = (f32x2){t.z, t.w}; }
        const int i0 = *(const GAS int*)(idx + (size_t)m * 128 + lane), i1 = *(const GAS int*)(idx + (size_t)m * 128 + 64 + lane);
        f32x2 y2[16];
#pragma unroll
        for (int i = 0; i < 16; ++i) y2[i] = (f32x2){0.f, 0.f};
        v4u buf[4][2];
#pragma unroll
        for (int q = 0; q < 4; ++q) { const int e = __builtin_amdgcn_readlane(i0, q); ROWLD8(buf[q], TU8, e); }
        for (int hb_ = 0; hb_ < 8; ++hb_) {
            const int isel = (hb_ < 4) ? i0 : i1, inext = (hb_ + 1 < 4) ? i0 : i1;
            const int lb0 = (hb_ & 3) << 4, lbn = ((hb_ + 1) & 3) << 4;
            const float gt = *(const GAS float*)(gate + (size_t)m * 128 + hb_ * 16 + (lane & 15));
            float part[16];
#pragma unroll
            for (int kk = 0; kk < 16; ++kk) {
                part[kk] = udot8(buf[kk & 3], x2);
                if (kk + 4 < 16) { const int e = __builtin_amdgcn_readlane(isel, lb0 + kk + 4); ROWLD8(buf[kk & 3], TU8, e); }
                else { const int e = __builtin_amdgcn_readlane(isel, lb0 + kk + 4 - 16); ROWLD8(buf[kk & 3], TV8, e); }
                __builtin_amdgcn_sched_barrier(0);
            }
#pragma unroll
            for (int kk = 0; kk < 16; ++kk) { part[kk] += SHFL_XOR(part[kk], 32); part[kk] += SHFL_XOR(part[kk], 16); }
            {
                const bool b3 = (lane & 8) != 0, b2 = (lane & 4) != 0, b1 = (lane & 2) != 0, b0 = (lane & 1) != 0;
#pragma unroll
                for (int i = 0; i < 8; ++i) { const float send = b3 ? part[i] : part[i + 8], keep = b3 ? part[i + 8] : part[i]; part[i] = keep + SHFL_XOR(send, 8); }
#pragma unroll
                for (int i = 0; i < 4; ++i) { const float send = b2 ? part[i] : part[i + 4], keep = b2 ? part[i + 4] : part[i]; part[i] = keep + SHFL_XOR(send, 4); }
#pragma unroll
                for (int i = 0; i < 2; ++i) { const float send = b1 ? part[i] : part[i + 2], keep = b1 ? part[i + 2] : part[i]; part[i] = keep + SHFL_XOR(send, 2); }
                { const float send = b0 ? part[0] : part[1], keep = b0 ? part[1] : part[0]; part[0] = keep + SHFL_XOR(send, 1); }
            }
            const float act = gelu_f(part[0] * (1.f / TU_SCALE)) * gt * (1.f / TV_SCALE);
            const int acti = __builtin_bit_cast(int, act);
#pragma unroll
            for (int kk = 0; kk < 16; ++kk) {
                const float a = __builtin_bit_cast(float, __builtin_amdgcn_readlane(acti, kk));
                vacc8(buf[kk & 3], (f32x2){a, a}, y2);
                if (kk + 4 < 16) { const int e = __builtin_amdgcn_readlane(isel, lb0 + kk + 4); ROWLD8(buf[kk & 3], TV8, e); }
                else if (hb_ < 7) { const int e = __builtin_amdgcn_readlane(inext, lbn + kk + 4 - 16); ROWLD8(buf[kk & 3], TU8, e); }
                __builtin_amdgcn_sched_barrier(0);
            }
        }
        float s = 0.f;
#pragma unroll
        for (int i = 0; i < 16; ++i) { y2[i] = y2[i] + x2[i] * DN_ALPHA; s += y2[i].x + y2[i].y; }
        const float mean = wave_sum(s) * (1.f / D); float s2 = 0.f;
#pragma unroll
        for (int i = 0; i < 16; ++i) { y2[i] = y2[i] - mean; s2 += y2[i].x * y2[i].x + y2[i].y * y2[i].y; }
        const float rstd = 1.f / sqrtf(wave_sum(s2) * (1.f / D) + LN_EPS);
#pragma unroll
        for (int j = 0; j < 2; ++j)
#pragma unroll
            for (int q = 0; q < 4; ++q) { const int off = 1024 * j + 16 * lane + 4 * q;
                const f32x4 g4 = *(const GAS f32x4*)(lg + off), b4 = *(const GAS f32x4*)(lb + off);
                const f32x2 ya = y2[8 * j + 2 * q], yb = y2[8 * j + 2 * q + 1];
                f32x4 o; o.x = ya.x * rstd * g4.x + b4.x; o.y = ya.y * rstd * g4.y + b4.y; o.z = yb.x * rstd * g4.z + b4.z; o.w = yb.y * rstd * g4.w + b4.w;
                *(GAS f32x4*)(hio_w + (size_t)m * D + off) = o;
                v2u w; w.x = pk2(o.x, o.y); w.y = pk2(o.z, o.w); *(GAS v2u*)(hb_w + (size_t)m * D + off) = w; }
    }
}


__device__ __forceinline__ float wave_max(float v) {
    v = fmaxf(v, WDPP(v, 0xB1)); v = fmaxf(v, WDPP(v, 0x4E)); v = fmaxf(v, WDPP(v, 0x141)); v = fmaxf(v, WDPP(v, 0x140));
    return fmaxf(fmaxf(WRL(v, 0), WRL(v, 16)), fmaxf(WRL(v, 32), WRL(v, 48)));
}
__device__ __forceinline__ void cvt_rows_fp4(const float* src, u8* dst, float* scales, int nrows, int gw, int NGW, int lane) {
    for (int r0 = gw; r0 < nrows; r0 += 4 * NGW) {
        f32x4 v[4][8];
#pragma unroll
        for (int u = 0; u < 4; ++u) { const GAS f32x4* p = (const GAS f32x4*)(src + (size_t)(r0 + u * NGW) * D + 4 * lane);
#pragma unroll
            for (int q = 0; q < 8; ++q) v[u][q] = p[64 * q]; }
#pragma unroll
        for (int u = 0; u < 4; ++u) { const int r = r0 + u * NGW; float mx = 0.f;
#pragma unroll
            for (int q = 0; q < 8; ++q) mx = fmaxf(mx, fmaxf(fmaxf(__builtin_fabsf(v[u][q].x), __builtin_fabsf(v[u][q].y)), fmaxf(__builtin_fabsf(v[u][q].z), __builtin_fabsf(v[u][q].w))));
            mx = wave_max(mx);
            const float inv = mx > 0.f ? 6.f / mx : 0.f;
            const int lay = r / NEXP, e = r % NEXP;
#pragma unroll
            for (int q = 0; q < 8; ++q) { unsigned t = 0u; const f32x4 a = v[u][q] * inv;
                t = __builtin_amdgcn_cvt_scalef32_pk_fp4_f32(t, a.x, a.y, 1.0f, 0); t = __builtin_amdgcn_cvt_scalef32_pk_fp4_f32(t, a.z, a.w, 1.0f, 1);
                *(GAS unsigned short*)(dst + (((size_t)lay * 8 + q) * NEXP + e) * 128 + 2 * lane) = (unsigned short)(t & 0xffffu); }
            if (lane == 0) scales[r] = mx * (1.f / 6.f); }
    }
}
__device__ __forceinline__ float udot4(const v4u w, const f32x2 (&x2)[16]) {
    f32x2 a0 = {0.f, 0.f}, a1 = {0.f, 0.f};
    const unsigned d0 = w.x, d1 = w.y, d2 = w.z, d3 = w.w;
#define UD4(dw, k) a0 = __builtin_elementwise_fma(__builtin_amdgcn_cvt_scalef32_pk_f32_fp4(dw, 1.0f, 0), x2[4 * (k) + 0], a0); a1 = __builtin_elementwise_fma(__builtin_amdgcn_cvt_scalef32_pk_f32_fp4(dw, 1.0f, 1), x2[4 * (k) + 1], a1); \
                   a0 = __builtin_elementwise_fma(__builtin_amdgcn_cvt_scalef32_pk_f32_fp4(dw, 1.0f, 2), x2[4 * (k) + 2], a0); a1 = __builtin_elementwise_fma(__builtin_amdgcn_cvt_scalef32_pk_f32_fp4(dw, 1.0f, 3), x2[4 * (k) + 3], a1);
    UD4(d0, 0) UD4(d1, 1) UD4(d2, 2) UD4(d3, 3)
#undef UD4
    return (a0.x + a0.y) + (a1.x + a1.y);
}
__device__ __forceinline__ void vacc4(const v4u w, const f32x2 a2, f32x2 (&y2)[16]) {
    const unsigned d0 = w.x, d1 = w.y, d2 = w.z, d3 = w.w;
#define VA4(dw, k) y2[4 * (k) + 0] = __builtin_elementwise_fma(__builtin_amdgcn_cvt_scalef32_pk_f32_fp4(dw, 1.0f, 0), a2, y2[4 * (k) + 0]); y2[4 * (k) + 1] = __builtin_elementwise_fma(__builtin_amdgcn_cvt_scalef32_pk_f32_fp4(dw, 1.0f, 1), a2, y2[4 * (k) + 1]); \
                   y2[4 * (k) + 2] = __builtin_elementwise_fma(__builtin_amdgcn_cvt_scalef32_pk_f32_fp4(dw, 1.0f, 2), a2, y2[4 * (k) + 2]); y2[4 * (k) + 3] = __builtin_elementwise_fma(__builtin_amdgcn_cvt_scalef32_pk_f32_fp4(dw, 1.0f, 3), a2, y2[4 * (k) + 3]);
    VA4(d0, 0) VA4(d1, 1) VA4(d2, 2) VA4(d3, 3)
#undef VA4
}
#define ROWLD4(dst, base, e) do { dst = gld16((base) + (size_t)(e) * 1024 + 16 * lane); } while (0)
__device__ __forceinline__ void peer_gather_fp4(float* hio, bf16* hb, float* hio_w, bf16* hb_w, const int* idx, const float* gate, const u8* TU4, const u8* TV4, const float* SU, const float* SV,
                                                const float* lg, const float* lb, int gw, int NGW, int lane_in) {
    for (int m = gw; m < M; m += NGW) {
        int lane = lane_in; asm volatile("" : "+v"(lane));
        const float* row = hio + (size_t)m * D + 32 * lane;
        f32x2 x2[16];
#pragma unroll
        for (int q = 0; q < 8; ++q) { const f32x4 t = *(const GAS f32x4*)(row + 4 * q); x2[2 * q] = (f32x2){t.x, t.y}; x2[2 * q + 1] = (f32x2){t.z, t.w}; }
        const int i0 = *(const GAS int*)(idx + (size_t)m * 128 + lane), i1 = *(const GAS int*)(idx + (size_t)m * 128 + 64 + lane);
        f32x2 y2[16];
#pragma unroll
        for (int i = 0; i < 16; ++i) y2[i] = (f32x2){0.f, 0.f};
        v4u buf[8];
#pragma unroll
        for (int q = 0; q < 8; ++q) { const int e = __builtin_amdgcn_readlane(i0, q); ROWLD4(buf[q], TU4, e); }
        for (int hb_ = 0; hb_ < 8; ++hb_) {
            const int isel = (hb_ < 4) ? i0 : i1, inext = (hb_ + 1 < 4) ? i0 : i1;
            const int lb0 = (hb_ & 3) << 4, lbn = ((hb_ + 1) & 3) << 4;
            const float gt = *(const GAS float*)(gate + (size_t)m * 128 + hb_ * 16 + (lane & 15));
            const int ek = shfl_idx_lane(isel, lb0 + (lane & 15));
            const float su = *(const GAS float*)(SU + ek), sv = *(const GAS float*)(SV + ek);
            float part[16];
#pragma unroll
            for (int kk = 0; kk < 16; ++kk) {
                part[kk] = udot4(buf[kk & 7], x2);
                if (kk + 8 < 16) { const int e = __builtin_amdgcn_readlane(isel, lb0 + kk + 8); ROWLD4(buf[kk & 7], TU4, e); }
                else { const int e = __builtin_amdgcn_readlane(isel, lb0 + kk + 8 - 16); ROWLD4(buf[kk & 7], TV4, e); }
                __builtin_amdgcn_sched_barrier(0);
            }
#pragma unroll
            for (int kk = 0; kk < 16; ++kk) { part[kk] += SHFL_XOR(part[kk], 32); part[kk] += SHFL_XOR(part[kk], 16); }
            {
                const bool b3 = (lane & 8) != 0, b2 = (lane & 4) != 0, b1 = (lane & 2) != 0, b0 = (lane & 1) != 0;
#pragma unroll
                for (int i = 0; i < 8; ++i) { const float send = b3 ? part[i] : part[i + 8], keep = b3 ? part[i + 8] : part[i]; part[i] = keep + SHFL_XOR(send, 8); }
#pragma unroll
                for (int i = 0; i < 4; ++i) { const float send = b2 ? part[i] : part[i + 4], keep = b2 ? part[i + 4] : part[i]; part[i] = keep + SHFL_XOR(send, 4); }
#pragma unroll
                for (int i = 0; i < 2; ++i) { const float send = b1 ? part[i] : part[i + 2], keep = b1 ? part[i + 2] : part[i]; part[i] = keep + SHFL_XOR(send, 2); }
                { const float send = b0 ? part[0] : part[1], keep = b0 ? part[1] : part[0]; part[0] = keep + SHFL_XOR(send, 1); }
            }
            const float act = gelu_f(part[0] * su) * gt * sv;
            const int acti = __builtin_bit_cast(int, act);
#pragma unroll
            for (int kk = 0; kk < 16; ++kk) {
                const float a = __builtin_bit_cast(float, __builtin_amdgcn_readlane(acti, kk));
                vacc4(buf[kk & 7], (f32x2){a, a}, y2);
                if (kk + 8 < 16) { const int e = __builtin_amdgcn_readlane(isel, lb0 + kk + 8); ROWLD4(buf[kk & 7], TV4, e); }
                else if (hb_ < 7) { const int e = __builtin_amdgcn_readlane(inext, lbn + kk + 8 - 16); ROWLD4(buf[kk & 7], TU4, e); }
                __builtin_amdgcn_sched_barrier(0);
            }
        }
        float s = 0.f;
#pragma unroll
        for (int i = 0; i < 16; ++i) { y2[i] = y2[i] + x2[i] * DN_ALPHA; s += y2[i].x + y2[i].y; }
        const float mean = wave_sum(s) * (1.f / D); float s2 = 0.f;
#pragma unroll
        for (int i = 0; i < 16; ++i) { y2[i] = y2[i] - mean; s2 += y2[i].x * y2[i].x + y2[i].y * y2[i].y; }
        const float rstd = 1.f / sqrtf(wave_sum(s2) * (1.f / D) + LN_EPS);
#pragma unroll
        for (int q = 0; q < 8; ++q) { const int off = 32 * lane + 4 * q;
            const f32x4 g4 = *(const GAS f32x4*)(lg + off), b4 = *(const GAS f32x4*)(lb + off);
            const f32x2 ya = y2[2 * q], yb = y2[2 * q + 1];
            f32x4 o; o.x = ya.x * rstd * g4.x + b4.x; o.y = ya.y * rstd * g4.y + b4.y; o.z = yb.x * rstd * g4.z + b4.z; o.w = yb.y * rstd * g4.w + b4.w;
            *(GAS f32x4*)(hio_w + (size_t)m * D + off) = o;
            v2u w; w.x = pk2(o.x, o.y); w.y = pk2(o.z, o.w); *(GAS v2u*)(hb_w + (size_t)m * D + off) = w; }
    }
}


typedef _Float16 h16x2 __attribute__((ext_vector_type(2)));
#define CVT_H2_FP4(dw, b) __builtin_bit_cast(h16x2, __builtin_amdgcn_cvt_scalef32_pk_f16_fp4(dw, 1.0f, b))
__device__ __forceinline__ float udot4h(const v4u w, const h16x2 (&xh)[16]) {
    h16x2 a0 = {(_Float16)0.f, (_Float16)0.f}, a1 = {(_Float16)0.f, (_Float16)0.f};
    const unsigned d0 = w.x, d1 = w.y, d2 = w.z, d3 = w.w;
#define UD4H(dw, k) a0 = __builtin_elementwise_fma(CVT_H2_FP4(dw, 0), xh[4 * (k) + 0], a0); a1 = __builtin_elementwise_fma(CVT_H2_FP4(dw, 1), xh[4 * (k) + 1], a1); \
                    a0 = __builtin_elementwise_fma(CVT_H2_FP4(dw, 2), xh[4 * (k) + 2], a0); a1 = __builtin_elementwise_fma(CVT_H2_FP4(dw, 3), xh[4 * (k) + 3], a1);
    UD4H(d0, 0) UD4H(d1, 1) UD4H(d2, 2) UD4H(d3, 3)
#undef UD4H
    return ((float)a0.x + (float)a0.y) + ((float)a1.x + (float)a1.y);
}
__device__ __forceinline__ void vacc4h(const v4u w, const h16x2 a2, h16x2 (&yh)[16]) {
    const unsigned d0 = w.x, d1 = w.y, d2 = w.z, d3 = w.w;
#define VA4H(dw, k) yh[4 * (k) + 0] = __builtin_elementwise_fma(CVT_H2_FP4(dw, 0), a2, yh[4 * (k) + 0]); yh[4 * (k) + 1] = __builtin_elementwise_fma(CVT_H2_FP4(dw, 1), a2, yh[4 * (k) + 1]); \
                    yh[4 * (k) + 2] = __builtin_elementwise_fma(CVT_H2_FP4(dw, 2), a2, yh[4 * (k) + 2]); yh[4 * (k) + 3] = __builtin_elementwise_fma(CVT_H2_FP4(dw, 3), a2, yh[4 * (k) + 3]);
    VA4H(d0, 0) VA4H(d1, 1) VA4H(d2, 2) VA4H(d3, 3)
#undef VA4H
}

#define DPP_ADD(v, ctrl) ((v) + __builtin_bit_cast(float, __builtin_amdgcn_update_dpp(0, __builtin_bit_cast(int, (v)), (ctrl), 0xF, 0xF, true)))
#define LOAD_II16(dst, mm) do { const GAS v4u* _ip = (const GAS v4u*)(idx + (size_t)(mm) * 128 + 16 * eg); const v4u _a = _ip[0], _b = _ip[1], _c = _ip[2], _d = _ip[3]; \
    dst[0] = _a.x; dst[1] = _a.y; dst[2] = _a.z; dst[3] = _a.w; dst[4] = _b.x; dst[5] = _b.y; dst[6] = _b.z; dst[7] = _b.w; dst[8] = _c.x; dst[9] = _c.y; dst[10] = _c.z; dst[11] = _c.w; dst[12] = _d.x; dst[13] = _d.y; dst[14] = _d.z; dst[15] = _d.w; } while (0)
typedef int v8i_m __attribute__((ext_vector_type(8)));
#define U_QADD(keep, send, ctrl) ((keep) + __builtin_bit_cast(float, __builtin_amdgcn_update_dpp(0, __builtin_bit_cast(int, (send)), (ctrl), 0xF, 0xF, true)))
__device__ __forceinline__ void u_step(const u8* x4, const int* idx, const u8* tab, float* Ps, int m, int mn, int mnn, int eg, int aoff, int xoff, bool xval, bool b0, bool b1, int poff, int sc1, int scb,
                                       const v4u (&bufC)[16], const v4u& xC, const unsigned (&idxN)[16], v4u (&bufN)[16], v4u& xN, unsigned (&idxNN)[16]) {
#pragma unroll
    for (int t = 0; t < 16; ++t) bufN[t] = gld16(tab + (size_t)idxN[t] * 128 + aoff);
    xN = gld16(x4 + (size_t)mn * 2048 + xoff);
    LOAD_II16(idxNN, mnn);
    __builtin_amdgcn_sched_barrier(0);
    const v8i_m bx = {xval ? (int)xC.x : 0, xval ? (int)xC.y : 0, xval ? (int)xC.z : 0, xval ? (int)xC.w : 0, 0, 0, 0, 0};
    f32x4 acc[16];
#pragma unroll
    for (int t = 0; t < 16; ++t) { const v8i_m a8 = {(int)bufC[t].x, (int)bufC[t].y, (int)bufC[t].z, (int)bufC[t].w, 0, 0, 0, 0};
        acc[t] = __builtin_amdgcn_mfma_scale_f32_16x16x128_f8f6f4(a8, bx, (f32x4){0.f, 0.f, 0.f, 0.f}, 4, 4, 0, sc1, 0, scb); }
    float v[16];
#pragma unroll
    for (int t = 0; t < 16; ++t) { const float lo = b0 ? acc[t].y : acc[t].x, hi = b0 ? acc[t].w : acc[t].z; const float vv = b1 ? hi : lo; v[t] = U_QADD(vv, vv, 0x128); }
    float w[8];
#pragma unroll
    for (int i = 0; i < 8; ++i) { const float send = b0 ? v[i] : v[i + 8], keep = b0 ? v[i + 8] : v[i]; w[i] = U_QADD(keep, send, 0xB1); }
    f32x4 z;
#pragma unroll
    for (int i = 0; i < 4; ++i) { const float send = b1 ? w[i] : w[i + 4], keep = b1 ? w[i + 4] : w[i]; z[i] = U_QADD(keep, send, 0x4E); }
    if (poff >= 0) { const h16x2 zl = {(_Float16)z[0], (_Float16)z[1]}, zh = {(_Float16)z[2], (_Float16)z[3]};
        *(GAS v2u*)((_Float16*)Ps + (size_t)m * 128 + poff) = (v2u){__builtin_bit_cast(unsigned, zl), __builtin_bit_cast(unsigned, zh)}; }
    __builtin_amdgcn_sched_barrier(0);
}
__device__ __forceinline__ void peer_u_pass(const u8* x4, const int* idx, const u8* TUl, float* P, int bx, int G, int wave, int lane_in) {
    const int s = bx & 7, cu = bx >> 3, nW = (G >> 3) * NWAVES;
    const u8* tab = TUl + (size_t)s * NEXP * 128;
    float* Ps = (float*)((_Float16*)P + (size_t)s * M * 128);
    int lane = lane_in; asm volatile("" : "+v"(lane));
    const int n = lane & 15, kg = lane >> 4;
    const int eg = 2 * (n >> 2) + (kg >> 1);
    const int aoff = 16 * (4 * (kg & 1) + (n & 3));
    const int xoff = 128 * s + aoff + ((n & 8) ? 1024 : 0);
    const bool xval = (kg >> 1) == ((n >> 2) & 1);
    const bool b0 = (lane & 1) != 0, b1 = (lane & 2) != 0;
    const int poff = (n < 8) ? 16 * (2 * kg + (n >> 2)) + (b0 ? 8 : 0) + (b1 ? 4 : 0) : -1;
    const int m0 = cu * NWAVES + wave;
    int sc1 = 0x7F7F7F7F, sc8 = (n & 8) ? 0x7C7C7C7C : 0x7F7F7F7F; asm volatile("" : "+v"(sc1), "+v"(sc8));
    unsigned iiX[16], iiY[16]; v4u bufA[16], bufB[16]; v4u xA, xB;
    {   LOAD_II16(iiY, m0);
#pragma unroll
        for (int t = 0; t < 16; ++t) bufA[t] = gld16(tab + (size_t)iiY[t] * 128 + aoff);
        xA = gld16(x4 + (size_t)m0 * 2048 + xoff);
        const int m1 = (m0 + nW < M) ? m0 + nW : m0; LOAD_II16(iiX, m1); }
#define CLAMPM(x) (((x) < M) ? (x) : m0)
    for (int m = m0; m < M; m += 2 * nW) {
        u_step(x4, idx, tab, Ps, m, CLAMPM(m + nW), CLAMPM(m + 2 * nW), eg, aoff, xoff, xval, b0, b1, poff, sc1, sc8, bufA, xA, iiX, bufB, xB, iiY);
        u_step(x4, idx, tab, Ps, m + nW, CLAMPM(m + 2 * nW), CLAMPM(m + 3 * nW), eg, aoff, xoff, xval, b0, b1, poff, sc1, sc8, bufB, xB, iiY, bufA, xA, iiX);
    }
}
__device__ __forceinline__ void peer_act_phase(const float* P, const int* idx, float* gate, const float* SU, const float* SV, int gw, int NGW, int lane) {
    for (int m = gw; m < M; m += NGW) {
#pragma unroll
        for (int h = 0; h < 2; ++h) { const int k = 64 * h + lane;
            float z = 0.f;
#pragma unroll
            for (int sl = 0; sl < 8; ++sl) z += (float)*(const GAS _Float16*)((const _Float16*)P + ((size_t)sl * M + m) * 128 + k);
            const int e = *(const GAS int*)(idx + (size_t)m * 128 + k);
            const float su = *(const GAS float*)(SU + e), sv = *(const GAS float*)(SV + e), gt = *(const GAS float*)(gate + (size_t)m * 128 + k);
            *(GAS float*)(gate + (size_t)m * 128 + k) = gelu_f(z * su) * gt * sv; }
    }
}
#define LOAD_AA16(dst, mm) do { const GAS f32x4* _ap = (const GAS f32x4*)(act + (size_t)(mm) * 128 + 16 * eg); const f32x4 _a = _ap[0], _b = _ap[1], _c = _ap[2], _d = _ap[3]; \
    dst[0] = _a.x; dst[1] = _a.y; dst[2] = _a.z; dst[3] = _a.w; dst[4] = _b.x; dst[5] = _b.y; dst[6] = _b.z; dst[7] = _b.w; dst[8] = _c.x; dst[9] = _c.y; dst[10] = _c.z; dst[11] = _c.w; dst[12] = _d.x; dst[13] = _d.y; dst[14] = _d.z; dst[15] = _d.w; } while (0)
__device__ __forceinline__ void v_step(bf16* hio, const int* idx, const float* act, const u8* tab, const float* stats, const f32x4 lg, const f32x4 lb, int m, int mn, int mnn, int lane, int c, int eg, int coff, bool b0,
                                       const v4u (&bufC)[16], const float (&aaC)[16], const unsigned (&idxN)[16], v4u (&bufN)[16], float (&aaN)[16], unsigned (&idxNN)[16]) {
#pragma unroll
    for (int g = 0; g < 16; ++g) bufN[g] = gld16(tab + (size_t)idxN[g] * 128 + 16 * c);
    LOAD_AA16(aaN, mn);
    LOAD_II16(idxNN, mnn);
    bf16* op = hio + (size_t)m * D + coff;
    const v2u xw = *(const GAS v2u*)op;
    const f32x2 st = *(const GAS f32x2*)(stats + 2 * (size_t)m);
    __builtin_amdgcn_sched_barrier(0);
    h16x2 y2[16];
#pragma unroll
    for (int i = 0; i < 16; ++i) y2[i] = (h16x2){(_Float16)0.f, (_Float16)0.f};
#pragma unroll
    for (int g = 0; g < 16; ++g) { const _Float16 a = (_Float16)aaC[g]; vacc4h(bufC[g], (h16x2){a, a}, y2); }
#pragma unroll
    for (int i = 0; i < 8; ++i) { const h16x2 send = b0 ? y2[i] : y2[i + 8], keep = b0 ? y2[i + 8] : y2[i];
        y2[i] = keep + __builtin_bit_cast(h16x2, __builtin_amdgcn_update_dpp(0, __builtin_bit_cast(int, send), 0x128, 0xF, 0xF, true)); }
#pragma unroll
    for (int i = 0; i < 4; ++i) { const auto sw = __builtin_amdgcn_permlane16_swap(__builtin_bit_cast(unsigned, y2[i]), __builtin_bit_cast(unsigned, y2[i + 4]), false, false);
        const unsigned s0 = sw[0], s1 = sw[1]; y2[i] = __builtin_bit_cast(h16x2, s0) + __builtin_bit_cast(h16x2, s1); }
#pragma unroll
    for (int i = 0; i < 2; ++i) { const auto sw = __builtin_amdgcn_permlane32_swap(__builtin_bit_cast(unsigned, y2[i]), __builtin_bit_cast(unsigned, y2[i + 2]), false, false);
        const unsigned s0 = sw[0], s1 = sw[1]; y2[i] = __builtin_bit_cast(h16x2, s0) + __builtin_bit_cast(h16x2, s1); }
    const float x0 = (bflo(xw.x) - st.x) * st.y * lg.x + lb.x, x1 = (bfhi(xw.x) - st.x) * st.y * lg.y + lb.y, x2 = (bflo(xw.y) - st.x) * st.y * lg.z + lb.z, x3 = (bfhi(xw.y) - st.x) * st.y * lg.w + lb.w;
    v2u o; o.x = pk2(x0 * DN_ALPHA + (float)y2[0].x, x1 * DN_ALPHA + (float)y2[0].y); o.y = pk2(x2 * DN_ALPHA + (float)y2[1].x, x3 * DN_ALPHA + (float)y2[1].y);
    *(GAS v2u*)op = o;
    __builtin_amdgcn_sched_barrier(0);
}
__device__ __forceinline__ void peer_v_pass(bf16* hio, const int* idx, const float* act, const u8* TVl, const float* stats, const float* lng, const float* lnb, int bx, int G, int wave, int lane_in) {
    const int s = bx & 7, cu = bx >> 3, nW = (G >> 3) * NWAVES;
    const u8* tab = TVl + (size_t)s * NEXP * 128;
    int lane = lane_in; asm volatile("" : "+v"(lane));
    const int c = lane & 7, eg = lane >> 3;
    const bool b0 = (lane & 8) != 0, b1 = (lane & 16) != 0, b2 = (lane & 32) != 0;
    const int coff = 256 * s + 32 * c + (b0 ? 16 : 0) + (b1 ? 8 : 0) + (b2 ? 4 : 0);
    const int m0 = cu * NWAVES + wave;
    const f32x4 lg = *(const GAS f32x4*)(lng + coff), lb = *(const GAS f32x4*)(lnb + coff);
    unsigned iiX[16], iiY[16]; v4u bufA[16], bufB[16]; float aaA[16], aaB[16];
    {   LOAD_II16(iiY, m0);
#pragma unroll
        for (int g = 0; g < 16; ++g) bufA[g] = gld16(tab + (size_t)iiY[g] * 128 + 16 * c);
        LOAD_AA16(aaA, m0);
        const int m1 = (m0 + nW < M) ? m0 + nW : m0; LOAD_II16(iiX, m1); }
    for (int m = m0; m < M; m += 2 * nW) {
        v_step(hio, idx, act, tab, stats, lg, lb, m, CLAMPM(m + nW), CLAMPM(m + 2 * nW), lane, c, eg, coff, b0, bufA, aaA, iiX, bufB, aaB, iiY);
        v_step(hio, idx, act, tab, stats, lg, lb, m + nW, CLAMPM(m + 2 * nW), CLAMPM(m + 3 * nW), lane, c, eg, coff, b0, bufB, aaB, iiY, bufA, aaA, iiX);
    }
}

constexpr int N_SLOTS = 11;
struct Args { const float* in[31]; float* out; unsigned char* ws; int slot, layer, pad0, pad1; };

constexpr int TAB_OFF = MISC_OFF + 128;
__device__ __forceinline__ void store_tab(const Args& a, LAS unsigned char* lds) {
    if (threadIdx.x == 0) { LAS unsigned long long* t = (LAS unsigned long long*)(lds + TAB_OFF);
#pragma unroll
        for (int i = 0; i < 31; ++i) t[i] = (unsigned long long)a.in[i];
        t[31] = (unsigned long long)a.out; t[32] = (unsigned long long)a.ws; }
    __syncthreads();
}
struct Tab { unsigned tab;
    __device__ __forceinline__ unsigned long long raw(int k) const { const v2u v = *(const LAS v2u*)(tab + 8 * k);
        return ((unsigned long long)(unsigned)__builtin_amdgcn_readfirstlane((int)v.y) << 32) | (unsigned)__builtin_amdgcn_readfirstlane((int)v.x); }
    __device__ __forceinline__ const float* in(int k) const { return (const float*)raw(k); }
};
#define ARG_IN(k) T_.in(k)

template <int SLOT>
__device__ __forceinline__ void run_slot(LAS unsigned char* lds, int layer, int wave_s) {
    int tid = wave_s * 64 + lane_id(); asm volatile("" : "+v"(tid));
    Tab T_; T_.tab = (unsigned)(unsigned long long)(lds + TAB_OFF); asm volatile("" : "+s"(T_.tab));
    unsigned char* ws = (unsigned char*)T_.raw(32);
    const int lane = tid & 63, wave = __builtin_amdgcn_readfirstlane(tid >> 6);
    const int G = gridDim.x; const int bx = blockIdx.x; const int vcu = (G % 8 == 0) ? (bx % 8) * (G / 8) + bx / 8 : bx;
    const int gw = vcu * NWAVES + wave, NGW = G * NWAVES;
    const int gtid = vcu * (NWAVES * 64) + tid, gthreads = G * NWAVES * 64;
    const int kind = layer % 3, jj = layer / 3;
    float* hout = (float*)T_.raw(31);
    bf16* HB0 = (bf16*)(ws + WS_HB0); bf16* HB1 = (bf16*)(ws + WS_HB1);
    bf16* T1 = (bf16*)(ws + WS_T1); bf16* T2 = (bf16*)(ws + WS_T2); bf16* T3 = (bf16*)(ws + WS_T3);
    int* IDX = (int*)(ws + WS_IDX); float* GATE = (float*)(ws + WS_GATE);
    bf16* TU = (bf16*)(ws + WS_TU); bf16* TV = (bf16*)(ws + WS_TV); bf16* PB = (bf16*)(ws + WS_PB); bf16* SKB = (bf16*)(ws + WS_SK);
    bf16* Sin = (layer & 1) ? HB1 : HB0;
    bf16* Sout = (layer & 1) ? HB0 : HB1;

    if constexpr (SLOT == 0) {
        LAS float* scr = (LAS float*)(lds + wave * 16384); LAS unsigned* scr8 = (LAS unsigned*)(lds + wave * 16384); int woff = 0;
        for (int j = 0; j < 2; ++j) {
            transpose_mat8b(ARG_IN(6) + (size_t)j * D * D, D, D, ws + W_POOL_IN + (size_t)j * D * D, 0, scr8, gw, NGW, lane, woff);
            for (int g = 0; g < 4; ++g) transpose_mat8b(ARG_IN(7) + (size_t)(j * 4 + g) * 512 * 512, 512, 512, ws + W_POOL_GRP + (size_t)j * D * 512, g * 512, scr8, gw, NGW, lane, woff);
            transpose_mat8b(ARG_IN(9) + (size_t)j * D * D, D, D, ws + W_POOL_OUT + (size_t)j * D * D, 0, scr8, gw, NGW, lane, woff);
        }
        transpose_mat8b(ARG_IN(10), D, D, ws + W_SSM_IN, 0, scr8, gw, NGW, lane, woff);
        transpose_mat8b(ARG_IN(19), D, D, ws + W_SSM_GLU, 0, scr8, gw, NGW, lane, woff);
        transpose_mat8b(ARG_IN(20), D, D, ws + W_SSM_OUT, 0, scr8, gw, NGW, lane, woff);
        transpose_mat8b(ARG_IN(21), D, 3 * D, ws + W_ATTN_QKV, 0, scr8, gw, NGW, lane, woff);
        transpose_mat8b(ARG_IN(23), D, D, ws + W_ATTN_OUT, 0, scr8, gw, NGW, lane, woff);
        for (int i = 0; i < DEPTH; ++i) {
            transpose_mat8b(ARG_IN(24) + (size_t)i * D * D, D, D, ws + W_PEER_Q + (size_t)i * D * D, 0, scr8, gw, NGW, lane, woff);
            transpose_mat8b(ARG_IN(29) + (size_t)i * D * D, D, D, ws + W_PLE_GATE + (size_t)i * D * D, 0, scr8, gw, NGW, lane, woff);
            transpose_mat(ARG_IN(28) + (size_t)i * PLE * D, PLE, D, (bf16*)(ws + W_PLE_PROJ) + (size_t)i * PLE * D, 0, scr, gw, NGW, lane, woff);
        }
        cvt_rows_fp4(ARG_IN(26), (u8*)TU, (float*)(ws + WS_SU), DEPTH * NEXP, gw, NGW, lane);
        cvt_rows_fp4(ARG_IN(27), (u8*)TV, (float*)(ws + WS_SV), DEPTH * NEXP, gw, NGW, lane);
        cvt_rows(ARG_IN(1), PB, (size_t)DEPTH * M * PLE, (size_t)gtid, (size_t)gthreads);
        cvt_rows(ARG_IN(25), SKB, (size_t)DEPTH * 2 * 128 * 128, (size_t)gtid, (size_t)gthreads);
        {
            const float* xs = ARG_IN(0); unsigned char* s8 = ws + WS_S8;
            const size_t gs = (size_t)gthreads * 8;
            for (size_t i0 = (size_t)gtid * 8; i0 < (size_t)M * D; i0 += 4 * gs) {
                f32x4 a[4], b[4];
#pragma unroll
                for (int u = 0; u < 4; ++u) { a[u] = *(const GAS f32x4*)(xs + i0 + u * gs); b[u] = *(const GAS f32x4*)(xs + i0 + u * gs + 4); }
#pragma unroll
                for (int u = 0; u < 4; ++u) { const size_t i = i0 + u * gs;
                    v4u o; o.x = pk2(a[u].x, a[u].y); o.y = pk2(a[u].z, a[u].w); o.z = pk2(b[u].x, b[u].y); o.w = pk2(b[u].z, b[u].w);
                    *(GAS v4u*)(HB0 + i) = o;
                    int w0 = 0, w1 = 0;
                    w0 = __builtin_amdgcn_cvt_pk_fp8_f32(a[u].x, a[u].y, w0, false); w0 = __builtin_amdgcn_cvt_pk_fp8_f32(a[u].z, a[u].w, w0, true);
                    w1 = __builtin_amdgcn_cvt_pk_fp8_f32(b[u].x, b[u].y, w1, false); w1 = __builtin_amdgcn_cvt_pk_fp8_f32(b[u].z, b[u].w, w1, true);
                    v2u o8; o8.x = (unsigned)w0; o8.y = (unsigned)w1; *(GAS v2u*)(s8 + i) = o8; } } }
        {
            const float* lam_re = ARG_IN(11); const float* lam_im = ARG_IN(12); const float* log_step = ARG_IN(13); const float* b_re = ARG_IN(14); const float* b_im = ARG_IN(15);
            float* ssmp = (float*)(ws + WS_SSMP);
            for (int i = gtid; i < 128 * 64; i += gthreads) { const int g = i >> 6;
                const float lr = lam_re[i], li = lam_im[i], dt = expf(log_step[g]);
                const float mag = expf(dt * lr), ar = mag * cosf(dt * li), ai = mag * sinf(dt * li);
                const float den = lr * lr + li * li;
                const float kr = ((ar - 1.f) * lr + ai * li) / den, ki = (ai * lr - (ar - 1.f) * li) / den;
                float* o = ssmp + (size_t)i * 34; o[0] = ar; o[1] = ai;
                for (int c = 0; c < 16; ++c) { const float br = b_re[i * 16 + c], bi = b_im[i * 16 + c]; o[2 + c] = kr * br - ki * bi; o[18 + c] = kr * bi + ki * br; } }
        }
    }
    if constexpr (SLOT == 1) {
        pg8::StaticOrder S;
        if (kind == 2) {
            pg8::Gemm g{(const bf16*)(ws + WS_S8), (const bf16*)(ws + W_ATTN_QKV), M, 3 * D, D / 2, D / 2, 0}; S.init(M, 3 * D, G, bx);
            pg8::EpiBf16 E{T1, D, nullptr, D, (size_t)(WS_T2 - WS_T1) / 2, ATTN_QSCALE, nullptr, 1.f / W8S};
            pg8::gemm_phase<pg8::EpiBf16, true>(lds, g, S, E, tid);
        } else {
            const unsigned char* W = (kind == 0) ? ws + W_POOL_IN + (size_t)jj * D * D : ws + W_SSM_IN;
            pg8::Gemm g{(const bf16*)(ws + WS_S8), (const bf16*)W, M, D, D / 2, D / 2, 0}; S.init(M, D, G, bx);
            pg8::EpiBf16 E{T1, D, nullptr, 0, 0, 1.f, nullptr, 1.f / W8S};
            pg8::gemm_phase<pg8::EpiBf16, true>(lds, g, S, E, tid);
        }
    }
    if constexpr (SLOT == 2) {
        if (kind == 0) pool_phase(T1, (u8*)T2, gw, NGW, lane);
        else if (kind == 1) ssm_phase_m(T1, (u8*)T2, (const float*)(ws + WS_SSMP), ARG_IN(16), ARG_IN(17), ARG_IN(18), lds, vcu, G, wave, lane);
        else {
            LAS float* rb = (LAS float*)lds;
            for (int i = tid; i < 16 * 257; i += NWAVES * 64) rb[i] = ARG_IN(22)[i] * LOG2E;
            __syncthreads();
            attn_phase_split(T1, T2, T3, ws + WS_X8, rb, lds + 32768, vcu, G, wave, lane);
            __syncthreads();
        }
    }
    if constexpr (SLOT == 3) {
        pg8::StaticOrder S; S.init(M, D, G, bx);
        if (kind == 0) {
            pg8::Gemm g{(const bf16*)T2, (const bf16*)(ws + W_POOL_GRP + (size_t)jj * D * 512), M, D, 256, D / 2, 2};
            pg8::EpiF8 E{(unsigned char*)T1, D, ARG_IN(8) + (size_t)jj * D, 1.f / W8S};
            pg8::gemm_phase<pg8::EpiF8, true>(lds, g, S, E, tid);
        } else if (kind == 1) {
            pg8::Gemm g{(const bf16*)T2, (const bf16*)(ws + W_SSM_GLU), M, D, D / 2, D / 2, 0};
            pg8::EpiGlu8 E{(const unsigned char*)T2, (unsigned char*)T1, D, 1.f / W8S};
            pg8::gemm_phase<pg8::EpiGlu8, true>(lds, g, S, E, tid);
        }
    }
    if constexpr (SLOT == 4) {
        const unsigned char* W = (kind == 0) ? ws + W_POOL_OUT + (size_t)jj * D * D : (kind == 1) ? ws + W_SSM_OUT : ws + W_ATTN_OUT;
        pg8::Gemm g{(kind == 2) ? (const bf16*)(ws + WS_X8) : (const bf16*)T1, (const bf16*)W, M, D, D / 2, D / 2, 0}; pg8::StaticOrder S; S.init(M, D, G, bx);
        pg8::EpiRes E{Sin, Sin, D, DN_ALPHA, (kind == 2) ? 1.f / (W8S * O8S) : 1.f / W8S};
        pg8::gemm_phase<pg8::EpiRes, true>(lds, g, S, E, tid);
    }
    if constexpr (SLOT == 5) ln_phase<true>(Sin, ARG_IN(2) + (size_t)layer * D, ARG_IN(3) + (size_t)layer * D, gw, NGW, lane, ws + WS_X8, ws + WS_S8, (float*)(ws + WS_STATS));
    if constexpr (SLOT == 6) {
        { pg8::Gemm g{(const bf16*)(ws + WS_S8), (const bf16*)(ws + W_PEER_Q + (size_t)layer * D * D), M, D, D / 2, D / 2, 0}; pg8::StaticOrder S; S.init(M, D, G, bx);
          pg8::EpiBf16 E{T1, D, nullptr, 0, 0, 1.f, nullptr, 1.f / W8S};
          pg8::gemm_phase<pg8::EpiBf16, true>(lds, g, S, E, tid); }
    }
    if constexpr (SLOT == 14) {
        __syncthreads();
        { pg8::Gemm g{PB + (size_t)layer * M * PLE, (const bf16*)(ws + W_PLE_PROJ) + (size_t)layer * PLE * D, M, D, PLE, PLE, 0}; pg8::StaticOrder S; S.init(M, D, G, bx);
          pg8::EpiF8 E{(unsigned char*)T3, D, nullptr, 8.f};
          pg8::gemm_phase<pg8::EpiF8>(lds, g, S, E, tid); }
    }
    if constexpr (SLOT == 7) {
        const bf16* sk = SKB + (size_t)layer * 2 * 128 * 128;
        for (int i = tid; i < 256 * 16; i += NWAVES * 64) { const int rowi = i >> 4, ch = i & 15; *(LAS v4u*)(lds + rowi * 272 + ch * 16) = *(const v4u*)(sk + rowi * 128 + ch * 8); }
        __syncthreads();
        peer_select_phase(T1, lds, IDX, GATE, gw, NGW, lane);
        __syncthreads();
    }
    if constexpr (SLOT == 8) peer_u_pass(ws + WS_X8, IDX, (const u8*)TU + (size_t)layer * NEXP * 1024, (float*)T2, bx, G, wave, lane);
    if constexpr (SLOT == 11) peer_act_phase((const float*)T2, IDX, GATE, (const float*)(ws + WS_SU) + layer * NEXP, (const float*)(ws + WS_SV) + layer * NEXP, gw, NGW, lane);
    if constexpr (SLOT == 12) peer_v_pass(Sin, IDX, GATE, (const u8*)TV + (size_t)layer * NEXP * 1024, (const float*)(ws + WS_STATS), ARG_IN(2) + (size_t)layer * D, ARG_IN(3) + (size_t)layer * D, bx, G, wave, lane);
    if constexpr (SLOT == 13) ln_phase(Sin, ARG_IN(4) + (size_t)layer * D, ARG_IN(5) + (size_t)layer * D, gw, NGW, lane, ws + WS_X8);
    if constexpr (SLOT == 10) {
        pg8::Gemm g{(const bf16*)(ws + WS_X8), (const bf16*)(ws + W_PLE_GATE + (size_t)layer * D * D), M, D, D / 2, D / 2, 0}; pg8::StaticOrder S; S.init(M, D, G, bx);
        pg8::EpiPle E{Sin, (const unsigned char*)T3, Sout, ws + WS_S8, (layer == DEPTH - 1) ? hout : nullptr, ARG_IN(30) + (size_t)layer * D, D, 1.f / W8S};
        pg8::gemm_phase<pg8::EpiPle, true>(lds, g, S, E, tid);
    }
}

template <int SLOT>
__global__ void __launch_bounds__(NWAVES * 64, 2) mk_slot(Args args) {
    extern __shared__ __attribute__((aligned(16))) unsigned char lds_raw[];
    store_tab(args, (LAS unsigned char*)lds_raw);
    run_slot<SLOT>((LAS unsigned char*)lds_raw, args.layer, __builtin_amdgcn_readfirstlane((int)(threadIdx.x >> 6)));
}

#if !MK_PER_PHASE
__global__ void __launch_bounds__(NWAVES * 64, 2) mk_fwd(Args args) {
    extern __shared__ __attribute__((aligned(16))) unsigned char lds_raw[];
    LAS unsigned char* lds = (LAS unsigned char*)lds_raw;
    volatile LAS unsigned* MISC = (volatile LAS unsigned*)(lds + MISC_OFF);
    for (int u = threadIdx.x; u < (LDS_BYTES - LDSCTL_OFF) / 4; u += NWAVES * 64) ((LAS unsigned*)(lds + LDSCTL_OFF))[u] = 0u;
    __syncthreads();
    store_tab(args, lds);
    const XcdBarrier bar = xcd_barrier_post((unsigned*)(args.ws + WS_CTL) + CW_BAR, MISC + 8);
    run_slot<0>(lds, 0, bar.wave); xcd_barrier(bar);
    for (int layer = 0; layer < DEPTH; ++layer) {
        run_slot<1>(lds, layer, bar.wave); xcd_barrier(bar);
        run_slot<2>(lds, layer, bar.wave); xcd_barrier(bar);
        if (layer % 3 != 2) { run_slot<3>(lds, layer, bar.wave); xcd_barrier(bar); }
        run_slot<4>(lds, layer, bar.wave); xcd_barrier(bar);
        run_slot<5>(lds, layer, bar.wave); xcd_barrier(bar);
        run_slot<6>(lds, layer, bar.wave); run_slot<14>(lds, layer, bar.wave); xcd_barrier(bar);
        run_slot<7>(lds, layer, bar.wave); xcd_barrier(bar);
        run_slot<8>(lds, layer, bar.wave); xcd_barrier(bar);
        run_slot<11>(lds, layer, bar.wave); xcd_barrier(bar);
        run_slot<12>(lds, layer, bar.wave); xcd_barrier(bar);
        run_slot<13>(lds, layer, bar.wave); xcd_barrier(bar);
        run_slot<10>(lds, layer, bar.wave); if (layer + 1 < DEPTH) xcd_barrier(bar);
    }
}
#endif

template <int SLOT> static void launch_slot(const Args& a0, int layer, int grid, hipStream_t stream) {
    static bool attr_done = false;
    if (!attr_done) { (void)hipFuncSetAttribute((const void*)mk_slot<SLOT>, hipFuncAttributeMaxDynamicSharedMemorySize, LDS_BYTES); attr_done = true; }
    Args a = a0; a.slot = SLOT; a.layer = layer;
    hipLaunchKernelGGL(mk_slot<SLOT>, dim3(grid), dim3(NWAVES * 64), LDS_BYTES, stream, a);
}

extern "C" void kernel_launch(void* const* d_in, const int* in_sizes, int n_in, void* d_out, int out_size, void* d_ws, size_t ws_size, hipStream_t stream) {
    static int grid = 0;
    if (grid == 0) {
        if (n_in != 31 || out_size != M * D || ws_size < WS_END) { fprintf(stderr, "kernel_launch: unexpected shapes (n_in %d out %d ws %zu)\n", n_in, out_size, ws_size); grid = -1; return; }
        int dev = 0, cus = 0, per_cu = 0;
        if (hipGetDevice(&dev) != hipSuccess || hipDeviceGetAttribute(&cus, hipDeviceAttributeMultiprocessorCount, dev) != hipSuccess) { grid = -1; return; }
#if !MK_PER_PHASE
        if (hipFuncSetAttribute((const void*)mk_fwd, hipFuncAttributeMaxDynamicSharedMemorySize, LDS_BYTES) != hipSuccess) { fprintf(stderr, "kernel_launch: hipFuncSetAttribute failed\n"); grid = -1; return; }
        if (hipOccupancyMaxActiveBlocksPerMultiprocessor(&per_cu, (const void*)mk_fwd, NWAVES * 64, LDS_BYTES) != hipSuccess || per_cu < 1) { fprintf(stderr, "kernel_launch: occupancy query says %d\n", per_cu); }
        (void)hipGetLastError();
#endif
        (void)per_cu;
        grid = cus;
    }
    if (grid < 0) return;
    Args a{};
    for (int i = 0; i < 31; ++i) a.in[i] = (const float*)d_in[i];
    a.out = (float*)d_out; a.ws = (unsigned char*)d_ws;
#if MK_PER_PHASE
    launch_slot<0>(a, 0, grid, stream);
    for (int layer = 0; layer < DEPTH; ++layer) {
        launch_slot<1>(a, layer, grid, stream); launch_slot<2>(a, layer, grid, stream);
        if (layer % 3 != 2) launch_slot<3>(a, layer, grid, stream);
        launch_slot<4>(a, layer, grid, stream); launch_slot<5>(a, layer, grid, stream); launch_slot<6>(a, layer, grid, stream); launch_slot<14>(a, layer, grid, stream); launch_slot<7>(a, layer, grid, stream);
        launch_slot<8>(a, layer, grid, stream); launch_slot<11>(a, layer, grid, stream); launch_slot<12>(a, layer, grid, stream); launch_slot<13>(a, layer, grid, stream); launch_slot<10>(a, layer, grid, stream);
    }
#else
    if (hipMemsetAsync((char*)d_ws + WS_CTL, 0, CTL_ZERO_BYTES, stream) != hipSuccess) return;
    hipLaunchKernelGGL(mk_fwd, dim3(grid), dim3(NWAVES * 64), LDS_BYTES, stream, a);
#endif
}
```

```cpp
#include <hip/hip_runtime.h>
#include <cstdio>
#include <cstdint>

#ifndef MK_PER_PHASE
#define MK_PER_PHASE 0
#endif

namespace pg8 {
#define PG8_LAS __attribute__((address_space(3)))
typedef unsigned short bf16_t;
typedef short bf16x8 __attribute__((ext_vector_type(8)));
typedef float f32x4 __attribute__((ext_vector_type(4)));
typedef unsigned u32x4 __attribute__((ext_vector_type(4)));
constexpr int BM = 256, BK = 64, HALF = 128, HTB = HALF * BK * 2, STAGE_BYTES = 8 * HTB, NXCD = 8, WGM = 8;

__host__ __device__ __forceinline__ int lds_byte(int r, int c) { const int st = (r >> 4) * 2 + (c >> 5), rr = r & 15, cc = c & 31, ob = rr * 64 + cc * 2; return st * 1024 + (ob ^ (((ob >> 9) & 1) << 5)); }
__host__ __device__ __forceinline__ int lds_byte8(int r, int c) { const int st = (r >> 4) * 2 + (c >> 5), rr = r & 15, cc = c & 31, ob = rr * 64 + cc * 2; return st * 1024 + (ob ^ (((ob >> 9) & 1) << 5) ^ (((ob >> 8) & 1) << 4)); }
__host__ __device__ __forceinline__ void stage_rc8(int b, int& R, int& C) { const int st = b / 1024, sb = b % 1024, swz = sb ^ (((sb >> 9) & 1) << 5) ^ (((sb >> 8) & 1) << 4); R = (st >> 1) * 16 + swz / 64; C = (st & 1) * 32 + (swz % 64) / 2; }
__host__ __device__ __forceinline__ void stage_rc(int b, int& R, int& C) { const int st = b / 1024, sb = b % 1024, swz = sb ^ (((sb >> 9) & 1) << 5); R = (st >> 1) * 16 + swz / 64; C = (st & 1) * 32 + (swz % 64) / 2; }
__host__ __device__ __forceinline__ int perm32(int rho) { const int n = rho >> 4, i = rho & 15; return 8 * (i >> 2) + 4 * n + (i & 3); }
__host__ __device__ __forceinline__ int perm32f8(int rho) { return 16 * ((rho >> 2) & 1) + (rho & 3) + 4 * (rho >> 3); }

__device__ __forceinline__ int lane_now() { int l; asm volatile("v_mbcnt_lo_u32_b32 %0, -1, 0\n\tv_mbcnt_hi_u32_b32 %0, -1, %0" : "=v"(l)); return l; }
struct Unit { int pm, pn; };
struct Gemm { const bf16_t* A; const bf16_t* Bt; int M, N, K, lda, agrp; };

struct StaticOrder {
    int nM, nN, nwg, G, c;
    __host__ __device__ void init(int M, int N, int G_, int c_) { nM = M / BM; nN = N / BM; nwg = nM * nN; G = G_; c = c_; }
    __host__ __device__ bool next(int i, Unit& u) const {
        const long L = (long)i * G + c; if (L >= nwg) return false;
        int wgid = (int)L; { const int q = nwg / NXCD, r = nwg % NXCD, xcd = wgid % NXCD, off = wgid / NXCD; wgid = (xcd < r ? xcd * (q + 1) : r * (q + 1) + (xcd - r) * q) + off; }
        const int nig = WGM * nN, gid = wgid / nig, fm = gid * WGM, gsz = (nM - fm) < WGM ? (nM - fm) : WGM;
        u.pm = fm + ((wgid % nig) % gsz); u.pn = (wgid % nig) / gsz; return true;
    }
};

__device__ __forceinline__ unsigned cvt_pk_bf16(float lo, float hi) { unsigned r; asm volatile("v_cvt_pk_bf16_f32 %0, %1, %2" : "=v"(r) : "v"(lo), "v"(hi)); return r; }
__device__ __forceinline__ float bf_lo(unsigned w) { return __builtin_bit_cast(float, w << 16); }
__device__ __forceinline__ float bf_hi(unsigned w) { return __builtin_bit_cast(float, w & 0xffff0000u); }
__device__ __forceinline__ float sigmoid_f(float x) { return __builtin_amdgcn_rcpf(1.f + __builtin_amdgcn_exp2f(-1.4426950408889634f * x)); }
#ifdef DBG_PLE_HALF
__device__ __forceinline__ float sigmoid_p(float x) { return 0.5f; }
#else
__device__ __forceinline__ float sigmoid_p(float x) { return sigmoid_f(x); }
#endif

typedef int v8i_t __attribute__((ext_vector_type(8)));
typedef unsigned u32x2 __attribute__((ext_vector_type(2)));
typedef float f32x16 __attribute__((ext_vector_type(16)));
typedef float f32x2_ __attribute__((ext_vector_type(2)));
__device__ __forceinline__ u32x2 pack8_fp8(const f32x4 v0, const f32x4 v1) {
    int a = 0, b = 0;
    a = __builtin_amdgcn_cvt_pk_fp8_f32(v0[0], v0[1], a, false); a = __builtin_amdgcn_cvt_pk_fp8_f32(v0[2], v0[3], a, true);
    b = __builtin_amdgcn_cvt_pk_fp8_f32(v1[0], v1[1], b, false); b = __builtin_amdgcn_cvt_pk_fp8_f32(v1[2], v1[3], b, true);
    return (u32x2){(unsigned)a, (unsigned)b};
}
__device__ __forceinline__ u32x4 pack8_bf16(const f32x4 v0, const f32x4 v1) { u32x4 w; w.x = cvt_pk_bf16(v0[0], v0[1]); w.y = cvt_pk_bf16(v0[2], v0[3]); w.z = cvt_pk_bf16(v1[0], v1[1]); w.w = cvt_pk_bf16(v1[2], v1[3]); return w; }
struct EpiBf16 {
    bf16_t* O; int ldc; const float* cscale; int split_cols; size_t split_stride; float scale0; bf16_t* VT; float oscale;
    __device__ __forceinline__ void chunk(int row, int col, f32x4 v0, f32x4 v1) const {
        if (cscale) { v0 = v0 * *(const f32x4*)(cscale + col); v1 = v1 * *(const f32x4*)(cscale + col + 4); }
        if (!split_cols) { *(u32x4*)(O + (size_t)row * ldc + col) = pack8_bf16(v0 * oscale, v1 * oscale); return; }
        const int t = col / split_cols, c = col - t * split_cols, hd = c >> 7, d = c & 127, b = row >> 13, sq = row & 8191;
        const float sc = (t == 0) ? oscale * scale0 : oscale;
        const u32x4 w = pack8_bf16(v0 * sc, v1 * sc);
        bf16_t* base = O + (size_t)t * split_stride;
        const size_t bh = (size_t)(b * 16 + hd) * 256 + (sq >> 5);
        if (t < 2) *(u32x4*)(base + ((bh * 8 + (d >> 4)) * 512) + (size_t)((sq & 31) + 32 * ((d >> 3) & 1)) * 8) = w;
        else { const int kk = sq & 31, k16 = kk & 15; bf16_t* p = base + ((((bh * 4 + (d >> 5)) * 2 + (kk >> 4)) * 512) + (size_t)((d & 31) + 32 * ((k16 >> 2) & 1)) * 8) + (k16 & 3) + 4 * (k16 >> 3);
            p[0] = (bf16_t)(w.x & 0xffffu); p[8] = (bf16_t)(w.x >> 16); p[16] = (bf16_t)(w.y & 0xffffu); p[24] = (bf16_t)(w.y >> 16);
            p[32] = (bf16_t)(w.z & 0xffffu); p[40] = (bf16_t)(w.z >> 16); p[48] = (bf16_t)(w.w & 0xffffu); p[56] = (bf16_t)(w.w >> 16); }
    }
};
struct EpiF8 {
    unsigned char* O; int ldc; const float* cscale; float oscale;
    __device__ __forceinline__ void chunk(int row, int col, f32x4 v0, f32x4 v1) const {
        if (cscale) { v0 = v0 * *(const f32x4*)(cscale + col); v1 = v1 * *(const f32x4*)(cscale + col + 4); }
        *(u32x2*)(O + (size_t)row * ldc + col) = pack8_fp8(v0 * oscale, v1 * oscale);
    }
    struct Pre { f32x4 c0, c1; };
    __device__ __forceinline__ Pre pre(int row, int col) const { Pre p; p.c0 = (f32x4){1.f, 1.f, 1.f, 1.f}; p.c1 = p.c0;
        if (cscale) { p.c0 = *(const __attribute__((address_space(1))) f32x4*)(cscale + col); p.c1 = *(const __attribute__((address_space(1))) f32x4*)(cscale + col + 4); } return p; }
    __device__ __forceinline__ void fin(int row, int col, f32x4 v0, f32x4 v1, const Pre& p) const {
        if (cscale) { v0 = v0 * p.c0; v1 = v1 * p.c1; }
        *(__attribute__((address_space(1))) u32x2*)(O + (size_t)row * ldc + col) = pack8_fp8(v0 * oscale, v1 * oscale);
    }
};
#define PG8_GAS __attribute__((address_space(1)))
struct EpiGlu8 {
    const unsigned char* Gin; unsigned char* O; int ld; float oscale;
    typedef u32x2 Pre;
    __device__ __forceinline__ Pre pre(int row, int col) const { return *(const PG8_GAS u32x2*)(Gin + (size_t)row * ld + col); }
    __device__ __forceinline__ void fin(int row, int col, f32x4 a0, f32x4 a1, const Pre g) const {
        const size_t ro = (size_t)row * ld + col; a0 = a0 * oscale; a1 = a1 * oscale;
        const unsigned gx = g.x, gy = g.y;
        const f32x2_ g01 = __builtin_amdgcn_cvt_pk_f32_fp8((int)gx, false), g23 = __builtin_amdgcn_cvt_pk_f32_fp8((int)gx, true), g45 = __builtin_amdgcn_cvt_pk_f32_fp8((int)gy, false), g67 = __builtin_amdgcn_cvt_pk_f32_fp8((int)gy, true);
        const f32x4 o0 = {g01.x * sigmoid_f(a0[0]), g01.y * sigmoid_f(a0[1]), g23.x * sigmoid_f(a0[2]), g23.y * sigmoid_f(a0[3])};
        const f32x4 o1 = {g45.x * sigmoid_f(a1[0]), g45.y * sigmoid_f(a1[1]), g67.x * sigmoid_f(a1[2]), g67.y * sigmoid_f(a1[3])};
        *(PG8_GAS u32x2*)(O + ro) = pack8_fp8(o0, o1);
    }
};
struct EpiRes {
    const bf16_t* hres; bf16_t* out; int ld; float alpha; float mscale;
    typedef u32x4 Pre;
    __device__ __forceinline__ Pre pre(int row, int col) const { return *(const PG8_GAS u32x4*)(hres + (size_t)row * ld + col); }
    __device__ __forceinline__ void fin(int row, int col, f32x4 a0, f32x4 a1, const Pre h) const {
        const size_t ro = (size_t)row * ld + col; a0 = a0 * mscale; a1 = a1 * mscale;
        const f32x4 o0 = {bf_lo(h.x) * alpha + a0[0], bf_hi(h.x) * alpha + a0[1], bf_lo(h.y) * alpha + a0[2], bf_hi(h.y) * alpha + a0[3]};
        const f32x4 o1 = {bf_lo(h.z) * alpha + a1[0], bf_hi(h.z) * alpha + a1[1], bf_lo(h.w) * alpha + a1[2], bf_hi(h.w) * alpha + a1[3]};
        *(PG8_GAS u32x4*)(out + ro) = pack8_bf16(o0, o1);
    }
};
struct EpiPle {
    const bf16_t* hin; const unsigned char* proj; bf16_t* hob; unsigned char* ho8; float* fout; const float* bias; int ld; float oscale;
    struct Pre { u32x2 pj8; u32x4 hh; f32x4 b0, b1; };
    __device__ __forceinline__ Pre pre(int row, int col) const { const size_t ro = (size_t)row * ld + col; Pre p; p.pj8 = *(const PG8_GAS u32x2*)(proj + ro); p.hh = *(const PG8_GAS u32x4*)(hin + ro);
        p.b0 = *(const PG8_GAS f32x4*)(bias + col); p.b1 = *(const PG8_GAS f32x4*)(bias + col + 4); return p; }
    __device__ __forceinline__ void fin(int row, int col, f32x4 a0, f32x4 a1, const Pre& p) const {
        const size_t ro = (size_t)row * ld + col; const u32x2 pj8 = p.pj8; const u32x4 hh = p.hh;
        const unsigned pjx = pj8.x, pjy = pj8.y;
        const f32x2_ q01 = __builtin_amdgcn_cvt_pk_f32_fp8((int)pjx, false), q23 = __builtin_amdgcn_cvt_pk_f32_fp8((int)pjx, true), q45 = __builtin_amdgcn_cvt_pk_f32_fp8((int)pjy, false), q67 = __builtin_amdgcn_cvt_pk_f32_fp8((int)pjy, true);
        const float pjs = 1.f / 8.f;
        const float p0 = q01.x * pjs, p1 = q01.y * pjs, p2 = q23.x * pjs, p3 = q23.y * pjs, p4 = q45.x * pjs, p5 = q45.y * pjs, p6 = q67.x * pjs, p7 = q67.y * pjs;
        a0 = a0 * oscale + p.b0; a1 = a1 * oscale + p.b1;
        f32x4 h0, h1;
        h0[0] = bf_lo(hh.x) + sigmoid_p(a0[0]) * p0; h0[1] = bf_hi(hh.x) + sigmoid_p(a0[1]) * p1; h0[2] = bf_lo(hh.y) + sigmoid_p(a0[2]) * p2; h0[3] = bf_hi(hh.y) + sigmoid_p(a0[3]) * p3;
        h1[0] = bf_lo(hh.z) + sigmoid_p(a1[0]) * p4; h1[1] = bf_hi(hh.z) + sigmoid_p(a1[1]) * p5; h1[2] = bf_lo(hh.w) + sigmoid_p(a1[2]) * p6; h1[3] = bf_hi(hh.w) + sigmoid_p(a1[3]) * p7;
        if (fout != nullptr) { *(PG8_GAS f32x4*)(fout + ro) = h0; *(PG8_GAS f32x4*)(fout + ro + 4) = h1; }
        else { *(PG8_GAS u32x4*)(hob + ro) = pack8_bf16(h0, h1); *(PG8_GAS u32x2*)(ho8 + ro) = pack8_fp8(h0, h1); }
    }
};

template <class E, class = void> struct HasPre { static constexpr bool value = false; };
template <class E> struct HasPre<E, decltype((void)sizeof(typename E::Pre))> { static constexpr bool value = true; };
template <class Epi, bool F8 = false>
__device__ __forceinline__ void gemm_phase(PG8_LAS unsigned char* lds, const Gemm g, const StaticOrder& S, const Epi& E, const int tid) {
    const int wid = __builtin_amdgcn_readfirstlane(tid >> 6), lane = tid & 63, wr = wid >> 2, wc = wid & 3, fr = lane & 15, fq = lane >> 4;
    const int K = g.K, nt = K / BK, lda = g.lda;
    unsigned voffA[2], voffB[2];
#pragma unroll
    for (int i = 0; i < 2; ++i) { int R, C; if (F8) stage_rc8(tid * 16 + i * 8192, R, C); else stage_rc(tid * 16 + i * 8192, R, C); const int Rb = (R & ~31) + (F8 ? perm32f8(R & 31) : perm32(R & 31));
        voffA[i] = (unsigned)(R * lda + C) * 2u; voffB[i] = (unsigned)(Rb * K + C) * 2u; }
    const size_t kstep = (size_t)(BK * 2);
    const size_t hstepA = (size_t)HALF * lda * 2, hstepB = (size_t)HALF * K * 2;
    const size_t tstepA = 2 * hstepA, tstepB = 2 * hstepB;
    const unsigned ldsw = (unsigned)wid * 1024u;
    const int l31 = lane & 31, h32 = lane >> 5;
    const int aoff = F8 ? lds_byte8(wr * 64 + l31, 16 * h32) : lds_byte(wr * 64 + fr, fq * 8);
    const int boff = F8 ? lds_byte8(wc * 32 + l31, 16 * h32) : lds_byte(wc * 32 + fr, fq * 8);
    const int aoffx = aoff ^ 16, boffx = boff ^ 16;
#define PG8_SA(b, h) (((b) * 2 + (h)) * HTB)
#define PG8_SB(b, h) ((4 + (b) * 2 + (h)) * HTB)
#define PG8_STAGE(bufoff, gbase, voff) do { _Pragma("unroll") for (int _i = 0; _i < 2; ++_i) \
        __builtin_amdgcn_global_load_lds((const unsigned*)((const char*)(gbase) + (voff)[_i]), (PG8_LAS unsigned*)(lds + (bufoff) + ldsw + _i * 8192), 16, 0, 0); } while (0)
#define PG8_LD32(dst, off, offx) do { typedef int _v4i __attribute__((ext_vector_type(4))); const _v4i _lo = *(const PG8_LAS _v4i*)(lds + (off)), _hi = *(const PG8_LAS _v4i*)(lds + (offx)); \
        dst = __builtin_shufflevector(_lo, _hi, 0, 1, 2, 3, 4, 5, 6, 7); } while (0)
#define PG8_LDA(dst, b, h) do { if constexpr (F8) { _Pragma("unroll") for (int m2 = 0; m2 < 2; ++m2) _Pragma("unroll") for (int ks = 0; ks < 2; ++ks) PG8_LD32(dst##8[m2][ks], PG8_SA(b, h) + aoff + m2 * 4096 + ks * 1024, PG8_SA(b, h) + aoffx + m2 * 4096 + ks * 1024); } \
        else { _Pragma("unroll") for (int m = 0; m < 4; ++m) _Pragma("unroll") for (int k = 0; k < 2; ++k) dst[m][k] = *(const PG8_LAS bf16x8*)(lds + PG8_SA(b, h) + aoff + m * 2048 + k * 1024); } } while (0)
#define PG8_LDB(dst, b, h) do { if constexpr (F8) { _Pragma("unroll") for (int ks = 0; ks < 2; ++ks) PG8_LD32(dst##8[ks], PG8_SB(b, h) + boff + ks * 1024, PG8_SB(b, h) + boffx + ks * 1024); } \
        else { _Pragma("unroll") for (int n = 0; n < 2; ++n) _Pragma("unroll") for (int k = 0; k < 2; ++k) dst[n][k] = *(const PG8_LAS bf16x8*)(lds + PG8_SB(b, h) + boff + n * 2048 + k * 1024); } } while (0)
#define PG8_MMA(ai, bj, At, Bt) do { __builtin_amdgcn_s_setprio(1); \
        if constexpr (F8) { _Pragma("unroll") for (int m2 = 0; m2 < 2; ++m2) _Pragma("unroll") for (int ks = 0; ks < 2; ++ks) \
            acc32[ai][bj][m2] = __builtin_amdgcn_mfma_scale_f32_32x32x64_f8f6f4(Bt##8[ks], At##8[m2][ks], acc32[ai][bj][m2], 0, 0, 0, 0, 0, 0); } \
        else { _Pragma("unroll") for (int m = 0; m < 4; ++m) _Pragma("unroll") for (int n = 0; n < 2; ++n) _Pragma("unroll") for (int k = 0; k < 2; ++k) \
            acc[ai][bj][m][n] = __builtin_amdgcn_mfma_f32_16x16x32_bf16(Bt[n][k], At[m][k], acc[ai][bj][m][n], 0, 0, 0); } \
        __builtin_amdgcn_s_setprio(0); } while (0)
#define PG8_WAIT_V(n) asm volatile("s_waitcnt vmcnt(" #n ")" ::: "memory")
#define PG8_WAIT_L(n) asm volatile("s_waitcnt lgkmcnt(" #n ")" ::: "memory")
#define PG8_BAR __builtin_amdgcn_s_barrier()
#define PG8_SCHED __builtin_amdgcn_sched_barrier(0)
#define PG8_ACOL(u) ((g.agrp > 0) ? (size_t)((u).pn / g.agrp) * (size_t)K * 2 : (size_t)0)
    Unit cur, nxt; int ui = 0;
    if (!S.next(0, cur)) return;
    f32x4 acc[2][2][4][2];
#pragma unroll
    for (int a = 0; a < 2; ++a)
#pragma unroll
        for (int b = 0; b < 2; ++b)
#pragma unroll
            for (int m = 0; m < 4; ++m)
#pragma unroll
                for (int n = 0; n < 2; ++n) acc[a][b][m][n] = (f32x4){0.f, 0.f, 0.f, 0.f};
    bf16x8 At[4][2], B0[2][2], B1[2][2];
    v8i_t At8[2][2], B08[2], B18[2];
    f32x16 acc32[2][2][2];
#pragma unroll
    for (int a = 0; a < 2; ++a)
#pragma unroll
        for (int b = 0; b < 2; ++b)
#pragma unroll
            for (int m2 = 0; m2 < 2; ++m2)
#pragma unroll
                for (int i = 0; i < 16; ++i) acc32[a][b][m2][i] = 0.f;
    const char* cA = (const char*)g.A + (size_t)cur.pm * tstepA + PG8_ACOL(cur); const char* cB = (const char*)g.Bt + (size_t)cur.pn * tstepB;
    PG8_STAGE(PG8_SB(0, 0), cB, voffB); PG8_STAGE(PG8_SB(0, 1), cB + hstepB, voffB); PG8_STAGE(PG8_SA(0, 0), cA, voffA); PG8_STAGE(PG8_SA(0, 1), cA + hstepA, voffA);
    if (wr == 1) PG8_BAR;
    PG8_WAIT_V(2); PG8_BAR;
    PG8_STAGE(PG8_SB(1, 0), cB + kstep, voffB); PG8_STAGE(PG8_SA(1, 0), cA + kstep, voffA); PG8_STAGE(PG8_SB(1, 1), cB + hstepB + kstep, voffB);
    PG8_WAIT_V(6); PG8_BAR;
    for (;;) {
        const bool has_next = S.next(ui + 1, nxt);
        const char* nA = has_next ? (const char*)g.A + (size_t)nxt.pm * tstepA + PG8_ACOL(nxt) : cA; const char* nB = has_next ? (const char*)g.Bt + (size_t)nxt.pn * tstepB : cB;
        for (int t = 0; t < nt; t += 2) {
            const bool last = (t == nt - 2);
            const char* a1 = cA + (size_t)(t + 1) * kstep;
            const char* a2 = last ? nA : cA + (size_t)(t + 2) * kstep; const char* b2 = last ? nB : cB + (size_t)(t + 2) * kstep;
            const char* a3 = a2 + kstep; const char* b3 = b2 + kstep;
            PG8_LDB(B0, 0, 0); PG8_LDB(B1, 0, 1); PG8_SCHED; PG8_LDA(At, 0, 0); PG8_STAGE(PG8_SA(1, 1), a1 + hstepA, voffA);
            PG8_WAIT_V(8); PG8_WAIT_L(0); PG8_BAR; PG8_MMA(0, 0, At, B0); PG8_MMA(0, 1, At, B1); PG8_BAR; PG8_SCHED;
            PG8_LDA(At, 0, 1); PG8_STAGE(PG8_SB(0, 0), b2, voffB); PG8_STAGE(PG8_SB(0, 1), b2 + hstepB, voffB); PG8_STAGE(PG8_SA(0, 0), a2, voffA);
            PG8_WAIT_V(8); PG8_WAIT_L(0); PG8_BAR; PG8_MMA(1, 0, At, B0); PG8_MMA(1, 1, At, B1); PG8_BAR; PG8_SCHED;
            PG8_LDB(B0, 1, 0); PG8_LDB(B1, 1, 1); PG8_SCHED; PG8_LDA(At, 1, 0); PG8_STAGE(PG8_SA(0, 1), a2 + hstepA, voffA);
            PG8_WAIT_V(8); PG8_WAIT_L(0); PG8_BAR; PG8_MMA(0, 0, At, B0); PG8_MMA(0, 1, At, B1); PG8_BAR; PG8_SCHED;
            PG8_LDA(At, 1, 1); PG8_STAGE(PG8_SB(1, 0), b3, voffB); PG8_STAGE(PG8_SB(1, 1), b3 + hstepB, voffB); PG8_STAGE(PG8_SA(1, 0), a3, voffA);
            PG8_WAIT_V(8); PG8_WAIT_L(0); PG8_BAR; PG8_MMA(1, 0, At, B0); PG8_MMA(1, 1, At, B1); PG8_BAR; PG8_SCHED;
        }
        if (wr == 0) PG8_BAR;
        if constexpr (F8) {
            const int lnE = lane_now(); const int rowF = cur.pm * BM + wr * 64 + (lnE & 31), colF = cur.pn * BM + wc * 32 + 16 * (lnE >> 5);
            if constexpr (HasPre<Epi>::value) {
#pragma unroll
                for (int a = 0; a < 2; ++a)
#pragma unroll
                    for (int m2 = 0; m2 < 2; ++m2) { const int rowG = rowF + a * HALF + 32 * m2;
                        typename Epi::Pre pq[4];
#pragma unroll
                        for (int b = 0; b < 2; ++b) { pq[2 * b] = E.pre(rowG, colF + b * HALF); pq[2 * b + 1] = E.pre(rowG, colF + b * HALF + 8); }
                        __builtin_amdgcn_sched_barrier(0);
#pragma unroll
                        for (int b = 0; b < 2; ++b) { const f32x16 v = acc32[a][b][m2];
                            E.fin(rowG, colF + b * HALF, (f32x4){v[0], v[1], v[2], v[3]}, (f32x4){v[4], v[5], v[6], v[7]}, pq[2 * b]);
                            E.fin(rowG, colF + b * HALF + 8, (f32x4){v[8], v[9], v[10], v[11]}, (f32x4){v[12], v[13], v[14], v[15]}, pq[2 * b + 1]);
#pragma unroll
                            for (int i = 0; i < 16; ++i) acc32[a][b][m2][i] = 0.f; }
                        __builtin_amdgcn_sched_barrier(0); }
            } else {
#pragma unroll
            for (int a = 0; a < 2; ++a)
#pragma unroll
                for (int m2 = 0; m2 < 2; ++m2)
#pragma unroll
                    for (int b = 0; b < 2; ++b) { const f32x16 v = acc32[a][b][m2];
                        E.chunk(rowF + a * HALF + 32 * m2, colF + b * HALF, (f32x4){v[0], v[1], v[2], v[3]}, (f32x4){v[4], v[5], v[6], v[7]});
                        E.chunk(rowF + a * HALF + 32 * m2, colF + b * HALF + 8, (f32x4){v[8], v[9], v[10], v[11]}, (f32x4){v[12], v[13], v[14], v[15]});
#pragma unroll
                        for (int i = 0; i < 16; ++i) acc32[a][b][m2][i] = 0.f; }
            }
        } else {
            const int lnE = lane_now(); const int row0 = cur.pm * BM + wr * 64 + (lnE & 15), col0 = cur.pn * BM + wc * 32 + 8 * (lnE >> 4);
#pragma unroll
            for (int a = 0; a < 2; ++a)
#pragma unroll
                for (int m = 0; m < 4; ++m)
#pragma unroll
                    for (int b = 0; b < 2; ++b) E.chunk(row0 + a * HALF + m * 16, col0 + b * HALF, acc[a][b][m][0], acc[a][b][m][1]);
        }
        if (!has_next) break;
#pragma unroll
        for (int a = 0; a < 2; ++a)
#pragma unroll
            for (int b = 0; b < 2; ++b)
#pragma unroll
                for (int m = 0; m < 4; ++m)
#pragma unroll
                    for (int n = 0; n < 2; ++n) acc[a][b][m][n] = (f32x4){0.f, 0.f, 0.f, 0.f};
        cur = nxt; cA = nA; cB = nB; ++ui;
        if (wr == 1) PG8_BAR;
    }
    PG8_WAIT_V(0);
    PG8_BAR;
#undef PG8_SA
#undef PG8_SB
#undef PG8_STAGE
#undef PG8_LDA
#undef PG8_LD32
#undef PG8_LDB
#undef PG8_MMA
#undef PG8_WAIT_V
#undef PG8_WAIT_L
#undef PG8_BAR
#undef PG8_SCHED
#undef PG8_ACOL
}
}

constexpr int NWAVES = 8;
constexpr int D = 2048, BATCH = 4, SEQ = 8192, DEPTH = 4, M = BATCH * SEQ;
constexpr int NEXP = 16384, PLE = 256;
constexpr float LN_EPS = 1e-5f;
constexpr float DN_ALPHA = 1.681792830507429f;
constexpr float LOG2E = 1.4426950408889634f;
constexpr float ATTN_QSCALE = 0.08838834764831845f * LOG2E;
constexpr float W8S = 64.f, O8S = 16.f;

constexpr size_t MiB = 1u << 20;
constexpr size_t WS_CTL = 0, CTL_ZERO_BYTES = 1 * MiB;
constexpr size_t WS_STATS = WS_CTL + 512 * 1024;
constexpr size_t WS_W = 1 * MiB;
constexpr size_t W_POOL_IN = WS_W, W_POOL_GRP = W_POOL_IN + 16 * MiB, W_POOL_OUT = W_POOL_GRP + 4 * MiB;
constexpr size_t W_SSM_IN = W_POOL_OUT + 16 * MiB, W_SSM_GLU = W_SSM_IN + 8 * MiB, W_SSM_OUT = W_SSM_GLU + 8 * MiB;
constexpr size_t W_ATTN_QKV = W_SSM_OUT + 8 * MiB, W_ATTN_OUT = W_ATTN_QKV + 24 * MiB;
constexpr size_t W_PEER_Q = W_ATTN_OUT + 8 * MiB, W_PLE_GATE = W_PEER_Q + 32 * MiB, W_PLE_PROJ = W_PLE_GATE + 32 * MiB;
constexpr size_t WS_SK = W_PLE_PROJ + 4 * MiB;
constexpr size_t WS_TU = WS_SK + 1 * MiB;
constexpr size_t WS_TV = WS_TU + 256 * MiB;
constexpr size_t WS_PB = WS_TV + 256 * MiB;
constexpr size_t WS_HB0 = WS_PB + 64 * MiB, WS_HB1 = WS_HB0 + 128 * MiB;
constexpr size_t WS_T1 = WS_HB1 + 128 * MiB, WS_T2 = WS_T1 + 128 * MiB, WS_T3 = WS_T2 + 128 * MiB;
constexpr size_t WS_IDX = WS_T3 + 128 * MiB, WS_GATE = WS_IDX + 16 * MiB;
constexpr size_t WS_SSMP = WS_GATE + 16 * MiB;
constexpr size_t WS_SU = WS_SSMP + 2 * MiB, WS_SV = WS_SU + 1 * MiB;
constexpr size_t WS_S8 = WS_SV + 1 * MiB;
constexpr size_t WS_X8 = WS_S8 + 64 * MiB;
constexpr size_t WS_END = WS_X8 + 64 * MiB;
static_assert(WS_END <= 2048 * MiB, "d_ws map");
constexpr int CW_BAR = 4096;

constexpr int RING_BYTES = 131072;
constexpr int LDSCTL_OFF = RING_BYTES, MISC_OFF = LDSCTL_OFF + 320;
constexpr int LDS_BYTES = 147456;

#define LAS __attribute__((address_space(3)))
typedef unsigned short bf16;
typedef unsigned v4u __attribute__((ext_vector_type(4)));
typedef unsigned v2u __attribute__((ext_vector_type(2)));
typedef float f32x4 __attribute__((ext_vector_type(4)));
typedef float f32x16 __attribute__((ext_vector_type(16)));
typedef short bf16x8 __attribute__((ext_vector_type(8)));
typedef __bf16 bf16x2_t __attribute__((ext_vector_type(2)));
#define LDS_WAIT() asm volatile("s_waitcnt lgkmcnt(0)" ::: "memory")
#define VM_WAIT() asm volatile("s_waitcnt vmcnt(0)" ::: "memory")
__device__ __forceinline__ unsigned f2bf(float f) { unsigned u = __builtin_bit_cast(unsigned, f); return (u + 0x7fffu + ((u >> 16) & 1u)) >> 16; }
__device__ __forceinline__ unsigned pk2(float lo, float hi) { return f2bf(lo) | (f2bf(hi) << 16); }
__device__ __forceinline__ float bflo(unsigned w) { return __builtin_bit_cast(float, w << 16); }
__device__ __forceinline__ float bfhi(unsigned w) { return __builtin_bit_cast(float, w & 0xffff0000u); }
__device__ __forceinline__ float dot2bf(unsigned a, unsigned b, float c) { return __builtin_amdgcn_fdot2_f32_bf16(__builtin_bit_cast(bf16x2_t, a), __builtin_bit_cast(bf16x2_t, b), c, false); }
__device__ __forceinline__ float gelu_f(float v) {
    const float av = __builtin_fabsf(v), d = av * 0.2316418882f + 1.0f, t = __builtin_amdgcn_rcpf(d);
    float q = t * 0.5307027145f + (-0.7265760135f); q = q * t + 0.7107068705f; q = q * t + (-0.142248368f); q = q * t + 0.127414796f; q = q * t;
    const float e = __builtin_amdgcn_exp2f((v * v) * (-0.72134752044f));
    const float m = v * (q * e); return v < 0.f ? m : v - m;
}
#define WDPP(v, ctrl) __builtin_bit_cast(float, __builtin_amdgcn_update_dpp(0, __builtin_bit_cast(int, (v)), (ctrl), 0xF, 0xF, true))
#define WRL(v, l) __builtin_bit_cast(float, __builtin_amdgcn_readlane(__builtin_bit_cast(int, (v)), (l)))
__device__ __forceinline__ float wave_sum(float v) {
    v += WDPP(v, 0xB1); v += WDPP(v, 0x4E); v += WDPP(v, 0x141); v += WDPP(v, 0x140);
    return (WRL(v, 0) + WRL(v, 16)) + (WRL(v, 32) + WRL(v, 48));
}
__device__ __forceinline__ float shfl_xor_lane(float v, int m, int lane) { return __builtin_bit_cast(float, __builtin_amdgcn_ds_bpermute((lane ^ m) << 2, __builtin_bit_cast(int, v))); }
__device__ __forceinline__ int shfl_idx_lane(int v, int src) { return __builtin_amdgcn_ds_bpermute(src << 2, v); }
#define SHFL_XOR(v, m) shfl_xor_lane((v), (m), lane)

#define XB_TMO      128
#define XB_XCNT(j)  (256  + 64 * (j))
#define XB_XSUB(j)  (1280 + 64 * (j))
#define XB_XGEN(j)  (2304 + 64 * (j))
#define XB_TOP      3328
#define XB_TOPGEN   3392
#define XCD_BAR_WORDS 3456
#define XB_SPIN_CAP (1u << 23)

__device__ __forceinline__ unsigned xb_ld(unsigned* p)              { return __hip_atomic_load(p, __ATOMIC_RELAXED, __HIP_MEMORY_SCOPE_AGENT); }
__device__ __forceinline__ unsigned xb_add(unsigned* p, unsigned v) { return __hip_atomic_fetch_add(p, v, __ATOMIC_RELAXED, __HIP_MEMORY_SCOPE_AGENT); }
__device__ __forceinline__ unsigned xb_xcc_id() { return (unsigned)__builtin_amdgcn_s_getreg((3 << 11) | 20) & 0xFu; }
#define XB_SPIN(cond, bar) do { unsigned _sp = 0; while (cond) { __builtin_amdgcn_s_sleep(1); \
    if ((++_sp & 255u) == 0u) { if (xb_ld(&(bar)[XB_TMO])) break; if (_sp > XB_SPIN_CAP) { atomicAdd(&(bar)[XB_TMO], 1u); break; } } } } while (0)

struct XcdBarrier { unsigned* bar; unsigned x; volatile LAS unsigned* st; int wave; };
__device__ __forceinline__ int lane_id() { int l; asm volatile("v_mbcnt_lo_u32_b32 %0, -1, 0\n\tv_mbcnt_hi_u32_b32 %0, -1, %0" : "=v"(l)); return l; }

__device__ __forceinline__ XcdBarrier xcd_barrier_post(unsigned* bar, volatile LAS unsigned* st) {
    XcdBarrier b; b.bar = bar; b.x = xb_xcc_id(); b.st = st; b.wave = __builtin_amdgcn_readfirstlane((int)(threadIdx.x >> 6));
    if (threadIdx.x == 0) (void)xb_add(&bar[XB_XCNT(b.x)], 1u);
    return b;
}
__device__ __forceinline__ void xcd_barrier_complete(unsigned* bar, unsigned x, unsigned& nloc, unsigned& nx) {
    const unsigned G = gridDim.x * gridDim.y * gridDim.z;
    unsigned sum, cnt, mine, sp = 0u;
    for (;;) {
        sum = 0u; cnt = 0u; mine = 0u;
#pragma unroll
        for (unsigned j = 0; j < 16; ++j) { const unsigned c = xb_ld(&bar[XB_XCNT(j)]); sum += c; cnt += (c > 0u) ? 1u : 0u; mine = (j == x) ? c : mine; }
        if (sum == G) break;
        __builtin_amdgcn_s_sleep(1);
        if ((++sp & 255u) == 0u) { if (xb_ld(&bar[XB_TMO])) break; if (sp > XB_SPIN_CAP) { atomicAdd(&bar[XB_TMO], 1u); break; } }
    }
    nloc = mine > 0u ? mine : 1u; nx = cnt > 0u ? cnt : 1u;
}
__device__ __forceinline__ void xcd_barrier(const XcdBarrier& b_in) {
    asm volatile("s_waitcnt vmcnt(0)" ::: "memory");
    __syncthreads();
    if (b_in.wave == 0 && lane_id() == 0) {
        XcdBarrier b = b_in; asm volatile("" : "+s"(b.x)); asm volatile("" : "+s"(b.bar));
        unsigned* bar = b.bar;
        __builtin_amdgcn_s_waitcnt(0);
        unsigned nloc = b.st[0], nx = b.st[1];
        if (nloc == 0u) { xcd_barrier_complete(bar, b.x, nloc, nx); b.st[0] = nloc; b.st[1] = nx; }
        const unsigned old = xb_add(&bar[XB_XSUB(b.x)], 1u);
        const unsigned gen = old / nloc;
        if (old + 1u == (gen + 1u) * nloc) {
            __builtin_amdgcn_fence(__ATOMIC_RELEASE, "agent");
            asm volatile("s_waitcnt vmcnt(0)" ::: "memory");
            const unsigned og = xb_add(&bar[XB_TOP], 1u);
            const unsigned tg = og / nx;
            if (og + 1u == (tg + 1u) * nx) xb_add(&bar[XB_TOPGEN], 1u);
            else XB_SPIN(xb_ld(&bar[XB_TOPGEN]) == tg, bar);
            __builtin_amdgcn_fence(__ATOMIC_ACQUIRE, "agent");
            xb_add(&bar[XB_XGEN(b.x)], 1u);
            asm volatile("s_waitcnt vmcnt(0)" ::: "memory");
        } else {
            XB_SPIN(xb_ld(&bar[XB_XGEN(b.x)]) == gen, bar);
            __builtin_amdgcn_fence(__ATOMIC_ACQUIRE, "agent");
            asm volatile("s_waitcnt vmcnt(0)" ::: "memory");
        }
    }
    __syncthreads();
}

__device__ __forceinline__ void transpose_item(const float* W, int K, int N, bf16* WT, int row_off, LAS float* scr, int item, int lane) {
    const int nblk = N / 32, kb = item / nblk, nb = item % nblk, k0 = 64 * kb, n0 = 32 * nb;
    const __attribute__((address_space(1))) float* Wg = (const __attribute__((address_space(1))) float*)W + (size_t)(k0 + (lane >> 5)) * N + n0 + (lane & 31);
    float v[32];
#pragma unroll
    for (int i = 0; i < 32; ++i) v[i] = Wg[(size_t)(2 * i) * N];
#pragma unroll
    for (int i = 0; i < 32; ++i) scr[(2 * i + (lane >> 5)) * 33 + (lane & 31)] = v[i];
    LDS_WAIT(); asm volatile("" ::: "memory");
    const int c = lane & 7;
#pragma unroll
    for (int j = 0; j < 4; ++j) { const int n = (lane >> 3) + 8 * j; const LAS float* s = scr + (8 * c) * 33 + n;
        v4u o; o.x = pk2(s[0 * 33], s[1 * 33]); o.y = pk2(s[2 * 33], s[3 * 33]); o.z = pk2(s[4 * 33], s[5 * 33]); o.w = pk2(s[6 * 33], s[7 * 33]);
        *(v4u*)(WT + (size_t)(row_off + n0 + n) * K + k0 + 8 * c) = o; }
    LDS_WAIT(); asm volatile("" ::: "memory");
}
__device__ __forceinline__ void transpose_item8(const float* W, int K, int N, unsigned char* WT, int row_off, LAS float* scr, int item, int lane) {
    const int nblk = N / 32, kb = item / nblk, nb = item % nblk, k0 = 64 * kb, n0 = 32 * nb;
#pragma unroll 8
    for (int i = 0; i < 32; ++i) { const int kk = 2 * i + (lane >> 5); scr[kk * 33 + (lane & 31)] = W[(size_t)(k0 + kk) * N + n0 + (lane & 31)]; }
    LDS_WAIT(); asm volatile("" ::: "memory");
    const int c = lane & 7;
#pragma unroll
    for (int j = 0; j < 4; ++j) { const int n = (lane >> 3) + 8 * j; const LAS float* sp = scr + (8 * c) * 33 + n;
        int a = 0, b = 0;
        a = __builtin_amdgcn_cvt_pk_fp8_f32(sp[0 * 33] * W8S, sp[1 * 33] * W8S, a, false); a = __builtin_amdgcn_cvt_pk_fp8_f32(sp[2 * 33] * W8S, sp[3 * 33] * W8S, a, true);
        b = __builtin_amdgcn_cvt_pk_fp8_f32(sp[4 * 33] * W8S, sp[5 * 33] * W8S, b, false); b = __builtin_amdgcn_cvt_pk_fp8_f32(sp[6 * 33] * W8S, sp[7 * 33] * W8S, b, true);
        v2u o; o.x = (unsigned)a; o.y = (unsigned)b;
        *(v2u*)(WT + (size_t)(row_off + n0 + n) * K + k0 + 8 * c) = o; }
    LDS_WAIT(); asm volatile("" ::: "memory");
}
__device__ __forceinline__ void transpose_item8b(const float* W, int K, int N, unsigned char* WT, int row_off, LAS unsigned* scr, int item, int lane) {
    const int nblk = N / 64, kb = item / nblk, nb = item % nblk, k0 = 128 * kb, n0 = 64 * nb;
    const int r4 = lane >> 4, l15 = lane & 15;
    f32x4 v[32];
#pragma unroll
    for (int i = 0; i < 32; ++i) v[i] = *(const __attribute__((address_space(1))) f32x4*)(W + (size_t)(k0 + 32 * r4 + i) * N + n0 + 4 * l15);
#pragma unroll
    for (int i4 = 0; i4 < 8; ++i4) {
        const f32x4 q0 = v[4 * i4] * W8S, q1 = v[4 * i4 + 1] * W8S, q2 = v[4 * i4 + 2] * W8S, q3 = v[4 * i4 + 3] * W8S;
        int a0 = 0, a1 = 0, a2 = 0, a3 = 0;
        a0 = __builtin_amdgcn_cvt_pk_fp8_f32(q0.x, q1.x, a0, false); a0 = __builtin_amdgcn_cvt_pk_fp8_f32(q2.x, q3.x, a0, true);
        a1 = __builtin_amdgcn_cvt_pk_fp8_f32(q0.y, q1.y, a1, false); a1 = __builtin_amdgcn_cvt_pk_fp8_f32(q2.y, q3.y, a1, true);
        a2 = __builtin_amdgcn_cvt_pk_fp8_f32(q0.z, q1.z, a2, false); a2 = __builtin_amdgcn_cvt_pk_fp8_f32(q2.z, q3.z, a2, true);
        a3 = __builtin_amdgcn_cvt_pk_fp8_f32(q0.w, q1.w, a3, false); a3 = __builtin_amdgcn_cvt_pk_fp8_f32(q2.w, q3.w, a3, true);
        LAS unsigned* rowp = scr + (8 * r4 + i4) * 64;
        rowp[(4 * l15 + 0 + r4) & 63] = (unsigned)a0; rowp[(4 * l15 + 1 + r4) & 63] = (unsigned)a1; rowp[(4 * l15 + 2 + r4) & 63] = (unsigned)a2; rowp[(4 * l15 + 3 + r4) & 63] = (unsigned)a3; }
    LDS_WAIT(); asm volatile("" ::: "memory");
    unsigned char* orow = WT + (size_t)(row_off + n0 + lane) * K + k0;
#pragma unroll
    for (int q = 0; q < 8; ++q) { v4u o;
        o.x = scr[(4 * q + 0) * 64 + ((lane + (q >> 1)) & 63)]; o.y = scr[(4 * q + 1) * 64 + ((lane + (q >> 1)) & 63)]; o.z = scr[(4 * q + 2) * 64 + ((lane + (q >> 1)) & 63)]; o.w = scr[(4 * q + 3) * 64 + ((lane + (q >> 1)) & 63)];
        *(__attribute__((address_space(1))) v4u*)(orow + 16 * q) = o; }
    LDS_WAIT(); asm volatile("" ::: "memory");
}
__device__ __forceinline__ void transpose_mat8b(const float* W, int K, int N, unsigned char* WT, int row_off, LAS unsigned* scr, int gw, int NGW, int lane, int& woff) {
    const int nit = (K / 128) * (N / 64);
    int sgw = gw - woff % NGW; if (sgw < 0) sgw += NGW;
    for (int it = sgw; it < nit; it += NGW) transpose_item8b(W, K, N, WT, row_off, scr, it, lane);
    woff += nit;
}
__device__ __forceinline__ void transpose_mat8(const float* W, int K, int N, unsigned char* WT, int row_off, LAS float* scr, int gw, int NGW, int lane) {
    const int nit = (K / 64) * (N / 32);
    for (int it = gw; it < nit; it += NGW) transpose_item8(W, K, N, WT, row_off, scr, it, lane);
}
__device__ __forceinline__ void transpose_mat(const float* W, int K, int N, bf16* WT, int row_off, LAS float* scr, int gw, int NGW, int lane, int& woff) {
    const int nit = (K / 64) * (N / 32);
    int sgw = gw - woff % NGW; if (sgw < 0) sgw += NGW;
    for (int it = sgw; it < nit; it += NGW) transpose_item(W, K, N, WT, row_off, scr, it, lane);
    woff += nit;
}
__device__ __forceinline__ void cvt_rows(const float* src, bf16* dst, size_t n, size_t gtid, size_t gthreads) {
    size_t i = gtid * 8;
    for (; i + 3 * gthreads * 8 < n; i += gthreads * 32) {
        f32x4 a[4], b[4];
#pragma unroll
        for (int u = 0; u < 4; ++u) { a[u] = *(const __attribute__((address_space(1))) f32x4*)(src + i + u * gthreads * 8); b[u] = *(const __attribute__((address_space(1))) f32x4*)(src + i + u * gthreads * 8 + 4); }
#pragma unroll
        for (int u = 0; u < 4; ++u) { v4u o; o.x = pk2(a[u].x, a[u].y); o.y = pk2(a[u].z, a[u].w); o.z = pk2(b[u].x, b[u].y); o.w = pk2(b[u].z, b[u].w);
            *(__attribute__((address_space(1))) v4u*)(dst + i + u * gthreads * 8) = o; }
    }
    for (; i < n; i += gthreads * 8) {
        const f32x4 a = *(const f32x4*)(src + i), b = *(const f32x4*)(src + i + 4);
        v4u o; o.x = pk2(a.x, a.y); o.y = pk2(a.z, a.w); o.z = pk2(b.x, b.y); o.w = pk2(b.z, b.w);
        *(v4u*)(dst + i) = o;
    }
}


#define GAS __attribute__((address_space(1)))
typedef unsigned char u8;
typedef float f32x2 __attribute__((ext_vector_type(2)));
constexpr float TU_SCALE = 64.f, TV_SCALE = 4.f;
__device__ __forceinline__ v4u gld16(const void* p) { return *(const GAS v4u*)p; }
__device__ __forceinline__ void cvt_rows_fp8(const float* src, u8* dst, size_t n, float scale, size_t gtid, size_t gthreads) {
    for (size_t i = gtid * 16; i < n; i += gthreads * 16) {
        const GAS f32x4* p = (const GAS f32x4*)(src + i);
        const f32x4 a = p[0] * scale, b = p[1] * scale, c = p[2] * scale, d = p[3] * scale;
        int w0 = 0, w1 = 0, w2 = 0, w3 = 0;
        w0 = __builtin_amdgcn_cvt_pk_fp8_f32(a.x, a.y, w0, false); w0 = __builtin_amdgcn_cvt_pk_fp8_f32(a.z, a.w, w0, true);
        w1 = __builtin_amdgcn_cvt_pk_fp8_f32(b.x, b.y, w1, false); w1 = __builtin_amdgcn_cvt_pk_fp8_f32(b.z, b.w, w1, true);
        w2 = __builtin_amdgcn_cvt_pk_fp8_f32(c.x, c.y, w2, false); w2 = __builtin_amdgcn_cvt_pk_fp8_f32(c.z, c.w, w2, true);
        w3 = __builtin_amdgcn_cvt_pk_fp8_f32(d.x, d.y, w3, false); w3 = __builtin_amdgcn_cvt_pk_fp8_f32(d.z, d.w, w3, true);
        v4u o; o.x = (unsigned)w0; o.y = (unsigned)w1; o.z = (unsigned)w2; o.w = (unsigned)w3;
        *(GAS v4u*)(dst + i) = o;
    }
}

template <bool X4 = false>
__device__ __forceinline__ void ln_phase(bf16* S, const float* g, const float* b, int gw, int NGW, int lane, unsigned char* f8 = nullptr, unsigned char* f8b = nullptr, float* stats = nullptr) {
    f32x4 G0[4], G1[4], B0[4], B1[4];
#pragma unroll
    for (int j = 0; j < 4; ++j) { const float* gp = g + 512 * j + 8 * lane; const float* bp = b + 512 * j + 8 * lane;
        G0[j] = *(const GAS f32x4*)gp; G1[j] = *(const GAS f32x4*)(gp + 4); B0[j] = *(const GAS f32x4*)bp; B1[j] = *(const GAS f32x4*)(bp + 4); }
    v4u nx[4];
#pragma unroll
    for (int j = 0; j < 4; ++j) nx[j] = *(const GAS v4u*)(S + (size_t)((gw < M) ? gw : 0) * D + 8 * lane + 512 * j);
    for (int m = gw; m < M; m += NGW) {
        bf16* row = S + (size_t)m * D + 8 * lane;
        float v[32]; float s = 0.f;
        const int mn = (m + NGW < M) ? m + NGW : m;
#pragma unroll
        for (int j = 0; j < 4; ++j) { const v4u w = nx[j];
            v[8 * j + 0] = bflo(w.x); v[8 * j + 1] = bfhi(w.x); v[8 * j + 2] = bflo(w.y); v[8 * j + 3] = bfhi(w.y); v[8 * j + 4] = bflo(w.z); v[8 * j + 5] = bfhi(w.z); v[8 * j + 6] = bflo(w.w); v[8 * j + 7] = bfhi(w.w); }
#pragma unroll
        for (int j = 0; j < 4; ++j) nx[j] = *(const GAS v4u*)(S + (size_t)mn * D + 8 * lane + 512 * j);
#pragma unroll
        for (int i = 0; i < 32; ++i) s += v[i];
        const float mean = wave_sum(s) * (1.f / D); float s2 = 0.f;
#pragma unroll
        for (int i = 0; i < 32; ++i) { v[i] -= mean; s2 += v[i] * v[i]; }
        const float rstd = 1.f / sqrtf(wave_sum(s2) * (1.f / D) + LN_EPS);
        if constexpr (X4) { if (lane == 0) *(GAS f32x2*)(stats + 2 * (size_t)m) = (f32x2){mean, rstd}; }
#pragma unroll
        for (int j = 0; j < 4; ++j) { const f32x4 g0 = G0[j], g1 = G1[j], b0 = B0[j], b1 = B1[j];
            v4u w; w.x = pk2(v[8 * j + 0] * rstd * g0.x + b0.x, v[8 * j + 1] * rstd * g0.y + b0.y); w.y = pk2(v[8 * j + 2] * rstd * g0.z + b0.z, v[8 * j + 3] * rstd * g0.w + b0.w);
            w.z = pk2(v[8 * j + 4] * rstd * g1.x + b1.x, v[8 * j + 5] * rstd * g1.y + b1.y); w.w = pk2(v[8 * j + 6] * rstd * g1.z + b1.z, v[8 * j + 7] * rstd * g1.w + b1.w);
            if constexpr (!X4) *(GAS v4u*)(row + 512 * j) = w;
            if constexpr (X4) {
                const float y0 = v[8 * j + 0] * rstd * g0.x + b0.x, y1 = v[8 * j + 1] * rstd * g0.y + b0.y, y2 = v[8 * j + 2] * rstd * g0.z + b0.z, y3 = v[8 * j + 3] * rstd * g0.w + b0.w;
                const float y4 = v[8 * j + 4] * rstd * g1.x + b1.x, y5 = v[8 * j + 5] * rstd * g1.y + b1.y, y6 = v[8 * j + 6] * rstd * g1.z + b1.z, y7 = v[8 * j + 7] * rstd * g1.w + b1.w;
                unsigned wh = 0u; wh = __builtin_amdgcn_cvt_scalef32_pk_fp4_f32(wh, y0, y1, 1.0f, 0); wh = __builtin_amdgcn_cvt_scalef32_pk_fp4_f32(wh, y2, y3, 1.0f, 1);
                wh = __builtin_amdgcn_cvt_scalef32_pk_fp4_f32(wh, y4, y5, 1.0f, 2); wh = __builtin_amdgcn_cvt_scalef32_pk_fp4_f32(wh, y6, y7, 1.0f, 3);
                const f32x2 h01 = __builtin_amdgcn_cvt_scalef32_pk_f32_fp4(wh, 1.0f, 0), h23 = __builtin_amdgcn_cvt_scalef32_pk_f32_fp4(wh, 1.0f, 1), h45 = __builtin_amdgcn_cvt_scalef32_pk_f32_fp4(wh, 1.0f, 2), h67 = __builtin_amdgcn_cvt_scalef32_pk_f32_fp4(wh, 1.0f, 3);
                unsigned wl = 0u; wl = __builtin_amdgcn_cvt_scalef32_pk_fp4_f32(wl, (y0 - h01.x) * 8.f, (y1 - h01.y) * 8.f, 1.0f, 0); wl = __builtin_amdgcn_cvt_scalef32_pk_fp4_f32(wl, (y2 - h23.x) * 8.f, (y3 - h23.y) * 8.f, 1.0f, 1);
                wl = __builtin_amdgcn_cvt_scalef32_pk_fp4_f32(wl, (y4 - h45.x) * 8.f, (y5 - h45.y) * 8.f, 1.0f, 2); wl = __builtin_amdgcn_cvt_scalef32_pk_fp4_f32(wl, (y6 - h67.x) * 8.f, (y7 - h67.y) * 8.f, 1.0f, 3);
                unsigned char* xq = f8 + (size_t)m * 2048 + 256 * j + 4 * lane;
                *(GAS unsigned*)xq = wh; *(GAS unsigned*)(xq + 1024) = wl;
                int a8 = 0, b8 = 0;
                a8 = __builtin_amdgcn_cvt_pk_fp8_f32(y0, y1, a8, false); a8 = __builtin_amdgcn_cvt_pk_fp8_f32(y2, y3, a8, true);
                b8 = __builtin_amdgcn_cvt_pk_fp8_f32(y4, y5, b8, false); b8 = __builtin_amdgcn_cvt_pk_fp8_f32(y6, y7, b8, true);
                v2u o8; o8.x = (unsigned)a8; o8.y = (unsigned)b8; *(GAS v2u*)(f8b + (size_t)m * D + 512 * j + 8 * lane) = o8; }
            else if (f8 != nullptr) { int a8 = 0, b8 = 0;
                a8 = __builtin_amdgcn_cvt_pk_fp8_f32(v[8 * j + 0] * rstd * g0.x + b0.x, v[8 * j + 1] * rstd * g0.y + b0.y, a8, false); a8 = __builtin_amdgcn_cvt_pk_fp8_f32(v[8 * j + 2] * rstd * g0.z + b0.z, v[8 * j + 3] * rstd * g0.w + b0.w, a8, true);
                b8 = __builtin_amdgcn_cvt_pk_fp8_f32(v[8 * j + 4] * rstd * g1.x + b1.x, v[8 * j + 5] * rstd * g1.y + b1.y, b8, false); b8 = __builtin_amdgcn_cvt_pk_fp8_f32(v[8 * j + 6] * rstd * g1.z + b1.z, v[8 * j + 7] * rstd * g1.w + b1.w, b8, true);
                v2u o8; o8.x = (unsigned)a8; o8.y = (unsigned)b8; *(GAS v2u*)(f8 + (size_t)m * D + 512 * j + 8 * lane) = o8; } }
    }
}

__device__ __forceinline__ void pool_phase(const bf16* U, unsigned char* P, int gw, int NGW, int lane) {
    for (int it = gw; it < (M / 64) * 4; it += NGW) {
        const int g = it & 3, t0 = (it >> 2) * 64, w = 2 << g, col = g * 512 + 8 * lane;
        const int s0 = t0 & (SEQ - 1);
        float a[8];
#pragma unroll
        for (int i = 0; i < 8; ++i) a[i] = 0.f;
        const GAS bf16* base = (const GAS bf16*)U + (size_t)t0 * D + col;
        const int nb = (s0 < w - 1) ? s0 : (w - 1);
        {   v4u x[15];
#pragma unroll
            for (int r = 1; r <= 15; ++r) x[r - 1] = *(const GAS v4u*)(base - (ptrdiff_t)((r <= nb) ? r : 0) * D);
#pragma unroll
            for (int r = 1; r <= 15; ++r) if (r <= nb) { const v4u y = x[r - 1];
                a[0] += bflo(y.x); a[1] += bfhi(y.x); a[2] += bflo(y.y); a[3] += bfhi(y.y); a[4] += bflo(y.z); a[5] += bfhi(y.z); a[6] += bflo(y.w); a[7] += bfhi(y.w); }
        }
        for (int t = 0; t < 64; t += 8) {
            v4u cr[8], lv[8];
#pragma unroll
            for (int j = 0; j < 8; ++j) cr[j] = *(const GAS v4u*)(base + (ptrdiff_t)(t + j) * D);
#pragma unroll
            for (int j = 0; j < 8; ++j) { const int s = s0 + t + j; const int r = (s + 1 >= w) ? (t + j + 1 - w) : (t + j); lv[j] = *(const GAS v4u*)(base + (ptrdiff_t)r * D); }
            __builtin_amdgcn_sched_barrier(0);
#pragma unroll
            for (int j = 0; j < 8; ++j) {
                const int s = s0 + t + j;
                const v4u cur = cr[j];
                a[0] += bflo(cur.x); a[1] += bfhi(cur.x); a[2] += bflo(cur.y); a[3] += bfhi(cur.y); a[4] += bflo(cur.z); a[5] += bfhi(cur.z); a[6] += bflo(cur.w); a[7] += bfhi(cur.w);
                const int n = (s + 1 < w) ? (s + 1) : w;
                const float inv = 1.f / (float)n;
                int w0 = 0, w1 = 0;
                w0 = __builtin_amdgcn_cvt_pk_fp8_f32(a[0] * inv - bflo(cur.x), a[1] * inv - bfhi(cur.x), w0, false); w0 = __builtin_amdgcn_cvt_pk_fp8_f32(a[2] * inv - bflo(cur.y), a[3] * inv - bfhi(cur.y), w0, true);
                w1 = __builtin_amdgcn_cvt_pk_fp8_f32(a[4] * inv - bflo(cur.z), a[5] * inv - bfhi(cur.z), w1, false); w1 = __builtin_amdgcn_cvt_pk_fp8_f32(a[6] * inv - bflo(cur.w), a[7] * inv - bfhi(cur.w), w1, true);
                v2u o; o.x = (unsigned)w0; o.y = (unsigned)w1;
                *(GAS v2u*)(P + (size_t)(t0 + t + j) * D + col) = o;
                if (s + 1 >= w) { const v4u x = lv[j];
                    a[0] -= bflo(x.x); a[1] -= bfhi(x.x); a[2] -= bflo(x.y); a[3] -= bfhi(x.y); a[4] -= bflo(x.z); a[5] -= bfhi(x.z); a[6] -= bflo(x.w); a[7] -= bfhi(x.w); }
            }
            __builtin_amdgcn_sched_barrier(0);
        }
    }
}

typedef __bf16 bf16x2v __attribute__((ext_vector_type(2)));
__device__ __forceinline__ unsigned cvtpk(float lo, float hi) { const f32x2 v = {lo, hi}; return __builtin_bit_cast(unsigned, __builtin_convertvector(v, bf16x2v)); }
constexpr int SSM_L = 1664, SSM_L3 = SEQ - 3 * SSM_L;
static_assert(SSM_L % 64 == 0 && SSM_L3 % 64 == 0 && SSM_L3 > 0, "segments");
template <bool WR>
__device__ __forceinline__ void ssm_block16m(const bf16x8 ua, const bf16x8 (&BbR)[4], const bf16x8 (&BbI)[4], LAS unsigned char* bubuf, LAS unsigned char* hbuf, const f32x2 ar2, const f32x2 ai2, f32x2& h2, int p, int lane) {
    f32x4 dr[4], di[4];
    const f32x4 z = {0.f, 0.f, 0.f, 0.f};
    __builtin_amdgcn_sched_barrier(0);
    asm volatile("s_nop 15\n\ts_nop 15\n\ts_nop 15\n\ts_nop 15" ::: "memory");
    __builtin_amdgcn_sched_barrier(0);
#pragma unroll
    for (int pt = 0; pt < 4; ++pt) { dr[pt] = __builtin_amdgcn_mfma_f32_16x16x32_bf16(ua, BbR[pt], z, 0, 0, 0); di[pt] = __builtin_amdgcn_mfma_f32_16x16x32_bf16(ua, BbI[pt], z, 0, 0, 0); }
    __builtin_amdgcn_sched_barrier(0);
    asm volatile("s_nop 15\n\ts_nop 15\n\ts_nop 15\n\ts_nop 15\n\ts_nop 15\n\ts_nop 15\n\ts_nop 15\n\ts_nop 15" ::: "memory");
    __builtin_amdgcn_sched_barrier(0);
#pragma unroll
    for (int pt = 0; pt < 4; ++pt)
#pragma unroll
        for (int r = 0; r < 4; ++r) *(LAS f32x2*)(bubuf + (4 * (lane >> 4) + r) * 528 + (16 * pt + (lane & 15)) * 8) = (f32x2){dr[pt][r], di[pt][r]};
    LDS_WAIT();
#pragma unroll
    for (int l = 0; l < 16; ++l) {
        const f32x2 bu = *(const LAS f32x2*)(bubuf + l * 528 + p * 8);
        float tx, ty, nx, ny; const float hx = h2.x, hy = h2.y, bux = bu.x, buy = bu.y, arx = ar2.x, aix = ai2.x, aiy = ai2.y;
        asm("v_fma_f32 %0, %1, %2, %3" : "=v"(tx) : "v"(arx), "v"(hx), "v"(bux));
        asm("v_fma_f32 %0, %1, %2, %3" : "=v"(ty) : "v"(arx), "v"(hy), "v"(buy));
        asm("v_fma_f32 %0, %1, %2, %3" : "=v"(nx) : "v"(aix), "v"(hy), "v"(tx));
        asm("v_fma_f32 %0, %1, %2, %3" : "=v"(ny) : "v"(aiy), "v"(hx), "v"(ty));
        h2 = (f32x2){nx, ny};
        if (WR) *(LAS unsigned*)(hbuf + l * 272 + 4 * p) = cvtpk(h2.x, h2.y);
    }
}
__device__ __forceinline__ void ssm_phase_m(const bf16* U, unsigned char* Y, const float* ssmp,
                                          const float* c_re, const float* c_im, const float* d_skip, LAS unsigned char* lds, int vcu, int G, int wave, int lane) {
    LAS unsigned char* hbuf = lds + wave * 16384;
    LAS unsigned char* ebuf = lds + wave * 16384 + 4352;
    LAS unsigned char* bubuf = lds + wave * 16384 + 4864;
    const int ntask = BATCH * 128 * 4;
    for (int tb = vcu * NWAVES; tb < ntask; tb += G * NWAVES) {
        const int task = tb + wave, seg = (wave + 3 * (wave >> 2)) & 3, g = (task >> 2) & 127, b = task >> 9, p = lane;
        const float* pp_ = ssmp + (size_t)(g * 64 + p) * 34;
        const float ar = pp_[0], ai = pp_[1];
        const int cc = lane & 15, kg = lane >> 4;
        bf16x8 BbR[4], BbI[4];
#pragma unroll
        for (int pt = 0; pt < 4; ++pt) { const float* q_ = ssmp + (size_t)(g * 64 + 16 * pt + cc) * 34 + 8 * (kg & 1);
            v4u tr, ti; tr.x = cvtpk(q_[2], q_[3]); tr.y = cvtpk(q_[4], q_[5]); tr.z = cvtpk(q_[6], q_[7]); tr.w = cvtpk(q_[8], q_[9]);
            ti.x = cvtpk(q_[18], q_[19]); ti.y = cvtpk(q_[20], q_[21]); ti.z = cvtpk(q_[22], q_[23]); ti.w = cvtpk(q_[24], q_[25]);
            if (kg >= 2) { tr = (v4u){0u, 0u, 0u, 0u}; ti = (v4u){0u, 0u, 0u, 0u}; }
            BbR[pt] = __builtin_bit_cast(bf16x8, tr); BbI[pt] = __builtin_bit_cast(bf16x8, ti); }
        const int tstart = seg * SSM_L, tlen = (seg == 3) ? SSM_L3 : SSM_L;
        const bf16* ub = U + ((size_t)b * SEQ + tstart) * D + g * 16;
        const bf16* ua_p = ub + (size_t)(lane & 15) * D + 8 * (kg & 1);
        unsigned char* yb = Y + ((size_t)b * SEQ + tstart) * D + g * 16;
        const f32x2 ar2 = {ar, ar}, ai2 = {-ai, ai};
        f32x2 h2 = {0.f, 0.f};
        const v4u zero4 = {0u, 0u, 0u, 0u};
        if (seg < 3) {
            v4u pre[4];
#pragma unroll
            for (int i = 0; i < 4; ++i) pre[i] = *(const GAS v4u*)(ua_p + (size_t)(16 * i) * D);
            for (int t0 = 0; t0 < SSM_L; t0 += 64) {
                v4u cur[4];
#pragma unroll
                for (int i = 0; i < 4; ++i) cur[i] = (kg < 2) ? pre[i] : zero4;
                if (t0 + 64 < SSM_L) {
#pragma unroll
                    for (int i = 0; i < 4; ++i) pre[i] = *(const GAS v4u*)(ua_p + (size_t)(t0 + 64 + 16 * i) * D); }
#pragma unroll
                for (int blk = 0; blk < 4; ++blk) { ssm_block16m<false>(__builtin_bit_cast(bf16x8, cur[blk]), BbR, BbI, bubuf, hbuf, ar2, ai2, h2, p, lane); LDS_WAIT(); }
            }
            *(LAS f32x2*)(ebuf + 8 * p) = h2;
        }
        LDS_WAIT();
        __syncthreads();
        {
            f32x2 pw = {1.f, 0.f}, base = {ar, ai};
#pragma unroll 1
            for (int bit = SSM_L; bit > 0; bit >>= 1) {
                if (bit & 1) pw = (f32x2){pw.x * base.x - pw.y * base.y, pw.x * base.y + pw.y * base.x};
                base = (f32x2){base.x * base.x - base.y * base.y, 2.f * base.x * base.y};
            }
            LAS unsigned char* e0 = lds + (wave & 4) * 16384 + 4352;
            f32x2 sst = {0.f, 0.f};
            for (int j = 0; j < seg; ++j) { const f32x2 e = *(const LAS f32x2*)(e0 + ((j + (wave >> 2)) & 3) * 16384 + 8 * p);
                sst = (f32x2){pw.x * sst.x - pw.y * sst.y + e.x, pw.x * sst.y + pw.y * sst.x + e.y}; }
            h2 = sst;
        }
        bf16x8 cB[4];
#pragma unroll
        for (int ks = 0; ks < 4; ++ks) { unsigned w[4];
#pragma unroll
            for (int jj = 0; jj < 4; ++jj) { const int k = 32 * ks + 8 * (lane >> 4) + 2 * jj, pp = k >> 1;
                w[jj] = cvtpk(c_re[(g * 16 + cc) * 64 + pp], -c_im[(g * 16 + cc) * 64 + pp]); }
            v4u t; t.x = w[0]; t.y = w[1]; t.z = w[2]; t.w = w[3]; cB[ks] = __builtin_bit_cast(bf16x8, t); }
        const float dd = d_skip[g * 16 + cc];
        {
            v4u pre[4];
#pragma unroll
            for (int i = 0; i < 4; ++i) pre[i] = *(const GAS v4u*)(ua_p + (size_t)(16 * i) * D);
            for (int t0 = 0; t0 < tlen; t0 += 64) {
                v4u cur[4];
#pragma unroll
                for (int i = 0; i < 4; ++i) cur[i] = (kg < 2) ? pre[i] : zero4;
                if (t0 + 64 < tlen) {
#pragma unroll
                    for (int i = 0; i < 4; ++i) pre[i] = *(const GAS v4u*)(ua_p + (size_t)(t0 + 64 + 16 * i) * D); }
#pragma unroll
                for (int blk = 0; blk < 4; ++blk) {
                    unsigned short uq[4];
#pragma unroll
                    for (int r = 0; r < 4; ++r) uq[r] = *(const GAS unsigned short*)(ub + (size_t)(t0 + 16 * blk + 4 * (lane >> 4) + r) * D + cc);
                    ssm_block16m<true>(__builtin_bit_cast(bf16x8, cur[blk]), BbR, BbI, bubuf, hbuf, ar2, ai2, h2, p, lane);
                    LDS_WAIT();
                    f32x4 acc = (f32x4){0.f, 0.f, 0.f, 0.f};
#pragma unroll
                    for (int ks = 0; ks < 4; ++ks) { const bf16x8 a = *(const LAS bf16x8*)(hbuf + (lane & 15) * 272 + 16 * (lane >> 4) + 64 * ks);
                        acc = __builtin_amdgcn_mfma_f32_16x16x32_bf16(a, cB[ks], acc, 0, 0, 0); }
#pragma unroll
                    for (int r = 0; r < 4; ++r) { const int l = 4 * (lane >> 4) + r;
                        const float uu = __builtin_bit_cast(float, (unsigned)uq[r] << 16);
                        const float y = acc[r] + dd * uu;
                        *(GAS unsigned char*)(yb + (size_t)(t0 + 16 * blk + l) * D + cc) = (unsigned char)(__builtin_amdgcn_cvt_pk_fp8_f32(gelu_f(y), 0.f, 0, false) & 0xff); }
                    LDS_WAIT();
                }
            }
        }
        __syncthreads();
    }
}

__device__ __forceinline__ void attn_tile(const bf16* Kbh, const bf16* Vbh, const LAS float* rbh, int kp0, bool has_next, int qpos, int hl, int lane,
                                          const bf16x8 (&kc)[8], bf16x8 (&kn)[8], const bf16x8 (&qf)[8], f32x16 (&o)[4], float& mrun, float& lrun) {
    bf16x8 vf[8];
    { const bf16* vp = Vbh + (size_t)(kp0 >> 5) * 4096 + (size_t)lane * 8;
#pragma unroll
      for (int q = 0; q < 8; ++q) vf[q] = *(const GAS bf16x8*)(vp + 512 * q); }
    if (has_next) { const bf16* kp = Kbh + (size_t)((kp0 >> 5) + 1) * 4096 + (size_t)lane * 8;
#pragma unroll
      for (int ks = 0; ks < 8; ++ks) kn[ks] = *(const GAS bf16x8*)(kp + 512 * ks); }
    __builtin_amdgcn_sched_barrier(0);
    f32x16 s;
#pragma unroll
    for (int i = 0; i < 16; ++i) s[i] = 0.f;
#pragma unroll
    for (int ks = 0; ks < 8; ++ks) s = __builtin_amdgcn_mfma_f32_32x32x16_bf16(kc[ks], qf[ks], s, 0, 0, 0);
    float tmax = -1e30f;
#pragma unroll
    for (int i = 0; i < 16; ++i) { const int kpos = kp0 + (i & 3) + 8 * (i >> 2) + 4 * hl; int rel = qpos - kpos; rel = rel > 128 ? 128 : rel; s[i] += rbh[rel + 128]; tmax = fmaxf(tmax, s[i]); }
    tmax = fmaxf(tmax, SHFL_XOR(tmax, 32));
    const float mnew = fmaxf(mrun, tmax), alpha = __builtin_amdgcn_exp2f(mrun - mnew);
    float rs = 0.f;
#pragma unroll
    for (int i = 0; i < 16; ++i) { s[i] = __builtin_amdgcn_exp2f(s[i] - mnew); rs += s[i]; }
    rs += SHFL_XOR(rs, 32);
    lrun = lrun * alpha + rs; mrun = mnew;
    bf16x8 pf[2];
#pragma unroll
    for (int sidx = 0; sidx < 2; ++sidx) { v4u t; t.x = cvtpk(s[8 * sidx + 0], s[8 * sidx + 1]); t.y = cvtpk(s[8 * sidx + 2], s[8 * sidx + 3]);
        t.z = cvtpk(s[8 * sidx + 4], s[8 * sidx + 5]); t.w = cvtpk(s[8 * sidx + 6], s[8 * sidx + 7]); pf[sidx] = __builtin_bit_cast(bf16x8, t); }
#pragma unroll
    for (int dt = 0; dt < 4; ++dt) {
#pragma unroll
        for (int i = 0; i < 16; ++i) o[dt][i] *= alpha;
#pragma unroll
        for (int sidx = 0; sidx < 2; ++sidx) o[dt] = __builtin_amdgcn_mfma_f32_32x32x16_bf16(vf[2 * dt + sidx], pf[sidx], o[dt], 0, 0, 0);
    }
}
__device__ __forceinline__ void attn_phase(const bf16* QO, const bf16* Kb, const bf16* VT, unsigned char* O8, const LAS float* rb, int gw, int NGW, int lane) {
    const int r32 = lane & 31, hl = lane >> 5;
    for (int task = gw; task < BATCH * 16 * 128 * 2; task += NGW) {
        const int half = task & 1, c = (task >> 1) & 127, h = (task >> 8) & 15, b = task >> 12;
        const int qpos = 64 * c + 32 * half + r32;
        const size_t qrow = (size_t)b * SEQ + qpos;
        bf16x8 qf[8];
        const size_t bh256 = (size_t)(b * 16 + h) * 256;
        { const bf16* qt = QO + ((bh256 + 2 * c + half) * 8) * 512 + (size_t)lane * 8;
#pragma unroll
          for (int ks = 0; ks < 8; ++ks) qf[ks] = *(const GAS bf16x8*)(qt + ks * 512); }
        f32x16 o[4];
#pragma unroll
        for (int dt = 0; dt < 4; ++dt)
#pragma unroll
            for (int i = 0; i < 16; ++i) o[dt][i] = 0.f;
        float mrun = -1e30f, lrun = 0.f;
        const LAS float* rbh = rb + h * 257;
        const bf16* Kbh = Kb + bh256 * 4096; const bf16* Vbh = VT + bh256 * 4096;
        int kt0 = 16 - 2 * c; if (kt0 < 0) kt0 = 0;
        bf16x8 kA[8], kB[8];
        { const bf16* kp = Kbh + (size_t)((64 * c - 512 + 32 * kt0) >> 5) * 4096 + (size_t)lane * 8;
#pragma unroll
          for (int ks = 0; ks < 8; ++ks) kA[ks] = *(const GAS bf16x8*)(kp + 512 * ks); }
        for (int kt = kt0; kt < 18; kt += 2) {
            const int kp0 = 64 * c - 512 + 32 * kt;
            attn_tile(Kbh, Vbh, rbh, kp0, true, qpos, hl, lane, kA, kB, qf, o, mrun, lrun);
            attn_tile(Kbh, Vbh, rbh, kp0 + 32, kt + 2 < 18, qpos, hl, lane, kB, kA, qf, o, mrun, lrun);
        }
        const float inv = O8S / lrun;
        unsigned char* op = O8 + qrow * D + h * 128 + 4 * hl;
#pragma unroll
        for (int dt = 0; dt < 4; ++dt)
#pragma unroll
            for (int rq = 0; rq < 4; ++rq) { int w = 0; w = __builtin_amdgcn_cvt_pk_fp8_f32(o[dt][4 * rq + 0] * inv, o[dt][4 * rq + 1] * inv, w, false); w = __builtin_amdgcn_cvt_pk_fp8_f32(o[dt][4 * rq + 2] * inv, o[dt][4 * rq + 3] * inv, w, true);
                *(int*)(op + 32 * dt + 8 * rq) = w; }
    }
}

__device__ __forceinline__ void attn_a_qk(f32x16& s, const bf16x8 (&kc)[8], const bf16x8 (&qh)[8]) {
#pragma unroll
    for (int i = 0; i < 16; ++i) s[i] = 0.f;
#pragma unroll
    for (int ks = 0; ks < 8; ++ks) s = __builtin_amdgcn_mfma_f32_32x32x16_bf16(kc[ks], qh[ks], s, 0, 0, 0);
}
__device__ __forceinline__ void attn_a_half(f32x16& s, const LAS float* rbh, int kp0, int qbase, int r32, int hl, int lane, float& mrun, float& lrun, LAS unsigned char* pw, LAS float* aw) {
    const int qpos = qbase + r32; float tmax = -1e30f;
    if (qbase - (kp0 + 31) >= 128) { const float cb = rbh[256];
#pragma unroll
        for (int i = 0; i < 16; ++i) { s[i] += cb; tmax = fmaxf(tmax, s[i]); } }
    else {
#pragma unroll
        for (int i = 0; i < 16; ++i) { const int kpos = kp0 + (i & 3) + 8 * (i >> 2) + 4 * hl; int rel = qpos - kpos; rel = rel > 128 ? 128 : rel; s[i] += rbh[rel + 128]; tmax = fmaxf(tmax, s[i]); } }
    tmax = fmaxf(tmax, SHFL_XOR(tmax, 32));
    const float mnew = fmaxf(mrun, tmax), alpha = __builtin_amdgcn_exp2f(mrun - mnew);
    float rs = 0.f;
#pragma unroll
    for (int i = 0; i < 16; ++i) { s[i] = __builtin_amdgcn_exp2f(s[i] - mnew); rs += s[i]; }
    rs += SHFL_XOR(rs, 32);
    lrun = lrun * alpha + rs; mrun = mnew;
    v4u t0, t1; t0.x = cvtpk(s[0], s[1]); t0.y = cvtpk(s[2], s[3]); t0.z = cvtpk(s[4], s[5]); t0.w = cvtpk(s[6], s[7]);
    t1.x = cvtpk(s[8], s[9]); t1.y = cvtpk(s[10], s[11]); t1.z = cvtpk(s[12], s[13]); t1.w = cvtpk(s[14], s[15]);
    *(LAS v4u*)pw = t0; *(LAS v4u*)(pw + 16) = t1; *aw = alpha;
}
__device__ __forceinline__ void attn_b_half(const bf16x8 (&vc)[8], f32x16 (&oh)[4], const LAS unsigned char* pr, const LAS float* ar) {
    const v4u p0 = *(const LAS v4u*)pr, p1 = *(const LAS v4u*)(pr + 16); const float al = *ar;
    const bf16x8 pf0 = __builtin_bit_cast(bf16x8, p0), pf1 = __builtin_bit_cast(bf16x8, p1);
#pragma unroll
    for (int dt = 0; dt < 4; ++dt) {
#pragma unroll
        for (int i = 0; i < 16; ++i) oh[dt][i] *= al;
        oh[dt] = __builtin_amdgcn_mfma_f32_32x32x16_bf16(vc[2 * dt], pf0, oh[dt], 0, 0, 0); oh[dt] = __builtin_amdgcn_mfma_f32_32x32x16_bf16(vc[2 * dt + 1], pf1, oh[dt], 0, 0, 0); }
}
__device__ __forceinline__ void attn_ld8(bf16x8 (&d)[8], const bf16* p) {
#pragma unroll
    for (int q = 0; q < 8; ++q) d[q] = *(const GAS bf16x8*)(p + 512 * q);
}
__device__ __forceinline__ void attn_phase_split(const bf16* QO, const bf16* Kb, const bf16* VT, unsigned char* O8, const LAS float* rb, LAS unsigned char* xch, int vcu, int G, int wave, int lane) {
    const int r32 = lane & 31, hl = lane >> 5;
    const int pr = wave & 3, role = wave >> 2;
    LAS unsigned char* xp = xch + pr * 9728;
    LAS unsigned char* pl = xp + lane * 32; LAS float* al = (LAS float*)(xp + 8192) + lane;
    for (int batch = vcu; batch < BATCH * 16 * 128 * 2 / 8; batch += G) {
        const int T0 = batch * 8, c0 = (T0 >> 1) & 127, h = (T0 >> 8) & 15, b = T0 >> 12, c = c0 + pr;
        const size_t bh256 = (size_t)(b * 16 + h) * 256;
        const bf16* Kl = Kb + bh256 * 4096 + (size_t)lane * 8; const bf16* Vl = VT + bh256 * 4096 + (size_t)lane * 8;
        const LAS float* rbh = rb + h * 257;
        int kt0 = 16 - 2 * c; if (kt0 < 0) kt0 = 0;
        const int kbase = 64 * c - 512, tb = kbase >> 5;
        if (role == 0) {
            bf16x8 q0[8], q1[8];
            attn_ld8(q0, QO + ((bh256 + 2 * c + 0) * 8) * 512 + (size_t)lane * 8); attn_ld8(q1, QO + ((bh256 + 2 * c + 1) * 8) * 512 + (size_t)lane * 8);
            float mrun0 = -1e30f, mrun1 = -1e30f, lrun0 = 0.f, lrun1 = 0.f;
            bf16x8 kc[8];
            attn_ld8(kc, Kl + (size_t)(tb + kt0) * 4096);
            for (int t = 0; t < 18; ++t) {
                if (t >= kt0) { f32x16 s0, s1;
                    attn_a_qk(s0, kc, q0); attn_a_qk(s1, kc, q1);
                    __builtin_amdgcn_sched_barrier(0);
                    if (t + 1 < 18) attn_ld8(kc, Kl + (size_t)(tb + t + 1) * 4096);
                    __builtin_amdgcn_sched_barrier(0);
                    const int so = (t & 1) * 4096, ao = (t & 1) * 128;
                    attn_a_half(s0, rbh, kbase + 32 * t, 64 * c, r32, hl, lane, mrun0, lrun0, pl + so, al + ao);
                    attn_a_half(s1, rbh, kbase + 32 * t, 64 * c + 32, r32, hl, lane, mrun1, lrun1, pl + so + 2048, al + ao + 64); }
                if (t == 17) { *(LAS float*)(xp + 9216 + lane * 4) = lrun0; *(LAS float*)(xp + 9216 + 256 + lane * 4) = lrun1; }
                LDS_WAIT(); __syncthreads();
            }
            __syncthreads();
        } else {
            f32x16 oA[4], oB[4];
#pragma unroll
            for (int dt = 0; dt < 4; ++dt)
#pragma unroll
                for (int i = 0; i < 16; ++i) { oA[dt][i] = 0.f; oB[dt][i] = 0.f; }
            bf16x8 vc[8];
            attn_ld8(vc, Vl + (size_t)(tb + kt0) * 4096);
            __syncthreads();
            for (int t = 0; t < 18; ++t) {
                if (t >= kt0) { const int so = (t & 1) * 4096, ao = (t & 1) * 128;
                    attn_b_half(vc, oA, pl + so, al + ao); attn_b_half(vc, oB, pl + so + 2048, al + ao + 64);
                    __builtin_amdgcn_sched_barrier(0);
                    if (t + 1 < 18) attn_ld8(vc, Vl + (size_t)(tb + t + 1) * 4096); }
                LDS_WAIT(); __syncthreads();
            }
            {   const float lf0 = *(const LAS float*)(xp + 9216 + lane * 4), lf1 = *(const LAS float*)(xp + 9216 + 256 + lane * 4);
                const float inv0 = O8S / lf0, inv1 = O8S / lf1;
                unsigned char* op0 = O8 + ((size_t)b * SEQ + 64 * c + r32) * D + h * 128 + 4 * hl; unsigned char* op1 = op0 + (size_t)32 * D;
#pragma unroll
                for (int dt = 0; dt < 4; ++dt)
#pragma unroll
                    for (int rq = 0; rq < 4; ++rq) { int w = 0; w = __builtin_amdgcn_cvt_pk_fp8_f32(oA[dt][4 * rq + 0] * inv0, oA[dt][4 * rq + 1] * inv0, w, false); w = __builtin_amdgcn_cvt_pk_fp8_f32(oA[dt][4 * rq + 2] * inv0, oA[dt][4 * rq + 3] * inv0, w, true);
                        *(int*)(op0 + 32 * dt + 8 * rq) = w;
                        int w2 = 0; w2 = __builtin_amdgcn_cvt_pk_fp8_f32(oB[dt][4 * rq + 0] * inv1, oB[dt][4 * rq + 1] * inv1, w2, false); w2 = __builtin_amdgcn_cvt_pk_fp8_f32(oB[dt][4 * rq + 2] * inv1, oB[dt][4 * rq + 3] * inv1, w2, true);
                        *(int*)(op1 + 32 * dt + 8 * rq) = w2; }
            }
        }
        __syncthreads();
    }
}

#define INS16(L, x) do { _Pragma("unroll") for (int _j = 15; _j >= 1; --_j) L[_j] = __builtin_amdgcn_fmed3f(L[_j - 1], L[_j], (x)); L[0] = fmaxf(L[0], (x)); } while (0)
__device__ __forceinline__ void peer_select_phase(const bf16* Q, const LAS unsigned char* skl  , int* idx_out, float* gate_out, int gw, int NGW, int lane) {
    const int r = lane & 31, half = lane >> 5;
    for (int it = gw; it < M / 4; it += NGW) {
        const int t = 4 * it + (r >> 3), hh = r & 7;
        float L[2][16];
#pragma unroll
        for (int s = 0; s < 2; ++s) {
#pragma unroll
            for (int j = 0; j < 16; ++j) L[s][j] = -3.0e38f;
            bf16x8 qf[8];
            const bf16* qp = Q + (size_t)t * D + hh * 256 + s * 128 + 8 * half;
#pragma unroll
            for (int ks = 0; ks < 8; ++ks) qf[ks] = *(const bf16x8*)(qp + 16 * ks);
#pragma unroll 1
            for (int nt = 0; nt < 4; ++nt) {
                f32x16 sc;
#pragma unroll
                for (int i = 0; i < 16; ++i) sc[i] = 0.f;
                const LAS unsigned char* kp = skl + (size_t)(s * 128 + 32 * nt + r) * 272 + 16 * half;
#pragma unroll
                for (int ks = 0; ks < 8; ++ks) { const bf16x8 kf = *(const LAS bf16x8*)(kp + 32 * ks); sc = __builtin_amdgcn_mfma_f32_32x32x16_bf16(kf, qf[ks], sc, 0, 0, 0); }
#pragma unroll
                for (int i = 0; i < 16; ++i) { const unsigned n = 32 * nt + (i & 3) + 8 * (i >> 2) + 4 * half;
                    const float sv = sc[i];
                    const float x = __builtin_bit_cast(float, (__builtin_bit_cast(unsigned, sv) & ~127u) | n);
                    INS16(L[s], x); }
            }
        }
        float mine[16], oth[16];
#pragma unroll
        for (int j = 0; j < 16; ++j) { const float o0 = SHFL_XOR(L[0][j], 32), o1 = SHFL_XOR(L[1][j], 32); mine[j] = half ? L[1][j] : L[0][j]; oth[j] = half ? o1 : o0; }
#pragma unroll
        for (int j = 0; j < 16; ++j) { const float x = oth[j]; INS16(mine, x); }
        float A[16], B[16];
#pragma unroll
        for (int j = 0; j < 16; ++j) { const float o = SHFL_XOR(mine[j], 32); A[j] = half ? o : mine[j]; B[j] = half ? mine[j] : o; }
        float T[16];
#pragma unroll
        for (int j = 0; j < 16; ++j) T[j] = -3.0e38f;
#pragma unroll
        for (int a = 0; a < 16; ++a)
#pragma unroll
            for (int bq = 0; bq < 16; ++bq) if ((a + 1) * (bq + 1) <= 16) { const float x = A[a] + B[bq]; INS16(T, x); }
        const float tau = T[15], mx = T[0];
        float den = 0.f;
#pragma unroll
        for (int j = 0; j < 16; ++j) den += __builtin_amdgcn_exp2f((T[j] - mx) * LOG2E);
        const float rden = 1.f / den;
        int cnt = 0;
        const size_t ob = (size_t)t * 128 + hh * 16;
#pragma unroll
        for (int a = 0; a < 16; ++a)
#pragma unroll
            for (int bq = 0; bq < 16; ++bq) if ((a + 1) * (bq + 1) <= 16) {
                const float x = A[a] + B[bq];
                if (x >= tau && cnt < 16) {
                    if (half == 0) idx_out[ob + cnt] = (int)(((__builtin_bit_cast(unsigned, A[a]) & 127u) << 7) | (__builtin_bit_cast(unsigned, B[bq]) & 127u));
                    else gate_out[ob + cnt] = __builtin_amdgcn_exp2f((x - mx) * LOG2E) * rden;
                    ++cnt;
                }
            }
    }
}

__device__ __forceinline__ void peer_gather_phase(float* hio, bf16* hb, const int* idx, const float* gate, const bf16* TU, const bf16* TV, const float* lg, const float* lb, int gw, int NGW, int lane) {
    for (int m = gw; m < M; m += NGW) {
        v4u xr[4];
#pragma unroll
        for (int j = 0; j < 4; ++j) xr[j] = *(const v4u*)(hb + (size_t)m * D + 512 * j + 8 * lane);
        const int i0 = idx[(size_t)m * 128 + lane], i1 = idx[(size_t)m * 128 + 64 + lane];
        float y[32];
#pragma unroll
        for (int i = 0; i < 32; ++i) y[i] = 0.f;
#ifdef DBG_NO_PEER
        for (int hb_ = 0; hb_ < 0; ++hb_) {
#else
        for (int hb_ = 0; hb_ < 8; ++hb_) {
#endif
            float part[16];
            const int isel = (hb_ < 4) ? i0 : i1;
#pragma unroll
            for (int kk = 0; kk < 16; ++kk) {
                const int e = __builtin_amdgcn_readlane(isel, ((hb_ & 3) << 4) + kk);
                const bf16* up = TU + (size_t)e * D + 8 * lane;
                float acc = 0.f;
#pragma unroll
                for (int j = 0; j < 4; ++j) { const v4u w = *(const v4u*)(up + 512 * j);
                    acc = dot2bf(w.x, xr[j].x, acc); acc = dot2bf(w.y, xr[j].y, acc); acc = dot2bf(w.z, xr[j].z, acc); acc = dot2bf(w.w, xr[j].w, acc); }
                part[kk] = acc;
            }
#pragma unroll
            for (int kk = 0; kk < 16; ++kk) { part[kk] += SHFL_XOR(part[kk], 32); part[kk] += SHFL_XOR(part[kk], 16); }
            {
                const bool b3 = (lane & 8) != 0, b2 = (lane & 4) != 0, b1 = (lane & 2) != 0, b0 = (lane & 1) != 0;
#pragma unroll
                for (int i = 0; i < 8; ++i) { const float send = b3 ? part[i] : part[i + 8], keep = b3 ? part[i + 8] : part[i]; part[i] = keep + SHFL_XOR(send, 8); }
#pragma unroll
                for (int i = 0; i < 4; ++i) { const float send = b2 ? part[i] : part[i + 4], keep = b2 ? part[i + 4] : part[i]; part[i] = keep + SHFL_XOR(send, 4); }
#pragma unroll
                for (int i = 0; i < 2; ++i) { const float send = b1 ? part[i] : part[i + 2], keep = b1 ? part[i + 2] : part[i]; part[i] = keep + SHFL_XOR(send, 2); }
                { const float send = b0 ? part[0] : part[1], keep = b0 ? part[1] : part[0]; part[0] = keep + SHFL_XOR(send, 1); }
            }
            const float gt = gate[(size_t)m * 128 + hb_ * 16 + (lane & 15)];
            const float act = gelu_f(part[0]) * gt;
            const unsigned actb = f2bf(act);
#pragma unroll
            for (int kk = 0; kk < 16; ++kk) {
                const int e = __builtin_amdgcn_readlane(isel, ((hb_ & 3) << 4) + kk);
                const unsigned ab = (unsigned)__builtin_amdgcn_readlane((int)actb, kk);
                const unsigned alo = ab, ahi = ab << 16;
                const bf16* vp = TV + (size_t)e * D + 8 * lane;
#pragma unroll
                for (int j = 0; j < 4; ++j) { const v4u w = *(const v4u*)(vp + 512 * j);
                    y[8 * j + 0] = dot2bf(w.x, alo, y[8 * j + 0]); y[8 * j + 1] = dot2bf(w.x, ahi, y[8 * j + 1]);
                    y[8 * j + 2] = dot2bf(w.y, alo, y[8 * j + 2]); y[8 * j + 3] = dot2bf(w.y, ahi, y[8 * j + 3]);
                    y[8 * j + 4] = dot2bf(w.z, alo, y[8 * j + 4]); y[8 * j + 5] = dot2bf(w.z, ahi, y[8 * j + 5]);
                    y[8 * j + 6] = dot2bf(w.w, alo, y[8 * j + 6]); y[8 * j + 7] = dot2bf(w.w, ahi, y[8 * j + 7]); }
            }
        }
        float* row = hio + (size_t)m * D + 8 * lane;
        float s = 0.f;
#pragma unroll
        for (int j = 0; j < 4; ++j) { const f32x4 a = *(const f32x4*)(row + 512 * j), b = *(const f32x4*)(row + 512 * j + 4);
            y[8 * j + 0] += DN_ALPHA * a.x; y[8 * j + 1] += DN_ALPHA * a.y; y[8 * j + 2] += DN_ALPHA * a.z; y[8 * j + 3] += DN_ALPHA * a.w;
            y[8 * j + 4] += DN_ALPHA * b.x; y[8 * j + 5] += DN_ALPHA * b.y; y[8 * j + 6] += DN_ALPHA * b.z; y[8 * j + 7] += DN_ALPHA * b.w; }
#pragma unroll
        for (int i = 0; i < 32; ++i) s += y[i];
        const float mean = wave_sum(s) * (1.f / D); float s2 = 0.f;
#pragma unroll
        for (int i = 0; i < 32; ++i) { y[i] -= mean; s2 += y[i] * y[i]; }
        const float rstd = 1.f / sqrtf(wave_sum(s2) * (1.f / D) + LN_EPS);
#pragma unroll
        for (int j = 0; j < 4; ++j) { const float* gp = lg + 512 * j + 8 * lane; const float* bp = lb + 512 * j + 8 * lane;
            const f32x4 g0 = *(const f32x4*)gp, g1 = *(const f32x4*)(gp + 4), b0 = *(const f32x4*)bp, b1 = *(const f32x4*)(bp + 4);
            f32x4 o0, o1; o0.x = y[8 * j + 0] * rstd * g0.x + b0.x; o0.y = y[8 * j + 1] * rstd * g0.y + b0.y; o0.z = y[8 * j + 2] * rstd * g0.z + b0.z; o0.w = y[8 * j + 3] * rstd * g0.w + b0.w;
            o1.x = y[8 * j + 4] * rstd * g1.x + b1.x; o1.y = y[8 * j + 5] * rstd * g1.y + b1.y; o1.z = y[8 * j + 6] * rstd * g1.z + b1.z; o1.w = y[8 * j + 7] * rstd * g1.w + b1.w;
            *(f32x4*)(row + 512 * j) = o0; *(f32x4*)(row + 512 * j + 4) = o1;
            v4u w; w.x = pk2(o0.x, o0.y); w.y = pk2(o0.z, o0.w); w.z = pk2(o1.x, o1.y); w.w = pk2(o1.z, o1.w);
            *(v4u*)(hb + (size_t)m * D + 512 * j + 8 * lane) = w; }
    }
}


__device__ __forceinline__ float udot8(const v4u (&w)[2], const f32x2 (&x2)[16]) {
    f32x2 a0 = {0.f, 0.f}, a1 = {0.f, 0.f};
#pragma unroll
    for (int j = 0; j < 2; ++j) {
        const unsigned d0 = w[j].x, d1 = w[j].y, d2 = w[j].z, d3 = w[j].w;
        a0 = __builtin_elementwise_fma(__builtin_amdgcn_cvt_pk_f32_fp8((int)d0, false), x2[8 * j + 0], a0); a1 = __builtin_elementwise_fma(__builtin_amdgcn_cvt_pk_f32_fp8((int)d0, true), x2[8 * j + 1], a1);
        a0 = __builtin_elementwise_fma(__builtin_amdgcn_cvt_pk_f32_fp8((int)d1, false), x2[8 * j + 2], a0); a1 = __builtin_elementwise_fma(__builtin_amdgcn_cvt_pk_f32_fp8((int)d1, true), x2[8 * j + 3], a1);
        a0 = __builtin_elementwise_fma(__builtin_amdgcn_cvt_pk_f32_fp8((int)d2, false), x2[8 * j + 4], a0); a1 = __builtin_elementwise_fma(__builtin_amdgcn_cvt_pk_f32_fp8((int)d2, true), x2[8 * j + 5], a1);
        a0 = __builtin_elementwise_fma(__builtin_amdgcn_cvt_pk_f32_fp8((int)d3, false), x2[8 * j + 6], a0); a1 = __builtin_elementwise_fma(__builtin_amdgcn_cvt_pk_f32_fp8((int)d3, true), x2[8 * j + 7], a1);
    }
    return (a0.x + a0.y) + (a1.x + a1.y);
}
__device__ __forceinline__ void vacc8(const v4u (&w)[2], const f32x2 a2, f32x2 (&y2)[16]) {
#pragma unroll
    for (int j = 0; j < 2; ++j) {
        const unsigned d0 = w[j].x, d1 = w[j].y, d2 = w[j].z, d3 = w[j].w;
        y2[8 * j + 0] = __builtin_elementwise_fma(__builtin_amdgcn_cvt_pk_f32_fp8((int)d0, false), a2, y2[8 * j + 0]); y2[8 * j + 1] = __builtin_elementwise_fma(__builtin_amdgcn_cvt_pk_f32_fp8((int)d0, true), a2, y2[8 * j + 1]);
        y2[8 * j + 2] = __builtin_elementwise_fma(__builtin_amdgcn_cvt_pk_f32_fp8((int)d1, false), a2, y2[8 * j + 2]); y2[8 * j + 3] = __builtin_elementwise_fma(__builtin_amdgcn_cvt_pk_f32_fp8((int)d1, true), a2, y2[8 * j + 3]);
        y2[8 * j + 4] = __builtin_elementwise_fma(__builtin_amdgcn_cvt_pk_f32_fp8((int)d2, false), a2, y2[8 * j + 4]); y2[8 * j + 5] = __builtin_elementwise_fma(__builtin_amdgcn_cvt_pk_f32_fp8((int)d2, true), a2, y2[8 * j + 5]);
        y2[8 * j + 6] = __builtin_elementwise_fma(__builtin_amdgcn_cvt_pk_f32_fp8((int)d3, false), a2, y2[8 * j + 6]); y2[8 * j + 7] = __builtin_elementwise_fma(__builtin_amdgcn_cvt_pk_f32_fp8((int)d3, true), a2, y2[8 * j + 7]);
    }
}
#define ROWLD8(dst, base, e) do { const u8* _p = (base) + (size_t)(e) * D + 16 * lane; dst[0] = gld16(_p); dst[1] = gld16(_p + 1024); } while (0)
__device__ __forceinline__ void peer_gather_fp8(float* hio, bf16* hb, float* hio_w, bf16* hb_w, const int* idx, const float* gate, const u8* TU8, const u8* TV8, const float* lg, const float* lb, int gw, int NGW, int lane_in) {
    for (int m = gw; m < M; m += NGW) {
        int lane = lane_in; asm volatile("" : "+v"(lane));
        float* row = hio + (size_t)m * D + 16 * lane;
        f32x2 x2[16];
#pragma unroll
        for (int j = 0; j < 2; ++j)
#pragma unroll
            for (int q = 0; q < 4; ++q) { const f32x4 t = *(const GAS f32x4*)(row + 1024 * j + 4 * q); x2[8 * j + 2 * q] = (f32x2){t.x, t.y}; x2[8 * j + 2 * q + 1] = (f32x2){t.z, t.w}; }
        const int i0 = *(const GAS int*)(idx + (size_t)m * 128 + lane), i1 = *(const GAS int*)(idx + (size_t)m * 128 + 64 + lane);
        f32x2 y2[16];
#pragma unroll
        for (int i = 0; i < 16; ++i) y2[i] = (f32x2){0.f, 0.f};
        v4u buf[4][2];
#pragma unroll
        for (int q = 0; q < 4; ++q) { const int e = __builtin_amdgcn_readlane(i0, q); ROWLD8(buf[q], TU8, e); }
        for (int hb_ = 0; hb_ < 8; ++hb_) {
            const int isel = (hb_ < 4) ? i0 : i1, inext = (hb_ + 1 < 4) ? i0 : i1;
            const int lb0 = (hb_ & 3) << 4, lbn = ((hb_ + 1) & 3) << 4;
            const float gt = *(const GAS float*)(gate + (size_t)m * 128 + hb_ * 16 + (lane & 15));
            float part[16];
#pragma unroll
            for (int kk = 0; kk < 16; ++kk) {
                part[kk] = udot8(buf[kk & 3], x2);
                if (kk + 4 < 16) { const int e = __builtin_amdgcn_readlane(isel, lb0 + kk + 4); ROWLD8(buf[kk & 3], TU8, e); }
                else { const int e = __builtin_amdgcn_readlane(isel, lb0 + kk + 4 - 16); ROWLD8(buf[kk & 3], TV8, e); }
                __builtin_amdgcn_sched_barrier(0);
            }
#pragma unroll
            for (int kk = 0; kk < 16; ++kk) { part[kk] += SHFL_XOR(part[kk], 32); part[kk] += SHFL_XOR(part[kk], 16); }
            {
                const bool b3 = (lane & 8) != 0, b2 = (lane & 4) != 0, b1 = (lane & 2) != 0, b0 = (lane & 1) != 0;
#pragma unroll
                for (int i = 0; i < 8; ++i) { const float send = b3 ? part[i] : part[i + 8], keep = b3 ? part[i + 8] : part[i]; part[i] = keep + SHFL_XOR(send, 8); }
#pragma unroll
                for (int i = 0; i < 4; ++i) { const float send = b2 ? part[i] : part[i + 4], keep = b2 ? part[i + 4] : part[i]; part[i] = keep + SHFL_XOR(send, 4); }
#pragma unroll
                for (int i = 0; i < 2; ++i) { const float send = b1 ? part[i] : part[i + 2], keep = b1 ? part[i + 2] : part[i]; part[i] = keep + SHFL_XOR(send, 2); }
                { const float send = b0 ? part[0] : part[1], keep = b0 ? part[1] : part[0]; part[0] = keep + SHFL_XOR(send, 1); }
            }
            const float act = gelu_f(part[0] * (1.f / TU_SCALE)) * gt * (1.f / TV_SCALE);
            const int acti = __builtin_bit_cast(int, act);
#pragma unroll
            for (int kk = 0; kk < 16; ++kk) {
                const float a = __builtin_bit_cast(float, __builtin_amdgcn_readlane(acti, kk));
                vacc8(buf[kk & 3], (f32x2){a, a}, y2);
                if (kk + 4 < 16) { const int e = __builtin_amdgcn_readlane(isel, lb0 + kk + 4); ROWLD8(buf[kk & 3], TV8, e); }
                else if (hb_ < 7) { const int e = __builtin_amdgcn_readlane(inext, lbn + kk + 4 - 16); ROWLD8(buf[kk & 3], TU8, e); }
                __builtin_amdgcn_sched_barrier(0);
            }
        }
        float s = 0.f;
#pragma unroll
        for (int i = 0; i < 16; ++i) { y2[i] = y2[i] + x2[i] * DN_ALPHA; s += y2[i].x + y2[i].y; }
        const float mean = wave_sum(s) * (1.f / D); float s2 = 0.f;
#pragma unroll
        for (int i = 0; i < 16; ++i) { y2[i] = y2[i] - mean; s2 += y2[i].x * y2[i].x + y2[i].y * y2[i].y; }
        const float rstd = 1.f / sqrtf(wave_sum(s2) * (1.f / D) + LN_EPS);
#pragma unroll
        for (int j = 0; j < 2; ++j)
#pragma unroll
            for (int q = 0; q < 4; ++q) { const int off = 1024 * j + 16 * lane + 4 * q;
                const f32x4 g4 = *(const GAS f32x4*)(lg + off), b4 = *(const GAS f32x4*)(lb + off);
                const f32x2 ya = y2[8 * j + 2 * q], yb = y2[8 * j + 2 * q + 1];
                f32x4 o; o.x = ya.x * rstd * g4.x + b4.x; o.y = ya.y * rstd * g4.y + b4.y; o.z = yb.x * rstd * g4.z + b4.z; o.w = yb.y * rstd * g4.w + b4.w;
                *(GAS f32x4*)(hio_w + (size_t)m * D + off) = o;
                v2u w; w.x = pk2(o.x, o.y); w.y = pk2(o.z, o.w); *(GAS v2u*)(hb_w + (size_t)m * D + off) = w; }
    }
}


__device__ __forceinline__ float wave_max(float v) {
    v = fmaxf(v, WDPP(v, 0xB1)); v = fmaxf(v, WDPP(v, 0x4E)); v = fmaxf(v, WDPP(v, 0x141)); v = fmaxf(v, WDPP(v, 0x140));
    return fmaxf(fmaxf(WRL(v, 0), WRL(v, 16)), fmaxf(WRL(v, 32), WRL(v, 48)));
}
__device__ __forceinline__ void cvt_rows_fp4(const float* src, u8* dst, float* scales, int nrows, int gw, int NGW, int lane) {
    for (int r0 = gw; r0 < nrows; r0 += 4 * NGW) {
        f32x4 v[4][8];
#pragma unroll
        for (int u = 0; u < 4; ++u) { const GAS f32x4* p = (const GAS f32x4*)(src + (size_t)(r0 + u * NGW) * D + 4 * lane);
#pragma unroll
            for (int q = 0; q < 8; ++q) v[u][q] = p[64 * q]; }
#pragma unroll
        for (int u = 0; u < 4; ++u) { const int r = r0 + u * NGW; float mx = 0.f;
#pragma unroll
            for (int q = 0; q < 8; ++q) mx = fmaxf(mx, fmaxf(fmaxf(__builtin_fabsf(v[u][q].x), __builtin_fabsf(v[u][q].y)), fmaxf(__builtin_fabsf(v[u][q].z), __builtin_fabsf(v[u][q].w))));
            mx = wave_max(mx);
            const float inv = mx > 0.f ? 6.f / mx : 0.f;
            const int lay = r / NEXP, e = r % NEXP;
#pragma unroll
            for (int q = 0; q < 8; ++q) { unsigned t = 0u; const f32x4 a = v[u][q] * inv;
                t = __builtin_amdgcn_cvt_scalef32_pk_fp4_f32(t, a.x, a.y, 1.0f, 0); t = __builtin_amdgcn_cvt_scalef32_pk_fp4_f32(t, a.z, a.w, 1.0f, 1);
                *(GAS unsigned short*)(dst + (((size_t)lay * 8 + q) * NEXP + e) * 128 + 2 * lane) = (unsigned short)(t & 0xffffu); }
            if (lane == 0) scales[r] = mx * (1.f / 6.f); }
    }
}
__device__ __forceinline__ float udot4(const v4u w, const f32x2 (&x2)[16]) {
    f32x2 a0 = {0.f, 0.f}, a1 = {0.f, 0.f};
    const unsigned d0 = w.x, d1 = w.y, d2 = w.z, d3 = w.w;
#define UD4(dw, k) a0 = __builtin_elementwise_fma(__builtin_amdgcn_cvt_scalef32_pk_f32_fp4(dw, 1.0f, 0), x2[4 * (k) + 0], a0); a1 = __builtin_elementwise_fma(__builtin_amdgcn_cvt_scalef32_pk_f32_fp4(dw, 1.0f, 1), x2[4 * (k) + 1], a1); \
                   a0 = __builtin_elementwise_fma(__builtin_amdgcn_cvt_scalef32_pk_f32_fp4(dw, 1.0f, 2), x2[4 * (k) + 2], a0); a1 = __builtin_elementwise_fma(__builtin_amdgcn_cvt_scalef32_pk_f32_fp4(dw, 1.0f, 3), x2[4 * (k) + 3], a1);
    UD4(d0, 0) UD4(d1, 1) UD4(d2, 2) UD4(d3, 3)
#undef UD4
    return (a0.x + a0.y) + (a1.x + a1.y);
}
__device__ __forceinline__ void vacc4(const v4u w, const f32x2 a2, f32x2 (&y2)[16]) {
    const unsigned d0 = w.x, d1 = w.y, d2 = w.z, d3 = w.w;
#define VA4(dw, k) y2[4 * (k) + 0] = __builtin_elementwise_fma(__builtin_amdgcn_cvt_scalef32_pk_f32_fp4(dw, 1.0f, 0), a2, y2[4 * (k) + 0]); y2[4 * (k) + 1] = __builtin_elementwise_fma(__builtin_amdgcn_cvt_scalef32_pk_f32_fp4(dw, 1.0f, 1), a2, y2[4 * (k) + 1]); \
                   y2[4 * (k) + 2] = __builtin_elementwise_fma(__builtin_amdgcn_cvt_scalef32_pk_f32_fp4(dw, 1.0f, 2), a2, y2[4 * (k) + 2]); y2[4 * (k) + 3] = __builtin_elementwise_fma(__builtin_amdgcn_cvt_scalef32_pk_f32_fp4(dw, 1.0f, 3), a2, y2[4 * (k) + 3]);
    VA4(d0, 0) VA4(d1, 1) VA4(d2, 2) VA4(d3, 3)
#undef VA4
}
#define ROWLD4(dst, base, e) do { dst = gld16((base) + (size_t)(e) * 1024 + 16 * lane); } while (0)
__device__ __forceinline__ void peer_gather_fp4(float* hio, bf16* hb, float* hio_w, bf16* hb_w, const int* idx, const float* gate, const u8* TU4, const u8* TV4, const float* SU, const float* SV,
                                                const float* lg, const float* lb, int gw, int NGW, int lane_in) {
    for (int m = gw; m < M; m += NGW) {
        int lane = lane_in; asm volatile("" : "+v"(lane));
        const float* row = hio + (size_t)m * D + 32 * lane;
        f32x2 x2[16];
#pragma unroll
        for (int q = 0; q < 8; ++q) { const f32x4 t = *(const GAS f32x4*)(row + 4 * q); x2[2 * q] = (f32x2){t.x, t.y}; x2[2 * q + 1] = (f32x2){t.z, t.w}; }
        const int i0 = *(const GAS int*)(idx + (size_t)m * 128 + lane), i1 = *(const GAS int*)(idx + (size_t)m * 128 + 64 + lane);
        f32x2 y2[16];
#pragma unroll
        for (int i = 0; i < 16; ++i) y2[i] = (f32x2){0.f, 0.f};
        v4u buf[8];
#pragma unroll
        for (int q = 0; q < 8; ++q) { const int e = __builtin_amdgcn_readlane(i0, q); ROWLD4(buf[q], TU4, e); }
        for (int hb_ = 0; hb_ < 8; ++hb_) {
            const int isel = (hb_ < 4) ? i0 : i1, inext = (hb_ + 1 < 4) ? i0 : i1;
            const int lb0 = (hb_ & 3) << 4, lbn = ((hb_ + 1) & 3) << 4;
            const float gt = *(const GAS float*)(gate + (size_t)m * 128 + hb_ * 16 + (lane & 15));
            const int ek = shfl_idx_lane(isel, lb0 + (lane & 15));
            const float su = *(const GAS float*)(SU + ek), sv = *(const GAS float*)(SV + ek);
            float part[16];
#pragma unroll
            for (int kk = 0; kk < 16; ++kk) {
                part[kk] = udot4(buf[kk & 7], x2);
                if (kk + 8 < 16) { const int e = __builtin_amdgcn_readlane(isel, lb0 + kk + 8); ROWLD4(buf[kk & 7], TU4, e); }
                else { const int e = __builtin_amdgcn_readlane(isel, lb0 + kk + 8 - 16); ROWLD4(buf[kk & 7], TV4, e); }
                __builtin_amdgcn_sched_barrier(0);
            }
#pragma unroll
            for (int kk = 0; kk < 16; ++kk) { part[kk] += SHFL_XOR(part[kk], 32); part[kk] += SHFL_XOR(part[kk], 16); }
            {
                const bool b3 = (lane & 8) != 0, b2 = (lane & 4) != 0, b1 = (lane & 2) != 0, b0 = (lane & 1) != 0;
#pragma unroll
                for (int i = 0; i < 8; ++i) { const float send = b3 ? part[i] : part[i + 8], keep = b3 ? part[i + 8] : part[i]; part[i] = keep + SHFL_XOR(send, 8); }
#pragma unroll
                for (int i = 0; i < 4; ++i) { const float send = b2 ? part[i] : part[i + 4], keep = b2 ? part[i + 4] : part[i]; part[i] = keep + SHFL_XOR(send, 4); }
#pragma unroll
                for (int i = 0; i < 2; ++i) { const float send = b1 ? part[i] : part[i + 2], keep = b1 ? part[i + 2] : part[i]; part[i] = keep + SHFL_XOR(send, 2); }
                { const float send = b0 ? part[0] : part[1], keep = b0 ? part[1] : part[0]; part[0] = keep + SHFL_XOR(send, 1); }
            }
            const float act = gelu_f(part[0] * su) * gt * sv;
            const int acti = __builtin_bit_cast(int, act);
#pragma unroll
            for (int kk = 0; kk < 16; ++kk) {
                const float a = __builtin_bit_cast(float, __builtin_amdgcn_readlane(acti, kk));
                vacc4(buf[kk & 7], (f32x2){a, a}, y2);
                if (kk + 8 < 16) { const int e = __builtin_amdgcn_readlane(isel, lb0 + kk + 8); ROWLD4(buf[kk & 7], TV4, e); }
                else if (hb_ < 7) { const int e = __builtin_amdgcn_readlane(inext, lbn + kk + 8 - 16); ROWLD4(buf[kk & 7], TU4, e); }
                __builtin_amdgcn_sched_barrier(0);
            }
        }
        float s = 0.f;
#pragma unroll
        for (int i = 0; i < 16; ++i) { y2[i] = y2[i] + x2[i] * DN_ALPHA; s += y2[i].x + y2[i].y; }
        const float mean = wave_sum(s) * (1.f / D); float s2 = 0.f;
#pragma unroll
        for (int i = 0; i < 16; ++i) { y2[i] = y2[i] - mean; s2 += y2[i].x * y2[i].x + y2[i].y * y2[i].y; }
        const float rstd = 1.f / sqrtf(wave_sum(s2) * (1.f / D) + LN_EPS);
#pragma unroll
        for (int q = 0; q < 8; ++q) { const int off = 32 * lane + 4 * q;
            const f32x4 g4 = *(const GAS f32x4*)(lg + off), b4 = *(const GAS f32x4*)(lb + off);
            const f32x2 ya = y2[2 * q], yb = y2[2 * q + 1];
            f32x4 o; o.x = ya.x * rstd * g4.x + b4.x; o.y = ya.y * rstd * g4.y + b4.y; o.z = yb.x * rstd * g4.z + b4.z; o.w = yb.y * rstd * g4.w + b4.w;
            *(GAS f32x4*)(hio_w + (size_t)m * D + off) = o;
            v2u w; w.x = pk2(o.x, o.y); w.y = pk2(o.z, o.w); *(GAS v2u*)(hb_w + (size_t)m * D + off) = w; }
    }
}


typedef _Float16 h16x2 __attribute__((ext_vector_type(2)));
#define CVT_H2_FP4(dw, b) __builtin_bit_cast(h16x2, __builtin_amdgcn_cvt_scalef32_pk_f16_fp4(dw, 1.0f, b))
__device__ __forceinline__ float udot4h(const v4u w, const h16x2 (&xh)[16]) {
    h16x2 a0 = {(_Float16)0.f, (_Float16)0.f}, a1 = {(_Float16)0.f, (_Float16)0.f};
    const unsigned d0 = w.x, d1 = w.y, d2 = w.z, d3 = w.w;
#define UD4H(dw, k) a0 = __builtin_elementwise_fma(CVT_H2_FP4(dw, 0), xh[4 * (k) + 0], a0); a1 = __builtin_elementwise_fma(CVT_H2_FP4(dw, 1), xh[4 * (k) + 1], a1); \
                    a0 = __builtin_elementwise_fma(CVT_H2_FP4(dw, 2), xh[4 * (k) + 2], a0); a1 = __builtin_elementwise_fma(CVT_H2_FP4(dw, 3), xh[4 * (k) + 3], a1);
    UD4H(d0, 0) UD4H(d1, 1) UD4H(d2, 2) UD4H(d3, 3)
#undef UD4H
    return ((float)a0.x + (float)a0.y) + ((float)a1.x + (float)a1.y);
}
__device__ __forceinline__ void vacc4h(const v4u w, const h16x2 a2, h16x2 (&yh)[16]) {
    const unsigned d0 = w.x, d1 = w.y, d2 = w.z, d3 = w.w;
#define VA4H(dw, k) yh[4 * (k) + 0] = __builtin_elementwise_fma(CVT_H2_FP4(dw, 0), a2, yh[4 * (k) + 0]); yh[4 * (k) + 1] = __builtin_elementwise_fma(CVT_H2_FP4(dw, 1), a2, yh[4 * (k) + 1]); \
                    yh[4 * (k) + 2] = __builtin_elementwise_fma(CVT_H2_FP4(dw, 2), a2, yh[4 * (k) + 2]); yh[4 * (k) + 3] = __builtin_elementwise_fma(CVT_H2_FP4(dw, 3), a2, yh[4 * (k) + 3]);
    VA4H(d0, 0) VA4H(d1, 1) VA4H(d2, 2) VA4H(d3, 3)
#undef VA4H
}

#define DPP_ADD(v, ctrl) ((v) + __builtin_bit_cast(float, __builtin_amdgcn_update_dpp(0, __builtin_bit_cast(int, (v)), (ctrl), 0xF, 0xF, true)))
#define LOAD_II16(dst, mm) do { const GAS v4u* _ip = (const GAS v4u*)(idx + (size_t)(mm) * 128 + 16 * eg); const v4u _a = _ip[0], _b = _ip[1], _c = _ip[2], _d = _ip[3]; \
    dst[0] = _a.x; dst[1] = _a.y; dst[2] = _a.z; dst[3] = _a.w; dst[4] = _b.x; dst[5] = _b.y; dst[6] = _b.z; dst[7] = _b.w; dst[8] = _c.x; dst[9] = _c.y; dst[10] = _c.z; dst[11] = _c.w; dst[12] = _d.x; dst[13] = _d.y; dst[14] = _d.z; dst[15] = _d.w; } while (0)
typedef int v8i_m __attribute__((ext_vector_type(8)));
#define U_QADD(keep, send, ctrl) ((keep) + __builtin_bit_cast(float, __builtin_amdgcn_update_dpp(0, __builtin_bit_cast(int, (send)), (ctrl), 0xF, 0xF, true)))
__device__ __forceinline__ void u_step(const u8* x4, const int* idx, const u8* tab, float* Ps, int m, int mn, int mnn, int eg, int aoff, int xoff, bool xval, bool b0, bool b1, int poff, int sc1, int scb,
                                       const v4u (&bufC)[16], const v4u& xC, const unsigned (&idxN)[16], v4u (&bufN)[16], v4u& xN, unsigned (&idxNN)[16]) {
#pragma unroll
    for (int t = 0; t < 16; ++t) bufN[t] = gld16(tab + (size_t)idxN[t] * 128 + aoff);
    xN = gld16(x4 + (size_t)mn * 2048 + xoff);
    LOAD_II16(idxNN, mnn);
    __builtin_amdgcn_sched_barrier(0);
    const v8i_m bx = {xval ? (int)xC.x : 0, xval ? (int)xC.y : 0, xval ? (int)xC.z : 0, xval ? (int)xC.w : 0, 0, 0, 0, 0};
    f32x4 acc[16];
#pragma unroll
    for (int t = 0; t < 16; ++t) { const v8i_m a8 = {(int)bufC[t].x, (int)bufC[t].y, (int)bufC[t].z, (int)bufC[t].w, 0, 0, 0, 0};
        acc[t] = __builtin_amdgcn_mfma_scale_f32_16x16x128_f8f6f4(a8, bx, (f32x4){0.f, 0.f, 0.f, 0.f}, 4, 4, 0, sc1, 0, scb); }
    float v[16];
#pragma unroll
    for (int t = 0; t < 16; ++t) { const float lo = b0 ? acc[t].y : acc[t].x, hi = b0 ? acc[t].w : acc[t].z; const float vv = b1 ? hi : lo; v[t] = U_QADD(vv, vv, 0x128); }
    float w[8];
#pragma unroll
    for (int i = 0; i < 8; ++i) { const float send = b0 ? v[i] : v[i + 8], keep = b0 ? v[i + 8] : v[i]; w[i] = U_QADD(keep, send, 0xB1); }
    f32x4 z;
#pragma unroll
    for (int i = 0; i < 4; ++i) { const float send = b1 ? w[i] : w[i + 4], keep = b1 ? w[i + 4] : w[i]; z[i] = U_QADD(keep, send, 0x4E); }
    if (poff >= 0) { const h16x2 zl = {(_Float16)z[0], (_Float16)z[1]}, zh = {(_Float16)z[2], (_Float16)z[3]};
        *(GAS v2u*)((_Float16*)Ps + (size_t)m * 128 + poff) = (v2u){__builtin_bit_cast(unsigned, zl), __builtin_bit_cast(unsigned, zh)}; }
    __builtin_amdgcn_sched_barrier(0);
}
__device__ __forceinline__ void peer_u_pass(const u8* x4, const int* idx, const u8* TUl, float* P, int bx, int G, int wave, int lane_in) {
    const int s = bx & 7, cu = bx >> 3, nW = (G >> 3) * NWAVES;
    const u8* tab = TUl + (size_t)s * NEXP * 128;
    float* Ps = (float*)((_Float16*)P + (size_t)s * M * 128);
    int lane = lane_in; asm volatile("" : "+v"(lane));
    const int n = lane & 15, kg = lane >> 4;
    const int eg = 2 * (n >> 2) + (kg >> 1);
    const int aoff = 16 * (4 * (kg & 1) + (n & 3));
    const int xoff = 128 * s + aoff + ((n & 8) ? 1024 : 0);
    const bool xval = (kg >> 1) == ((n >> 2) & 1);
    const bool b0 = (lane & 1) != 0, b1 = (lane & 2) != 0;
    const int poff = (n < 8) ? 16 * (2 * kg + (n >> 2)) + (b0 ? 8 : 0) + (b1 ? 4 : 0) : -1;
    const int m0 = cu * NWAVES + wave;
    int sc1 = 0x7F7F7F7F, sc8 = (n & 8) ? 0x7C7C7C7C : 0x7F7F7F7F; asm volatile("" : "+v"(sc1), "+v"(sc8));
    unsigned iiX[16], iiY[16]; v4u bufA[16], bufB[16]; v4u xA, xB;
    {   LOAD_II16(iiY, m0);
#pragma unroll
        for (int t = 0; t < 16; ++t) bufA[t] = gld16(tab + (size_t)iiY[t] * 128 + aoff);
        xA = gld16(x4 + (size_t)m0 * 2048 + xoff);
        const int m1 = (m0 + nW < M) ? m0 + nW : m0; LOAD_II16(iiX, m1); }
#define CLAMPM(x) (((x) < M) ? (x) : m0)
    for (int m = m0; m < M; m += 2 * nW) {
        u_step(x4, idx, tab, Ps, m, CLAMPM(m + nW), CLAMPM(m + 2 * nW), eg, aoff, xoff, xval, b0, b1, poff, sc1, sc8, bufA, xA, iiX, bufB, xB, iiY);
        u_step(x4, idx, tab, Ps, m + nW, CLAMPM(m + 2 * nW), CLAMPM(m + 3 * nW), eg, aoff, xoff, xval, b0, b1, poff, sc1, sc8, bufB, xB, iiY, bufA, xA, iiX);
    }
}
__device__ __forceinline__ void peer_act_phase(const float* P, const int* idx, float* gate, const float* SU, const float* SV, int gw, int NGW, int lane) {
    for (int m = gw; m < M; m += NGW) {
#pragma unroll
        for (int h = 0; h < 2; ++h) { const int k = 64 * h + lane;
            float z = 0.f;
#pragma unroll
            for (int sl = 0; sl < 8; ++sl) z += (float)*(const GAS _Float16*)((const _Float16*)P + ((size_t)sl * M + m) * 128 + k);
            const int e = *(const GAS int*)(idx + (size_t)m * 128 + k);
            const float su = *(const GAS float*)(SU + e), sv = *(const GAS float*)(SV + e), gt = *(const GAS float*)(gate + (size_t)m * 128 + k);
            *(GAS float*)(gate + (size_t)m * 128 + k) = gelu_f(z * su) * gt * sv; }
    }
}
#define LOAD_AA16(dst, mm) do { const GAS f32x4* _ap = (const GAS f32x4*)(act + (size_t)(mm) * 128 + 16 * eg); const f32x4 _a = _ap[0], _b = _ap[1], _c = _ap[2], _d = _ap[3]; \
    dst[0] = _a.x; dst[1] = _a.y; dst[2] = _a.z; dst[3] = _a.w; dst[4] = _b.x; dst[5] = _b.y; dst[6] = _b.z; dst[7] = _b.w; dst[8] = _c.x; dst[9] = _c.y; dst[10] = _c.z; dst[11] = _c.w; dst[12] = _d.x; dst[13] = _d.y; dst[14] = _d.z; dst[15] = _d.w; } while (0)
__device__ __forceinline__ void v_step(bf16* hio, const int* idx, const float* act, const u8* tab, const float* stats, const f32x4 lg, const f32x4 lb, int m, int mn, int mnn, int lane, int c, int eg, int coff, bool b0,
                                       const v4u (&bufC)[16], const float (&aaC)[16], const unsigned (&idxN)[16], v4u (&bufN)[16], float (&aaN)[16], unsigned (&idxNN)[16]) {
#pragma unroll
    for (int g = 0; g < 16; ++g) bufN[g] = gld16(tab + (size_t)idxN[g] * 128 + 16 * c);
    LOAD_AA16(aaN, mn);
    LOAD_II16(idxNN, mnn);
    bf16* op = hio + (size_t)m * D + coff;
    const v2u xw = *(const GAS v2u*)op;
    const f32x2 st = *(const GAS f32x2*)(stats + 2 * (size_t)m);
    __builtin_amdgcn_sched_barrier(0);
    h16x2 y2[16];
#pragma unroll
    for (int i = 0; i < 16; ++i) y2[i] = (h16x2){(_Float16)0.f, (_Float16)0.f};
#pragma unroll
    for (int g = 0; g < 16; ++g) { const _Float16 a = (_Float16)aaC[g]; vacc4h(bufC[g], (h16x2){a, a}, y2); }
#pragma unroll
    for (int i = 0; i < 8; ++i) { const h16x2 send = b0 ? y2[i] : y2[i + 8], keep = b0 ? y2[i + 8] : y2[i];
        y2[i] = keep + __builtin_bit_cast(h16x2, __builtin_amdgcn_update_dpp(0, __builtin_bit_cast(int, send), 0x128, 0xF, 0xF, true)); }
#pragma unroll
    for (int i = 0; i < 4; ++i) { const auto sw = __builtin_amdgcn_permlane16_swap(__builtin_bit_cast(unsigned, y2[i]), __builtin_bit_cast(unsigned, y2[i + 4]), false, false);
        const unsigned s0 = sw[0], s1 = sw[1]; y2[i] = __builtin_bit_cast(h16x2, s0) + __builtin_bit_cast(h16x2, s1); }
#pragma unroll
    for (int i = 0; i < 2; ++i) { const auto sw = __builtin_amdgcn_permlane32_swap(__builtin_bit_cast(unsigned, y2[i]), __builtin_bit_cast(unsigned, y2[i + 2]), false, false);
        const unsigned s0 = sw[0], s1 = sw[1]; y2[i] = __builtin_bit_cast(h16x2, s0) + __builtin_bit_cast(h16x2, s1); }
    const float x0 = (bflo(xw.x) - st.x) * st.y * lg.x + lb.x, x1 = (bfhi(xw.x) - st.x) * st.y * lg.y + lb.y, x2 = (bflo(xw.y) - st.x) * st.y * lg.z + lb.z, x3 = (bfhi(xw.y) - st.x) * st.y * lg.w + lb.w;
    v2u o; o.x = pk2(x0 * DN_ALPHA + (float)y2[0].x, x1 * DN_ALPHA + (float)y2[0].y); o.y = pk2(x2 * DN_ALPHA + (float)y2[1].x, x3 * DN_ALPHA + (float)y2[1].y);
    *(GAS v2u*)op = o;
    __builtin_amdgcn_sched_barrier(0);
}
__device__ __forceinline__ void peer_v_pass(bf16* hio, const int* idx, const float* act, const u8* TVl, const float* stats, const float* lng, const float* lnb, int bx, int G, int wave, int lane_in) {
    const int s = bx & 7, cu = bx >> 3, nW = (G >> 3) * NWAVES;
    const u8* tab = TVl + (size_t)s * NEXP * 128;
    int lane = lane_in; asm volatile("" : "+v"(lane));
    const int c = lane & 7, eg = lane >> 3;
    const bool b0 = (lane & 8) != 0, b1 = (lane & 16) != 0, b2 = (lane & 32) != 0;
    const int coff = 256 * s + 32 * c + (b0 ? 16 : 0) + (b1 ? 8 : 0) + (b2 ? 4 : 0);
    const int m0 = cu * NWAVES + wave;
    const f32x4 lg = *(const GAS f32x4*)(lng + coff), lb = *(const GAS f32x4*)(lnb + coff);
    unsigned iiX[16], iiY[16]; v4u bufA[16], bufB[16]; float aaA[16], aaB[16];
    {   LOAD_II16(iiY, m0);
#pragma unroll
        for (int g = 0; g < 16; ++g) bufA[g] = gld16(tab + (size_t)iiY[g] * 128 + 16 * c);
        LOAD_AA16(aaA, m0);
        const int m1 = (m0 + nW < M) ? m0 + nW : m0; LOAD_II16(iiX, m1); }
    for (int m = m0; m < M; m += 2 * nW) {
        v_step(hio, idx, act, tab, stats, lg, lb, m, CLAMPM(m + nW), CLAMPM(m + 2 * nW), lane, c, eg, coff, b0, bufA, aaA, iiX, bufB, aaB, iiY);
        v_step(hio, idx, act, tab, stats, lg, lb, m + nW, CLAMPM(m + 2 * nW), CLAMPM(m + 3 * nW), lane, c, eg, coff, b0, bufB, aaB, iiY, bufA, aaA, iiX);
    }
}

constexpr int N_SLOTS = 11;
struct Args { const float* in[31]; float* out; unsigned char* ws; int slot, layer, pad0, pad1; };

constexpr int TAB_OFF = MISC_OFF + 128;
__device__ __forceinline__ void store_tab(const Args& a, LAS unsigned char* lds) {
    if (threadIdx.x == 0) { LAS unsigned long long* t = (LAS unsigned long long*)(lds + TAB_OFF);
#pragma unroll
        for (int i = 0; i < 31; ++i) t[i] = (unsigned long long)a.in[i];
        t[31] = (unsigned long long)a.out; t[32] = (unsigned long long)a.ws; }
    __syncthreads();
}
struct Tab { unsigned tab;
    __device__ __forceinline__ unsigned long long raw(int k) const { const v2u v = *(const LAS v2u*)(tab + 8 * k);
        return ((unsigned long long)(unsigned)__builtin_amdgcn_readfirstlane((int)v.y) << 32) | (unsigned)__builtin_amdgcn_readfirstlane((int)v.x); }
    __device__ __forceinline__ const float* in(int k) const { return (const float*)raw(k); }
};
#define ARG_IN(k) T_.in(k)

template <int SLOT>
__device__ __forceinline__ void run_slot(LAS unsigned char* lds, int layer, int wave_s) {
    int tid = wave_s * 64 + lane_id(); asm volatile("" : "+v"(tid));
    Tab T_; T_.tab = (unsigned)(unsigned long long)(lds + TAB_OFF); asm volatile("" : "+s"(T_.tab));
    unsigned char* ws = (unsigned char*)T_.raw(32);
    const int lane = tid & 63, wave = __builtin_amdgcn_readfirstlane(tid >> 6);
    const int G = gridDim.x; const int bx = blockIdx.x; const int vcu = (G % 8 == 0) ? (bx % 8) * (G / 8) + bx / 8 : bx;
    const int gw = vcu * NWAVES + wave, NGW = G * NWAVES;
    const int gtid = vcu * (NWAVES * 64) + tid, gthreads = G * NWAVES * 64;
    const int kind = layer % 3, jj = layer / 3;
    float* hout = (float*)T_.raw(31);
    bf16* HB0 = (bf16*)(ws + WS_HB0); bf16* HB1 = (bf16*)(ws + WS_HB1);
    bf16* T1 = (bf16*)(ws + WS_T1); bf16* T2 = (bf16*)(ws + WS_T2); bf16* T3 = (bf16*)(ws + WS_T3);
    int* IDX = (int*)(ws + WS_IDX); float* GATE = (float*)(ws + WS_GATE);
    bf16* TU = (bf16*)(ws + WS_TU); bf16* TV = (bf16*)(ws + WS_TV); bf16* PB = (bf16*)(ws + WS_PB); bf16* SKB = (bf16*)(ws + WS_SK);
    bf16* Sin = (layer & 1) ? HB1 : HB0;
    bf16* Sout = (layer & 1) ? HB0 : HB1;

    if constexpr (SLOT == 0) {
        LAS float* scr = (LAS float*)(lds + wave * 16384); LAS unsigned* scr8 = (LAS unsigned*)(lds + wave * 16384); int woff = 0;
        for (int j = 0; j < 2; ++j) {
            transpose_mat8b(ARG_IN(6) + (size_t)j * D * D, D, D, ws + W_POOL_IN + (size_t)j * D * D, 0, scr8, gw, NGW, lane, woff);
            for (int g = 0; g < 4; ++g) transpose_mat8b(ARG_IN(7) + (size_t)(j * 4 + g) * 512 * 512, 512, 512, ws + W_POOL_GRP + (size_t)j * D * 512, g * 512, scr8, gw, NGW, lane, woff);
            transpose_mat8b(ARG_IN(9) + (size_t)j * D * D, D, D, ws + W_POOL_OUT + (size_t)j * D * D, 0, scr8, gw, NGW, lane, woff);
        }
        transpose_mat8b(ARG_IN(10), D, D, ws + W_SSM_IN, 0, scr8, gw, NGW, lane, woff);
        transpose_mat8b(ARG_IN(19), D, D, ws + W_SSM_GLU, 0, scr8, gw, NGW, lane, woff);
        transpose_mat8b(ARG_IN(20), D, D, ws + W_SSM_OUT, 0, scr8, gw, NGW, lane, woff);
        transpose_mat8b(ARG_IN(21), D, 3 * D, ws + W_ATTN_QKV, 0, scr8, gw, NGW, lane, woff);
        transpose_mat8b(ARG_IN(23), D, D, ws + W_ATTN_OUT, 0, scr8, gw, NGW, lane, woff);
        for (int i = 0; i < DEPTH; ++i) {
            transpose_mat8b(ARG_IN(24) + (size_t)i * D * D, D, D, ws + W_PEER_Q + (size_t)i * D * D, 0, scr8, gw, NGW, lane, woff);
            transpose_mat8b(ARG_IN(29) + (size_t)i * D * D, D, D, ws + W_PLE_GATE + (size_t)i * D * D, 0, scr8, gw, NGW, lane, woff);
            transpose_mat(ARG_IN(28) + (size_t)i * PLE * D, PLE, D, (bf16*)(ws + W_PLE_PROJ) + (size_t)i * PLE * D, 0, scr, gw, NGW, lane, woff);
        }
        cvt_rows_fp4(ARG_IN(26), (u8*)TU, (float*)(ws + WS_SU), DEPTH * NEXP, gw, NGW, lane);
        cvt_rows_fp4(ARG_IN(27), (u8*)TV, (float*)(ws + WS_SV), DEPTH * NEXP, gw, NGW, lane);
        cvt_rows(ARG_IN(1), PB, (size_t)DEPTH * M * PLE, (size_t)gtid, (size_t)gthreads);
        cvt_rows(ARG_IN(25), SKB, (size_t)DEPTH * 2 * 128 * 128, (size_t)gtid, (size_t)gthreads);
        {
            const float* xs = ARG_IN(0); unsigned char* s8 = ws + WS_S8;
            const size_t gs = (size_t)gthreads * 8;
            for (size_t i0 = (size_t)gtid * 8; i0 < (size_t)M * D; i0 += 4 * gs) {
                f32x4 a[4], b[4];
#pragma unroll
                for (int u = 0; u < 4; ++u) { a[u] = *(const GAS f32x4*)(xs + i0 + u * gs); b[u] = *(const GAS f32x4*)(xs + i0 + u * gs + 4); }
#pragma unroll
                for (int u = 0; u < 4; ++u) { const size_t i = i0 + u * gs;
                    v4u o; o.x = pk2(a[u].x, a[u].y); o.y = pk2(a[u].z, a[u].w); o.z = pk2(b[u].x, b[u].y); o.w = pk2(b[u].z, b[u].w);
                    *(GAS v4u*)(HB0 + i) = o;
                    int w0 = 0, w1 = 0;
                    w0 = __builtin_amdgcn_cvt_pk_fp8_f32(a[u].x, a[u].y, w0, false); w0 = __builtin_amdgcn_cvt_pk_fp8_f32(a[u].z, a[u].w, w0, true);
                    w1 = __builtin_amdgcn_cvt_pk_fp8_f32(b[u].x, b[u].y, w1, false); w1 = __builtin_amdgcn_cvt_pk_fp8_f32(b[u].z, b[u].w, w1, true);
                    v2u o8; o8.x = (unsigned)w0; o8.y = (unsigned)w1; *(GAS v2u*)(s8 + i) = o8; } } }
        {
            const float* lam_re = ARG_IN(11); const float* lam_im = ARG_IN(12); const float* log_step = ARG_IN(13); const float* b_re = ARG_IN(14); const float* b_im = ARG_IN(15);
            float* ssmp = (float*)(ws + WS_SSMP);
            for (int i = vcu + G * tid; i < 128 * 64; i += G * NWAVES * 64) { const int g = i >> 6;
                f32x4 brv[4], biv[4];
#pragma unroll
                for (int c = 0; c < 4; ++c) { brv[c] = *(const GAS f32x4*)(b_re + (size_t)i * 16 + 4 * c); biv[c] = *(const GAS f32x4*)(b_im + (size_t)i * 16 + 4 * c); }
                const float lr = *(const GAS float*)(lam_re + i), li = *(const GAS float*)(lam_im + i), dt = expf(*(const GAS float*)(log_step + g));
                const float mag = expf(dt * lr), ar = mag * cosf(dt * li), ai = mag * sinf(dt * li);
                const float den = lr * lr + li * li;
                const float kr = ((ar - 1.f) * lr + ai * li) / den, ki = (ai * lr - (ar - 1.f) * li) / den;
                GAS float* o = (GAS float*)ssmp + (size_t)i * 34; o[0] = ar; o[1] = ai;
#pragma unroll
                for (int c = 0; c < 16; ++c) { const float br = brv[c >> 2][c & 3], bi = biv[c >> 2][c & 3]; o[2 + c] = kr * br - ki * bi; o[18 + c] = kr * bi + ki * br; } }
        }
    }
    if constexpr (SLOT == 1) {
        pg8::StaticOrder S;
        if (kind == 2) {
            pg8::Gemm g{(const bf16*)(ws + WS_S8), (const bf16*)(ws + W_ATTN_QKV), M, 3 * D, D / 2, D / 2, 0}; S.init(M, 3 * D, G, bx);
            pg8::EpiBf16 E{T1, D, nullptr, D, (size_t)(WS_T2 - WS_T1) / 2, ATTN_QSCALE, nullptr, 1.f / W8S};
            pg8::gemm_phase<pg8::EpiBf16, true>(lds, g, S, E, tid);
        } else {
            const unsigned char* W = (kind == 0) ? ws + W_POOL_IN + (size_t)jj * D * D : ws + W_SSM_IN;
            pg8::Gemm g{(const bf16*)(ws + WS_S8), (const bf16*)W, M, D, D / 2, D / 2, 0}; S.init(M, D, G, bx);
            pg8::EpiBf16 E{T1, D, nullptr, 0, 0, 1.f, nullptr, 1.f / W8S};
            pg8::gemm_phase<pg8::EpiBf16, true>(lds, g, S, E, tid);
        }
    }
    if constexpr (SLOT == 2) {
        if (kind == 0) pool_phase(T1, (u8*)T2, gw, NGW, lane);
        else if (kind == 1) ssm_phase_m(T1, (u8*)T2, (const float*)(ws + WS_SSMP), ARG_IN(16), ARG_IN(17), ARG_IN(18), lds, vcu, G, wave, lane);
        else {
            LAS float* rb = (LAS float*)lds;
            for (int i = tid; i < 16 * 257; i += NWAVES * 64) rb[i] = ARG_IN(22)[i] * LOG2E;
            __syncthreads();
            attn_phase_split(T1, T2, T3, ws + WS_X8, rb, lds + 32768, vcu, G, wave, lane);
            __syncthreads();
        }
    }
    if constexpr (SLOT == 3) {
        pg8::StaticOrder S; S.init(M, D, G, bx);
        if (kind == 0) {
            pg8::Gemm g{(const bf16*)T2, (const bf16*)(ws + W_POOL_GRP + (size_t)jj * D * 512), M, D, 256, D / 2, 2};
            pg8::EpiF8 E{(unsigned char*)T1, D, ARG_IN(8) + (size_t)jj * D, 1.f / W8S};
            pg8::gemm_phase<pg8::EpiF8, true>(lds, g, S, E, tid);
        } else if (kind == 1) {
            pg8::Gemm g{(const bf16*)T2, (const bf16*)(ws + W_SSM_GLU), M, D, D / 2, D / 2, 0};
            pg8::EpiGlu8 E{(const unsigned char*)T2, (unsigned char*)T1, D, 1.f / W8S};
            pg8::gemm_phase<pg8::EpiGlu8, true>(lds, g, S, E, tid);
        }
    }
    if constexpr (SLOT == 4) {
        const unsigned char* W = (kind == 0) ? ws + W_POOL_OUT + (size_t)jj * D * D : (kind == 1) ? ws + W_SSM_OUT : ws + W_ATTN_OUT;
        pg8::Gemm g{(kind == 2) ? (const bf16*)(ws + WS_X8) : (const bf16*)T1, (const bf16*)W, M, D, D / 2, D / 2, 0}; pg8::StaticOrder S; S.init(M, D, G, bx);
        pg8::EpiRes E{Sin, Sin, D, DN_ALPHA, (kind == 2) ? 1.f / (W8S * O8S) : 1.f / W8S};
        pg8::gemm_phase<pg8::EpiRes, true>(lds, g, S, E, tid);
    }
    if constexpr (SLOT == 5) ln_phase<true>(Sin, ARG_IN(2) + (size_t)layer * D, ARG_IN(3) + (size_t)layer * D, gw, NGW, lane, ws + WS_X8, ws + WS_S8, (float*)(ws + WS_STATS));
    if constexpr (SLOT == 6) {
        { pg8::Gemm g{(const bf16*)(ws + WS_S8), (const bf16*)(ws + W_PEER_Q + (size_t)layer * D * D), M, D, D / 2, D / 2, 0}; pg8::StaticOrder S; S.init(M, D, G, bx);
          pg8::EpiBf16 E{T1, D, nullptr, 0, 0, 1.f, nullptr, 1.f / W8S};
          pg8::gemm_phase<pg8::EpiBf16, true>(lds, g, S, E, tid); }
    }
    if constexpr (SLOT == 14) {
        __syncthreads();
        { pg8::Gemm g{PB + (size_t)layer * M * PLE, (const bf16*)(ws + W_PLE_PROJ) + (size_t)layer * PLE * D, M, D, PLE, PLE, 0}; pg8::StaticOrder S; S.init(M, D, G, bx);
          pg8::EpiF8 E{(unsigned char*)T3, D, nullptr, 8.f};
          pg8::gemm_phase<pg8::EpiF8>(lds, g, S, E, tid); }
    }
    if constexpr (SLOT == 7) {
        const bf16* sk = SKB + (size_t)layer * 2 * 128 * 128;
        for (int i = tid; i < 256 * 16; i += NWAVES * 64) { const int rowi = i >> 4, ch = i & 15; *(LAS v4u*)(lds + rowi * 272 + ch * 16) = *(const v4u*)(sk + rowi * 128 + ch * 8); }
        __syncthreads();
        peer_select_phase(T1, lds, IDX, GATE, gw, NGW, lane);
        __syncthreads();
    }
    if constexpr (SLOT == 8) peer_u_pass(ws + WS_X8, IDX, (const u8*)TU + (size_t)layer * NEXP * 1024, (float*)T2, bx, G, wave, lane);
    if constexpr (SLOT == 11) peer_act_phase((const float*)T2, IDX, GATE, (const float*)(ws + WS_SU) + layer * NEXP, (const float*)(ws + WS_SV) + layer * NEXP, gw, NGW, lane);
    if constexpr (SLOT == 12) peer_v_pass(Sin, IDX, GATE, (const u8*)TV + (size_t)layer * NEXP * 1024, (const float*)(ws + WS_STATS), ARG_IN(2) + (size_t)layer * D, ARG_IN(3) + (size_t)layer * D, bx, G, wave, lane);
    if constexpr (SLOT == 13) ln_phase(Sin, ARG_IN(4) + (size_t)layer * D, ARG_IN(5) + (size_t)layer * D, gw, NGW, lane, ws + WS_X8);
    if constexpr (SLOT == 10) {
        pg8::Gemm g{(const bf16*)(ws + WS_X8), (const bf16*)(ws + W_PLE_GATE + (size_t)layer * D * D), M, D, D / 2, D / 2, 0}; pg8::StaticOrder S; S.init(M, D, G, bx);
        pg8::EpiPle E{Sin, (const unsigned char*)T3, Sout, ws + WS_S8, (layer == DEPTH - 1) ? hout : nullptr, ARG_IN(30) + (size_t)layer * D, D, 1.f / W8S};
        pg8::gemm_phase<pg8::EpiPle, true>(lds, g, S, E, tid);
    }
}

template <int SLOT>
__global__ void __launch_bounds__(NWAVES * 64, 2) mk_slot(Args args) {
    extern __shared__ __attribute__((aligned(16))) unsigned char lds_raw[];
    store_tab(args, (LAS unsigned char*)lds_raw);
    run_slot<SLOT>((LAS unsigned char*)lds_raw, args.layer, __builtin_amdgcn_readfirstlane((int)(threadIdx.x >> 6)));
}

#if !MK_PER_PHASE
__global__ void __launch_bounds__(NWAVES * 64, 2) mk_fwd(Args args) {
    extern __shared__ __attribute__((aligned(16))) unsigned char lds_raw[];
    LAS unsigned char* lds = (LAS unsigned char*)lds_raw;
    volatile LAS unsigned* MISC = (volatile LAS unsigned*)(lds + MISC_OFF);
    for (int u = threadIdx.x; u < (LDS_BYTES - LDSCTL_OFF) / 4; u += NWAVES * 64) ((LAS unsigned*)(lds + LDSCTL_OFF))[u] = 0u;
    __syncthreads();
    store_tab(args, lds);
    const XcdBarrier bar = xcd_barrier_post((unsigned*)(args.ws + WS_CTL) + CW_BAR, MISC + 8);
    run_slot<0>(lds, 0, bar.wave); xcd_barrier(bar);
    for (int layer = 0; layer < DEPTH; ++layer) {
        run_slot<1>(lds, layer, bar.wave); xcd_barrier(bar);
        run_slot<2>(lds, layer, bar.wave); xcd_barrier(bar);
        if (layer % 3 != 2) { run_slot<3>(lds, layer, bar.wave); xcd_barrier(bar); }
        run_slot<4>(lds, layer, bar.wave); xcd_barrier(bar);
        run_slot<5>(lds, layer, bar.wave); xcd_barrier(bar);
        run_slot<6>(lds, layer, bar.wave); run_slot<14>(lds, layer, bar.wave); xcd_barrier(bar);
        run_slot<7>(lds, layer, bar.wave); xcd_barrier(bar);
        run_slot<8>(lds, layer, bar.wave); xcd_barrier(bar);
        run_slot<11>(lds, layer, bar.wave); xcd_barrier(bar);
        run_slot<12>(lds, layer, bar.wave); xcd_barrier(bar);
        run_slot<13>(lds, layer, bar.wave); xcd_barrier(bar);
        run_slot<10>(lds, layer, bar.wave); if (layer + 1 < DEPTH) xcd_barrier(bar);
    }
}
#endif

template <int SLOT> static void launch_slot(const Args& a0, int layer, int grid, hipStream_t stream) {
    static bool attr_done = false;
    if (!attr_done) { (void)hipFuncSetAttribute((const void*)mk_slot<SLOT>, hipFuncAttributeMaxDynamicSharedMemorySize, LDS_BYTES); attr_done = true; }
    Args a = a0; a.slot = SLOT; a.layer = layer;
    hipLaunchKernelGGL(mk_slot<SLOT>, dim3(grid), dim3(NWAVES * 64), LDS_BYTES, stream, a);
}

extern "C" void kernel_launch(void* const* d_in, const int* in_sizes, int n_in, void* d_out, int out_size, void* d_ws, size_t ws_size, hipStream_t stream) {
    static int grid = 0;
    if (grid == 0) {
        if (n_in != 31 || out_size != M * D || ws_size < WS_END) { fprintf(stderr, "kernel_launch: unexpected shapes (n_in %d out %d ws %zu)\n", n_in, out_size, ws_size); grid = -1; return; }
        int dev = 0, cus = 0, per_cu = 0;
        if (hipGetDevice(&dev) != hipSuccess || hipDeviceGetAttribute(&cus, hipDeviceAttributeMultiprocessorCount, dev) != hipSuccess) { grid = -1; return; }
#if !MK_PER_PHASE
        if (hipFuncSetAttribute((const void*)mk_fwd, hipFuncAttributeMaxDynamicSharedMemorySize, LDS_BYTES) != hipSuccess) { fprintf(stderr, "kernel_launch: hipFuncSetAttribute failed\n"); grid = -1; return; }
        if (hipOccupancyMaxActiveBlocksPerMultiprocessor(&per_cu, (const void*)mk_fwd, NWAVES * 64, LDS_BYTES) != hipSuccess || per_cu < 1) { fprintf(stderr, "kernel_launch: occupancy query says %d\n", per_cu); }
        (void)hipGetLastError();
#endif
        (void)per_cu;
        grid = cus;
    }
    if (grid < 0) return;
    Args a{};
    for (int i = 0; i < 31; ++i) a.in[i] = (const float*)d_in[i];
    a.out = (float*)d_out; a.ws = (unsigned char*)d_ws;
#if MK_PER_PHASE
    launch_slot<0>(a, 0, grid, stream);
    for (int layer = 0; layer < DEPTH; ++layer) {
        launch_slot<1>(a, layer, grid, stream); launch_slot<2>(a, layer, grid, stream);
        if (layer % 3 != 2) launch_slot<3>(a, layer, grid, stream);
        launch_slot<4>(a, layer, grid, stream); launch_slot<5>(a, layer, grid, stream); launch_slot<6>(a, layer, grid, stream); launch_slot<14>(a, layer, grid, stream); launch_slot<7>(a, layer, grid, stream);
        launch_slot<8>(a, layer, grid, stream); launch_slot<11>(a, layer, grid, stream); launch_slot<12>(a, layer, grid, stream); launch_slot<13>(a, layer, grid, stream); launch_slot<10>(a, layer, grid, stream);
    }
#else
    if (hipMemsetAsync((char*)d_ws + WS_CTL, 0, CTL_ZERO_BYTES, stream) != hipSuccess) return;
    hipLaunchKernelGGL(mk_fwd, dim3(grid), dim3(NWAVES * 64), LDS_BYTES, stream, a);
#endif
}
```

```cpp
#include <hip/hip_runtime.h>
#include <cstdio>
#include <cstdint>

#ifndef MK_PER_PHASE
#define MK_PER_PHASE 0
#endif

namespace pg8 {
#define PG8_LAS __attribute__((address_space(3)))
typedef unsigned short bf16_t;
typedef short bf16x8 __attribute__((ext_vector_type(8)));
typedef float f32x4 __attribute__((ext_vector_type(4)));
typedef unsigned u32x4 __attribute__((ext_vector_type(4)));
constexpr int BM = 256, BK = 64, HALF = 128, HTB = HALF * BK * 2, STAGE_BYTES = 8 * HTB, NXCD = 8, WGM = 8;

__host__ __device__ __forceinline__ int lds_byte(int r, int c) { const int st = (r >> 4) * 2 + (c >> 5), rr = r & 15, cc = c & 31, ob = rr * 64 + cc * 2; return st * 1024 + (ob ^ (((ob >> 9) & 1) << 5)); }
__host__ __device__ __forceinline__ int lds_byte8(int r, int c) { const int st = (r >> 4) * 2 + (c >> 5), rr = r & 15, cc = c & 31, ob = rr * 64 + cc * 2; return st * 1024 + (ob ^ (((ob >> 9) & 1) << 5) ^ (((ob >> 8) & 1) << 4)); }
__host__ __device__ __forceinline__ void stage_rc8(int b, int& R, int& C) { const int st = b / 1024, sb = b % 1024, swz = sb ^ (((sb >> 9) & 1) << 5) ^ (((sb >> 8) & 1) << 4); R = (st >> 1) * 16 + swz / 64; C = (st & 1) * 32 + (swz % 64) / 2; }
__host__ __device__ __forceinline__ void stage_rc(int b, int& R, int& C) { const int st = b / 1024, sb = b % 1024, swz = sb ^ (((sb >> 9) & 1) << 5); R = (st >> 1) * 16 + swz / 64; C = (st & 1) * 32 + (swz % 64) / 2; }
__host__ __device__ __forceinline__ int perm32(int rho) { const int n = rho >> 4, i = rho & 15; return 8 * (i >> 2) + 4 * n + (i & 3); }
__host__ __device__ __forceinline__ int perm32f8(int rho) { return 16 * ((rho >> 2) & 1) + (rho & 3) + 4 * (rho >> 3); }

__device__ __forceinline__ int lane_now() { int l; asm volatile("v_mbcnt_lo_u32_b32 %0, -1, 0\n\tv_mbcnt_hi_u32_b32 %0, -1, %0" : "=v"(l)); return l; }
struct Unit { int pm, pn; };
struct Gemm { const bf16_t* A; const bf16_t* Bt; int M, N, K, lda, agrp; };

struct StaticOrder {
    int nM, nN, nwg, G, c;
    __host__ __device__ void init(int M, int N, int G_, int c_) { nM = M / BM; nN = N / BM; nwg = nM * nN; G = G_; c = c_; }
    __host__ __device__ bool next(int i, Unit& u) const {
        const long L = (long)i * G + c; if (L >= nwg) return false;
        int wgid = (int)L; { const int q = nwg / NXCD, r = nwg % NXCD, xcd = wgid % NXCD, off = wgid / NXCD; wgid = (xcd < r ? xcd * (q + 1) : r * (q + 1) + (xcd - r) * q) + off; }
        const int nig = WGM * nN, gid = wgid / nig, fm = gid * WGM, gsz = (nM - fm) < WGM ? (nM - fm) : WGM;
        u.pm = fm + ((wgid % nig) % gsz); u.pn = (wgid % nig) / gsz; return true;
    }
};

__device__ __forceinline__ unsigned cvt_pk_bf16(float lo, float hi) { unsigned r; asm volatile("v_cvt_pk_bf16_f32 %0, %1, %2" : "=v"(r) : "v"(lo), "v"(hi)); return r; }
__device__ __forceinline__ float bf_lo(unsigned w) { return __builtin_bit_cast(float, w << 16); }
__device__ __forceinline__ float bf_hi(unsigned w) { return __builtin_bit_cast(float, w & 0xffff0000u); }
__device__ __forceinline__ float sigmoid_f(float x) { return __builtin_amdgcn_rcpf(1.f + __builtin_amdgcn_exp2f(-1.4426950408889634f * x)); }
#ifdef DBG_PLE_HALF
__device__ __forceinline__ float sigmoid_p(float x) { return 0.5f; }
#else
__device__ __forceinline__ float sigmoid_p(float x) { return sigmoid_f(x); }
#endif

typedef int v8i_t __attribute__((ext_vector_type(8)));
typedef unsigned u32x2 __attribute__((ext_vector_type(2)));
typedef float f32x16 __attribute__((ext_vector_type(16)));
typedef float f32x2_ __attribute__((ext_vector_type(2)));
__device__ __forceinline__ u32x2 pack8_fp8(const f32x4 v0, const f32x4 v1) {
    int a = 0, b = 0;
    a = __builtin_amdgcn_cvt_pk_fp8_f32(v0[0], v0[1], a, false); a = __builtin_amdgcn_cvt_pk_fp8_f32(v0[2], v0[3], a, true);
    b = __builtin_amdgcn_cvt_pk_fp8_f32(v1[0], v1[1], b, false); b = __builtin_amdgcn_cvt_pk_fp8_f32(v1[2], v1[3], b, true);
    return (u32x2){(unsigned)a, (unsigned)b};
}
__device__ __forceinline__ u32x4 pack8_bf16(const f32x4 v0, const f32x4 v1) { u32x4 w; w.x = cvt_pk_bf16(v0[0], v0[1]); w.y = cvt_pk_bf16(v0[2], v0[3]); w.z = cvt_pk_bf16(v1[0], v1[1]); w.w = cvt_pk_bf16(v1[2], v1[3]); return w; }
struct EpiBf16 {
    bf16_t* O; int ldc; const float* cscale; int split_cols; size_t split_stride; float scale0; bf16_t* VT; float oscale;
    __device__ __forceinline__ void chunk(int row, int col, f32x4 v0, f32x4 v1) const {
        if (cscale) { v0 = v0 * *(const f32x4*)(cscale + col); v1 = v1 * *(const f32x4*)(cscale + col + 4); }
        if (!split_cols) { *(u32x4*)(O + (size_t)row * ldc + col) = pack8_bf16(v0 * oscale, v1 * oscale); return; }
        const int t = col / split_cols, c = col - t * split_cols, hd = c >> 7, d = c & 127, b = row >> 13, sq = row & 8191;
        const float sc = (t == 0) ? oscale * scale0 : oscale;
        const u32x4 w = pack8_bf16(v0 * sc, v1 * sc);
        bf16_t* base = O + (size_t)t * split_stride;
        const size_t bh = (size_t)(b * 16 + hd) * 256 + (sq >> 5);
        if (t < 2) *(u32x4*)(base + ((bh * 8 + (d >> 4)) * 512) + (size_t)((sq & 31) + 32 * ((d >> 3) & 1)) * 8) = w;
        else { const int kk = sq & 31, k16 = kk & 15; bf16_t* p = base + ((((bh * 4 + (d >> 5)) * 2 + (kk >> 4)) * 512) + (size_t)((d & 31) + 32 * ((k16 >> 2) & 1)) * 8) + (k16 & 3) + 4 * (k16 >> 3);
            p[0] = (bf16_t)(w.x & 0xffffu); p[8] = (bf16_t)(w.x >> 16); p[16] = (bf16_t)(w.y & 0xffffu); p[24] = (bf16_t)(w.y >> 16);
            p[32] = (bf16_t)(w.z & 0xffffu); p[40] = (bf16_t)(w.z >> 16); p[48] = (bf16_t)(w.w & 0xffffu); p[56] = (bf16_t)(w.w >> 16); }
    }
};
struct EpiF8 {
    unsigned char* O; int ldc; const float* cscale; float oscale;
    __device__ __forceinline__ void chunk(int row, int col, f32x4 v0, f32x4 v1) const {
        if (cscale) { v0 = v0 * *(const f32x4*)(cscale + col); v1 = v1 * *(const f32x4*)(cscale + col + 4); }
        *(u32x2*)(O + (size_t)row * ldc + col) = pack8_fp8(v0 * oscale, v1 * oscale);
    }
    struct Pre { f32x4 c0, c1; };
    __device__ __forceinline__ Pre pre(int row, int col) const { Pre p; p.c0 = (f32x4){1.f, 1.f, 1.f, 1.f}; p.c1 = p.c0;
        if (cscale) { p.c0 = *(const __attribute__((address_space(1))) f32x4*)(cscale + col); p.c1 = *(const __attribute__((address_space(1))) f32x4*)(cscale + col + 4); } return p; }
    __device__ __forceinline__ void fin(int row, int col, f32x4 v0, f32x4 v1, const Pre& p) const {
        if (cscale) { v0 = v0 * p.c0; v1 = v1 * p.c1; }
        *(__attribute__((address_space(1))) u32x2*)(O + (size_t)row * ldc + col) = pack8_fp8(v0 * oscale, v1 * oscale);
    }
};
#define PG8_GAS __attribute__((address_space(1)))
struct EpiGlu8 {
    const unsigned char* Gin; unsigned char* O; int ld; float oscale;
    typedef u32x2 Pre;
    __device__ __forceinline__ Pre pre(int row, int col) const { return *(const PG8_GAS u32x2*)(Gin + (size_t)row * ld + col); }
    __device__ __forceinline__ void fin(int row, int col, f32x4 a0, f32x4 a1, const Pre g) const {
        const size_t ro = (size_t)row * ld + col; a0 = a0 * oscale; a1 = a1 * oscale;
        const unsigned gx = g.x, gy = g.y;
        const f32x2_ g01 = __builtin_amdgcn_cvt_pk_f32_fp8((int)gx, false), g23 = __builtin_amdgcn_cvt_pk_f32_fp8((int)gx, true), g45 = __builtin_amdgcn_cvt_pk_f32_fp8((int)gy, false), g67 = __builtin_amdgcn_cvt_pk_f32_fp8((int)gy, true);
        const f32x4 o0 = {g01.x * sigmoid_f(a0[0]), g01.y * sigmoid_f(a0[1]), g23.x * sigmoid_f(a0[2]), g23.y * sigmoid_f(a0[3])};
        const f32x4 o1 = {g45.x * sigmoid_f(a1[0]), g45.y * sigmoid_f(a1[1]), g67.x * sigmoid_f(a1[2]), g67.y * sigmoid_f(a1[3])};
        *(PG8_GAS u32x2*)(O + ro) = pack8_fp8(o0, o1);
    }
};
struct EpiRes {
    const bf16_t* hres; bf16_t* out; int ld; float alpha; float mscale;
    typedef u32x4 Pre;
    __device__ __forceinline__ Pre pre(int row, int col) const { return *(const PG8_GAS u32x4*)(hres + (size_t)row * ld + col); }
    __device__ __forceinline__ void fin(int row, int col, f32x4 a0, f32x4 a1, const Pre h) const {
        const size_t ro = (size_t)row * ld + col; a0 = a0 * mscale; a1 = a1 * mscale;
        const f32x4 o0 = {bf_lo(h.x) * alpha + a0[0], bf_hi(h.x) * alpha + a0[1], bf_lo(h.y) * alpha + a0[2], bf_hi(h.y) * alpha + a0[3]};
        const f32x4 o1 = {bf_lo(h.z) * alpha + a1[0], bf_hi(h.z) * alpha + a1[1], bf_lo(h.w) * alpha + a1[2], bf_hi(h.w) * alpha + a1[3]};
        *(PG8_GAS u32x4*)(out + ro) = pack8_bf16(o0, o1);
    }
};
struct EpiPle {
    const bf16_t* hin; const unsigned char* proj; bf16_t* hob; unsigned char* ho8; float* fout; const float* bias; int ld; float oscale;
    struct Pre { u32x2 pj8; u32x4 hh; f32x4 b0, b1; };
    __device__ __forceinline__ Pre pre(int row, int col) const { const size_t ro = (size_t)row * ld + col; Pre p; p.pj8 = *(const PG8_GAS u32x2*)(proj + ro); p.hh = *(const PG8_GAS u32x4*)(hin + ro);
        p.b0 = *(const PG8_GAS f32x4*)(bias + col); p.b1 = *(const PG8_GAS f32x4*)(bias + col + 4); return p; }
    __device__ __forceinline__ void fin(int row, int col, f32x4 a0, f32x4 a1, const Pre& p) const {
        const size_t ro = (size_t)row * ld + col; const u32x2 pj8 = p.pj8; const u32x4 hh = p.hh;
        const unsigned pjx = pj8.x, pjy = pj8.y;
        const f32x2_ q01 = __builtin_amdgcn_cvt_pk_f32_fp8((int)pjx, false), q23 = __builtin_amdgcn_cvt_pk_f32_fp8((int)pjx, true), q45 = __builtin_amdgcn_cvt_pk_f32_fp8((int)pjy, false), q67 = __builtin_amdgcn_cvt_pk_f32_fp8((int)pjy, true);
        const float pjs = 1.f / 8.f;
        const float p0 = q01.x * pjs, p1 = q01.y * pjs, p2 = q23.x * pjs, p3 = q23.y * pjs, p4 = q45.x * pjs, p5 = q45.y * pjs, p6 = q67.x * pjs, p7 = q67.y * pjs;
        a0 = a0 * oscale + p.b0; a1 = a1 * oscale + p.b1;
        f32x4 h0, h1;
        h0[0] = bf_lo(hh.x) + sigmoid_p(a0[0]) * p0; h0[1] = bf_hi(hh.x) + sigmoid_p(a0[1]) * p1; h0[2] = bf_lo(hh.y) + sigmoid_p(a0[2]) * p2; h0[3] = bf_hi(hh.y) + sigmoid_p(a0[3]) * p3;
        h1[0] = bf_lo(hh.z) + sigmoid_p(a1[0]) * p4; h1[1] = bf_hi(hh.z) + sigmoid_p(a1[1]) * p5; h1[2] = bf_lo(hh.w) + sigmoid_p(a1[2]) * p6; h1[3] = bf_hi(hh.w) + sigmoid_p(a1[3]) * p7;
        if (fout != nullptr) { *(PG8_GAS f32x4*)(fout + ro) = h0; *(PG8_GAS f32x4*)(fout + ro + 4) = h1; }
        else { *(PG8_GAS u32x4*)(hob + ro) = pack8_bf16(h0, h1); *(PG8_GAS u32x2*)(ho8 + ro) = pack8_fp8(h0, h1); }
    }
};

template <class E, class = void> struct HasPre { static constexpr bool value = false; };
template <class E> struct HasPre<E, decltype((void)sizeof(typename E::Pre))> { static constexpr bool value = true; };
template <class Epi, bool F8 = false>
__device__ __forceinline__ void gemm_phase(PG8_LAS unsigned char* lds, const Gemm g, const StaticOrder& S, const Epi& E, const int tid) {
    const int wid = __builtin_amdgcn_readfirstlane(tid >> 6), lane = tid & 63, wr = wid >> 2, wc = wid & 3, fr = lane & 15, fq = lane >> 4;
    const int K = g.K, nt = K / BK, lda = g.lda;
    unsigned voffA[2], voffB[2];
#pragma unroll
    for (int i = 0; i < 2; ++i) { int R, C; if (F8) stage_rc8(tid * 16 + i * 8192, R, C); else stage_rc(tid * 16 + i * 8192, R, C); const int Rb = (R & ~31) + (F8 ? perm32f8(R & 31) : perm32(R & 31));
        voffA[i] = (unsigned)(R * lda + C) * 2u; voffB[i] = (unsigned)(Rb * K + C) * 2u; }
    const size_t kstep = (size_t)(BK * 2);
    const size_t hstepA = (size_t)HALF * lda * 2, hstepB = (size_t)HALF * K * 2;
    const size_t tstepA = 2 * hstepA, tstepB = 2 * hstepB;
    const unsigned ldsw = (unsigned)wid * 1024u;
    const int l31 = lane & 31, h32 = lane >> 5;
    const int aoff = F8 ? lds_byte8(wr * 64 + l31, 16 * h32) : lds_byte(wr * 64 + fr, fq * 8);
    const int boff = F8 ? lds_byte8(wc * 32 + l31, 16 * h32) : lds_byte(wc * 32 + fr, fq * 8);
    const int aoffx = aoff ^ 16, boffx = boff ^ 16;
#define PG8_SA(b, h) (((b) * 2 + (h)) * HTB)
#define PG8_SB(b, h) ((4 + (b) * 2 + (h)) * HTB)
#define PG8_STAGE(bufoff, gbase, voff) do { _Pragma("unroll") for (int _i = 0; _i < 2; ++_i) \
        __builtin_amdgcn_global_load_lds((const unsigned*)((const char*)(gbase) + (voff)[_i]), (PG8_LAS unsigned*)(lds + (bufoff) + ldsw + _i * 8192), 16, 0, 0); } while (0)
#define PG8_LD32(dst, off, offx) do { typedef int _v4i __attribute__((ext_vector_type(4))); const _v4i _lo = *(const PG8_LAS _v4i*)(lds + (off)), _hi = *(const PG8_LAS _v4i*)(lds + (offx)); \
        dst = __builtin_shufflevector(_lo, _hi, 0, 1, 2, 3, 4, 5, 6, 7); } while (0)
#define PG8_LDA(dst, b, h) do { if constexpr (F8) { _Pragma("unroll") for (int m2 = 0; m2 < 2; ++m2) _Pragma("unroll") for (int ks = 0; ks < 2; ++ks) PG8_LD32(dst##8[m2][ks], PG8_SA(b, h) + aoff + m2 * 4096 + ks * 1024, PG8_SA(b, h) + aoffx + m2 * 4096 + ks * 1024); } \
        else { _Pragma("unroll") for (int m = 0; m < 4; ++m) _Pragma("unroll") for (int k = 0; k < 2; ++k) dst[m][k] = *(const PG8_LAS bf16x8*)(lds + PG8_SA(b, h) + aoff + m * 2048 + k * 1024); } } while (0)
#define PG8_LDB(dst, b, h) do { if constexpr (F8) { _Pragma("unroll") for (int ks = 0; ks < 2; ++ks) PG8_LD32(dst##8[ks], PG8_SB(b, h) + boff + ks * 1024, PG8_SB(b, h) + boffx + ks * 1024); } \
        else { _Pragma("unroll") for (int n = 0; n < 2; ++n) _Pragma("unroll") for (int k = 0; k < 2; ++k) dst[n][k] = *(const PG8_LAS bf16x8*)(lds + PG8_SB(b, h) + boff + n * 2048 + k * 1024); } } while (0)
#define PG8_MMA(ai, bj, At, Bt) do { __builtin_amdgcn_s_setprio(1); \
        if constexpr (F8) { _Pragma("unroll") for (int m2 = 0; m2 < 2; ++m2) _Pragma("unroll") for (int ks = 0; ks < 2; ++ks) \
            acc32[ai][bj][m2] = __builtin_amdgcn_mfma_scale_f32_32x32x64_f8f6f4(Bt##8[ks], At##8[m2][ks], acc32[ai][bj][m2], 0, 0, 0, 0, 0, 0); } \
        else { _Pragma("unroll") for (int m = 0; m < 4; ++m) _Pragma("unroll") for (int n = 0; n < 2; ++n) _Pragma("unroll") for (int k = 0; k < 2; ++k) \
            acc[ai][bj][m][n] = __builtin_amdgcn_mfma_f32_16x16x32_bf16(Bt[n][k], At[m][k], acc[ai][bj][m][n], 0, 0, 0); } \
        __builtin_amdgcn_s_setprio(0); } while (0)
#define PG8_WAIT_V(n) asm volatile("s_waitcnt vmcnt(" #n ")" ::: "memory")
#define PG8_WAIT_L(n) asm volatile("s_waitcnt lgkmcnt(" #n ")" ::: "memory")
#define PG8_BAR __builtin_amdgcn_s_barrier()
#define PG8_SCHED __builtin_amdgcn_sched_barrier(0)
#define PG8_ACOL(u) ((g.agrp > 0) ? (size_t)((u).pn / g.agrp) * (size_t)K * 2 : (size_t)0)
    Unit cur, nxt; int ui = 0;
    if (!S.next(0, cur)) return;
    f32x4 acc[2][2][4][2];
#pragma unroll
    for (int a = 0; a < 2; ++a)
#pragma unroll
        for (int b = 0; b < 2; ++b)
#pragma unroll
            for (int m = 0; m < 4; ++m)
#pragma unroll
                for (int n = 0; n < 2; ++n) acc[a][b][m][n] = (f32x4){0.f, 0.f, 0.f, 0.f};
    bf16x8 At[4][2], B0[2][2], B1[2][2];
    v8i_t At8[2][2], B08[2], B18[2];
    f32x16 acc32[2][2][2];
#pragma unroll
    for (int a = 0; a < 2; ++a)
#pragma unroll
        for (int b = 0; b < 2; ++b)
#pragma unroll
            for (int m2 = 0; m2 < 2; ++m2)
#pragma unroll
                for (int i = 0; i < 16; ++i) acc32[a][b][m2][i] = 0.f;
    const char* cA = (const char*)g.A + (size_t)cur.pm * tstepA + PG8_ACOL(cur); const char* cB = (const char*)g.Bt + (size_t)cur.pn * tstepB;
    PG8_STAGE(PG8_SB(0, 0), cB, voffB); PG8_STAGE(PG8_SB(0, 1), cB + hstepB, voffB); PG8_STAGE(PG8_SA(0, 0), cA, voffA); PG8_STAGE(PG8_SA(0, 1), cA + hstepA, voffA);
    if (wr == 1) PG8_BAR;
    PG8_WAIT_V(2); PG8_BAR;
    PG8_STAGE(PG8_SB(1, 0), cB + kstep, voffB); PG8_STAGE(PG8_SA(1, 0), cA + kstep, voffA); PG8_STAGE(PG8_SB(1, 1), cB + hstepB + kstep, voffB);
    PG8_WAIT_V(6); PG8_BAR;
    for (;;) {
        const bool has_next = S.next(ui + 1, nxt);
        const char* nA = has_next ? (const char*)g.A + (size_t)nxt.pm * tstepA + PG8_ACOL(nxt) : cA; const char* nB = has_next ? (const char*)g.Bt + (size_t)nxt.pn * tstepB : cB;
        for (int t = 0; t < nt; t += 2) {
            const bool last = (t == nt - 2);
            const char* a1 = cA + (size_t)(t + 1) * kstep;
            const char* a2 = last ? nA : cA + (size_t)(t + 2) * kstep; const char* b2 = last ? nB : cB + (size_t)(t + 2) * kstep;
            const char* a3 = a2 + kstep; const char* b3 = b2 + kstep;
            PG8_LDB(B0, 0, 0); PG8_LDB(B1, 0, 1); PG8_SCHED; PG8_LDA(At, 0, 0); PG8_STAGE(PG8_SA(1, 1), a1 + hstepA, voffA);
            PG8_WAIT_V(8); PG8_WAIT_L(0); PG8_BAR; PG8_MMA(0, 0, At, B0); PG8_MMA(0, 1, At, B1); PG8_BAR; PG8_SCHED;
            PG8_LDA(At, 0, 1); PG8_STAGE(PG8_SB(0, 0), b2, voffB); PG8_STAGE(PG8_SB(0, 1), b2 + hstepB, voffB); PG8_STAGE(PG8_SA(0, 0), a2, voffA);
            PG8_WAIT_V(8); PG8_WAIT_L(0); PG8_BAR; PG8_MMA(1, 0, At, B0); PG8_MMA(1, 1, At, B1); PG8_BAR; PG8_SCHED;
            PG8_LDB(B0, 1, 0); PG8_LDB(B1, 1, 1); PG8_SCHED; PG8_LDA(At, 1, 0); PG8_STAGE(PG8_SA(0, 1), a2 + hstepA, voffA);
            PG8_WAIT_V(8); PG8_WAIT_L(0); PG8_BAR; PG8_MMA(0, 0, At, B0); PG8_MMA(0, 1, At, B1); PG8_BAR; PG8_SCHED;
            PG8_LDA(At, 1, 1); PG8_STAGE(PG8_SB(1, 0), b3, voffB); PG8_STAGE(PG8_SB(1, 1), b3 + hstepB, voffB); PG8_STAGE(PG8_SA(1, 0), a3, voffA);
            PG8_WAIT_V(8); PG8_WAIT_L(0); PG8_BAR; PG8_MMA(1, 0, At, B0); PG8_MMA(1, 1, At, B1); PG8_BAR; PG8_SCHED;
        }
        if (wr == 0) PG8_BAR;
        if constexpr (F8) {
            const int lnE = lane_now(); const int rowF = cur.pm * BM + wr * 64 + (lnE & 31), colF = cur.pn * BM + wc * 32 + 16 * (lnE >> 5);
            if constexpr (HasPre<Epi>::value) {
#pragma unroll
                for (int a = 0; a < 2; ++a)
#pragma unroll
                    for (int m2 = 0; m2 < 2; ++m2) { const int rowG = rowF + a * HALF + 32 * m2;
                        typename Epi::Pre pq[4];
#pragma unroll
                        for (int b = 0; b < 2; ++b) { pq[2 * b] = E.pre(rowG, colF + b * HALF); pq[2 * b + 1] = E.pre(rowG, colF + b * HALF + 8); }
                        __builtin_amdgcn_sched_barrier(0);
#pragma unroll
                        for (int b = 0; b < 2; ++b) { const f32x16 v = acc32[a][b][m2];
                            E.fin(rowG, colF + b * HALF, (f32x4){v[0], v[1], v[2], v[3]}, (f32x4){v[4], v[5], v[6], v[7]}, pq[2 * b]);
                            E.fin(rowG, colF + b * HALF + 8, (f32x4){v[8], v[9], v[10], v[11]}, (f32x4){v[12], v[13], v[14], v[15]}, pq[2 * b + 1]);
#pragma unroll
                            for (int i = 0; i < 16; ++i) acc32[a][b][m2][i] = 0.f; }
                        __builtin_amdgcn_sched_barrier(0); }
            } else {
#pragma unroll
            for (int a = 0; a < 2; ++a)
#pragma unroll
                for (int m2 = 0; m2 < 2; ++m2)
#pragma unroll
                    for (int b = 0; b < 2; ++b) { const f32x16 v = acc32[a][b][m2];
                        E.chunk(rowF + a * HALF + 32 * m2, colF + b * HALF, (f32x4){v[0], v[1], v[2], v[3]}, (f32x4){v[4], v[5], v[6], v[7]});
                        E.chunk(rowF + a * HALF + 32 * m2, colF + b * HALF + 8, (f32x4){v[8], v[9], v[10], v[11]}, (f32x4){v[12], v[13], v[14], v[15]});
#pragma unroll
                        for (int i = 0; i < 16; ++i) acc32[a][b][m2][i] = 0.f; }
            }
        } else {
            const int lnE = lane_now(); const int row0 = cur.pm * BM + wr * 64 + (lnE & 15), col0 = cur.pn * BM + wc * 32 + 8 * (lnE >> 4);
#pragma unroll
            for (int a = 0; a < 2; ++a)
#pragma unroll
                for (int m = 0; m < 4; ++m)
#pragma unroll
                    for (int b = 0; b < 2; ++b) E.chunk(row0 + a * HALF + m * 16, col0 + b * HALF, acc[a][b][m][0], acc[a][b][m][1]);
        }
        if (!has_next) break;
#pragma unroll
        for (int a = 0; a < 2; ++a)
#pragma unroll
            for (int b = 0; b < 2; ++b)
#pragma unroll
                for (int m = 0; m < 4; ++m)
#pragma unroll
                    for (int n = 0; n < 2; ++n) acc[a][b][m][n] = (f32x4){0.f, 0.f, 0.f, 0.f};
        cur = nxt; cA = nA; cB = nB; ++ui;
        if (wr == 1) PG8_BAR;
    }
    PG8_WAIT_V(0);
    PG8_BAR;
#undef PG8_SA
#undef PG8_SB
#undef PG8_STAGE
#undef PG8_LDA
#undef PG8_LD32
#undef PG8_LDB
#undef PG8_MMA
#undef PG8_WAIT_V
#undef PG8_WAIT_L
#undef PG8_BAR
#undef PG8_SCHED
#undef PG8_ACOL
}
}

constexpr int NWAVES = 8;
constexpr int D = 2048, BATCH = 4, SEQ = 8192, DEPTH = 4, M = BATCH * SEQ;
constexpr int NEXP = 16384, PLE = 256;
constexpr float LN_EPS = 1e-5f;
constexpr float DN_ALPHA = 1.681792830507429f;
constexpr float LOG2E = 1.4426950408889634f;
constexpr float ATTN_QSCALE = 0.08838834764831845f * LOG2E;
constexpr float W8S = 64.f, O8S = 16.f;

constexpr size_t MiB = 1u << 20;
constexpr size_t WS_CTL = 0, CTL_ZERO_BYTES = 1 * MiB;
constexpr size_t WS_STATS = WS_CTL + 512 * 1024;
constexpr size_t WS_W = 1 * MiB;
constexpr size_t W_POOL_IN = WS_W, W_POOL_GRP = W_POOL_IN + 16 * MiB, W_POOL_OUT = W_POOL_GRP + 4 * MiB;
constexpr size_t W_SSM_IN = W_POOL_OUT + 16 * MiB, W_SSM_GLU = W_SSM_IN + 8 * MiB, W_SSM_OUT = W_SSM_GLU + 8 * MiB;
constexpr size_t W_ATTN_QKV = W_SSM_OUT + 8 * MiB, W_ATTN_OUT = W_ATTN_QKV + 24 * MiB;
constexpr size_t W_PEER_Q = W_ATTN_OUT + 8 * MiB, W_PLE_GATE = W_PEER_Q + 32 * MiB, W_PLE_PROJ = W_PLE_GATE + 32 * MiB;
constexpr size_t WS_SK = W_PLE_PROJ + 4 * MiB;
constexpr size_t WS_TU = WS_SK + 1 * MiB;
constexpr size_t WS_TV = WS_TU + 256 * MiB;
constexpr size_t WS_PB = WS_TV + 256 * MiB;
constexpr size_t WS_HB0 = WS_PB + 64 * MiB, WS_HB1 = WS_HB0 + 128 * MiB;
constexpr size_t WS_T1 = WS_HB1 + 128 * MiB, WS_T2 = WS_T1 + 128 * MiB, WS_T3 = WS_T2 + 128 * MiB;
constexpr size_t WS_IDX = WS_T3 + 128 * MiB, WS_GATE = WS_IDX + 16 * MiB;
constexpr size_t WS_SSMP = WS_GATE + 16 * MiB;
constexpr size_t WS_SU = WS_SSMP + 2 * MiB, WS_SV = WS_SU + 1 * MiB;
constexpr size_t WS_S8 = WS_SV + 1 * MiB;
constexpr size_t WS_X8 = WS_S8 + 64 * MiB;
constexpr size_t WS_END = WS_X8 + 64 * MiB;
static_assert(WS_END <= 2048 * MiB, "d_ws map");
constexpr int CW_BAR = 4096;

constexpr int RING_BYTES = 131072;
constexpr int LDSCTL_OFF = RING_BYTES, MISC_OFF = LDSCTL_OFF + 320;
constexpr int LDS_BYTES = 147456;

#define LAS __attribute__((address_space(3)))
typedef unsigned short bf16;
typedef unsigned v4u __attribute__((ext_vector_type(4)));
typedef unsigned v2u __attribute__((ext_vector_type(2)));
typedef float f32x4 __attribute__((ext_vector_type(4)));
typedef float f32x16 __attribute__((ext_vector_type(16)));
typedef short bf16x8 __attribute__((ext_vector_type(8)));
typedef __bf16 bf16x2_t __attribute__((ext_vector_type(2)));
#define LDS_WAIT() asm volatile("s_waitcnt lgkmcnt(0)" ::: "memory")
#define VM_WAIT() asm volatile("s_waitcnt vmcnt(0)" ::: "memory")
__device__ __forceinline__ unsigned f2bf(float f) { unsigned u = __builtin_bit_cast(unsigned, f); return (u + 0x7fffu + ((u >> 16) & 1u)) >> 16; }
__device__ __forceinline__ unsigned pk2(float lo, float hi) { return f2bf(lo) | (f2bf(hi) << 16); }
__device__ __forceinline__ float bflo(unsigned w) { return __builtin_bit_cast(float, w << 16); }
__device__ __forceinline__ float bfhi(unsigned w) { return __builtin_bit_cast(float, w & 0xffff0000u); }
__device__ __forceinline__ float dot2bf(unsigned a, unsigned b, float c) { return __builtin_amdgcn_fdot2_f32_bf16(__builtin_bit_cast(bf16x2_t, a), __builtin_bit_cast(bf16x2_t, b), c, false); }
__device__ __forceinline__ float gelu_f(float v) {
    const float av = __builtin_fabsf(v), d = av * 0.2316418882f + 1.0f, t = __builtin_amdgcn_rcpf(d);
    float q = t * 0.5307027145f + (-0.7265760135f); q = q * t + 0.7107068705f; q = q * t + (-0.142248368f); q = q * t + 0.127414796f; q = q * t;
    const float e = __builtin_amdgcn_exp2f((v * v) * (-0.72134752044f));
    const float m = v * (q * e); return v < 0.f ? m : v - m;
}
#define WDPP(v, ctrl) __builtin_bit_cast(float, __builtin_amdgcn_update_dpp(0, __builtin_bit_cast(int, (v)), (ctrl), 0xF, 0xF, true))
#define WRL(v, l) __builtin_bit_cast(float, __builtin_amdgcn_readlane(__builtin_bit_cast(int, (v)), (l)))
__device__ __forceinline__ float wave_sum(float v) {
    v += WDPP(v, 0xB1); v += WDPP(v, 0x4E); v += WDPP(v, 0x141); v += WDPP(v, 0x140);
    return (WRL(v, 0) + WRL(v, 16)) + (WRL(v, 32) + WRL(v, 48));
}
__device__ __forceinline__ float shfl_xor_lane(float v, int m, int lane) { return __builtin_bit_cast(float, __builtin_amdgcn_ds_bpermute((lane ^ m) << 2, __builtin_bit_cast(int, v))); }
__device__ __forceinline__ int shfl_idx_lane(int v, int src) { return __builtin_amdgcn_ds_bpermute(src << 2, v); }
#define SHFL_XOR(v, m) shfl_xor_lane((v), (m), lane)

#define XB_TMO      128
#define XB_XCNT(j)  (256  + 64 * (j))
#define XB_XSUB(j)  (1280 + 64 * (j))
#define XB_XGEN(j)  (2304 + 64 * (j))
#define XB_TOP      3328
#define XB_TOPGEN   3392
#define XCD_BAR_WORDS 3456
#define XB_SPIN_CAP (1u << 23)

__device__ __forceinline__ unsigned xb_ld(unsigned* p)              { return __hip_atomic_load(p, __ATOMIC_RELAXED, __HIP_MEMORY_SCOPE_AGENT); }
__device__ __forceinline__ unsigned xb_add(unsigned* p, unsigned v) { return __hip_atomic_fetch_add(p, v, __ATOMIC_RELAXED, __HIP_MEMORY_SCOPE_AGENT); }
__device__ __forceinline__ unsigned xb_xcc_id() { return (unsigned)__builtin_amdgcn_s_getreg((3 << 11) | 20) & 0xFu; }
#define XB_SPIN(cond, bar) do { unsigned _sp = 0; while (cond) { __builtin_amdgcn_s_sleep(1); \
    if ((++_sp & 255u) == 0u) { if (xb_ld(&(bar)[XB_TMO])) break; if (_sp > XB_SPIN_CAP) { atomicAdd(&(bar)[XB_TMO], 1u); break; } } } } while (0)

struct XcdBarrier { unsigned* bar; unsigned x; volatile LAS unsigned* st; int wave; };
__device__ __forceinline__ int lane_id() { int l; asm volatile("v_mbcnt_lo_u32_b32 %0, -1, 0\n\tv_mbcnt_hi_u32_b32 %0, -1, %0" : "=v"(l)); return l; }

__device__ __forceinline__ XcdBarrier xcd_barrier_post(unsigned* bar, volatile LAS unsigned* st) {
    XcdBarrier b; b.bar = bar; b.x = xb_xcc_id(); b.st = st; b.wave = __builtin_amdgcn_readfirstlane((int)(threadIdx.x >> 6));
    if (threadIdx.x == 0) (void)xb_add(&bar[XB_XCNT(b.x)], 1u);
    return b;
}
__device__ __forceinline__ void xcd_barrier_complete(unsigned* bar, unsigned x, unsigned& nloc, unsigned& nx) {
    const unsigned G = gridDim.x * gridDim.y * gridDim.z;
    unsigned sum, cnt, mine, sp = 0u;
    for (;;) {
        sum = 0u; cnt = 0u; mine = 0u;
#pragma unroll
        for (unsigned j = 0; j < 16; ++j) { const unsigned c = xb_ld(&bar[XB_XCNT(j)]); sum += c; cnt += (c > 0u) ? 1u : 0u; mine = (j == x) ? c : mine; }
        if (sum == G) break;
        __builtin_amdgcn_s_sleep(1);
        if ((++sp & 255u) == 0u) { if (xb_ld(&bar[XB_TMO])) break; if (sp > XB_SPIN_CAP) { atomicAdd(&bar[XB_TMO], 1u); break; } }
    }
    nloc = mine > 0u ? mine : 1u; nx = cnt > 0u ? cnt : 1u;
}
__device__ __forceinline__ void xcd_barrier(const XcdBarrier& b_in) {
    asm volatile("s_waitcnt vmcnt(0)" ::: "memory");
    __syncthreads();
    if (b_in.wave == 0 && lane_id() == 0) {
        XcdBarrier b = b_in; asm volatile("" : "+s"(b.x)); asm volatile("" : "+s"(b.bar));
        unsigned* bar = b.bar;
        __builtin_amdgcn_s_waitcnt(0);
        unsigned nloc = b.st[0], nx = b.st[1];
        if (nloc == 0u) { xcd_barrier_complete(bar, b.x, nloc, nx); b.st[0] = nloc; b.st[1] = nx; }
        const unsigned old = xb_add(&bar[XB_XSUB(b.x)], 1u);
        const unsigned gen = old / nloc;
        if (old + 1u == (gen + 1u) * nloc) {
            __builtin_amdgcn_fence(__ATOMIC_RELEASE, "agent");
            asm volatile("s_waitcnt vmcnt(0)" ::: "memory");
            const unsigned og = xb_add(&bar[XB_TOP], 1u);
            const unsigned tg = og / nx;
            if (og + 1u == (tg + 1u) * nx) xb_add(&bar[XB_TOPGEN], 1u);
            else XB_SPIN(xb_ld(&bar[XB_TOPGEN]) == tg, bar);
            __builtin_amdgcn_fence(__ATOMIC_ACQUIRE, "agent");
            xb_add(&bar[XB_XGEN(b.x)], 1u);
            asm volatile("s_waitcnt vmcnt(0)" ::: "memory");
        } else {
            XB_SPIN(xb_ld(&bar[XB_XGEN(b.x)]) == gen, bar);
            __builtin_amdgcn_fence(__ATOMIC_ACQUIRE, "agent");
            asm volatile("s_waitcnt vmcnt(0)" ::: "memory");
        }
    }
    __syncthreads();
}

__device__ __forceinline__ void transpose_item(const float* W, int K, int N, bf16* WT, int row_off, LAS float* scr, int item, int lane) {
    const int nblk = N / 32, kb = item / nblk, nb = item % nblk, k0 = 64 * kb, n0 = 32 * nb;
    const __attribute__((address_space(1))) float* Wg = (const __attribute__((address_space(1))) float*)W + (size_t)(k0 + (lane >> 5)) * N + n0 + (lane & 31);
    float v[32];
#pragma unroll
    for (int i = 0; i < 32; ++i) v[i] = Wg[(size_t)(2 * i) * N];
#pragma unroll
    for (int i = 0; i < 32; ++i) scr[(2 * i + (lane >> 5)) * 33 + (lane & 31)] = v[i];
    LDS_WAIT(); asm volatile("" ::: "memory");
    const int c = lane & 7;
#pragma unroll
    for (int j = 0; j < 4; ++j) { const int n = (lane >> 3) + 8 * j; const LAS float* s = scr + (8 * c) * 33 + n;
        v4u o; o.x = pk2(s[0 * 33], s[1 * 33]); o.y = pk2(s[2 * 33], s[3 * 33]); o.z = pk2(s[4 * 33], s[5 * 33]); o.w = pk2(s[6 * 33], s[7 * 33]);
        *(v4u*)(WT + (size_t)(row_off + n0 + n) * K + k0 + 8 * c) = o; }
    LDS_WAIT(); asm volatile("" ::: "memory");
}
__device__ __forceinline__ void transpose_item8(const float* W, int K, int N, unsigned char* WT, int row_off, LAS float* scr, int item, int lane) {
    const int nblk = N / 32, kb = item / nblk, nb = item % nblk, k0 = 64 * kb, n0 = 32 * nb;
#pragma unroll 8
    for (int i = 0; i < 32; ++i) { const int kk = 2 * i + (lane >> 5); scr[kk * 33 + (lane & 31)] = W[(size_t)(k0 + kk) * N + n0 + (lane & 31)]; }
    LDS_WAIT(); asm volatile("" ::: "memory");
    const int c = lane & 7;
#pragma unroll
    for (int j = 0; j < 4; ++j) { const int n = (lane >> 3) + 8 * j; const LAS float* sp = scr + (8 * c) * 33 + n;
        int a = 0, b = 0;
        a = __builtin_amdgcn_cvt_pk_fp8_f32(sp[0 * 33] * W8S, sp[1 * 33] * W8S, a, false); a = __builtin_amdgcn_cvt_pk_fp8_f32(sp[2 * 33] * W8S, sp[3 * 33] * W8S, a, true);
        b = __builtin_amdgcn_cvt_pk_fp8_f32(sp[4 * 33] * W8S, sp[5 * 33] * W8S, b, false); b = __builtin_amdgcn_cvt_pk_fp8_f32(sp[6 * 33] * W8S, sp[7 * 33] * W8S, b, true);
        v2u o; o.x = (unsigned)a; o.y = (unsigned)b;
        *(v2u*)(WT + (size_t)(row_off + n0 + n) * K + k0 + 8 * c) = o; }
    LDS_WAIT(); asm volatile("" ::: "memory");
}
__device__ __forceinline__ void transpose_item8b(const float* W, int K, int N, unsigned char* WT, int row_off, LAS unsigned* scr, int item, int lane) {
    const int nblk = N / 64, kb = item / nblk, nb = item % nblk, k0 = 128 * kb, n0 = 64 * nb;
    const int r4 = lane >> 4, l15 = lane & 15;
    f32x4 v[32];
#pragma unroll
    for (int i = 0; i < 32; ++i) v[i] = *(const __attribute__((address_space(1))) f32x4*)(W + (size_t)(k0 + 32 * r4 + i) * N + n0 + 4 * l15);
#pragma unroll
    for (int i4 = 0; i4 < 8; ++i4) {
        const f32x4 q0 = v[4 * i4] * W8S, q1 = v[4 * i4 + 1] * W8S, q2 = v[4 * i4 + 2] * W8S, q3 = v[4 * i4 + 3] * W8S;
        int a0 = 0, a1 = 0, a2 = 0, a3 = 0;
        a0 = __builtin_amdgcn_cvt_pk_fp8_f32(q0.x, q1.x, a0, false); a0 = __builtin_amdgcn_cvt_pk_fp8_f32(q2.x, q3.x, a0, true);
        a1 = __builtin_amdgcn_cvt_pk_fp8_f32(q0.y, q1.y, a1, false); a1 = __builtin_amdgcn_cvt_pk_fp8_f32(q2.y, q3.y, a1, true);
        a2 = __builtin_amdgcn_cvt_pk_fp8_f32(q0.z, q1.z, a2, false); a2 = __builtin_amdgcn_cvt_pk_fp8_f32(q2.z, q3.z, a2, true);
        a3 = __builtin_amdgcn_cvt_pk_fp8_f32(q0.w, q1.w, a3, false); a3 = __builtin_amdgcn_cvt_pk_fp8_f32(q2.w, q3.w, a3, true);
        LAS unsigned* rowp = scr + (8 * r4 + i4) * 64;
        rowp[(4 * l15 + 0 + r4) & 63] = (unsigned)a0; rowp[(4 * l15 + 1 + r4) & 63] = (unsigned)a1; rowp[(4 * l15 + 2 + r4) & 63] = (unsigned)a2; rowp[(4 * l15 + 3 + r4) & 63] = (unsigned)a3; }
    LDS_WAIT(); asm volatile("" ::: "memory");
    unsigned char* orow = WT + (size_t)(row_off + n0 + lane) * K + k0;
#pragma unroll
    for (int q = 0; q < 8; ++q) { v4u o;
        o.x = scr[(4 * q + 0) * 64 + ((lane + (q >> 1)) & 63)]; o.y = scr[(4 * q + 1) * 64 + ((lane + (q >> 1)) & 63)]; o.z = scr[(4 * q + 2) * 64 + ((lane + (q >> 1)) & 63)]; o.w = scr[(4 * q + 3) * 64 + ((lane + (q >> 1)) & 63)];
        *(__attribute__((address_space(1))) v4u*)(orow + 16 * q) = o; }
    LDS_WAIT(); asm volatile("" ::: "memory");
}
__device__ __forceinline__ void transpose_mat8b(const float* W, int K, int N, unsigned char* WT, int row_off, LAS unsigned* scr, int gw, int NGW, int lane, int& woff) {
    const int nit = (K / 128) * (N / 64);
    int sgw = gw - woff % NGW; if (sgw < 0) sgw += NGW;
    for (int it = sgw; it < nit; it += NGW) transpose_item8b(W, K, N, WT, row_off, scr, it, lane);
    woff += nit;
}
__device__ __forceinline__ void transpose_mat8(const float* W, int K, int N, unsigned char* WT, int row_off, LAS float* scr, int gw, int NGW, int lane) {
    const int nit = (K / 64) * (N / 32);
    for (int it = gw; it < nit; it += NGW) transpose_item8(W, K, N, WT, row_off, scr, it, lane);
}
__device__ __forceinline__ void transpose_mat(const float* W, int K, int N, bf16* WT, int row_off, LAS float* scr, int gw, int NGW, int lane, int& woff) {
    const int nit = (K / 64) * (N / 32);
    int sgw = gw - woff % NGW; if (sgw < 0) sgw += NGW;
    for (int it = sgw; it < nit; it += NGW) transpose_item(W, K, N, WT, row_off, scr, it, lane);
    woff += nit;
}
__device__ __forceinline__ void cvt_rows(const float* src, bf16* dst, size_t n, size_t gtid, size_t gthreads) {
    size_t i = gtid * 8;
    for (; i + 3 * gthreads * 8 < n; i += gthreads * 32) {
        f32x4 a[4], b[4];
#pragma unroll
        for (int u = 0; u < 4; ++u) { a[u] = *(const __attribute__((address_space(1))) f32x4*)(src + i + u * gthreads * 8); b[u] = *(const __attribute__((address_space(1))) f32x4*)(src + i + u * gthreads * 8 + 4); }
#pragma unroll
        for (int u = 0; u < 4; ++u) { v4u o; o.x = pk2(a[u].x, a[u].y); o.y = pk2(a[u].z, a[u].w); o.z = pk2(b[u].x, b[u].y); o.w = pk2(b[u].z, b[u].w);
            *(__attribute__((address_space(1))) v4u*)(dst + i + u * gthreads * 8) = o; }
    }
    for (; i < n; i += gthreads * 8) {
        const f32x4 a = *(const f32x4*)(src + i), b = *(const f32x4*)(src + i + 4);
        v4u o; o.x = pk2(a.x, a.y); o.y = pk2(a.z, a.w); o.z = pk2(b.x, b.y); o.w = pk2(b.z, b.w);
        *(v4u*)(dst + i) = o;
    }
}


#define GAS __attribute__((address_space(1)))
typedef unsigned char u8;
typedef float f32x2 __attribute__((ext_vector_type(2)));
constexpr float TU_SCALE = 64.f, TV_SCALE = 4.f;
__device__ __forceinline__ v4u gld16(const void* p) { return *(const GAS v4u*)p; }
__device__ __forceinline__ void cvt_rows_fp8(const float* src, u8* dst, size_t n, float scale, size_t gtid, size_t gthreads) {
    for (size_t i = gtid * 16; i < n; i += gthreads * 16) {
        const GAS f32x4* p = (const GAS f32x4*)(src + i);
        const f32x4 a = p[0] * scale, b = p[1] * scale, c = p[2] * scale, d = p[3] * scale;
        int w0 = 0, w1 = 0, w2 = 0, w3 = 0;
        w0 = __builtin_amdgcn_cvt_pk_fp8_f32(a.x, a.y, w0, false); w0 = __builtin_amdgcn_cvt_pk_fp8_f32(a.z, a.w, w0, true);
        w1 = __builtin_amdgcn_cvt_pk_fp8_f32(b.x, b.y, w1, false); w1 = __builtin_amdgcn_cvt_pk_fp8_f32(b.z, b.w, w1, true);
        w2 = __builtin_amdgcn_cvt_pk_fp8_f32(c.x, c.y, w2, false); w2 = __builtin_amdgcn_cvt_pk_fp8_f32(c.z, c.w, w2, true);
        w3 = __builtin_amdgcn_cvt_pk_fp8_f32(d.x, d.y, w3, false); w3 = __builtin_amdgcn_cvt_pk_fp8_f32(d.z, d.w, w3, true);
        v4u o; o.x = (unsigned)w0; o.y = (unsigned)w1; o.z = (unsigned)w2; o.w = (unsigned)w3;
        *(GAS v4u*)(dst + i) = o;
    }
}

template <bool X4 = false>
__device__ __forceinline__ void ln_phase(bf16* S, const float* g, const float* b, int gw, int NGW, int lane, unsigned char* f8 = nullptr, unsigned char* f8b = nullptr, float* stats = nullptr) {
    f32x4 G0[4], G1[4], B0[4], B1[4];
#pragma unroll
    for (int j = 0; j < 4; ++j) { const float* gp = g + 512 * j + 8 * lane; const float* bp = b + 512 * j + 8 * lane;
        G0[j] = *(const GAS f32x4*)gp; G1[j] = *(const GAS f32x4*)(gp + 4); B0[j] = *(const GAS f32x4*)bp; B1[j] = *(const GAS f32x4*)(bp + 4); }
    v4u nx[4];
#pragma unroll
    for (int j = 0; j < 4; ++j) nx[j] = *(const GAS v4u*)(S + (size_t)((gw < M) ? gw : 0) * D + 8 * lane + 512 * j);
    for (int m = gw; m < M; m += NGW) {
        bf16* row = S + (size_t)m * D + 8 * lane;
        float v[32]; float s = 0.f;
        const int mn = (m + NGW < M) ? m + NGW : m;
#pragma unroll
        for (int j = 0; j < 4; ++j) { const v4u w = nx[j];
            v[8 * j + 0] = bflo(w.x); v[8 * j + 1] = bfhi(w.x); v[8 * j + 2] = bflo(w.y); v[8 * j + 3] = bfhi(w.y); v[8 * j + 4] = bflo(w.z); v[8 * j + 5] = bfhi(w.z); v[8 * j + 6] = bflo(w.w); v[8 * j + 7] = bfhi(w.w); }
#pragma unroll
        for (int j = 0; j < 4; ++j) nx[j] = *(const GAS v4u*)(S + (size_t)mn * D + 8 * lane + 512 * j);
#pragma unroll
        for (int i = 0; i < 32; ++i) s += v[i];
        const float mean = wave_sum(s) * (1.f / D); float s2 = 0.f;
#pragma unroll
        for (int i = 0; i < 32; ++i) { v[i] -= mean; s2 += v[i] * v[i]; }
        const float rstd = 1.f / sqrtf(wave_sum(s2) * (1.f / D) + LN_EPS);
        if constexpr (X4) { if (lane == 0) *(GAS f32x2*)(stats + 2 * (size_t)m) = (f32x2){mean, rstd}; }
#pragma unroll
        for (int j = 0; j < 4; ++j) { const f32x4 g0 = G0[j], g1 = G1[j], b0 = B0[j], b1 = B1[j];
            v4u w; w.x = pk2(v[8 * j + 0] * rstd * g0.x + b0.x, v[8 * j + 1] * rstd * g0.y + b0.y); w.y = pk2(v[8 * j + 2] * rstd * g0.z + b0.z, v[8 * j + 3] * rstd * g0.w + b0.w);
            w.z = pk2(v[8 * j + 4] * rstd * g1.x + b1.x, v[8 * j + 5] * rstd * g1.y + b1.y); w.w = pk2(v[8 * j + 6] * rstd * g1.z + b1.z, v[8 * j + 7] * rstd * g1.w + b1.w);
            if constexpr (!X4) *(GAS v4u*)(row + 512 * j) = w;
            if constexpr (X4) {
                const float y0 = v[8 * j + 0] * rstd * g0.x + b0.x, y1 = v[8 * j + 1] * rstd * g0.y + b0.y, y2 = v[8 * j + 2] * rstd * g0.z + b0.z, y3 = v[8 * j + 3] * rstd * g0.w + b0.w;
                const float y4 = v[8 * j + 4] * rstd * g1.x + b1.x, y5 = v[8 * j + 5] * rstd * g1.y + b1.y, y6 = v[8 * j + 6] * rstd * g1.z + b1.z, y7 = v[8 * j + 7] * rstd * g1.w + b1.w;
                unsigned wh = 0u; wh = __builtin_amdgcn_cvt_scalef32_pk_fp4_f32(wh, y0, y1, 1.0f, 0); wh = __builtin_amdgcn_cvt_scalef32_pk_fp4_f32(wh, y2, y3, 1.0f, 1);
                wh = __builtin_amdgcn_cvt_scalef32_pk_fp4_f32(wh, y4, y5, 1.0f, 2); wh = __builtin_amdgcn_cvt_scalef32_pk_fp4_f32(wh, y6, y7, 1.0f, 3);
                const f32x2 h01 = __builtin_amdgcn_cvt_scalef32_pk_f32_fp4(wh, 1.0f, 0), h23 = __builtin_amdgcn_cvt_scalef32_pk_f32_fp4(wh, 1.0f, 1), h45 = __builtin_amdgcn_cvt_scalef32_pk_f32_fp4(wh, 1.0f, 2), h67 = __builtin_amdgcn_cvt_scalef32_pk_f32_fp4(wh, 1.0f, 3);
                unsigned wl = 0u; wl = __builtin_amdgcn_cvt_scalef32_pk_fp4_f32(wl, (y0 - h01.x) * 8.f, (y1 - h01.y) * 8.f, 1.0f, 0); wl = __builtin_amdgcn_cvt_scalef32_pk_fp4_f32(wl, (y2 - h23.x) * 8.f, (y3 - h23.y) * 8.f, 1.0f, 1);
                wl = __builtin_amdgcn_cvt_scalef32_pk_fp4_f32(wl, (y4 - h45.x) * 8.f, (y5 - h45.y) * 8.f, 1.0f, 2); wl = __builtin_amdgcn_cvt_scalef32_pk_fp4_f32(wl, (y6 - h67.x) * 8.f, (y7 - h67.y) * 8.f, 1.0f, 3);
                unsigned char* xq = f8 + (size_t)m * 2048 + 256 * j + 4 * lane;
                *(GAS unsigned*)xq = wh; *(GAS unsigned*)(xq + 1024) = wl;
                int a8 = 0, b8 = 0;
                a8 = __builtin_amdgcn_cvt_pk_fp8_f32(y0, y1, a8, false); a8 = __builtin_amdgcn_cvt_pk_fp8_f32(y2, y3, a8, true);
                b8 = __builtin_amdgcn_cvt_pk_fp8_f32(y4, y5, b8, false); b8 = __builtin_amdgcn_cvt_pk_fp8_f32(y6, y7, b8, true);
                v2u o8; o8.x = (unsigned)a8; o8.y = (unsigned)b8; *(GAS v2u*)(f8b + (size_t)m * D + 512 * j + 8 * lane) = o8; }
            else if (f8 != nullptr) { int a8 = 0, b8 = 0;
                a8 = __builtin_amdgcn_cvt_pk_fp8_f32(v[8 * j + 0] * rstd * g0.x + b0.x, v[8 * j + 1] * rstd * g0.y + b0.y, a8, false); a8 = __builtin_amdgcn_cvt_pk_fp8_f32(v[8 * j + 2] * rstd * g0.z + b0.z, v[8 * j + 3] * rstd * g0.w + b0.w, a8, true);
                b8 = __builtin_amdgcn_cvt_pk_fp8_f32(v[8 * j + 4] * rstd * g1.x + b1.x, v[8 * j + 5] * rstd * g1.y + b1.y, b8, false); b8 = __builtin_amdgcn_cvt_pk_fp8_f32(v[8 * j + 6] * rstd * g1.z + b1.z, v[8 * j + 7] * rstd * g1.w + b1.w, b8, true);
                v2u o8; o8.x = (unsigned)a8; o8.y = (unsigned)b8; *(GAS v2u*)(f8 + (size_t)m * D + 512 * j + 8 * lane) = o8; } }
    }
}

__device__ __forceinline__ void pool_phase(const bf16* U, unsigned char* P, int gw, int NGW, int lane) {
    for (int it = gw; it < (M / 64) * 4; it += NGW) {
        const int g = it & 3, t0 = (it >> 2) * 64, w = 2 << g, col = g * 512 + 8 * lane;
        const int s0 = t0 & (SEQ - 1);
        float a[8];
#pragma unroll
        for (int i = 0; i < 8; ++i) a[i] = 0.f;
        const GAS bf16* base = (const GAS bf16*)U + (size_t)t0 * D + col;
        const int nb = (s0 < w - 1) ? s0 : (w - 1);
        {   v4u x[15];
#pragma unroll
            for (int r = 1; r <= 15; ++r) x[r - 1] = *(const GAS v4u*)(base - (ptrdiff_t)((r <= nb) ? r : 0) * D);
#pragma unroll
            for (int r = 1; r <= 15; ++r) if (r <= nb) { const v4u y = x[r - 1];
                a[0] += bflo(y.x); a[1] += bfhi(y.x); a[2] += bflo(y.y); a[3] += bfhi(y.y); a[4] += bflo(y.z); a[5] += bfhi(y.z); a[6] += bflo(y.w); a[7] += bfhi(y.w); }
        }
        for (int t = 0; t < 64; t += 8) {
            v4u cr[8], lv[8];
#pragma unroll
            for (int j = 0; j < 8; ++j) cr[j] = *(const GAS v4u*)(base + (ptrdiff_t)(t + j) * D);
#pragma unroll
            for (int j = 0; j < 8; ++j) { const int s = s0 + t + j; const int r = (s + 1 >= w) ? (t + j + 1 - w) : (t + j); lv[j] = *(const GAS v4u*)(base + (ptrdiff_t)r * D); }
            __builtin_amdgcn_sched_barrier(0);
#pragma unroll
            for (int j = 0; j < 8; ++j) {
                const int s = s0 + t + j;
                const v4u cur = cr[j];
                a[0] += bflo(cur.x); a[1] += bfhi(cur.x); a[2] += bflo(cur.y); a[3] += bfhi(cur.y); a[4] += bflo(cur.z); a[5] += bfhi(cur.z); a[6] += bflo(cur.w); a[7] += bfhi(cur.w);
                const int n = (s + 1 < w) ? (s + 1) : w;
                const float inv = 1.f / (float)n;
                int w0 = 0, w1 = 0;
                w0 = __builtin_amdgcn_cvt_pk_fp8_f32(a[0] * inv - bflo(cur.x), a[1] * inv - bfhi(cur.x), w0, false); w0 = __builtin_amdgcn_cvt_pk_fp8_f32(a[2] * inv - bflo(cur.y), a[3] * inv - bfhi(cur.y), w0, true);
                w1 = __builtin_amdgcn_cvt_pk_fp8_f32(a[4] * inv - bflo(cur.z), a[5] * inv - bfhi(cur.z), w1, false); w1 = __builtin_amdgcn_cvt_pk_fp8_f32(a[6] * inv - bflo(cur.w), a[7] * inv - bfhi(cur.w), w1, true);
                v2u o; o.x = (unsigned)w0; o.y = (unsigned)w1;
                *(GAS v2u*)(P + (size_t)(t0 + t + j) * D + col) = o;
                if (s + 1 >= w) { const v4u x = lv[j];
                    a[0] -= bflo(x.x); a[1] -= bfhi(x.x); a[2] -= bflo(x.y); a[3] -= bfhi(x.y); a[4] -= bflo(x.z); a[5] -= bfhi(x.z); a[6] -= bflo(x.w); a[7] -= bfhi(x.w); }
            }
            __builtin_amdgcn_sched_barrier(0);
        }
    }
}

typedef __bf16 bf16x2v __attribute__((ext_vector_type(2)));
__device__ __forceinline__ unsigned cvtpk(float lo, float hi) { const f32x2 v = {lo, hi}; return __builtin_bit_cast(unsigned, __builtin_convertvector(v, bf16x2v)); }
constexpr int SSM_L = 1664, SSM_L3 = SEQ - 3 * SSM_L;
static_assert(SSM_L % 64 == 0 && SSM_L3 % 64 == 0 && SSM_L3 > 0, "segments");
template <bool WR>
__device__ __forceinline__ void ssm_block16m(const bf16x8 ua, const bf16x8 (&BbR)[4], const bf16x8 (&BbI)[4], LAS unsigned char* bubuf, LAS unsigned char* hbuf, const f32x2 ar2, const f32x2 ai2, f32x2& h2, int p, int lane) {
    f32x4 dr[4], di[4];
    const f32x4 z = {0.f, 0.f, 0.f, 0.f};
    __builtin_amdgcn_sched_barrier(0);
    asm volatile("s_nop 15\n\ts_nop 15\n\ts_nop 15\n\ts_nop 15" ::: "memory");
    __builtin_amdgcn_sched_barrier(0);
#pragma unroll
    for (int pt = 0; pt < 4; ++pt) { dr[pt] = __builtin_amdgcn_mfma_f32_16x16x32_bf16(ua, BbR[pt], z, 0, 0, 0); di[pt] = __builtin_amdgcn_mfma_f32_16x16x32_bf16(ua, BbI[pt], z, 0, 0, 0); }
    __builtin_amdgcn_sched_barrier(0);
    asm volatile("s_nop 15\n\ts_nop 15\n\ts_nop 15\n\ts_nop 15\n\ts_nop 15\n\ts_nop 15\n\ts_nop 15\n\ts_nop 15" ::: "memory");
    __builtin_amdgcn_sched_barrier(0);
#pragma unroll
    for (int pt = 0; pt < 4; ++pt)
#pragma unroll
        for (int r = 0; r < 4; ++r) *(LAS f32x2*)(bubuf + (4 * (lane >> 4) + r) * 528 + (16 * pt + (lane & 15)) * 8) = (f32x2){dr[pt][r], di[pt][r]};
    LDS_WAIT();
#pragma unroll
    for (int l = 0; l < 16; ++l) {
        const f32x2 bu = *(const LAS f32x2*)(bubuf + l * 528 + p * 8);
        float tx, ty, nx, ny; const float hx = h2.x, hy = h2.y, bux = bu.x, buy = bu.y, arx = ar2.x, aix = ai2.x, aiy = ai2.y;
        asm("v_fma_f32 %0, %1, %2, %3" : "=v"(tx) : "v"(arx), "v"(hx), "v"(bux));
        asm("v_fma_f32 %0, %1, %2, %3" : "=v"(ty) : "v"(arx), "v"(hy), "v"(buy));
        asm("v_fma_f32 %0, %1, %2, %3" : "=v"(nx) : "v"(aix), "v"(hy), "v"(tx));
        asm("v_fma_f32 %0, %1, %2, %3" : "=v"(ny) : "v"(aiy), "v"(hx), "v"(ty));
        h2 = (f32x2){nx, ny};
        if (WR) *(LAS unsigned*)(hbuf + l * 272 + 4 * p) = cvtpk(h2.x, h2.y);
    }
}
__device__ __forceinline__ void ssm_phase_m(const bf16* U, unsigned char* Y, const float* ssmp,
                                          const float* c_re, const float* c_im, const float* d_skip, LAS unsigned char* lds, int vcu, int G, int wave, int lane) {
    LAS unsigned char* hbuf = lds + wave * 16384;
    LAS unsigned char* ebuf = lds + wave * 16384 + 4352;
    LAS unsigned char* bubuf = lds + wave * 16384 + 4864;
    const int ntask = BATCH * 128 * 4;
    for (int tb = vcu * NWAVES; tb < ntask; tb += G * NWAVES) {
        const int task = tb + wave, seg = (wave + 3 * (wave >> 2)) & 3, g = (task >> 2) & 127, b = task >> 9, p = lane;
        const float* pp_ = ssmp + (size_t)(g * 64 + p) * 34;
        const float ar = pp_[0], ai = pp_[1];
        const int cc = lane & 15, kg = lane >> 4;
        bf16x8 BbR[4], BbI[4];
#pragma unroll
        for (int pt = 0; pt < 4; ++pt) { const float* q_ = ssmp + (size_t)(g * 64 + 16 * pt + cc) * 34 + 8 * (kg & 1);
            v4u tr, ti; tr.x = cvtpk(q_[2], q_[3]); tr.y = cvtpk(q_[4], q_[5]); tr.z = cvtpk(q_[6], q_[7]); tr.w = cvtpk(q_[8], q_[9]);
            ti.x = cvtpk(q_[18], q_[19]); ti.y = cvtpk(q_[20], q_[21]); ti.z = cvtpk(q_[22], q_[23]); ti.w = cvtpk(q_[24], q_[25]);
            if (kg >= 2) { tr = (v4u){0u, 0u, 0u, 0u}; ti = (v4u){0u, 0u, 0u, 0u}; }
            BbR[pt] = __builtin_bit_cast(bf16x8, tr); BbI[pt] = __builtin_bit_cast(bf16x8, ti); }
        const int tstart = seg * SSM_L, tlen = (seg == 3) ? SSM_L3 : SSM_L;
        const bf16* ub = U + ((size_t)b * SEQ + tstart) * D + g * 16;
        const bf16* ua_p = ub + (size_t)(lane & 15) * D + 8 * (kg & 1);
        unsigned char* yb = Y + ((size_t)b * SEQ + tstart) * D + g * 16;
        const f32x2 ar2 = {ar, ar}, ai2 = {-ai, ai};
        f32x2 h2 = {0.f, 0.f};
        const v4u zero4 = {0u, 0u, 0u, 0u};
        if (seg < 3) {
            v4u pre[4];
#pragma unroll
            for (int i = 0; i < 4; ++i) pre[i] = *(const GAS v4u*)(ua_p + (size_t)(16 * i) * D);
            for (int t0 = 0; t0 < SSM_L; t0 += 64) {
                v4u cur[4];
#pragma unroll
                for (int i = 0; i < 4; ++i) cur[i] = (kg < 2) ? pre[i] : zero4;
                if (t0 + 64 < SSM_L) {
#pragma unroll
                    for (int i = 0; i < 4; ++i) pre[i] = *(const GAS v4u*)(ua_p + (size_t)(t0 + 64 + 16 * i) * D); }
#pragma unroll
                for (int blk = 0; blk < 4; ++blk) { ssm_block16m<false>(__builtin_bit_cast(bf16x8, cur[blk]), BbR, BbI, bubuf, hbuf, ar2, ai2, h2, p, lane); LDS_WAIT(); }
            }
            *(LAS f32x2*)(ebuf + 8 * p) = h2;
        }
        LDS_WAIT();
        __syncthreads();
        {
            f32x2 pw = {1.f, 0.f}, base = {ar, ai};
#pragma unroll 1
            for (int bit = SSM_L; bit > 0; bit >>= 1) {
                if (bit & 1) pw = (f32x2){pw.x * base.x - pw.y * base.y, pw.x * base.y + pw.y * base.x};
                base = (f32x2){base.x * base.x - base.y * base.y, 2.f * base.x * base.y};
            }
            LAS unsigned char* e0 = lds + (wave & 4) * 16384 + 4352;
            f32x2 sst = {0.f, 0.f};
            for (int j = 0; j < seg; ++j) { const f32x2 e = *(const LAS f32x2*)(e0 + ((j + (wave >> 2)) & 3) * 16384 + 8 * p);
                sst = (f32x2){pw.x * sst.x - pw.y * sst.y + e.x, pw.x * sst.y + pw.y * sst.x + e.y}; }
            h2 = sst;
        }
        bf16x8 cB[4];
#pragma unroll
        for (int ks = 0; ks < 4; ++ks) { unsigned w[4];
#pragma unroll
            for (int jj = 0; jj < 4; ++jj) { const int k = 32 * ks + 8 * (lane >> 4) + 2 * jj, pp = k >> 1;
                w[jj] = cvtpk(c_re[(g * 16 + cc) * 64 + pp], -c_im[(g * 16 + cc) * 64 + pp]); }
            v4u t; t.x = w[0]; t.y = w[1]; t.z = w[2]; t.w = w[3]; cB[ks] = __builtin_bit_cast(bf16x8, t); }
        const float dd = d_skip[g * 16 + cc];
        {
            v4u pre[4];
#pragma unroll
            for (int i = 0; i < 4; ++i) pre[i] = *(const GAS v4u*)(ua_p + (size_t)(16 * i) * D);
            for (int t0 = 0; t0 < tlen; t0 += 64) {
                v4u cur[4];
#pragma unroll
                for (int i = 0; i < 4; ++i) cur[i] = (kg < 2) ? pre[i] : zero4;
                if (t0 + 64 < tlen) {
#pragma unroll
                    for (int i = 0; i < 4; ++i) pre[i] = *(const GAS v4u*)(ua_p + (size_t)(t0 + 64 + 16 * i) * D); }
#pragma unroll
                for (int blk = 0; blk < 4; ++blk) {
                    unsigned short uq[4];
#pragma unroll
                    for (int r = 0; r < 4; ++r) uq[r] = *(const GAS unsigned short*)(ub + (size_t)(t0 + 16 * blk + 4 * (lane >> 4) + r) * D + cc);
                    ssm_block16m<true>(__builtin_bit_cast(bf16x8, cur[blk]), BbR, BbI, bubuf, hbuf, ar2, ai2, h2, p, lane);
                    LDS_WAIT();
                    f32x4 acc = (f32x4){0.f, 0.f, 0.f, 0.f};
#pragma unroll
                    for (int ks = 0; ks < 4; ++ks) { const bf16x8 a = *(const LAS bf16x8*)(hbuf + (lane & 15) * 272 + 16 * (lane >> 4) + 64 * ks);
                        acc = __builtin_amdgcn_mfma_f32_16x16x32_bf16(a, cB[ks], acc, 0, 0, 0); }
#pragma unroll
                    for (int r = 0; r < 4; ++r) { const int l = 4 * (lane >> 4) + r;
                        const float uu = __builtin_bit_cast(float, (unsigned)uq[r] << 16);
                        const float y = acc[r] + dd * uu;
                        *(GAS unsigned char*)(yb + (size_t)(t0 + 16 * blk + l) * D + cc) = (unsigned char)(__builtin_amdgcn_cvt_pk_fp8_f32(gelu_f(y), 0.f, 0, false) & 0xff); }
                    LDS_WAIT();
                }
            }
        }
        __syncthreads();
    }
}

__device__ __forceinline__ void attn_tile(const bf16* Kbh, const bf16* Vbh, const LAS float* rbh, int kp0, bool has_next, int qpos, int hl, int lane,
                                          const bf16x8 (&kc)[8], bf16x8 (&kn)[8], const bf16x8 (&qf)[8], f32x16 (&o)[4], float& mrun, float& lrun) {
    bf16x8 vf[8];
    { const bf16* vp = Vbh + (size_t)(kp0 >> 5) * 4096 + (size_t)lane * 8;
#pragma unroll
      for (int q = 0; q < 8; ++q) vf[q] = *(const GAS bf16x8*)(vp + 512 * q); }
    if (has_next) { const bf16* kp = Kbh + (size_t)((kp0 >> 5) + 1) * 4096 + (size_t)lane * 8;
#pragma unroll
      for (int ks = 0; ks < 8; ++ks) kn[ks] = *(const GAS bf16x8*)(kp + 512 * ks); }
    __builtin_amdgcn_sched_barrier(0);
    f32x16 s;
#pragma unroll
    for (int i = 0; i < 16; ++i) s[i] = 0.f;
#pragma unroll
    for (int ks = 0; ks < 8; ++ks) s = __builtin_amdgcn_mfma_f32_32x32x16_bf16(kc[ks], qf[ks], s, 0, 0, 0);
    float tmax = -1e30f;
#pragma unroll
    for (int i = 0; i < 16; ++i) { const int kpos = kp0 + (i & 3) + 8 * (i >> 2) + 4 * hl; int rel = qpos - kpos; rel = rel > 128 ? 128 : rel; s[i] += rbh[rel + 128]; tmax = fmaxf(tmax, s[i]); }
    tmax = fmaxf(tmax, SHFL_XOR(tmax, 32));
    const float mnew = fmaxf(mrun, tmax), alpha = __builtin_amdgcn_exp2f(mrun - mnew);
    float rs = 0.f;
#pragma unroll
    for (int i = 0; i < 16; ++i) { s[i] = __builtin_amdgcn_exp2f(s[i] - mnew); rs += s[i]; }
    rs += SHFL_XOR(rs, 32);
    lrun = lrun * alpha + rs; mrun = mnew;
    bf16x8 pf[2];
#pragma unroll
    for (int sidx = 0; sidx < 2; ++sidx) { v4u t; t.x = cvtpk(s[8 * sidx + 0], s[8 * sidx + 1]); t.y = cvtpk(s[8 * sidx + 2], s[8 * sidx + 3]);
        t.z = cvtpk(s[8 * sidx + 4], s[8 * sidx + 5]); t.w = cvtpk(s[8 * sidx + 6], s[8 * sidx + 7]); pf[sidx] = __builtin_bit_cast(bf16x8, t); }
#pragma unroll
    for (int dt = 0; dt < 4; ++dt) {
#pragma unroll
        for (int i = 0; i < 16; ++i) o[dt][i] *= alpha;
#pragma unroll
        for (int sidx = 0; sidx < 2; ++sidx) o[dt] = __builtin_amdgcn_mfma_f32_32x32x16_bf16(vf[2 * dt + sidx], pf[sidx], o[dt], 0, 0, 0);
    }
}
__device__ __forceinline__ void attn_phase(const bf16* QO, const bf16* Kb, const bf16* VT, unsigned char* O8, const LAS float* rb, int gw, int NGW, int lane) {
    const int r32 = lane & 31, hl = lane >> 5;
    for (int task = gw; task < BATCH * 16 * 128 * 2; task += NGW) {
        const int half = task & 1, c = (task >> 1) & 127, h = (task >> 8) & 15, b = task >> 12;
        const int qpos = 64 * c + 32 * half + r32;
        const size_t qrow = (size_t)b * SEQ + qpos;
        bf16x8 qf[8];
        const size_t bh256 = (size_t)(b * 16 + h) * 256;
        { const bf16* qt = QO + ((bh256 + 2 * c + half) * 8) * 512 + (size_t)lane * 8;
#pragma unroll
          for (int ks = 0; ks < 8; ++ks) qf[ks] = *(const GAS bf16x8*)(qt + ks * 512); }
        f32x16 o[4];
#pragma unroll
        for (int dt = 0; dt < 4; ++dt)
#pragma unroll
            for (int i = 0; i < 16; ++i) o[dt][i] = 0.f;
        float mrun = -1e30f, lrun = 0.f;
        const LAS float* rbh = rb + h * 257;
        const bf16* Kbh = Kb + bh256 * 4096; const bf16* Vbh = VT + bh256 * 4096;
        int kt0 = 16 - 2 * c; if (kt0 < 0) kt0 = 0;
        bf16x8 kA[8], kB[8];
        { const bf16* kp = Kbh + (size_t)((64 * c - 512 + 32 * kt0) >> 5) * 4096 + (size_t)lane * 8;
#pragma unroll
          for (int ks = 0; ks < 8; ++ks) kA[ks] = *(const GAS bf16x8*)(kp + 512 * ks); }
        for (int kt = kt0; kt < 18; kt += 2) {
            const int kp0 = 64 * c - 512 + 32 * kt;
            attn_tile(Kbh, Vbh, rbh, kp0, true, qpos, hl, lane, kA, kB, qf, o, mrun, lrun);
            attn_tile(Kbh, Vbh, rbh, kp0 + 32, kt + 2 < 18, qpos, hl, lane, kB, kA, qf, o, mrun, lrun);
        }
        const float inv = O8S / lrun;
        unsigned char* op = O8 + qrow * D + h * 128 + 4 * hl;
#pragma unroll
        for (int dt = 0; dt < 4; ++dt)
#pragma unroll
            for (int rq = 0; rq < 4; ++rq) { int w = 0; w = __builtin_amdgcn_cvt_pk_fp8_f32(o[dt][4 * rq + 0] * inv, o[dt][4 * rq + 1] * inv, w, false); w = __builtin_amdgcn_cvt_pk_fp8_f32(o[dt][4 * rq + 2] * inv, o[dt][4 * rq + 3] * inv, w, true);
                *(int*)(op + 32 * dt + 8 * rq) = w; }
    }
}

__device__ __forceinline__ void attn_a_qk(f32x16& s, const bf16x8 (&kc)[8], const bf16x8 (&qh)[8]) {
#pragma unroll
    for (int i = 0; i < 16; ++i) s[i] = 0.f;
#pragma unroll
    for (int ks = 0; ks < 8; ++ks) s = __builtin_amdgcn_mfma_f32_32x32x16_bf16(kc[ks], qh[ks], s, 0, 0, 0);
}
__device__ __forceinline__ void attn_a_half(f32x16& s, const LAS float* rbh, int kp0, int qbase, int r32, int hl, int lane, float& mrun, float& lrun, LAS unsigned char* pw, LAS float* aw) {
    const int qpos = qbase + r32; float tmax = -1e30f;
    if (qbase - (kp0 + 31) >= 128) { const float cb = rbh[256];
#pragma unroll
        for (int i = 0; i < 16; ++i) { s[i] += cb; tmax = fmaxf(tmax, s[i]); } }
    else {
#pragma unroll
        for (int i = 0; i < 16; ++i) { const int kpos = kp0 + (i & 3) + 8 * (i >> 2) + 4 * hl; int rel = qpos - kpos; rel = rel > 128 ? 128 : rel; s[i] += rbh[rel + 128]; tmax = fmaxf(tmax, s[i]); } }
    tmax = fmaxf(tmax, SHFL_XOR(tmax, 32));
    const float mnew = fmaxf(mrun, tmax), alpha = __builtin_amdgcn_exp2f(mrun - mnew);
    float rs = 0.f;
#pragma unroll
    for (int i = 0; i < 16; ++i) { s[i] = __builtin_amdgcn_exp2f(s[i] - mnew); rs += s[i]; }
    rs += SHFL_XOR(rs, 32);
    lrun = lrun * alpha + rs; mrun = mnew;
    v4u t0, t1; t0.x = cvtpk(s[0], s[1]); t0.y = cvtpk(s[2], s[3]); t0.z = cvtpk(s[4], s[5]); t0.w = cvtpk(s[6], s[7]);
    t1.x = cvtpk(s[8], s[9]); t1.y = cvtpk(s[10], s[11]); t1.z = cvtpk(s[12], s[13]); t1.w = cvtpk(s[14], s[15]);
    *(LAS v4u*)pw = t0; *(LAS v4u*)(pw + 16) = t1; *aw = alpha;
}
__device__ __forceinline__ void attn_b_half(const bf16x8 (&vc)[8], f32x16 (&oh)[4], const LAS unsigned char* pr, const LAS float* ar) {
    const v4u p0 = *(const LAS v4u*)pr, p1 = *(const LAS v4u*)(pr + 16); const float al = *ar;
    const bf16x8 pf0 = __builtin_bit_cast(bf16x8, p0), pf1 = __builtin_bit_cast(bf16x8, p1);
#pragma unroll
    for (int dt = 0; dt < 4; ++dt) {
#pragma unroll
        for (int i = 0; i < 16; ++i) oh[dt][i] *= al;
        oh[dt] = __builtin_amdgcn_mfma_f32_32x32x16_bf16(vc[2 * dt], pf0, oh[dt], 0, 0, 0); oh[dt] = __builtin_amdgcn_mfma_f32_32x32x16_bf16(vc[2 * dt + 1], pf1, oh[dt], 0, 0, 0); }
}
__device__ __forceinline__ void attn_ld8(bf16x8 (&d)[8], const bf16* p) {
#pragma unroll
    for (int q = 0; q < 8; ++q) d[q] = *(const GAS bf16x8*)(p + 512 * q);
}
__device__ __forceinline__ void attn_phase_split(const bf16* QO, const bf16* Kb, const bf16* VT, unsigned char* O8, const LAS float* rb, LAS unsigned char* xch, int vcu, int G, int wave, int lane) {
    const int r32 = lane & 31, hl = lane >> 5;
    const int pr = wave & 3, role = wave >> 2;
    LAS unsigned char* xp = xch + pr * 9728;
    LAS unsigned char* pl = xp + lane * 32; LAS float* al = (LAS float*)(xp + 8192) + lane;
    for (int batch = vcu; batch < BATCH * 16 * 128 * 2 / 8; batch += G) {
        const int T0 = batch * 8, c0 = (T0 >> 1) & 127, h = (T0 >> 8) & 15, b = T0 >> 12, c = c0 + pr;
        const size_t bh256 = (size_t)(b * 16 + h) * 256;
        const bf16* Kl = Kb + bh256 * 4096 + (size_t)lane * 8; const bf16* Vl = VT + bh256 * 4096 + (size_t)lane * 8;
        const LAS float* rbh = rb + h * 257;
        int kt0 = 16 - 2 * c; if (kt0 < 0) kt0 = 0;
        const int kbase = 64 * c - 512, tb = kbase >> 5;
        if (role == 0) {
            bf16x8 q0[8], q1[8];
            attn_ld8(q0, QO + ((bh256 + 2 * c + 0) * 8) * 512 + (size_t)lane * 8); attn_ld8(q1, QO + ((bh256 + 2 * c + 1) * 8) * 512 + (size_t)lane * 8);
            float mrun0 = -1e30f, mrun1 = -1e30f, lrun0 = 0.f, lrun1 = 0.f;
            bf16x8 kc[8];
            attn_ld8(kc, Kl + (size_t)(tb + kt0) * 4096);
            for (int t = 0; t < 18; ++t) {
                if (t >= kt0) { f32x16 s0, s1;
                    attn_a_qk(s0, kc, q0); attn_a_qk(s1, kc, q1);
                    __builtin_amdgcn_sched_barrier(0);
                    if (t + 1 < 18) attn_ld8(kc, Kl + (size_t)(tb + t + 1) * 4096);
                    __builtin_amdgcn_sched_barrier(0);
                    const int so = (t & 1) * 4096, ao = (t & 1) * 128;
                    attn_a_half(s0, rbh, kbase + 32 * t, 64 * c, r32, hl, lane, mrun0, lrun0, pl + so, al + ao);
                    attn_a_half(s1, rbh, kbase + 32 * t, 64 * c + 32, r32, hl, lane, mrun1, lrun1, pl + so + 2048, al + ao + 64); }
                if (t == 17) { *(LAS float*)(xp + 9216 + lane * 4) = lrun0; *(LAS float*)(xp + 9216 + 256 + lane * 4) = lrun1; }
                LDS_WAIT(); __syncthreads();
            }
            __syncthreads();
        } else {
            f32x16 oA[4], oB[4];
#pragma unroll
            for (int dt = 0; dt < 4; ++dt)
#pragma unroll
                for (int i = 0; i < 16; ++i) { oA[dt][i] = 0.f; oB[dt][i] = 0.f; }
            bf16x8 vc[8];
            attn_ld8(vc, Vl + (size_t)(tb + kt0) * 4096);
            __syncthreads();
            for (int t = 0; t < 18; ++t) {
                if (t >= kt0) { const int so = (t & 1) * 4096, ao = (t & 1) * 128;
                    attn_b_half(vc, oA, pl + so, al + ao); attn_b_half(vc, oB, pl + so + 2048, al + ao + 64);
                    __builtin_amdgcn_sched_barrier(0);
                    if (t + 1 < 18) attn_ld8(vc, Vl + (size_t)(tb + t + 1) * 4096); }
                LDS_WAIT(); __syncthreads();
            }
            {   const float lf0 = *(const LAS float*)(xp + 9216 + lane * 4), lf1 = *(const LAS float*)(xp + 9216 + 256 + lane * 4);
                const float inv0 = O8S / lf0, inv1 = O8S / lf1;
                unsigned char* op0 = O8 + ((size_t)b * SEQ + 64 * c + r32) * D + h * 128 + 4 * hl; unsigned char* op1 = op0 + (size_t)32 * D;
#pragma unroll
                for (int dt = 0; dt < 4; ++dt)
#pragma unroll
                    for (int rq = 0; rq < 4; ++rq) { int w = 0; w = __builtin_amdgcn_cvt_pk_fp8_f32(oA[dt][4 * rq + 0] * inv0, oA[dt][4 * rq + 1] * inv0, w, false); w = __builtin_amdgcn_cvt_pk_fp8_f32(oA[dt][4 * rq + 2] * inv0, oA[dt][4 * rq + 3] * inv0, w, true);
                        *(int*)(op0 + 32 * dt + 8 * rq) = w;
                        int w2 = 0; w2 = __builtin_amdgcn_cvt_pk_fp8_f32(oB[dt][4 * rq + 0] * inv1, oB[dt][4 * rq + 1] * inv1, w2, false); w2 = __builtin_amdgcn_cvt_pk_fp8_f32(oB[dt][4 * rq + 2] * inv1, oB[dt][4 * rq + 3] * inv1, w2, true);
                        *(int*)(op1 + 32 * dt + 8 * rq) = w2; }
            }
        }
        __syncthreads();
    }
}

#define INS16(L, x) do { _Pragma("unroll") for (int _j = 15; _j >= 1; --_j) L[_j] = __builtin_amdgcn_fmed3f(L[_j - 1], L[_j], (x)); L[0] = fmaxf(L[0], (x)); } while (0)
__device__ __forceinline__ void peer_select_phase(const bf16* Q, const LAS unsigned char* skl  , int* idx_out, float* gate_out, int gw, int NGW, int lane) {
    const int r = lane & 31, half = lane >> 5;
    for (int it = gw; it < M / 4; it += NGW) {
        const int t = 4 * it + (r >> 3), hh = r & 7;
        float L[2][16];
#pragma unroll
        for (int s = 0; s < 2; ++s) {
#pragma unroll
            for (int j = 0; j < 16; ++j) L[s][j] = -3.0e38f;
            bf16x8 qf[8];
            const bf16* qp = Q + (size_t)t * D + hh * 256 + s * 128 + 8 * half;
#pragma unroll
            for (int ks = 0; ks < 8; ++ks) qf[ks] = *(const bf16x8*)(qp + 16 * ks);
#pragma unroll 1
            for (int nt = 0; nt < 4; ++nt) {
                f32x16 sc;
#pragma unroll
                for (int i = 0; i < 16; ++i) sc[i] = 0.f;
                const LAS unsigned char* kp = skl + (size_t)(s * 128 + 32 * nt + r) * 272 + 16 * half;
#pragma unroll
                for (int ks = 0; ks < 8; ++ks) { const bf16x8 kf = *(const LAS bf16x8*)(kp + 32 * ks); sc = __builtin_amdgcn_mfma_f32_32x32x16_bf16(kf, qf[ks], sc, 0, 0, 0); }
#pragma unroll
                for (int i = 0; i < 16; ++i) { const unsigned n = 32 * nt + (i & 3) + 8 * (i >> 2) + 4 * half;
                    const float sv = sc[i];
                    const float x = __builtin_bit_cast(float, (__builtin_bit_cast(unsigned, sv) & ~127u) | n);
                    INS16(L[s], x); }
            }
        }
        float mine[16], oth[16];
#pragma unroll
        for (int j = 0; j < 16; ++j) { const float o0 = SHFL_XOR(L[0][j], 32), o1 = SHFL_XOR(L[1][j], 32); mine[j] = half ? L[1][j] : L[0][j]; oth[j] = half ? o1 : o0; }
#pragma unroll
        for (int j = 0; j < 16; ++j) { const float x = oth[j]; INS16(mine, x); }
        float A[16], B[16];
#pragma unroll
        for (int j = 0; j < 16; ++j) { const float o = SHFL_XOR(mine[j], 32); A[j] = half ? o : mine[j]; B[j] = half ? mine[j] : o; }
        float T[16];
#pragma unroll
        for (int j = 0; j < 16; ++j) T[j] = -3.0e38f;
#pragma unroll
        for (int a = 0; a < 16; ++a)
#pragma unroll
            for (int bq = 0; bq < 16; ++bq) if ((a + 1) * (bq + 1) <= 16) { const float x = A[a] + B[bq]; INS16(T, x); }
        const float tau = T[15], mx = T[0];
        float den = 0.f;
#pragma unroll
        for (int j = 0; j < 16; ++j) den += __builtin_amdgcn_exp2f((T[j] - mx) * LOG2E);
        const float rden = 1.f / den;
        int cnt = 0;
        const size_t ob = (size_t)t * 128 + hh * 16;
#pragma unroll
        for (int a = 0; a < 16; ++a)
#pragma unroll
            for (int bq = 0; bq < 16; ++bq) if ((a + 1) * (bq + 1) <= 16) {
                const float x = A[a] + B[bq];
                if (x >= tau && cnt < 16) {
                    if (half == 0) idx_out[ob + cnt] = (int)(((__builtin_bit_cast(unsigned, A[a]) & 127u) << 7) | (__builtin_bit_cast(unsigned, B[bq]) & 127u));
                    else gate_out[ob + cnt] = __builtin_amdgcn_exp2f((x - mx) * LOG2E) * rden;
                    ++cnt;
                }
            }
    }
}

__device__ __forceinline__ void peer_gather_phase(float* hio, bf16* hb, const int* idx, const float* gate, const bf16* TU, const bf16* TV, const float* lg, const float* lb, int gw, int NGW, int lane) {
    for (int m = gw; m < M; m += NGW) {
        v4u xr[4];
#pragma unroll
        for (int j = 0; j < 4; ++j) xr[j] = *(const v4u*)(hb + (size_t)m * D + 512 * j + 8 * lane);
        const int i0 = idx[(size_t)m * 128 + lane], i1 = idx[(size_t)m * 128 + 64 + lane];
        float y[32];
#pragma unroll
        for (int i = 0; i < 32; ++i) y[i] = 0.f;
#ifdef DBG_NO_PEER
        for (int hb_ = 0; hb_ < 0; ++hb_) {
#else
        for (int hb_ = 0; hb_ < 8; ++hb_) {
#endif
            float part[16];
            const int isel = (hb_ < 4) ? i0 : i1;
#pragma unroll
            for (int kk = 0; kk < 16; ++kk) {
                const int e = __builtin_amdgcn_readlane(isel, ((hb_ & 3) << 4) + kk);
                const bf16* up = TU + (size_t)e * D + 8 * lane;
                float acc = 0.f;
#pragma unroll
                for (int j = 0; j < 4; ++j) { const v4u w = *(const v4u*)(up + 512 * j);
                    acc = dot2bf(w.x, xr[j].x, acc); acc = dot2bf(w.y, xr[j].y, acc); acc = dot2bf(w.z, xr[j].z, acc); acc = dot2bf(w.w, xr[j].w, acc); }
                part[kk] = acc;
            }
#pragma unroll
            for (int kk = 0; kk < 16; ++kk) { part[kk] += SHFL_XOR(part[kk], 32); part[kk] += SHFL_XOR(part[kk], 16); }
            {
                const bool b3 = (lane & 8) != 0, b2 = (lane & 4) != 0, b1 = (lane & 2) != 0, b0 = (lane & 1) != 0;
#pragma unroll
                for (int i = 0; i < 8; ++i) { const float send = b3 ? part[i] : part[i + 8], keep = b3 ? part[i + 8] : part[i]; part[i] = keep + SHFL_XOR(send, 8); }
#pragma unroll
                for (int i = 0; i < 4; ++i) { const float send = b2 ? part[i] : part[i + 4], keep = b2 ? part[i + 4] : part[i]; part[i] = keep + SHFL_XOR(send, 4); }
#pragma unroll
                for (int i = 0; i < 2; ++i) { const float send = b1 ? part[i] : part[i + 2], keep = b1 ? part[i + 2] : part[i]; part[i] = keep + SHFL_XOR(send, 2); }
                { const float send = b0 ? part[0] : part[1], keep = b0 ? part[1] : part[0]; part[0] = keep + SHFL_XOR(send, 1); }
            }
            const float gt = gate[(size_t)m * 128 + hb_ * 16 + (lane & 15)];
            const float act = gelu_f(part[0]) * gt;
            const unsigned actb = f2bf(act);
#pragma unroll
            for (int kk = 0; kk < 16; ++kk) {
                const int e = __builtin_amdgcn_readlane(isel, ((hb_ & 3) << 4) + kk);
                const unsigned ab = (unsigned)__builtin_amdgcn_readlane((int)actb, kk);
                const unsigned alo = ab, ahi = ab << 16;
                const bf16* vp = TV + (size_t)e * D + 8 * lane;
#pragma unroll
                for (int j = 0; j < 4; ++j) { const v4u w = *(const v4u*)(vp + 512 * j);
                    y[8 * j + 0] = dot2bf(w.x, alo, y[8 * j + 0]); y[8 * j + 1] = dot2bf(w.x, ahi, y[8 * j + 1]);
                    y[8 * j + 2] = dot2bf(w.y, alo, y[8 * j + 2]); y[8 * j + 3] = dot2bf(w.y, ahi, y[8 * j + 3]);
                    y[8 * j + 4] = dot2bf(w.z, alo, y[8 * j + 4]); y[8 * j + 5] = dot2bf(w.z, ahi, y[8 * j + 5]);
                    y[8 * j + 6] = dot2bf(w.w, alo, y[8 * j + 6]); y[8 * j + 7] = dot2bf(w.w, ahi, y[8 * j + 7]); }
            }
        }
        float* row = hio + (size_t)m * D + 8 * lane;
        float s = 0.f;
#pragma unroll
        for (int j = 0; j < 4; ++j) { const f32x4 a = *(const f32x4*)(row + 512 * j), b = *(const f32x4*)(row + 512 * j + 4);
            y[8 * j + 0] += DN_ALPHA * a.x; y[8 * j + 1] += DN_ALPHA * a.y; y[8 * j + 2] += DN_ALPHA * a.z; y[8 * j + 3] += DN_ALPHA * a.w;
            y[8 * j + 4] += DN_ALPHA * b.x; y[8 * j + 5] += DN_ALPHA * b.y; y[8 * j + 6] += DN_ALPHA * b.z; y[8 * j + 7] += DN_ALPHA * b.w; }
#pragma unroll
        for (int i = 0; i < 32; ++i) s += y[i];
        const float mean = wave_sum(s) * (1.f / D); float s2 = 0.f;
#pragma unroll
        for (int i = 0; i < 32; ++i) { y[i] -= mean; s2 += y[i] * y[i]; }
        const float rstd = 1.f / sqrtf(wave_sum(s2) * (1.f / D) + LN_EPS);
#pragma unroll
        for (int j = 0; j < 4; ++j) { const float* gp = lg + 512 * j + 8 * lane; const float* bp = lb + 512 * j + 8 * lane;
            const f32x4 g0 = *(const f32x4*)gp, g1 = *(const f32x4*)(gp + 4), b0 = *(const f32x4*)bp, b1 = *(const f32x4*)(bp + 4);
            f32x4 o0, o1; o0.x = y[8 * j + 0] * rstd * g0.x + b0.x; o0.y = y[8 * j + 1] * rstd * g0.y + b0.y; o0.z = y[8 * j + 2] * rstd * g0.z + b0.z; o0.w = y[8 * j + 3] * rstd * g0.w + b0.w;
            o1.x = y[8 * j + 4] * rstd * g1.x + b1.x; o1.y = y[8 * j + 5] * rstd * g1.y + b1.y; o1.z = y[8 * j + 6] * rstd * g1.z + b1.z; o1.w = y[8 * j + 7] * rstd * g1.w + b1.w;
            *(f32x4*)(row + 512 * j) = o0; *(f32x4*)(row + 512 * j + 4) = o1;
            v4u w; w.x = pk2(o0.x, o0.y); w.y = pk2(o0.z, o0.w); w.z = pk2(o1.x, o1.y); w.w = pk2(o1.z, o1.w);
            *(v4u*)(hb + (size_t)m * D + 512 * j + 8 * lane) = w; }
    }
}


__device__ __forceinline__ float udot8(const v4u (&w)[2], const f32x2 (&x2)[16]) {
    f32x2 a0 = {0.f, 0.f}, a1 = {0.f, 0.f};
#pragma unroll
    for (int j = 0; j < 2; ++j) {
        const unsigned d0 = w[j].x, d1 = w[j].y, d2 = w[j].z, d3 = w[j].w;
        a0 = __builtin_elementwise_fma(__builtin_amdgcn_cvt_pk_f32_fp8((int)d0, false), x2[8 * j + 0], a0); a1 = __builtin_elementwise_fma(__builtin_amdgcn_cvt_pk_f32_fp8((int)d0, true), x2[8 * j + 1], a1);
        a0 = __builtin_elementwise_fma(__builtin_amdgcn_cvt_pk_f32_fp8((int)d1, false), x2[8 * j + 2], a0); a1 = __builtin_elementwise_fma(__builtin_amdgcn_cvt_pk_f32_fp8((int)d1, true), x2[8 * j + 3], a1);
        a0 = __builtin_elementwise_fma(__builtin_amdgcn_cvt_pk_f32_fp8((int)d2, false), x2[8 * j + 4], a0); a1 = __builtin_elementwise_fma(__builtin_amdgcn_cvt_pk_f32_fp8((int)d2, true), x2[8 * j + 5], a1);
        a0 = __builtin_elementwise_fma(__builtin_amdgcn_cvt_pk_f32_fp8((int)d3, false), x2[8 * j + 6], a0); a1 = __builtin_elementwise_fma(__builtin_amdgcn_cvt_pk_f32_fp8((int)d3, true), x2[8 * j + 7], a1);
    }
    return (a0.x + a0.y) + (a1.x + a1.y);
}
__device__ __forceinline__ void vacc8(const v4u (&w)[2], const f32x2 a2, f32x2 (&y2)[16]) {
#pragma unroll
    for (int j = 0; j < 2; ++j) {
        const unsigned d0 = w[j].x, d1 = w[j].y, d2 = w[j].z, d3 = w[j].w;
        y2[8 * j + 0] = __builtin_elementwise_fma(__builtin_amdgcn_cvt_pk_f32_fp8((int)d0, false), a2, y2[8 * j + 0]); y2[8 * j + 1] = __builtin_elementwise_fma(__builtin_amdgcn_cvt_pk_f32_fp8((int)d0, true), a2, y2[8 * j + 1]);
        y2[8 * j + 2] = __builtin_elementwise_fma(__builtin_amdgcn_cvt_pk_f32_fp8((int)d1, false), a2, y2[8 * j + 2]); y2[8 * j + 3] = __builtin_elementwise_fma(__builtin_amdgcn_cvt_pk_f32_fp8((int)d1, true), a2, y2[8 * j + 3]);
        y2[8 * j + 4] = __builtin_elementwise_fma(__builtin_amdgcn_cvt_pk_f32_fp8((int)d2, false), a2, y2[8 * j + 4]); y2[8 * j + 5] = __builtin_elementwise_fma(__builtin_amdgcn_cvt_pk_f32_fp8((int)d2, true), a2, y2[8 * j + 5]);
        y2[8 * j + 6] = __builtin_elementwise_fma(__builtin_amdgcn_cvt_pk_f32_fp8((int)d3, false), a2, y2[8 * j + 6]); y2[8 * j + 7] = __builtin_elementwise_fma(__builtin_amdgcn_cvt_pk_f32_fp8((int)d3, true), a2, y2[8 * j + 7]);
    }
}
#define ROWLD8(dst, base, e) do { const u8* _p = (base) + (size_t)(e) * D + 16 * lane; dst[0] = gld16(_p); dst[1] = gld16(_p + 1024); } while (0)
__device__ __forceinline__ void peer_gather_fp8(float* hio, bf16* hb, float* hio_w, bf16* hb_w, const int* idx, const float* gate, const u8* TU8, const u8* TV8, const float* lg, const float* lb, int gw, int NGW, int lane_in) {
    for (int m = gw; m < M; m += NGW) {
        int lane = lane_in; asm volatile("" : "+v"(lane));
        float* row = hio + (size_t)m * D + 16 * lane;
        f32x2 x2[16];
#pragma unroll
        for (int j = 0; j < 2; ++j)
#pragma unroll
            for (int q = 0; q < 4; ++q) { const f32x4 t = *(const GAS f32x4*)(row + 1024 * j + 4 * q); x2[8 * j + 2 * q] = (f32x2){t.x, t.y}; x2[8 * j + 2 * q + 1] = (f32x2){t.z, t.w}; }
        const int i0 = *(const GAS int*)(idx + (size_t)m * 128 + lane), i1 = *(const GAS int*)(idx + (size_t)m * 128 + 64 + lane);
        f32x2 y2[16];
#pragma unroll
        for (int i = 0; i < 16; ++i) y2[i] = (f32x2){0.f, 0.f};
        v4u buf[4][2];
#pragma unroll
        for (int q = 0; q < 4; ++q) { const int e = __builtin_amdgcn_readlane(i0, q); ROWLD8(buf[q], TU8, e); }
        for (int hb_ = 0; hb_ < 8; ++hb_) {
            const int isel = (hb_ < 4) ? i0 : i1, inext = (hb_ + 1 < 4) ? i0 : i1;
            const int lb0 = (hb_ & 3) << 4, lbn = ((hb_ + 1) & 3) << 4;
            const float gt = *(const GAS float*)(gate + (size_t)m * 128 + hb_ * 16 + (lane & 15));
            float part[16];
#pragma unroll
            for (int kk = 0; kk < 16; ++kk) {
                part[kk] = udot8(buf[kk & 3], x2);
                if (kk + 4 < 16) { const int e = __builtin_amdgcn_readlane(isel, lb0 + kk + 4); ROWLD8(buf[kk & 3], TU8, e); }
                else { const int e = __builtin_amdgcn_readlane(isel, lb0 + kk + 4 - 16); ROWLD8(buf[kk & 3], TV8, e); }
                __builtin_amdgcn_sched_barrier(0);
            }
#pragma unroll
            for (int kk = 0; kk < 16; ++kk) { part[kk] += SHFL_XOR(part[kk], 32); part[kk] += SHFL_XOR(part[kk], 16); }
            {
                const bool b3 = (lane & 8) != 0, b2 = (lane & 4) != 0, b1 = (lane & 2) != 0, b0 = (lane & 1) != 0;
#pragma unroll
                for (int i = 0; i < 8; ++i) { const float send = b3 ? part[i] : part[i + 8], keep = b3 ? part[i + 8] : part[i]; part[i] = keep + SHFL_XOR(send, 8); }
#pragma unroll
                for (int i = 0; i < 4; ++i) { const float send = b2 ? part[i] : part[i + 4], keep = b2 ? part[i + 4] : part[i]; part[i] = keep + SHFL_XOR(send, 4); }
#pragma unroll
                for (int i = 0; i < 2; ++i) { const float send = b1 ? part[i] : part[i + 2], keep = b1 ? part[i + 2] : part[i]; part[i] = keep + SHFL_XOR(send, 2); }
                { const float send = b0 ? part[0] : part[1], keep = b0 ? part[1] : part[0]; part[0] = keep + SHFL_XOR(send, 1); }
            }
            const float act = gelu_f(part[0] * (1.f / TU_SCALE)) * gt * (1.f / TV_SCALE);
            const int acti = __builtin_bit_cast(int, act);
#pragma unroll
            for (int kk = 0; kk < 16; ++kk) {
                const float a = __builtin_bit_cast(float, __builtin_amdgcn_readlane(acti, kk));
                vacc8(buf[kk & 3], (f32x2){a, a}, y2);
                if (kk + 4 < 16) { const int e = __builtin_amdgcn_readlane(isel, lb0 + kk + 4); ROWLD8(buf[kk & 3], TV8, e); }
                else if (hb_ < 7) { const int e = __builtin_amdgcn_readlane(inext, lbn + kk + 4 - 16); ROWLD8(buf[kk & 3], TU8, e); }
                __builtin_amdgcn_sched_barrier(0);
            }
        }
        float s = 0.f;
#pragma unroll
        for (int i = 0; i < 16; ++i) { y2[i] = y2[i] + x2[i] * DN_ALPHA; s += y2[i].x + y2[i].y; }
        const float mean = wave_sum(s) * (1.f / D); float s2 = 0.f;
#pragma unroll
        for (int i = 0; i < 16; ++i) { y2[i] = y2[i] - mean; s2 += y2[i].x * y2[i].x + y2[i].y * y2[i].y; }
        const float rstd = 1.f / sqrtf(wave_sum(s2) * (1.f / D) + LN_EPS);
#pragma unroll
        for (int j = 0; j < 2; ++j)
#pragma unroll
            for (int q = 0; q < 4; ++q) { const int off = 1024 * j + 16 * lane + 4 * q;
                const f32x4 g4 = *(const GAS f32x4*)(lg + off), b4 = *(const GAS f32x4*)(lb + off);
                const f32x2 ya = y2[8 * j + 2 * q], yb = y2[8 * j + 2 * q + 1];
                f32x4 o; o.x = ya.x * rstd * g4.x + b4.x; o.y = ya.y * rstd * g4.y + b4.y; o.z = yb.x * rstd * g4.z + b4.z; o.w = yb.y * rstd * g4.w + b4.w;
                *(GAS f32x4*)(hio_w + (size_t)m * D + off) = o;
                v2u w; w.x = pk2(o.x, o.y); w.y = pk2(o.z, o.w); *(GAS v2u*)(hb_w + (size_t)m * D + off) = w; }
    }
}


__device__ __forceinline__ float wave_max(float v) {
    v = fmaxf(v, WDPP(v, 0xB1)); v = fmaxf(v, WDPP(v, 0x4E)); v = fmaxf(v, WDPP(v, 0x141)); v = fmaxf(v, WDPP(v, 0x140));
    return fmaxf(fmaxf(WRL(v, 0), WRL(v, 16)), fmaxf(WRL(v, 32), WRL(v, 48)));
}
__device__ __forceinline__ void cvt_rows_fp4(const float* src, u8* dst, float* scales, int nrows, int gw, int NGW, int lane) {
    for (int r0 = gw; r0 < nrows; r0 += 4 * NGW) {
        f32x4 v[4][8];
#pragma unroll
        for (int u = 0; u < 4; ++u) { const GAS f32x4* p = (const GAS f32x4*)(src + (size_t)(r0 + u * NGW) * D + 4 * lane);
#pragma unroll
            for (int q = 0; q < 8; ++q) v[u][q] = p[64 * q]; }
#pragma unroll
        for (int u = 0; u < 4; ++u) { const int r = r0 + u * NGW; float mx = 0.f;
#pragma unroll
            for (int q = 0; q < 8; ++q) mx = fmaxf(mx, fmaxf(fmaxf(__builtin_fabsf(v[u][q].x), __builtin_fabsf(v[u][q].y)), fmaxf(__builtin_fabsf(v[u][q].z), __builtin_fabsf(v[u][q].w))));
            mx = wave_max(mx);
            const float inv = mx > 0.f ? 6.f / mx : 0.f;
            const int lay = r / NEXP, e = r % NEXP;
#pragma unroll
            for (int q = 0; q < 8; ++q) { unsigned t = 0u; const f32x4 a = v[u][q] * inv;
                t = __builtin_amdgcn_cvt_scalef32_pk_fp4_f32(t, a.x, a.y, 1.0f, 0); t = __builtin_amdgcn_cvt_scalef32_pk_fp4_f32(t, a.z, a.w, 1.0f, 1);
                *(GAS unsigned short*)(dst + (((size_t)lay * 8 + q) * NEXP + e) * 128 + 2 * lane) = (unsigned short)(t & 0xffffu); }
            if (lane == 0) scales[r] = mx * (1.f / 6.f); }
    }
}
__device__ __forceinline__ float udot4(const v4u w, const f32x2 (&x2)[16]) {
    f32x2 a0 = {0.f, 0.f}, a1 = {0.f, 0.f};
    const unsigned d0 = w.x, d1 = w.y, d2 = w.z, d3 = w.w;
#define UD4(dw, k) a0 = __builtin_elementwise_fma(__builtin_amdgcn_cvt_scalef32_pk_f32_fp4(dw, 1.0f, 0), x2[4 * (k) + 0], a0); a1 = __builtin_elementwise_fma(__builtin_amdgcn_cvt_scalef32_pk_f32_fp4(dw, 1.0f, 1), x2[4 * (k) + 1], a1); \
                   a0 = __builtin_elementwise_fma(__builtin_amdgcn_cvt_scalef32_pk_f32_fp4(dw, 1.0f, 2), x2[4 * (k) + 2], a0); a1 = __builtin_elementwise_fma(__builtin_amdgcn_cvt_scalef32_pk_f32_fp4(dw, 1.0f, 3), x2[4 * (k) + 3], a1);
    UD4(d0, 0) UD4(d1, 1) UD4(d2, 2) UD4(d3, 3)
#undef UD4
    return (a0.x + a0.y) + (a1.x + a1.y);
}
__device__ __forceinline__ void vacc4(const v4u w, const f32x2 a2, f32x2 (&y2)[16]) {
    const unsigned d0 = w.x, d1 = w.y, d2 = w.z, d3 = w.w;
#define VA4(dw, k) y2[4 * (k) + 0] = __builtin_elementwise_fma(__builtin_amdgcn_cvt_scalef32_pk_f32_fp4(dw, 1.0f, 0), a2, y2[4 * (k) + 0]); y2[4 * (k) + 1] = __builtin_elementwise_fma(__builtin_amdgcn_cvt_scalef32_pk_f32_fp4(dw, 1.0f, 1), a2, y2[4 * (k) + 1]); \
                   y2[4 * (k) + 2] = __builtin_elementwise_fma(__builtin_amdgcn_cvt_scalef32_pk_f32_fp4(dw, 1.0f, 2), a2, y2[4 * (k) + 2]); y2[4 * (k) + 3] = __builtin_elementwise_fma(__builtin_amdgcn_cvt_scalef32_pk_f32_fp4(dw, 1.0f, 3), a2, y2[4 * (k) + 3]);
    VA4(d0, 0) VA4(d1, 1) VA4(d2, 2) VA4(d3, 3)
#undef VA4
}
#define ROWLD4(dst, base, e) do { dst = gld16((base) + (size_t)(e) * 1024 + 16 * lane); } while (0)
__device__ __forceinline__ void peer_gather_fp4(float* hio, bf16* hb, float* hio_w, bf16* hb_w, const int* idx, const float* gate, const u8* TU4, const u8* TV4, const float* SU, const float* SV,
                                                const float* lg, const float* lb, int gw, int NGW, int lane_in) {
    for (int m = gw; m < M; m += NGW) {
        int lane = lane_in; asm volatile("" : "+v"(lane));
        const float* row = hio + (size_t)m * D + 32 * lane;
        f32x2 x2[16];
#pragma unroll
        for (int q = 0; q < 8; ++q) { const f32x4 t = *(const GAS f32x4*)(row + 4 * q); x2[2 * q] = (f32x2){t.x, t.y}; x2[2 * q + 1] = (f32x2){t.z, t.w}; }
        const int i0 = *(const GAS int*)(idx + (size_t)m * 128 + lane), i1 = *(const GAS int*)(idx + (size_t)m * 128 + 64 + lane);
        f32x2 y2[16];
#pragma unroll
        for (int i = 0; i < 16; ++i) y2[i] = (f32x2){0.f, 0.f};
        v4u buf[8];
#pragma unroll
        for (int q = 0; q < 8; ++q) { const int e = __builtin_amdgcn_readlane(i0, q); ROWLD4(buf[q], TU4, e); }
        for (int hb_ = 0; hb_ < 8; ++hb_) {
            const int isel = (hb_ < 4) ? i0 : i1, inext = (hb_ + 1 < 4) ? i0 : i1;
            const int lb0 = (hb_ & 3) << 4, lbn = ((hb_ + 1) & 3) << 4;
            const float gt = *(const GAS float*)(gate + (size_t)m * 128 + hb_ * 16 + (lane & 15));
            const int ek = shfl_idx_lane(isel, lb0 + (lane & 15));
            const float su = *(const GAS float*)(SU + ek), sv = *(const GAS float*)(SV + ek);
            float part[16];
#pragma unroll
            for (int kk = 0; kk < 16; ++kk) {
                part[kk] = udot4(buf[kk & 7], x2);
                if (kk + 8 < 16) { const int e = __builtin_amdgcn_readlane(isel, lb0 + kk + 8); ROWLD4(buf[kk & 7], TU4, e); }
                else { const int e = __builtin_amdgcn_readlane(isel, lb0 + kk + 8 - 16); ROWLD4(buf[kk & 7], TV4, e); }
                __builtin_amdgcn_sched_barrier(0);
            }
#pragma unroll
            for (int kk = 0; kk < 16; ++kk) { part[kk] += SHFL_XOR(part[kk], 32); part[kk] += SHFL_XOR(part[kk], 16); }
            {
                const bool b3 = (lane & 8) != 0, b2 = (lane & 4) != 0, b1 = (lane & 2) != 0, b0 = (lane & 1) != 0;
#pragma unroll
                for (int i = 0; i < 8; ++i) { const float send = b3 ? part[i] : part[i + 8], keep = b3 ? part[i + 8] : part[i]; part[i] = keep + SHFL_XOR(send, 8); }
#pragma unroll
                for (int i = 0; i < 4; ++i) { const float send = b2 ? part[i] : part[i + 4], keep = b2 ? part[i + 4] : part[i]; part[i] = keep + SHFL_XOR(send, 4); }
#pragma unroll
                for (int i = 0; i < 2; ++i) { const float send = b1 ? part[i] : part[i + 2], keep = b1 ? part[i + 2] : part[i]; part[i] = keep + SHFL_XOR(send, 2); }
                { const float send = b0 ? part[0] : part[1], keep = b0 ? part[1] : part[0]; part[0] = keep + SHFL_XOR(send, 1); }
            }
            const float act = gelu_f(part[0] * su) * gt * sv;
            const int acti = __builtin_bit_cast(int, act);
#pragma unroll
            for (int kk = 0; kk < 16; ++kk) {
                const float a = __builtin_bit_cast(float, __builtin_amdgcn_readlane(acti, kk));
                vacc4(buf[kk & 7], (f32x2){a, a}, y2);
                if (kk + 8 < 16) { const int e = __builtin_amdgcn_readlane(isel, lb0 + kk + 8); ROWLD4(buf[kk & 7], TV4, e); }
                else if (hb_ < 7) { const int e = __builtin_amdgcn_readlane(inext, lbn + kk + 8 - 16); ROWLD4(buf[kk & 7], TU4, e); }
                __builtin_amdgcn_sched_barrier(0);
            }
        }
        float s = 0.f;
#pragma unroll
        for (int i = 0; i < 16; ++i) { y2[i] = y2[i] + x2[i] * DN_ALPHA; s += y2[i].x + y2[i].y; }
        const float mean = wave_sum(s) * (1.f / D); float s2 = 0.f;
#pragma unroll
        for (int i = 0; i < 16; ++i) { y2[i] = y2[i] - mean; s2 += y2[i].x * y2[i].x + y2[i].y * y2[i].y; }
        const float rstd = 1.f / sqrtf(wave_sum(s2) * (1.f / D) + LN_EPS);
#pragma unroll
        for (int q = 0; q < 8; ++q) { const int off = 32 * lane + 4 * q;
            const f32x4 g4 = *(const GAS f32x4*)(lg + off), b4 = *(const GAS f32x4*)(lb + off);
            const f32x2 ya = y2[2 * q], yb = y2[2 * q + 1];
            f32x4 o; o.x = ya.x * rstd * g4.x + b4.x; o.y = ya.y * rstd * g4.y + b4.y; o.z = yb.x * rstd * g4.z + b4.z; o.w = yb.y * rstd * g4.w + b4.w;
            *(GAS f32x4*)(hio_w + (size_t)m * D + off) = o;
            v2u w; w.x = pk2(o.x, o.y); w.y = pk2(o.z, o.w); *(GAS v2u*)(hb_w + (size_t)m * D + off) = w; }
    }
}


typedef _Float16 h16x2 __attribute__((ext_vector_type(2)));
#define CVT_H2_FP4(dw, b) __builtin_bit_cast(h16x2, __builtin_amdgcn_cvt_scalef32_pk_f16_fp4(dw, 1.0f, b))
__device__ __forceinline__ float udot4h(const v4u w, const h16x2 (&xh)[16]) {
    h16x2 a0 = {(_Float16)0.f, (_Float16)0.f}, a1 = {(_Float16)0.f, (_Float16)0.f};
    const unsigned d0 = w.x, d1 = w.y, d2 = w.z, d3 = w.w;
#define UD4H(dw, k) a0 = __builtin_elementwise_fma(CVT_H2_FP4(dw, 0), xh[4 * (k) + 0], a0); a1 = __builtin_elementwise_fma(CVT_H2_FP4(dw, 1), xh[4 * (k) + 1], a1); \
                    a0 = __builtin_elementwise_fma(CVT_H2_FP4(dw, 2), xh[4 * (k) + 2], a0); a1 = __builtin_elementwise_fma(CVT_H2_FP4(dw, 3), xh[4 * (k) + 3], a1);
    UD4H(d0, 0) UD4H(d1, 1) UD4H(d2, 2) UD4H(d3, 3)
#undef UD4H
    return ((float)a0.x + (float)a0.y) + ((float)a1.x + (float)a1.y);
}
__device__ __forceinline__ void vacc4h(const v4u w, const h16x2 a2, h16x2 (&yh)[16]) {
    const unsigned d0 = w.x, d1 = w.y, d2 = w.z, d3 = w.w;
#define VA4H(dw, k) yh[4 * (k) + 0] = __builtin_elementwise_fma(CVT_H2_FP4(dw, 0), a2, yh[4 * (k) + 0]); yh[4 * (k) + 1] = __builtin_elementwise_fma(CVT_H2_FP4(dw, 1), a2, yh[4 * (k) + 1]); \
                    yh[4 * (k) + 2] = __builtin_elementwise_fma(CVT_H2_FP4(dw, 2), a2, yh[4 * (k) + 2]); yh[4 * (k) + 3] = __builtin_elementwise_fma(CVT_H2_FP4(dw, 3), a2, yh[4 * (k) + 3]);
    VA4H(d0, 0) VA4H(d1, 1) VA4H(d2, 2) VA4H(d3, 3)
#undef VA4H
}

#define DPP_ADD(v, ctrl) ((v) + __builtin_bit_cast(float, __builtin_amdgcn_update_dpp(0, __builtin_bit_cast(int, (v)), (ctrl), 0xF, 0xF, true)))
#define LOAD_II16(dst, mm) do { const GAS v4u* _ip = (const GAS v4u*)(idx + (size_t)(mm) * 128 + 16 * eg); const v4u _a = _ip[0], _b = _ip[1], _c = _ip[2], _d = _ip[3]; \
    dst[0] = _a.x; dst[1] = _a.y; dst[2] = _a.z; dst[3] = _a.w; dst[4] = _b.x; dst[5] = _b.y; dst[6] = _b.z; dst[7] = _b.w; dst[8] = _c.x; dst[9] = _c.y; dst[10] = _c.z; dst[11] = _c.w; dst[12] = _d.x; dst[13] = _d.y; dst[14] = _d.z; dst[15] = _d.w; } while (0)
typedef int v8i_m __attribute__((ext_vector_type(8)));
#define U_QADD(keep, send, ctrl) ((keep) + __builtin_bit_cast(float, __builtin_amdgcn_update_dpp(0, __builtin_bit_cast(int, (send)), (ctrl), 0xF, 0xF, true)))
__device__ __forceinline__ void u_step(const u8* x4, const int* idx, const u8* tab, float* Ps, int m, int mn, int mnn, int eg, int aoff, int xoff, bool xval, bool b0, bool b1, int poff, int sc1, int scb,
                                       const v4u (&bufC)[16], const v4u& xC, const unsigned (&idxN)[16], v4u (&bufN)[16], v4u& xN, unsigned (&idxNN)[16]) {
#pragma unroll
    for (int t = 0; t < 16; ++t) bufN[t] = gld16(tab + (size_t)idxN[t] * 128 + aoff);
    xN = gld16(x4 + (size_t)mn * 2048 + xoff);
    LOAD_II16(idxNN, mnn);
    __builtin_amdgcn_sched_barrier(0);
    const v8i_m bx = {xval ? (int)xC.x : 0, xval ? (int)xC.y : 0, xval ? (int)xC.z : 0, xval ? (int)xC.w : 0, 0, 0, 0, 0};
    f32x4 acc[16];
#pragma unroll
    for (int t = 0; t < 16; ++t) { const v8i_m a8 = {(int)bufC[t].x, (int)bufC[t].y, (int)bufC[t].z, (int)bufC[t].w, 0, 0, 0, 0};
        acc[t] = __builtin_amdgcn_mfma_scale_f32_16x16x128_f8f6f4(a8, bx, (f32x4){0.f, 0.f, 0.f, 0.f}, 4, 4, 0, sc1, 0, scb); }
    float v[16];
#pragma unroll
    for (int t = 0; t < 16; ++t) { const float lo = b0 ? acc[t].y : acc[t].x, hi = b0 ? acc[t].w : acc[t].z; const float vv = b1 ? hi : lo; v[t] = U_QADD(vv, vv, 0x128); }
    float w[8];
#pragma unroll
    for (int i = 0; i < 8; ++i) { const float send = b0 ? v[i] : v[i + 8], keep = b0 ? v[i + 8] : v[i]; w[i] = U_QADD(keep, send, 0xB1); }
    f32x4 z;
#pragma unroll
    for (int i = 0; i < 4; ++i) { const float send = b1 ? w[i] : w[i + 4], keep = b1 ? w[i + 4] : w[i]; z[i] = U_QADD(keep, send, 0x4E); }
    if (poff >= 0) { const h16x2 zl = {(_Float16)z[0], (_Float16)z[1]}, zh = {(_Float16)z[2], (_Float16)z[3]};
        *(GAS v2u*)((_Float16*)Ps + (size_t)m * 128 + poff) = (v2u){__builtin_bit_cast(unsigned, zl), __builtin_bit_cast(unsigned, zh)}; }
    __builtin_amdgcn_sched_barrier(0);
}
__device__ __forceinline__ void peer_u_pass(const u8* x4, const int* idx, const u8* TUl, float* P, int bx, int G, int wave, int lane_in) {
    const int s = bx & 7, cu = bx >> 3, nW = (G >> 3) * NWAVES;
    const u8* tab = TUl + (size_t)s * NEXP * 128;
    float* Ps = (float*)((_Float16*)P + (size_t)s * M * 128);
    int lane = lane_in; asm volatile("" : "+v"(lane));
    const int n = lane & 15, kg = lane >> 4;
    const int eg = 2 * (n >> 2) + (kg >> 1);
    const int aoff = 16 * (4 * (kg & 1) + (n & 3));
    const int xoff = 128 * s + aoff + ((n & 8) ? 1024 : 0);
    const bool xval = (kg >> 1) == ((n >> 2) & 1);
    const bool b0 = (lane & 1) != 0, b1 = (lane & 2) != 0;
    const int poff = (n < 8) ? 16 * (2 * kg + (n >> 2)) + (b0 ? 8 : 0) + (b1 ? 4 : 0) : -1;
    const int m0 = cu * NWAVES + wave;
    int sc1 = 0x7F7F7F7F, sc8 = (n & 8) ? 0x7C7C7C7C : 0x7F7F7F7F; asm volatile("" : "+v"(sc1), "+v"(sc8));
    unsigned iiX[16], iiY[16]; v4u bufA[16], bufB[16]; v4u xA, xB;
    {   LOAD_II16(iiY, m0);
#pragma unroll
        for (int t = 0; t < 16; ++t) bufA[t] = gld16(tab + (size_t)iiY[t] * 128 + aoff);
        xA = gld16(x4 + (size_t)m0 * 2048 + xoff);
        const int m1 = (m0 + nW < M) ? m0 + nW : m0; LOAD_II16(iiX, m1); }
#define CLAMPM(x) (((x) < M) ? (x) : m0)
    for (int m = m0; m < M; m += 2 * nW) {
        u_step(x4, idx, tab, Ps, m, CLAMPM(m + nW), CLAMPM(m + 2 * nW), eg, aoff, xoff, xval, b0, b1, poff, sc1, sc8, bufA, xA, iiX, bufB, xB, iiY);
        u_step(x4, idx, tab, Ps, m + nW, CLAMPM(m + 2 * nW), CLAMPM(m + 3 * nW), eg, aoff, xoff, xval, b0, b1, poff, sc1, sc8, bufB, xB, iiY, bufA, xA, iiX);
    }
}
__device__ __forceinline__ void peer_act_phase(const float* P, const int* idx, float* gate, const float* SU, const float* SV, int gw, int NGW, int lane) {
    const GAS _Float16* Ph = (const GAS _Float16*)P;
    for (int m0 = gw; m0 < M; m0 += 4 * NGW) {
        int e[8]; float gt[8]; _Float16 pz[8][8];
#pragma unroll
        for (int i = 0; i < 8; ++i) { const int m = m0 + (i >> 1) * NGW, mm = (m < M) ? m : m0; e[i] = *(const GAS int*)(idx + (size_t)mm * 128 + 64 * (i & 1) + lane); }
#pragma unroll
        for (int i = 0; i < 8; ++i) { const int m = m0 + (i >> 1) * NGW, mm = (m < M) ? m : m0, k = 64 * (i & 1) + lane;
            gt[i] = *(const GAS float*)(gate + (size_t)mm * 128 + k);
#pragma unroll
            for (int sl = 0; sl < 8; ++sl) pz[i][sl] = Ph[((size_t)sl * M + mm) * 128 + k]; }
        float su[8], sv[8];
#pragma unroll
        for (int i = 0; i < 8; ++i) { su[i] = *(const GAS float*)(SU + e[i]); sv[i] = *(const GAS float*)(SV + e[i]); }
        __builtin_amdgcn_sched_barrier(0);
#pragma unroll
        for (int i = 0; i < 8; ++i) { const int m = m0 + (i >> 1) * NGW, k = 64 * (i & 1) + lane;
            float z = 0.f;
#pragma unroll
            for (int sl = 0; sl < 8; ++sl) z += (float)pz[i][sl];
            if (m < M) *(GAS float*)(gate + (size_t)m * 128 + k) = gelu_f(z * su[i]) * gt[i] * sv[i]; }
        __builtin_amdgcn_sched_barrier(0);
    }
}
#define LOAD_AA16(dst, mm) do { const GAS f32x4* _ap = (const GAS f32x4*)(act + (size_t)(mm) * 128 + 16 * eg); const f32x4 _a = _ap[0], _b = _ap[1], _c = _ap[2], _d = _ap[3]; \
    dst[0] = _a.x; dst[1] = _a.y; dst[2] = _a.z; dst[3] = _a.w; dst[4] = _b.x; dst[5] = _b.y; dst[6] = _b.z; dst[7] = _b.w; dst[8] = _c.x; dst[9] = _c.y; dst[10] = _c.z; dst[11] = _c.w; dst[12] = _d.x; dst[13] = _d.y; dst[14] = _d.z; dst[15] = _d.w; } while (0)
__device__ __forceinline__ void v_step(bf16* hio, const int* idx, const float* act, const u8* tab, const float* stats, const f32x4 lg, const f32x4 lb, int m, int mn, int mnn, int lane, int c, int eg, int coff, bool b0,
                                       const v4u (&bufC)[16], const float (&aaC)[16], const unsigned (&idxN)[16], v4u (&bufN)[16], float (&aaN)[16], unsigned (&idxNN)[16]) {
#pragma unroll
    for (int g = 0; g < 16; ++g) bufN[g] = gld16(tab + (size_t)idxN[g] * 128 + 16 * c);
    LOAD_AA16(aaN, mn);
    LOAD_II16(idxNN, mnn);
    bf16* op = hio + (size_t)m * D + coff;
    const v2u xw = *(const GAS v2u*)op;
    const f32x2 st = *(const GAS f32x2*)(stats + 2 * (size_t)m);
    __builtin_amdgcn_sched_barrier(0);
    h16x2 y2[16];
#pragma unroll
    for (int i = 0; i < 16; ++i) y2[i] = (h16x2){(_Float16)0.f, (_Float16)0.f};
#pragma unroll
    for (int g = 0; g < 16; ++g) { const _Float16 a = (_Float16)aaC[g]; vacc4h(bufC[g], (h16x2){a, a}, y2); }
#pragma unroll
    for (int i = 0; i < 8; ++i) { const h16x2 send = b0 ? y2[i] : y2[i + 8], keep = b0 ? y2[i + 8] : y2[i];
        y2[i] = keep + __builtin_bit_cast(h16x2, __builtin_amdgcn_update_dpp(0, __builtin_bit_cast(int, send), 0x128, 0xF, 0xF, true)); }
#pragma unroll
    for (int i = 0; i < 4; ++i) { const auto sw = __builtin_amdgcn_permlane16_swap(__builtin_bit_cast(unsigned, y2[i]), __builtin_bit_cast(unsigned, y2[i + 4]), false, false);
        const unsigned s0 = sw[0], s1 = sw[1]; y2[i] = __builtin_bit_cast(h16x2, s0) + __builtin_bit_cast(h16x2, s1); }
#pragma unroll
    for (int i = 0; i < 2; ++i) { const auto sw = __builtin_amdgcn_permlane32_swap(__builtin_bit_cast(unsigned, y2[i]), __builtin_bit_cast(unsigned, y2[i + 2]), false, false);
        const unsigned s0 = sw[0], s1 = sw[1]; y2[i] = __builtin_bit_cast(h16x2, s0) + __builtin_bit_cast(h16x2, s1); }
    const float x0 = (bflo(xw.x) - st.x) * st.y * lg.x + lb.x, x1 = (bfhi(xw.x) - st.x) * st.y * lg.y + lb.y, x2 = (bflo(xw.y) - st.x) * st.y * lg.z + lb.z, x3 = (bfhi(xw.y) - st.x) * st.y * lg.w + lb.w;
    v2u o; o.x = pk2(x0 * DN_ALPHA + (float)y2[0].x, x1 * DN_ALPHA + (float)y2[0].y); o.y = pk2(x2 * DN_ALPHA + (float)y2[1].x, x3 * DN_ALPHA + (float)y2[1].y);
    *(GAS v2u*)op = o;
    __builtin_amdgcn_sched_barrier(0);
}
__device__ __forceinline__ void peer_v_pass(bf16* hio, const int* idx, const float* act, const u8* TVl, const float* stats, const float* lng, const float* lnb, int bx, int G, int wave, int lane_in) {
    const int s = bx & 7, cu = bx >> 3, nW = (G >> 3) * NWAVES;
    const u8* tab = TVl + (size_t)s * NEXP * 128;
    int lane = lane_in; asm volatile("" : "+v"(lane));
    const int c = lane & 7, eg = lane >> 3;
    const bool b0 = (lane & 8) != 0, b1 = (lane & 16) != 0, b2 = (lane & 32) != 0;
    const int coff = 256 * s + 32 * c + (b0 ? 16 : 0) + (b1 ? 8 : 0) + (b2 ? 4 : 0);
    const int m0 = cu * NWAVES + wave;
    const f32x4 lg = *(const GAS f32x4*)(lng + coff), lb = *(const GAS f32x4*)(lnb + coff);
    unsigned iiX[16], iiY[16]; v4u bufA[16], bufB[16]; float aaA[16], aaB[16];
    {   LOAD_II16(iiY, m0);
#pragma unroll
        for (int g = 0; g < 16; ++g) bufA[g] = gld16(tab + (size_t)iiY[g] * 128 + 16 * c);
        LOAD_AA16(aaA, m0);
        const int m1 = (m0 + nW < M) ? m0 + nW : m0; LOAD_II16(iiX, m1); }
    for (int m = m0; m < M; m += 2 * nW) {
        v_step(hio, idx, act, tab, stats, lg, lb, m, CLAMPM(m + nW), CLAMPM(m + 2 * nW), lane, c, eg, coff, b0, bufA, aaA, iiX, bufB, aaB, iiY);
        v_step(hio, idx, act, tab, stats, lg, lb, m + nW, CLAMPM(m + 2 * nW), CLAMPM(m + 3 * nW), lane, c, eg, coff, b0, bufB, aaB, iiY, bufA, aaA, iiX);
    }
}

constexpr int N_SLOTS = 11;
struct Args { const float* in[31]; float* out; unsigned char* ws; int slot, layer, pad0, pad1; };

constexpr int TAB_OFF = MISC_OFF + 128;
__device__ __forceinline__ void store_tab(const Args& a, LAS unsigned char* lds) {
    if (threadIdx.x == 0) { LAS unsigned long long* t = (LAS unsigned long long*)(lds + TAB_OFF);
#pragma unroll
        for (int i = 0; i < 31; ++i) t[i] = (unsigned long long)a.in[i];
        t[31] = (unsigned long long)a.out; t[32] = (unsigned long long)a.ws; }
    __syncthreads();
}
struct Tab { unsigned tab;
    __device__ __forceinline__ unsigned long long raw(int k) const { const v2u v = *(const LAS v2u*)(tab + 8 * k);
        return ((unsigned long long)(unsigned)__builtin_amdgcn_readfirstlane((int)v.y) << 32) | (unsigned)__builtin_amdgcn_readfirstlane((int)v.x); }
    __device__ __forceinline__ const float* in(int k) const { return (const float*)raw(k); }
};
#define ARG_IN(k) T_.in(k)

template <int SLOT>
__device__ __forceinline__ void run_slot(LAS unsigned char* lds, int layer, int wave_s) {
    int tid = wave_s * 64 + lane_id(); asm volatile("" : "+v"(tid));
    Tab T_; T_.tab = (unsigned)(unsigned long long)(lds + TAB_OFF); asm volatile("" : "+s"(T_.tab));
    unsigned char* ws = (unsigned char*)T_.raw(32);
    const int lane = tid & 63, wave = __builtin_amdgcn_readfirstlane(tid >> 6);
    const int G = gridDim.x; const int bx = blockIdx.x; const int vcu = (G % 8 == 0) ? (bx % 8) * (G / 8) + bx / 8 : bx;
    const int gw = vcu * NWAVES + wave, NGW = G * NWAVES;
    const int gtid = vcu * (NWAVES * 64) + tid, gthreads = G * NWAVES * 64;
    const int kind = layer % 3, jj = layer / 3;
    float* hout = (float*)T_.raw(31);
    bf16* HB0 = (bf16*)(ws + WS_HB0); bf16* HB1 = (bf16*)(ws + WS_HB1);
    bf16* T1 = (bf16*)(ws + WS_T1); bf16* T2 = (bf16*)(ws + WS_T2); bf16* T3 = (bf16*)(ws + WS_T3);
    int* IDX = (int*)(ws + WS_IDX); float* GATE = (float*)(ws + WS_GATE);
    bf16* TU = (bf16*)(ws + WS_TU); bf16* TV = (bf16*)(ws + WS_TV); bf16* PB = (bf16*)(ws + WS_PB); bf16* SKB = (bf16*)(ws + WS_SK);
    bf16* Sin = (layer & 1) ? HB1 : HB0;
    bf16* Sout = (layer & 1) ? HB0 : HB1;

    if constexpr (SLOT == 0) {
        LAS float* scr = (LAS float*)(lds + wave * 16384); LAS unsigned* scr8 = (LAS unsigned*)(lds + wave * 16384); int woff = 0;
        for (int j = 0; j < 2; ++j) {
            transpose_mat8b(ARG_IN(6) + (size_t)j * D * D, D, D, ws + W_POOL_IN + (size_t)j * D * D, 0, scr8, gw, NGW, lane, woff);
            for (int g = 0; g < 4; ++g) transpose_mat8b(ARG_IN(7) + (size_t)(j * 4 + g) * 512 * 512, 512, 512, ws + W_POOL_GRP + (size_t)j * D * 512, g * 512, scr8, gw, NGW, lane, woff);
            transpose_mat8b(ARG_IN(9) + (size_t)j * D * D, D, D, ws + W_POOL_OUT + (size_t)j * D * D, 0, scr8, gw, NGW, lane, woff);
        }
        transpose_mat8b(ARG_IN(10), D, D, ws + W_SSM_IN, 0, scr8, gw, NGW, lane, woff);
        transpose_mat8b(ARG_IN(19), D, D, ws + W_SSM_GLU, 0, scr8, gw, NGW, lane, woff);
        transpose_mat8b(ARG_IN(20), D, D, ws + W_SSM_OUT, 0, scr8, gw, NGW, lane, woff);
        transpose_mat8b(ARG_IN(21), D, 3 * D, ws + W_ATTN_QKV, 0, scr8, gw, NGW, lane, woff);
        transpose_mat8b(ARG_IN(23), D, D, ws + W_ATTN_OUT, 0, scr8, gw, NGW, lane, woff);
        for (int i = 0; i < DEPTH; ++i) {
            transpose_mat8b(ARG_IN(24) + (size_t)i * D * D, D, D, ws + W_PEER_Q + (size_t)i * D * D, 0, scr8, gw, NGW, lane, woff);
            transpose_mat8b(ARG_IN(29) + (size_t)i * D * D, D, D, ws + W_PLE_GATE + (size_t)i * D * D, 0, scr8, gw, NGW, lane, woff);
            transpose_mat(ARG_IN(28) + (size_t)i * PLE * D, PLE, D, (bf16*)(ws + W_PLE_PROJ) + (size_t)i * PLE * D, 0, scr, gw, NGW, lane, woff);
        }
        cvt_rows_fp4(ARG_IN(26), (u8*)TU, (float*)(ws + WS_SU), DEPTH * NEXP, gw, NGW, lane);
        cvt_rows_fp4(ARG_IN(27), (u8*)TV, (float*)(ws + WS_SV), DEPTH * NEXP, gw, NGW, lane);
        cvt_rows(ARG_IN(1), PB, (size_t)DEPTH * M * PLE, (size_t)gtid, (size_t)gthreads);
        cvt_rows(ARG_IN(25), SKB, (size_t)DEPTH * 2 * 128 * 128, (size_t)gtid, (size_t)gthreads);
        {
            const float* xs = ARG_IN(0); unsigned char* s8 = ws + WS_S8;
            const size_t gs = (size_t)gthreads * 8;
            for (size_t i0 = (size_t)gtid * 8; i0 < (size_t)M * D; i0 += 4 * gs) {
                f32x4 a[4], b[4];
#pragma unroll
                for (int u = 0; u < 4; ++u) { a[u] = *(const GAS f32x4*)(xs + i0 + u * gs); b[u] = *(const GAS f32x4*)(xs + i0 + u * gs + 4); }
#pragma unroll
                for (int u = 0; u < 4; ++u) { const size_t i = i0 + u * gs;
                    v4u o; o.x = pk2(a[u].x, a[u].y); o.y = pk2(a[u].z, a[u].w); o.z = pk2(b[u].x, b[u].y); o.w = pk2(b[u].z, b[u].w);
                    *(GAS v4u*)(HB0 + i) = o;
                    int w0 = 0, w1 = 0;
                    w0 = __builtin_amdgcn_cvt_pk_fp8_f32(a[u].x, a[u].y, w0, false); w0 = __builtin_amdgcn_cvt_pk_fp8_f32(a[u].z, a[u].w, w0, true);
                    w1 = __builtin_amdgcn_cvt_pk_fp8_f32(b[u].x, b[u].y, w1, false); w1 = __builtin_amdgcn_cvt_pk_fp8_f32(b[u].z, b[u].w, w1, true);
                    v2u o8; o8.x = (unsigned)w0; o8.y = (unsigned)w1; *(GAS v2u*)(s8 + i) = o8; } } }
        {
            const float* lam_re = ARG_IN(11); const float* lam_im = ARG_IN(12); const float* log_step = ARG_IN(13); const float* b_re = ARG_IN(14); const float* b_im = ARG_IN(15);
            float* ssmp = (float*)(ws + WS_SSMP);
            for (int i = vcu + G * tid; i < 128 * 64; i += G * NWAVES * 64) { const int g = i >> 6;
                f32x4 brv[4], biv[4];
#pragma unroll
                for (int c = 0; c < 4; ++c) { brv[c] = *(const GAS f32x4*)(b_re + (size_t)i * 16 + 4 * c); biv[c] = *(const GAS f32x4*)(b_im + (size_t)i * 16 + 4 * c); }
                const float lr = *(const GAS float*)(lam_re + i), li = *(const GAS float*)(lam_im + i), dt = expf(*(const GAS float*)(log_step + g));
                const float mag = expf(dt * lr), ar = mag * cosf(dt * li), ai = mag * sinf(dt * li);
                const float den = lr * lr + li * li;
                const float kr = ((ar - 1.f) * lr + ai * li) / den, ki = (ai * lr - (ar - 1.f) * li) / den;
                GAS float* o = (GAS float*)ssmp + (size_t)i * 34; o[0] = ar; o[1] = ai;
#pragma unroll
                for (int c = 0; c < 16; ++c) { const float br = brv[c >> 2][c & 3], bi = biv[c >> 2][c & 3]; o[2 + c] = kr * br - ki * bi; o[18 + c] = kr * bi + ki * br; } }
        }
    }
    if constexpr (SLOT == 1) {
        pg8::StaticOrder S;
        if (kind == 2) {
            pg8::Gemm g{(const bf16*)(ws + WS_S8), (const bf16*)(ws + W_ATTN_QKV), M, 3 * D, D / 2, D / 2, 0}; S.init(M, 3 * D, G, bx);
            pg8::EpiBf16 E{T1, D, nullptr, D, (size_t)(WS_T2 - WS_T1) / 2, ATTN_QSCALE, nullptr, 1.f / W8S};
            pg8::gemm_phase<pg8::EpiBf16, true>(lds, g, S, E, tid);
        } else {
            const unsigned char* W = (kind == 0) ? ws + W_POOL_IN + (size_t)jj * D * D : ws + W_SSM_IN;
            pg8::Gemm g{(const bf16*)(ws + WS_S8), (const bf16*)W, M, D, D / 2, D / 2, 0}; S.init(M, D, G, bx);
            pg8::EpiBf16 E{T1, D, nullptr, 0, 0, 1.f, nullptr, 1.f / W8S};
            pg8::gemm_phase<pg8::EpiBf16, true>(lds, g, S, E, tid);
        }
    }
    if constexpr (SLOT == 2) {
        if (kind == 0) pool_phase(T1, (u8*)T2, gw, NGW, lane);
        else if (kind == 1) ssm_phase_m(T1, (u8*)T2, (const float*)(ws + WS_SSMP), ARG_IN(16), ARG_IN(17), ARG_IN(18), lds, vcu, G, wave, lane);
        else {
            LAS float* rb = (LAS float*)lds;
            for (int i = tid; i < 16 * 257; i += NWAVES * 64) rb[i] = ARG_IN(22)[i] * LOG2E;
            __syncthreads();
            attn_phase_split(T1, T2, T3, ws + WS_X8, rb, lds + 32768, vcu, G, wave, lane);
            __syncthreads();
        }
    }
    if constexpr (SLOT == 3) {
        pg8::StaticOrder S; S.init(M, D, G, bx);
        if (kind == 0) {
            pg8::Gemm g{(const bf16*)T2, (const bf16*)(ws + W_POOL_GRP + (size_t)jj * D * 512), M, D, 256, D / 2, 2};
            pg8::EpiF8 E{(unsigned char*)T1, D, ARG_IN(8) + (size_t)jj * D, 1.f / W8S};
            pg8::gemm_phase<pg8::EpiF8, true>(lds, g, S, E, tid);
        } else if (kind == 1) {
            pg8::Gemm g{(const bf16*)T2, (const bf16*)(ws + W_SSM_GLU), M, D, D / 2, D / 2, 0};
            pg8::EpiGlu8 E{(const unsigned char*)T2, (unsigned char*)T1, D, 1.f / W8S};
            pg8::gemm_phase<pg8::EpiGlu8, true>(lds, g, S, E, tid);
        }
    }
    if constexpr (SLOT == 4) {
        const unsigned char* W = (kind == 0) ? ws + W_POOL_OUT + (size_t)jj * D * D : (kind == 1) ? ws + W_SSM_OUT : ws + W_ATTN_OUT;
        pg8::Gemm g{(kind == 2) ? (const bf16*)(ws + WS_X8) : (const bf16*)T1, (const bf16*)W, M, D, D / 2, D / 2, 0}; pg8::StaticOrder S; S.init(M, D, G, bx);
        pg8::EpiRes E{Sin, Sin, D, DN_ALPHA, (kind == 2) ? 1.f / (W8S * O8S) : 1.f / W8S};
        pg8::gemm_phase<pg8::EpiRes, true>(lds, g, S, E, tid);
    }
    if constexpr (SLOT == 5) ln_phase<true>(Sin, ARG_IN(2) + (size_t)layer * D, ARG_IN(3) + (size_t)layer * D, gw, NGW, lane, ws + WS_X8, ws + WS_S8, (float*)(ws + WS_STATS));
    if constexpr (SLOT == 6) {
        { pg8::Gemm g{(const bf16*)(ws + WS_S8), (const bf16*)(ws + W_PEER_Q + (size_t)layer * D * D), M, D, D / 2, D / 2, 0}; pg8::StaticOrder S; S.init(M, D, G, bx);
          pg8::EpiBf16 E{T1, D, nullptr, 0, 0, 1.f, nullptr, 1.f / W8S};
          pg8::gemm_phase<pg8::EpiBf16, true>(lds, g, S, E, tid); }
    }
    if constexpr (SLOT == 14) {
        __syncthreads();
        { pg8::Gemm g{PB + (size_t)layer * M * PLE, (const bf16*)(ws + W_PLE_PROJ) + (size_t)layer * PLE * D, M, D, PLE, PLE, 0}; pg8::StaticOrder S; S.init(M, D, G, bx);
          pg8::EpiF8 E{(unsigned char*)T3, D, nullptr, 8.f};
          pg8::gemm_phase<pg8::EpiF8>(lds, g, S, E, tid); }
    }
    if constexpr (SLOT == 7) {
        const bf16* sk = SKB + (size_t)layer * 2 * 128 * 128;
        for (int i = tid; i < 256 * 16; i += NWAVES * 64) { const int rowi = i >> 4, ch = i & 15; *(LAS v4u*)(lds + rowi * 272 + ch * 16) = *(const v4u*)(sk + rowi * 128 + ch * 8); }
        __syncthreads();
        peer_select_phase(T1, lds, IDX, GATE, gw, NGW, lane);
        __syncthreads();
    }
    if constexpr (SLOT == 8) peer_u_pass(ws + WS_X8, IDX, (const u8*)TU + (size_t)layer * NEXP * 1024, (float*)T2, bx, G, wave, lane);
    if constexpr (SLOT == 11) peer_act_phase((const float*)T2, IDX, GATE, (const float*)(ws + WS_SU) + layer * NEXP, (const float*)(ws + WS_SV) + layer * NEXP, gw, NGW, lane);
    if constexpr (SLOT == 12) peer_v_pass(Sin, IDX, GATE, (const u8*)TV + (size_t)layer * NEXP * 1024, (const float*)(ws + WS_STATS), ARG_IN(2) + (size_t)layer * D, ARG_IN(3) + (size_t)layer * D, bx, G, wave, lane);
    if constexpr (SLOT == 13) ln_phase(Sin, ARG_IN(4) + (size_t)layer * D, ARG_IN(5) + (size_t)layer * D, gw, NGW, lane, ws + WS_X8);
    if constexpr (SLOT == 10) {
        pg8::Gemm g{(const bf16*)(ws + WS_X8), (const bf16*)(ws + W_PLE_GATE + (size_t)layer * D * D), M, D, D / 2, D / 2, 0}; pg8::StaticOrder S; S.init(M, D, G, bx);
        pg8::EpiPle E{Sin, (const unsigned char*)T3, Sout, ws + WS_S8, (layer == DEPTH - 1) ? hout : nullptr, ARG_IN(30) + (size_t)layer * D, D, 1.f / W8S};
        pg8::gemm_phase<pg8::EpiPle, true>(lds, g, S, E, tid);
    }
}

template <int SLOT>
__global__ void __launch_bounds__(NWAVES * 64, 2) mk_slot(Args args) {
    extern __shared__ __attribute__((aligned(16))) unsigned char lds_raw[];
    store_tab(args, (LAS unsigned char*)lds_raw);
    run_slot<SLOT>((LAS unsigned char*)lds_raw, args.layer, __builtin_amdgcn_readfirstlane((int)(threadIdx.x >> 6)));
}

#if !MK_PER_PHASE
__global__ void __launch_bounds__(NWAVES * 64, 2) mk_fwd(Args args) {
    extern __shared__ __attribute__((aligned(16))) unsigned char lds_raw[];
    LAS unsigned char* lds = (LAS unsigned char*)lds_raw;
    volatile LAS unsigned* MISC = (volatile LAS unsigned*)(lds + MISC_OFF);
    for (int u = threadIdx.x; u < (LDS_BYTES - LDSCTL_OFF) / 4; u += NWAVES * 64) ((LAS unsigned*)(lds + LDSCTL_OFF))[u] = 0u;
    __syncthreads();
    store_tab(args, lds);
    const XcdBarrier bar = xcd_barrier_post((unsigned*)(args.ws + WS_CTL) + CW_BAR, MISC + 8);
    run_slot<0>(lds, 0, bar.wave); xcd_barrier(bar);
    for (int layer = 0; layer < DEPTH; ++layer) {
        run_slot<1>(lds, layer, bar.wave); xcd_barrier(bar);
        run_slot<2>(lds, layer, bar.wave); xcd_barrier(bar);
        if (layer % 3 != 2) { run_slot<3>(lds, layer, bar.wave); xcd_barrier(bar); }
        run_slot<4>(lds, layer, bar.wave); xcd_barrier(bar);
        run_slot<5>(lds, layer, bar.wave); xcd_barrier(bar);
        run_slot<6>(lds, layer, bar.wave); run_slot<14>(lds, layer, bar.wave); xcd_barrier(bar);
        run_slot<7>(lds, layer, bar.wave); xcd_barrier(bar);
        run_slot<8>(lds, layer, bar.wave); xcd_barrier(bar);
        run_slot<11>(lds, layer, bar.wave); xcd_barrier(bar);
        run_slot<12>(lds, layer, bar.wave); xcd_barrier(bar);
        run_slot<13>(lds, layer, bar.wave); xcd_barrier(bar);
        run_slot<10>(lds, layer, bar.wave); if (layer + 1 < DEPTH) xcd_barrier(bar);
    }
}
#endif

template <int SLOT> static void launch_slot(const Args& a0, int layer, int grid, hipStream_t stream) {
    static bool attr_done = false;
    if (!attr_done) { (void)hipFuncSetAttribute((const void*)mk_slot<SLOT>, hipFuncAttributeMaxDynamicSharedMemorySize, LDS_BYTES); attr_done = true; }
    Args a = a0; a.slot = SLOT; a.layer = layer;
    hipLaunchKernelGGL(mk_slot<SLOT>, dim3(grid), dim3(NWAVES * 64), LDS_BYTES, stream, a);
}

extern "C" void kernel_launch(void* const* d_in, const int* in_sizes, int n_in, void* d_out, int out_size, void* d_ws, size_t ws_size, hipStream_t stream) {
    static int grid = 0;
    if (grid == 0) {
        if (n_in != 31 || out_size != M * D || ws_size < WS_END) { fprintf(stderr, "kernel_launch: unexpected shapes (n_in %d out %d ws %zu)\n", n_in, out_size, ws_size); grid = -1; return; }
        int dev = 0, cus = 0, per_cu = 0;
        if (hipGetDevice(&dev) != hipSuccess || hipDeviceGetAttribute(&cus, hipDeviceAttributeMultiprocessorCount, dev) != hipSuccess) { grid = -1; return; }
#if !MK_PER_PHASE
        if (hipFuncSetAttribute((const void*)mk_fwd, hipFuncAttributeMaxDynamicSharedMemorySize, LDS_BYTES) != hipSuccess) { fprintf(stderr, "kernel_launch: hipFuncSetAttribute failed\n"); grid = -1; return; }
        if (hipOccupancyMaxActiveBlocksPerMultiprocessor(&per_cu, (const void*)mk_fwd, NWAVES * 64, LDS_BYTES) != hipSuccess || per_cu < 1) { fprintf(stderr, "kernel_launch: occupancy query says %d\n", per_cu); }
        (void)hipGetLastError();
#endif
        (void)per_cu;
        grid = cus;
    }
    if (grid < 0) return;
    Args a{};
    for (int i = 0; i < 31; ++i) a.in[i] = (const float*)d_in[i];
    a.out = (float*)d_out; a.ws = (unsigned char*)d_ws;
#if MK_PER_PHASE
    launch_slot<0>(a, 0, grid, stream);
    for (int layer = 0; layer < DEPTH; ++layer) {
        launch_slot<1>(a, layer, grid, stream); launch_slot<2>(a, layer, grid, stream);
        if (layer % 3 != 2) launch_slot<3>(a, layer, grid, stream);
        launch_slot<4>(a, layer, grid, stream); launch_slot<5>(a, layer, grid, stream); launch_slot<6>(a, layer, grid, stream); launch_slot<14>(a, layer, grid, stream); launch_slot<7>(a, layer, grid, stream);
        launch_slot<8>(a, layer, grid, stream); launch_slot<11>(a, layer, grid, stream); launch_slot<12>(a, layer, grid, stream); launch_slot<13>(a, layer, grid, stream); launch_slot<10>(a, layer, grid, stream);
    }
#else
    if (hipMemsetAsync((char*)d_ws + WS_CTL, 0, CTL_ZERO_BYTES, stream) != hipSuccess) return;
    hipLaunchKernelGGL(mk_fwd, dim3(grid), dim3(NWAVES * 64), LDS_BYTES, stream, a);
#endif
}
```
